# Optimizing an MI355X kernel written in HIP

```python
import math
import jax
import jax.numpy as jnp
from jax import lax
import numpy as np

D_MODEL = 1024
BATCH = 4
SEQ = 4096
DEPTH = 4
DEC_BATCH = 128
DEC_SEQ = 4
PAST_LEN = 8192
PAGE_SIZE = 128

N_MIXERS = 3
N_A = (DEPTH + 2) // N_MIXERS
N_B = (DEPTH + 1) // N_MIXERS
N_C = DEPTH // N_MIXERS

HA = 8
DKA = D_MODEL // 2 // HA
DVA = D_MODEL // HA
GATE_SOFTCAP = 15.0
HB = 4
DKB = D_MODEL // 2 // HB
DVB = D_MODEL // HB
GLA_RANK = 16
GLA_TAU = 16.0
HC = 16
HKV = 4
HDC = D_MODEL // HC
GROUP = HC // HKV
WINDOW = 128
D_FF = 2816
CONV_W = 3

CHUNK = 64
EPS = 1e-6
NEG = -1e30

A_IN = 2 * HA * DKA + 2 * HA * DVA + 2 * HA
B_IN = 2 * HB * DKB + 2 * HB * DVB + GLA_RANK
C_IN = (HC + 2 * HKV) * HDC

kernel_name = "hybrid_mlstm_gla_swa_convffn_step"


def _rmsnorm(x, g):
    xf = x.astype(jnp.float32)
    y = xf * lax.rsqrt(jnp.mean(xf * xf, axis=-1, keepdims=True) + EPS)
    return (y * g.astype(jnp.float32)).astype(x.dtype)


def _softcap(z):
    return GATE_SOFTCAP * jnp.tanh(z / GATE_SOFTCAP)


def _to_chunks(t, L):
    b, T = t.shape[:2]
    return jnp.moveaxis(t.reshape((b, T // L, L) + t.shape[2:]), 1, 0)


def _from_chunks(t):
    nc, b, L = t.shape[:3]
    return jnp.moveaxis(t, 0, 1).reshape((b, nc * L) + t.shape[3:])


def _mlstm_chunk(carry, inp):
    c, n, m = carry
    q, k, v, ig, lf = inp
    L = q.shape[1]
    f_cum = jnp.cumsum(lf, axis=1)
    a = ig - f_cum
    m_t = f_cum + jnp.maximum(m[:, None], lax.cummax(a, axis=1))
    causal = jnp.tril(jnp.ones((L, L), bool))[None, :, :, None]
    logw = a[:, None, :, :] + (f_cum - m_t)[:, :, None, :]
    w = jnp.where(causal, jnp.exp(jnp.minimum(logw, 0.0)), 0.0)
    qk = jnp.einsum('bthd,bshd->btsh', q, k) * w
    g = jnp.exp(jnp.minimum(f_cum + m[:, None] - m_t, 0.0))
    num = jnp.einsum('btsh,bshv->bthv', qk, v) + g[..., None] * jnp.einsum('bthd,bhdv->bthv', q, c)
    den = jnp.sum(qk, axis=2) + g * jnp.einsum('bthd,bhd->bth', q, n)
    h = num / jnp.maximum(jnp.abs(den), jnp.exp(-m_t))[..., None]
    m_last = m_t[:, -1]
    f_last = f_cum[:, -1]
    w_last = jnp.exp(jnp.minimum(a + (f_last - m_last)[:, None], 0.0))
    g_last = jnp.exp(jnp.minimum(f_last + m - m_last, 0.0))
    c_new = g_last[..., None, None] * c + jnp.einsum('bsh,bshd,bshv->bhdv', w_last, k, v)
    n_new = g_last[..., None] * n + jnp.einsum('bsh,bshd->bhd', w_last, k)
    return (c_new, n_new, m_last), h


def _mlstm_mixer(h, c0, n0, m0, w_in, b_i, b_f, norm_g, w_out):
    b, T, _ = h.shape
    f32 = jnp.float32
    proj = jnp.einsum('btd,de->bte', h, w_in).astype(f32)
    s1 = HA * DKA
    s2 = 2 * HA * DKA
    s3 = s2 + HA * DVA
    s4 = s3 + HA * DVA
    s5 = s4 + HA
    q, k, v, o, ig, fg = jnp.split(proj, [s1, s2, s3, s4, s5], axis=-1)
    q = q.reshape(b, T, HA, DKA)
    k = k.reshape(b, T, HA, DKA) * (DKA ** -0.5)
    v = v.reshape(b, T, HA, DVA)
    ig = _softcap(ig + b_i.astype(f32))
    lf = jax.nn.log_sigmoid(_softcap(fg + b_f.astype(f32)))
    L = math.gcd(CHUNK, T)
    xs = (_to_chunks(q, L), _to_chunks(k, L), _to_chunks(v, L), _to_chunks(ig, L), _to_chunks(lf, L))
    carry0 = (c0.astype(f32), n0.astype(f32), m0.astype(f32))
    (c1, n1, m1), hs = lax.scan(_mlstm_chunk, carry0, xs)
    hs = _from_chunks(hs)
    hs = _rmsnorm(hs, norm_g.reshape(HA, DVA)) * jax.nn.sigmoid(o).reshape(b, T, HA, DVA)
    y = jnp.einsum('bte,ed->btd', hs.reshape(b, T, HA * DVA).astype(h.dtype), w_out)
    return y, c1, n1, m1


def _gla_chunk(s, inp):
    q, k, v, lg = inp
    L = q.shape[1]
    bc = jnp.cumsum(lg, axis=1)
    causal = jnp.tril(jnp.ones((L, L), bool))[None, :, :, None, None]
    diff = bc[:, :, None] - bc[:, None, :]
    decay = jnp.where(causal, jnp.exp(jnp.minimum(diff, 0.0)), 0.0)
    att = jnp.einsum('bthd,bshd,btshd->btsh', q, k, decay)
    o = jnp.einsum('btsh,bshv->bthv', att, v) + jnp.einsum('bthd,bhdv->bthv', q * jnp.exp(bc), s)
    b_last = bc[:, -1]
    s_new = jnp.exp(b_last)[..., None] * s + jnp.einsum('bshd,bshv->bhdv', k * jnp.exp(b_last[:, None] - bc), v)
    return s_new, o


def _gla_mixer(h, s0, w_in, w_gate_up, b_gate, norm_g, w_out):
    b, T, _ = h.shape
    f32 = jnp.float32
    proj = jnp.einsum('btd,de->bte', h, w_in).astype(f32)
    s1 = HB * DKB
    s2 = 2 * HB * DKB
    s3 = s2 + HB * DVB
    s4 = s3 + HB * DVB
    q, k, v, r, z = jnp.split(proj, [s1, s2, s3, s4], axis=-1)
    q = q.reshape(b, T, HB, DKB) * (DKB ** -0.5)
    k = k.reshape(b, T, HB, DKB)
    v = v.reshape(b, T, HB, DVB)
    lg = jax.nn.log_sigmoid(jnp.einsum('btr,re->bte', z, w_gate_up.astype(f32)) + b_gate.astype(f32)) / GLA_TAU
    lg = lg.reshape(b, T, HB, DKB)
    L = math.gcd(CHUNK, T)
    xs = (_to_chunks(q, L), _to_chunks(k, L), _to_chunks(v, L), _to_chunks(lg, L))
    s1_state, o = lax.scan(_gla_chunk, s0.astype(f32), xs)
    o = _from_chunks(o)
    o = _rmsnorm(o, norm_g.reshape(HB, DVB)) * jax.nn.silu(r).reshape(b, T, HB, DVB)
    y = jnp.einsum('bte,ed->btd', o.reshape(b, T, HB * DVB).astype(h.dtype), w_out)
    return y, s1_state


def _sink_attention(q, k, v, mask, sinks):
    s = jnp.einsum('bnqkgd,bnrkd->bnkgqr', q, k) * (HDC ** -0.5)
    s = jnp.where(mask[None, :, None, None], s, NEG)
    sink = jnp.broadcast_to(sinks[None, None, :, :, None, None], s.shape[:-1] + (1,))
    p = jax.nn.softmax(jnp.concatenate([s, sink], axis=-1), axis=-1)[..., :-1]
    return jnp.einsum('bnkgqr,bnrkd->bnqkgd', p, v)


def _swa_mixer(h, k_buf, v_buf, w_in, b_in, sinks, w_out):
    b, T, _ = h.shape
    f32 = jnp.float32
    proj = (jnp.einsum('btd,de->bte', h, w_in) + b_in).astype(f32)
    q, k, v = jnp.split(proj, [HC * HDC, HC * HDC + HKV * HDC], axis=-1)
    q = q.reshape(b, T, HKV, GROUP, HDC)
    k = k.reshape(b, T, HKV, HDC)
    v = v.reshape(b, T, HKV, HDC)
    sinks = sinks.astype(f32).reshape(HKV, GROUP)
    if k_buf is None:
        nb = T // WINDOW
        pad = jnp.zeros((b, WINDOW, HKV, HDC), f32)
        kb = jnp.concatenate([pad, k], axis=1).reshape(b, nb + 1, WINDOW, HKV, HDC)
        vb = jnp.concatenate([pad, v], axis=1).reshape(b, nb + 1, WINDOW, HKV, HDC)
        kb = jnp.concatenate([kb[:, :-1], kb[:, 1:]], axis=2)
        vb = jnp.concatenate([vb[:, :-1], vb[:, 1:]], axis=2)
        qi = jnp.arange(WINDOW)
        ri = jnp.arange(2 * WINDOW)
        rel = WINDOW + qi[:, None] - ri[None, :]
        key_pos = (jnp.arange(nb)[:, None] - 1) * WINDOW + ri[None, :]
        mask = ((rel >= 0) & (rel <= WINDOW))[None] & (key_pos >= 0)[:, None, :]
        out = _sink_attention(q.reshape(b, nb, WINDOW, HKV, GROUP, HDC), kb, vb, mask, sinks)
        k_keep = k[:, -WINDOW:]
        v_keep = v[:, -WINDOW:]
    else:
        wb = k_buf.shape[1]
        k_all = jnp.concatenate([k_buf.astype(f32), k], axis=1)
        v_all = jnp.concatenate([v_buf.astype(f32), v], axis=1)
        q_pos = PAST_LEN + jnp.arange(T)
        k_pos = PAST_LEN - wb + jnp.arange(wb + T)
        rel = q_pos[:, None] - k_pos[None, :]
        mask = ((rel >= 0) & (rel <= WINDOW))[None]
        out = _sink_attention(q[:, None], k_all[:, None], v_all[:, None], mask, sinks)
        k_keep = k_all[:, -wb:]
        v_keep = v_all[:, -wb:]
    y = jnp.einsum('bte,ed->btd', out.reshape(b, T, HC * HDC).astype(h.dtype), w_out)
    return y, k_keep, v_keep


def _conv_ffn(h, conv_state, w_up, conv_w, conv_b, w_down):
    b, T, _ = h.shape
    f32 = jnp.float32
    u = jnp.einsum('btd,df->btf', h, w_up).astype(f32)
    gate, up = jnp.split(u, 2, axis=-1)
    g_ext = jnp.concatenate([conv_state.astype(f32), gate], axis=1)
    cw = conv_w.astype(f32)
    conv = conv_b.astype(f32) + sum(cw[j] * g_ext[:, j:j + T] for j in range(CONV_W))
    y = jnp.einsum('btf,fd->btd', (jax.nn.silu(conv) * up).astype(h.dtype), w_down)
    return y, g_ext[:, -(CONV_W - 1):]


def _trunk(x, st, w):
    new = {'a_c': [], 'a_n': [], 'a_m': [], 'b_s': [], 'c_k': [], 'c_v': [], 'f': []}
    for i in range(DEPTH):
        kind, j = i % N_MIXERS, i // N_MIXERS
        hn = _rmsnorm(x, w['norm_mix'][i])
        if kind == 0:
            y, c1, n1, m1 = _mlstm_mixer(hn, st['a_c'][j], st['a_n'][j], st['a_m'][j], w['a_w_in'][j],
                                         w['a_b_i'][j], w['a_b_f'][j], w['a_norm'][j], w['a_w_out'][j])
            new['a_c'].append(c1)
            new['a_n'].append(n1)
            new['a_m'].append(m1)
        elif kind == 1:
            y, s1 = _gla_mixer(hn, st['b_s'][j], w['b_w_in'][j], w['b_w_gate_up'][j], w['b_b_gate'][j],
                               w['b_norm'][j], w['b_w_out'][j])
            new['b_s'].append(s1)
        else:
            y, k1, v1 = _swa_mixer(hn, st['c_k'][j], st['c_v'][j], w['c_w_in'][j], w['c_b_in'][j],
                                   w['c_sinks'][j], w['c_w_out'][j])
            new['c_k'].append(k1)
            new['c_v'].append(v1)
        x = x + y
        y, f1 = _conv_ffn(_rmsnorm(x, w['norm_ffn'][i]), st['f'][i], w['f_w_up'][i], w['f_conv_w'][i],
                          w['f_conv_b'][i], w['f_w_down'][i])
        x = x + y
        new['f'].append(f1)
    out = {name: jnp.stack(vals).astype(x.dtype) for name, vals in new.items()}
    return _rmsnorm(x, w['norm_final']), out


def setup_inputs(seed: int = 0) -> dict:
    key = jax.random.key(seed)
    ks = iter(jax.random.split(key, 32))

    def nrm(shape, scale=1.0):
        return jax.random.normal(next(ks), shape, jnp.float32) * scale

    w_buf = min(WINDOW, PAST_LEN)
    return {
        'x_prompt': nrm((BATCH, SEQ, D_MODEL)),
        'x_sample': nrm((DEC_BATCH, DEC_SEQ, D_MODEL)),
        'state_mlstm_c': nrm((N_A, DEC_BATCH, HA, DKA, DVA), 0.5),
        'state_mlstm_n': nrm((N_A, DEC_BATCH, HA, DKA), 0.5),
        'state_mlstm_m': nrm((N_A, DEC_BATCH, HA), 1.0),
        'state_gla': nrm((N_B, DEC_BATCH, HB, DKB, DVB), 0.5),
        'cache_swa_k': nrm((N_C, DEC_BATCH, w_buf, HKV, HDC)),
        'cache_swa_v': nrm((N_C, DEC_BATCH, w_buf, HKV, HDC)),
        'state_ffn_conv': nrm((DEPTH, DEC_BATCH, CONV_W - 1, D_FF)),
        'norm_mix_g': 1.0 + nrm((DEPTH, D_MODEL), 0.1),
        'norm_ffn_g': 1.0 + nrm((DEPTH, D_MODEL), 0.1),
        'norm_final_g': 1.0 + nrm((D_MODEL,), 0.1),
        'a_w_in': nrm((N_A, D_MODEL, A_IN), D_MODEL ** -0.5),
        'a_b_i': nrm((N_A, HA), 0.1),
        'a_b_f': 3.0 + nrm((N_A, HA), 0.5),
        'a_norm_g': 1.0 + nrm((N_A, HA * DVA), 0.1),
        'a_w_out': nrm((N_A, HA * DVA, D_MODEL), (HA * DVA) ** -0.5),
        'b_w_in': nrm((N_B, D_MODEL, B_IN), D_MODEL ** -0.5),
        'b_w_gate_up': nrm((N_B, GLA_RANK, HB * DKB), GLA_RANK ** -0.5),
        'b_b_gate': nrm((N_B, HB * DKB), 0.1),
        'b_norm_g': 1.0 + nrm((N_B, HB * DVB), 0.1),
        'b_w_out': nrm((N_B, HB * DVB, D_MODEL), (HB * DVB) ** -0.5),
        'c_w_in': nrm((N_C, D_MODEL, C_IN), D_MODEL ** -0.5),
        'c_b_in': nrm((N_C, C_IN), 0.02),
        'c_sinks': nrm((N_C, HC), 1.0),
        'c_w_out': nrm((N_C, HC * HDC, D_MODEL), (HC * HDC) ** -0.5),
        'f_w_up': nrm((DEPTH, D_MODEL, 2 * D_FF), D_MODEL ** -0.5),
        'f_conv_w': nrm((DEPTH, CONV_W, D_FF), CONV_W ** -0.5),
        'f_conv_b': nrm((DEPTH, D_FF), 0.02),
        'f_w_down': nrm((DEPTH, D_FF, D_MODEL), D_FF ** -0.5),
    }


def reference(x_prompt, x_sample, state_mlstm_c, state_mlstm_n, state_mlstm_m, state_gla,
              cache_swa_k, cache_swa_v, state_ffn_conv, norm_mix_g, norm_ffn_g, norm_final_g,
              a_w_in, a_b_i, a_b_f, a_norm_g, a_w_out, b_w_in, b_w_gate_up, b_b_gate, b_norm_g, b_w_out,
              c_w_in, c_b_in, c_sinks, c_w_out, f_w_up, f_conv_w, f_conv_b, f_w_down):
    w = {'norm_mix': norm_mix_g, 'norm_ffn': norm_ffn_g, 'norm_final': norm_final_g,
         'a_w_in': a_w_in, 'a_b_i': a_b_i, 'a_b_f': a_b_f, 'a_norm': a_norm_g, 'a_w_out': a_w_out,
         'b_w_in': b_w_in, 'b_w_gate_up': b_w_gate_up, 'b_b_gate': b_b_gate, 'b_norm': b_norm_g,
         'b_w_out': b_w_out, 'c_w_in': c_w_in, 'c_b_in': c_b_in, 'c_sinks': c_sinks, 'c_w_out': c_w_out,
         'f_w_up': f_w_up, 'f_conv_w': f_conv_w, 'f_conv_b': f_conv_b, 'f_w_down': f_w_down}
    f32 = jnp.float32
    bp = x_prompt.shape[0]
    st_p = {'a_c': jnp.zeros((N_A, bp, HA, DKA, DVA), f32),
            'a_n': jnp.zeros((N_A, bp, HA, DKA), f32),
            'a_m': jnp.zeros((N_A, bp, HA), f32),
            'b_s': jnp.zeros((N_B, bp, HB, DKB, DVB), f32),
            'c_k': [None] * N_C, 'c_v': [None] * N_C,
            'f': jnp.zeros((DEPTH, bp, CONV_W - 1, D_FF), x_prompt.dtype)}
    st_s = {'a_c': state_mlstm_c, 'a_n': state_mlstm_n, 'a_m': state_mlstm_m, 'b_s': state_gla,
            'c_k': cache_swa_k, 'c_v': cache_swa_v, 'f': state_ffn_conv}
    y_prompt, np_ = _trunk(x_prompt, st_p, w)
    y_sample, ns_ = _trunk(x_sample, st_s, w)
    return (y_prompt, y_sample,
            np_['a_c'], np_['a_n'], np_['a_m'], np_['b_s'], np_['c_k'], np_['c_v'], np_['f'],
            ns_['a_c'], ns_['a_n'], ns_['a_m'], ns_['b_s'], ns_['c_k'], ns_['c_v'], ns_['f'])
```

```cpp
#include <hip/hip_runtime.h>
#include <cstdio>
#include <cstdint>
#define MK_MULTI 0
namespace pg8 {
#define PG8_LAS __attribute__((address_space(3)))
typedef unsigned short bf16_t;
typedef short bf16x8 __attribute__((ext_vector_type(8)));
typedef float f32x4 __attribute__((ext_vector_type(4)));
typedef unsigned u32x4 __attribute__((ext_vector_type(4)));
constexpr int BM = 256, BK = 64, HALF = 128, HTB = HALF * BK * 2  , STAGE_BYTES = 8 * HTB, NXCD = 8, WGM = 8;

__host__ __device__ __forceinline__ int lds_byte(int r, int c) { const int st = (r >> 4) * 2 + (c >> 5), rr = r & 15, cc = c & 31, ob = rr * 64 + cc * 2; return st * 1024 + (ob ^ (((ob >> 9) & 1) << 5)); }
__host__ __device__ __forceinline__ void stage_rc(int b, int& R, int& C) { const int st = b / 1024, sb = b % 1024, swz = sb ^ (((sb >> 9) & 1) << 5); R = (st >> 1) * 16 + swz / 64; C = (st & 1) * 32 + (swz % 64) / 2; }
__host__ __device__ __forceinline__ int perm32(int rho) { const int n = rho >> 4, i = rho & 15; return 8 * (i >> 2) + 4 * n + (i & 3); }

struct Unit { int pm, pn; };
struct Gemm { const bf16_t* A; const bf16_t* Bt; int M, N, K; };

struct StaticOrder {
    int nM, nN, nwg, G, c;
    __host__ __device__ void init(int M, int N, int G_, int c_) { nM = M / BM; nN = N / BM; nwg = nM * nN; G = G_; c = c_; }
    __host__ __device__ bool next(int i, Unit& u) const {
        const long L = (long)i * G + c; if (L >= nwg) return false;
        int wgid = (int)L; { const int q = nwg / NXCD, r = nwg % NXCD, xcd = wgid % NXCD, off = wgid / NXCD; wgid = (xcd < r ? xcd * (q + 1) : r * (q + 1) + (xcd - r) * q) + off; }
        const int nig = WGM * nN, gid = wgid / nig, fm = gid * WGM, gsz = (nM - fm) < WGM ? (nM - fm) : WGM;
        u.pm = fm + ((wgid % nig) % gsz); u.pn = (wgid % nig) / gsz; return true;
    }
    __device__ __forceinline__ void a_ready(const Unit&) const {}
    __device__ __forceinline__ void done(const Unit&) const {}
};

__device__ __forceinline__ unsigned cvt_pk_bf16(float lo, float hi) { unsigned r; asm volatile("v_cvt_pk_bf16_f32 %0, %1, %2" : "=v"(r) : "v"(lo), "v"(hi)); return r; }
typedef float f32x2 __attribute__((ext_vector_type(2)));
struct EpiBf16 {
    static constexpr bool PERM = true, AFTER_DRAIN = false;
    bf16_t* O; int ldc; const float* bias;
    __device__ __forceinline__ void operator()(const f32x4 (&acc)[2][2][4][2], const Unit& u, int wr, int wc, int fr, int fq) const {
        const int row0 = u.pm * BM + wr * 64 + fr; const int col0 = u.pn * BM + wc * 32 + 8 * fq;
        f32x4 bv[2][2];
#pragma unroll
        for (int bj = 0; bj < 2; ++bj)
#pragma unroll
            for (int n = 0; n < 2; ++n) bv[bj][n] = bias ? *(const f32x4*)(bias + col0 + bj * HALF + 4 * n) : (f32x4){0.f, 0.f, 0.f, 0.f};
#pragma unroll
        for (int ai = 0; ai < 2; ++ai)
#pragma unroll
            for (int m = 0; m < 4; ++m) { bf16_t* rowp = O + (size_t)(row0 + ai * HALF + m * 16) * ldc + col0;
#pragma unroll
                for (int bj = 0; bj < 2; ++bj) { const f32x4 v0 = acc[ai][bj][m][0] + bv[bj][0], v1 = acc[ai][bj][m][1] + bv[bj][1];
                    u32x4 w; w.x = cvt_pk_bf16(v0[0], v0[1]); w.y = cvt_pk_bf16(v0[2], v0[3]); w.z = cvt_pk_bf16(v1[0], v1[1]); w.w = cvt_pk_bf16(v1[2], v1[3]);
                    *(u32x4*)(rowp + bj * HALF) = w; } }
    }
};
struct EpiRes {
    static constexpr bool PERM = false, AFTER_DRAIN = false;
    float* X; int ldc;
    __device__ __forceinline__ void operator()(const f32x4 (&acc)[2][2][4][2], const Unit& u, int wr, int wc, int fr, int fq) const {
        const int row0 = u.pm * BM + wr * 64 + fr, col0 = u.pn * BM + wc * 32 + 4 * fq;
#pragma unroll
        for (int ai = 0; ai < 2; ++ai)
#pragma unroll
            for (int m = 0; m < 4; ++m) { float* rowp = X + (size_t)(row0 + ai * HALF + m * 16) * ldc + col0;
                f32x4 b[2][2];
#pragma unroll
                for (int bj = 0; bj < 2; ++bj)
#pragma unroll
                    for (int n = 0; n < 2; ++n) b[bj][n] = *(const f32x4*)(rowp + bj * HALF + n * 16);
#pragma unroll
                for (int bj = 0; bj < 2; ++bj)
#pragma unroll
                    for (int n = 0; n < 2; ++n) *(f32x4*)(rowp + bj * HALF + n * 16) = b[bj][n] + acc[ai][bj][m][n];
                asm volatile("" ::: "memory"); }
    }
};
struct EpiDual {
    static constexpr bool AFTER_DRAIN = false;
    bool PERM; bf16_t* O; float* X; int ldc; const float* bias;
    __device__ __forceinline__ void operator()(const f32x4 (&acc)[2][2][4][2], const Unit& u, int wr, int wc, int fr, int fq) const {
        if (PERM) { EpiBf16 e{O, ldc, bias}; e(acc, u, wr, wc, fr, fq); } else { EpiRes e{X, ldc}; e(acc, u, wr, wc, fr, fq); }
    }
};
template <class Epi, class Sched, bool ALIGN_EPI = false, bool SP2 = false>
__device__ __forceinline__ void gemm_phase(PG8_LAS unsigned char* lds, const Gemm g, const Sched& S, const Epi& E) {
    const int tid = threadIdx.x, wid = __builtin_amdgcn_readfirstlane(tid >> 6), lane = tid & 63, wr = wid >> 2, wc = wid & 3, fr = lane & 15, fq = lane >> 4;
    const int K = g.K, nt = K / BK;
    unsigned voffA[2], voffB[2];
#pragma unroll
    for (int i = 0; i < 2; ++i) { int R, C; stage_rc(tid * 16 + i * 8192, R, C); const int Rb = E.PERM ? ((R & ~31) + perm32(R & 31)) : R;
        voffA[i] = (unsigned)(R * K + C) * 2u; voffB[i] = (unsigned)(Rb * K + C) * 2u; }
    const size_t kstep = (size_t)(BK * 2);
    const size_t hstep = (size_t)HALF * K * 2;
    const size_t tstep = 2 * hstep;
    const unsigned ldsw = (unsigned)wid * 1024u;
    const int aoff = lds_byte(wr * 64 + fr, fq * 8), boff = lds_byte(wc * 32 + fr, fq * 8);
#define PG8_SA(b, h) (((b) * 2 + (h)) * HTB)
#define PG8_SB(b, h) ((4 + (b) * 2 + (h)) * HTB)
#define PG8_STAGE(bufoff, gbase, voff) do { _Pragma("unroll") for (int _i = 0; _i < 2; ++_i) \
        __builtin_amdgcn_global_load_lds((const unsigned*)((const char*)(gbase) + (voff)[_i]), (PG8_LAS unsigned*)(lds + (bufoff) + ldsw + _i * 8192), 16, 0, 0); } while (0)
#define PG8_LDA(dst, b, h) do { _Pragma("unroll") for (int m = 0; m < 4; ++m) _Pragma("unroll") for (int k = 0; k < 2; ++k) dst[m][k] = *(const PG8_LAS bf16x8*)(lds + PG8_SA(b, h) + aoff + m * 2048 + k * 1024); } while (0)
#define PG8_LDB(dst, b, h) do { _Pragma("unroll") for (int n = 0; n < 2; ++n) _Pragma("unroll") for (int k = 0; k < 2; ++k) dst[n][k] = *(const PG8_LAS bf16x8*)(lds + PG8_SB(b, h) + boff + n * 2048 + k * 1024); } while (0)
#define PG8_MMA(ai, bj, At, Bt) do { __builtin_amdgcn_s_setprio(1); _Pragma("unroll") for (int m = 0; m < 4; ++m) _Pragma("unroll") for (int n = 0; n < 2; ++n) _Pragma("unroll") for (int k = 0; k < 2; ++k) \
        acc[ai][bj][m][n] = __builtin_amdgcn_mfma_f32_16x16x32_bf16(Bt[n][k], At[m][k], acc[ai][bj][m][n], 0, 0, 0); __builtin_amdgcn_s_setprio(0); } while (0)
#define PG8_WAIT_V(n) asm volatile("s_waitcnt vmcnt(" #n ")" ::: "memory")
#define PG8_WAIT_L(n) asm volatile("s_waitcnt lgkmcnt(" #n ")" ::: "memory")
#define PG8_BAR __builtin_amdgcn_s_barrier()
#define PG8_SCHED __builtin_amdgcn_sched_barrier(0)
    Unit cur, nxt; int ui = 0;
    if (!S.next(0, cur)) return;
    f32x4 acc[2][2][4][2];
#pragma unroll
    for (int a = 0; a < 2; ++a)
#pragma unroll
        for (int b = 0; b < 2; ++b)
#pragma unroll
            for (int m = 0; m < 4; ++m)
#pragma unroll
                for (int n = 0; n < 2; ++n) acc[a][b][m][n] = (f32x4){0.f, 0.f, 0.f, 0.f};
    bf16x8 At[4][2], B0[2][2], B1[2][2];
    const char* cA = (const char*)g.A + (size_t)cur.pm * tstep; const char* cB = (const char*)g.Bt + (size_t)cur.pn * tstep;
    S.a_ready(cur);
    if constexpr (SP2) {
        PG8_STAGE(PG8_SB(0, 0), cB, voffB); PG8_STAGE(PG8_SB(0, 1), cB + hstep, voffB); PG8_STAGE(PG8_SA(0, 0), cA, voffA); PG8_STAGE(PG8_SA(0, 1), cA + hstep, voffA);
        if (wr == 1) PG8_BAR;
        PG8_WAIT_V(2); PG8_BAR;
        PG8_STAGE(PG8_SB(1, 0), cB + kstep, voffB); PG8_STAGE(PG8_SA(1, 0), cA + kstep, voffA); PG8_STAGE(PG8_SB(1, 1), cB + hstep + kstep, voffB);
        PG8_WAIT_V(6); PG8_BAR;
    } else {
        PG8_STAGE(PG8_SB(0, 0), cB, voffB); PG8_STAGE(PG8_SA(0, 0), cA, voffA); PG8_STAGE(PG8_SB(0, 1), cB + hstep, voffB); PG8_STAGE(PG8_SA(0, 1), cA + hstep, voffA);
        if (wr == 1) PG8_BAR;
        PG8_WAIT_V(4); PG8_BAR;
        PG8_STAGE(PG8_SB(1, 0), cB + kstep, voffB); PG8_STAGE(PG8_SA(1, 0), cA + kstep, voffA); PG8_STAGE(PG8_SB(1, 1), cB + hstep + kstep, voffB);
        PG8_WAIT_V(6); PG8_BAR;
    }
    for (;;) {
        const bool has_next = S.next(ui + 1, nxt);
        const char* nA = has_next ? (const char*)g.A + (size_t)nxt.pm * tstep : cA; const char* nB = has_next ? (const char*)g.Bt + (size_t)nxt.pn * tstep : cB;
        for (int t = 0; t < nt; t += 2) {
            const bool last = (t == nt - 2);
            const char* a1 = cA + (size_t)(t + 1) * kstep;
            const char* a2 = last ? nA : cA + (size_t)(t + 2) * kstep; const char* b2 = last ? nB : cB + (size_t)(t + 2) * kstep;
            const char* a3 = a2 + kstep; const char* b3 = b2 + kstep;
            if (last && has_next) S.a_ready(nxt);
            if constexpr (SP2) {
            PG8_LDB(B0, 0, 0); PG8_LDB(B1, 0, 1); PG8_SCHED; PG8_LDA(At, 0, 0); PG8_STAGE(PG8_SA(1, 1), a1 + hstep, voffA);
            PG8_WAIT_V(8); PG8_WAIT_L(0); PG8_BAR; PG8_MMA(0, 0, At, B0); PG8_MMA(0, 1, At, B1); PG8_BAR; PG8_SCHED;
            PG8_LDA(At, 0, 1); PG8_STAGE(PG8_SB(0, 0), b2, voffB); PG8_STAGE(PG8_SB(0, 1), b2 + hstep, voffB); PG8_STAGE(PG8_SA(0, 0), a2, voffA);
            PG8_WAIT_V(8); PG8_WAIT_L(0); PG8_BAR; PG8_MMA(1, 0, At, B0); PG8_MMA(1, 1, At, B1); PG8_BAR; PG8_SCHED;
            PG8_LDB(B0, 1, 0); PG8_LDB(B1, 1, 1); PG8_SCHED; PG8_LDA(At, 1, 0); PG8_STAGE(PG8_SA(0, 1), a2 + hstep, voffA);
            PG8_WAIT_V(8); PG8_WAIT_L(0); PG8_BAR; PG8_MMA(0, 0, At, B0); PG8_MMA(0, 1, At, B1); PG8_BAR; PG8_SCHED;
            PG8_LDA(At, 1, 1); PG8_STAGE(PG8_SB(1, 0), b3, voffB); PG8_STAGE(PG8_SB(1, 1), b3 + hstep, voffB); PG8_STAGE(PG8_SA(1, 0), a3, voffA);
            PG8_WAIT_V(8); PG8_WAIT_L(0); PG8_BAR; PG8_MMA(1, 0, At, B0); PG8_MMA(1, 1, At, B1); PG8_BAR; PG8_SCHED;
            } else {
            PG8_LDB(B0, 0, 0); PG8_SCHED; PG8_LDA(At, 0, 0); PG8_STAGE(PG8_SA(1, 1), a1 + hstep, voffA);
            PG8_WAIT_L(8); PG8_BAR; PG8_WAIT_L(0); PG8_MMA(0, 0, At, B0); PG8_BAR; PG8_SCHED;
            PG8_LDB(B1, 0, 1); PG8_STAGE(PG8_SB(0, 0), b2, voffB);
            PG8_BAR; PG8_WAIT_L(0); PG8_MMA(0, 1, At, B1); PG8_BAR;
            PG8_LDA(At, 0, 1); PG8_STAGE(PG8_SA(0, 0), a2, voffA);
            PG8_BAR; PG8_WAIT_L(0); PG8_MMA(1, 0, At, B0); PG8_BAR; PG8_SCHED;
            PG8_STAGE(PG8_SB(0, 1), b2 + hstep, voffB);
            PG8_WAIT_V(6); PG8_BAR; PG8_MMA(1, 1, At, B1); PG8_BAR;
            PG8_LDB(B0, 1, 0); PG8_SCHED; PG8_LDA(At, 1, 0); PG8_STAGE(PG8_SA(0, 1), a2 + hstep, voffA);
            PG8_WAIT_L(8); PG8_BAR; PG8_WAIT_L(0); PG8_MMA(0, 0, At, B0); PG8_BAR; PG8_SCHED;
            PG8_LDB(B1, 1, 1); PG8_STAGE(PG8_SB(1, 0), b3, voffB);
            PG8_BAR; PG8_WAIT_L(0); PG8_MMA(0, 1, At, B1); PG8_BAR;
            PG8_LDA(At, 1, 1); PG8_STAGE(PG8_SA(1, 0), a3, voffA);
            PG8_BAR; PG8_WAIT_L(0); PG8_MMA(1, 0, At, B0); PG8_BAR; PG8_SCHED;
            PG8_STAGE(PG8_SB(1, 1), b3 + hstep, voffB);
            PG8_WAIT_V(6); PG8_BAR; PG8_MMA(1, 1, At, B1); PG8_BAR;
            }
        }
        if constexpr (ALIGN_EPI) { if (wr == 0) PG8_BAR; }
        if constexpr (!Epi::AFTER_DRAIN) { E(acc, cur, wr, wc, fr, fq); S.done(cur); }
        if (!has_next) break;
#pragma unroll
        for (int a = 0; a < 2; ++a)
#pragma unroll
            for (int b = 0; b < 2; ++b)
#pragma unroll
                for (int m = 0; m < 4; ++m)
#pragma unroll
                    for (int n = 0; n < 2; ++n) acc[a][b][m][n] = (f32x4){0.f, 0.f, 0.f, 0.f};
        cur = nxt; cA = nA; cB = nB; ++ui;
        if constexpr (ALIGN_EPI) { if (wr == 1) PG8_BAR; }
    }
    PG8_WAIT_V(0);
    if constexpr (!ALIGN_EPI) { if (wr == 0) PG8_BAR; }
    PG8_BAR;
    if constexpr (Epi::AFTER_DRAIN) { E.fused(acc, cur, wr, wc, fr, fq, lds, wid, lane); S.done(cur); }
#undef PG8_SA
#undef PG8_SB
#undef PG8_STAGE
#undef PG8_LDA
#undef PG8_LDB
#undef PG8_MMA
#undef PG8_WAIT_V
#undef PG8_WAIT_L
#undef PG8_BAR
#undef PG8_SCHED
}
}
constexpr int NWAVES = 8, NTHR = 512;
constexpr int D = 1024, BP = 4, TP = 4096, MP = BP * TP, BS = 128, TS = 4, MS = BS * TS, M = MP + MS;
constexpr int DEPTH = 4;
constexpr int HA = 8, DKA = 64, DVA = 128;
constexpr int HB = 4, DKB = 128, DVB = 256, RANK = 16;
constexpr int HC = 16, HKV = 4, HDC = 64, GROUP = 4, WIN = 128;
constexpr int DFF = 2816, A_IN = 3088, B_IN = 3088, C_IN = 1536, NPROJ = 3072;
constexpr int NCH = 64, LCH = 64;
constexpr float EPS = 1e-6f, SOFTCAP = 15.0f;

constexpr size_t O_YP = 0, O_YS = O_YP + (size_t)MP * D, O_PAC = O_YS + (size_t)MS * D, O_PAN = O_PAC + 2ull * BP * HA * DKA * DVA, O_PAM = O_PAN + 2ull * BP * HA * DKA,
    O_PG = O_PAM + 2ull * BP * HA, O_PSK = O_PG + (size_t)BP * HB * DKB * DVB, O_PSV = O_PSK + (size_t)BP * WIN * HKV * HDC, O_PF = O_PSV + (size_t)BP * WIN * HKV * HDC,
    O_SAC = O_PF + 4ull * BP * 2 * DFF, O_SAN = O_SAC + 2ull * BS * HA * DKA * DVA, O_SAM = O_SAN + 2ull * BS * HA * DKA, O_SG = O_SAM + 2ull * BS * HA,
    O_SSK = O_SG + (size_t)BS * HB * DKB * DVB, O_SSV = O_SSK + (size_t)BS * WIN * HKV * HDC, O_SF = O_SSV + (size_t)BS * WIN * HKV * HDC, O_END = O_SF + 4ull * BS * 2 * DFF;
static_assert(O_END == 63666240ull, "output size");

constexpr size_t MiB = 1u << 20;
constexpr size_t WS_CTL = 0, CTL_ZERO_BYTES = 1 * MiB;
constexpr size_t WS_WIN = 1 * MiB, WS_WOUT = 7 * MiB, WS_WUP = 9 * MiB, WS_WDN = 20 * MiB;
constexpr size_t WS_GATES = 26 * MiB;
constexpr size_t WS_XN = 28 * MiB;
constexpr size_t WS_H = 61 * MiB;
constexpr size_t WS_R1 = 94 * MiB;
constexpr size_t WS_PROJ = WS_R1;
constexpr size_t WS_SCR = WS_R1 + 99 * MiB;
constexpr size_t SC_LOC = WS_SCR;
constexpr size_t SC_ST = WS_SCR + 128 * MiB;
constexpr size_t SC_AUX = WS_SCR + 192 * MiB;
constexpr size_t WS_U = WS_R1;
constexpr size_t WS_ACT = WS_R1 + 182 * MiB;
constexpr size_t WS_END = WS_R1 + 293 * MiB;
static_assert(WS_WIN + (size_t)NPROJ * D * 2 <= WS_WOUT && WS_WOUT + (size_t)D * D * 2 <= WS_WUP && WS_WUP + 2ull * DFF * D * 2 <= WS_WDN && WS_WDN + (size_t)D * DFF * 2 <= WS_GATES, "ws map: weights");
static_assert(WS_GATES + (size_t)M * 16 * 4 <= WS_XN && WS_XN + (size_t)M * D * 2 <= WS_H && WS_H + (size_t)M * D * 2 <= WS_R1 && WS_PROJ + (size_t)M * NPROJ * 2 <= WS_SCR, "ws map: activations");
static_assert(WS_U + (size_t)M * 2 * DFF * 2 <= WS_ACT && WS_ACT + (size_t)M * DFF * 2 <= WS_END && SC_AUX + 2 * MiB <= WS_END, "ws map: ffn");
constexpr int AX_CHK = 0;
constexpr int AX_MST = 8192;
constexpr int AX_NLOC = 16384;
constexpr int AX_NST = 16384 + 131072;
constexpr int AX_BL = 0;
static_assert((AX_NST + 131072) * 4 <= (int)(2 * MiB), "aux");

constexpr int CW_BAR = 4096;

constexpr int RING_BYTES = 131072;
constexpr int LDSCTL_OFF = RING_BYTES, MISC_OFF = LDSCTL_OFF + 320;
constexpr int LDS_BYTES = 147456;

#define GAS __attribute__((address_space(1)))
#define LAS __attribute__((address_space(3)))
typedef unsigned short bf16;
typedef unsigned v4u __attribute__((ext_vector_type(4)));
typedef unsigned v2u __attribute__((ext_vector_type(2)));
typedef float f32x4 __attribute__((ext_vector_type(4)));
typedef float f32x2 __attribute__((ext_vector_type(2)));
typedef short bf16x8 __attribute__((ext_vector_type(8)));
#define LDS_WAIT() asm volatile("s_waitcnt lgkmcnt(0)" ::: "memory")
#define VM_WAIT() asm volatile("s_waitcnt vmcnt(0)" ::: "memory")
__device__ __forceinline__ unsigned f2bf(float f) { unsigned u = __builtin_bit_cast(unsigned, f); return (u + 0x7fffu + ((u >> 16) & 1u)) >> 16; }
__device__ __forceinline__ unsigned pk2(float lo, float hi) { return f2bf(lo) | (f2bf(hi) << 16); }
__device__ __forceinline__ float bf2f(unsigned h) { return __builtin_bit_cast(float, (h & 0xffffu) << 16); }
__device__ __forceinline__ float bflo(unsigned w) { return __builtin_bit_cast(float, w << 16); }
__device__ __forceinline__ float bfhi(unsigned w) { return __builtin_bit_cast(float, w & 0xffff0000u); }
__device__ __forceinline__ float wave_sum(float v) {
#pragma unroll
    for (int o = 1; o < 64; o <<= 1) v += __shfl_xor(v, o);
    return v;
}
__device__ __forceinline__ float wave_max(float v) {
#pragma unroll
    for (int o = 1; o < 64; o <<= 1) v = fmaxf(v, __shfl_xor(v, o));
    return v;
}
__device__ __forceinline__ float wave_scan_sum(float v, int lane) {
#pragma unroll
    for (int o = 1; o < 64; o <<= 1) { const float y = __shfl_up(v, o); if (lane >= o) v += y; }
    return v;
}
__device__ __forceinline__ float wave_scan_max(float v, int lane) {
#pragma unroll
    for (int o = 1; o < 64; o <<= 1) { const float y = __shfl_up(v, o); if (lane >= o) v = fmaxf(v, y); }
    return v;
}
__device__ __forceinline__ float logsigmoidf(float x) { return fminf(x, 0.f) - log1pf(__expf(-fabsf(x))); }
__device__ __forceinline__ float softcapf(float z) { return SOFTCAP * tanhf(z * (1.0f / SOFTCAP)); }
__device__ __forceinline__ float sigmoidf_(float x) { return 1.0f / (1.0f + __expf(-x)); }

template <int KS> __device__ __forceinline__ f32x4 mma_ll(const LAS bf16* X, int ldx, const LAS bf16* Y, int ldy, f32x4 acc, int lane) {
    const int r16 = lane & 15, q = lane >> 4;
#pragma unroll
    for (int ks = 0; ks < KS; ++ks) {
        const bf16x8 a = *(const LAS bf16x8*)(X + r16 * ldx + ks * 32 + q * 8);
        const bf16x8 b = *(const LAS bf16x8*)(Y + r16 * ldy + ks * 32 + q * 8);
        acc = __builtin_amdgcn_mfma_f32_16x16x32_bf16(a, b, acc, 0, 0, 0);
    }
    return acc;
}
template <int KS> __device__ __forceinline__ f32x4 mma_gl(const bf16* X, int ldx, const LAS bf16* Y, int ldy, f32x4 acc, int lane) {
    const int r16 = lane & 15, q = lane >> 4;
    bf16x8 a[KS];
#pragma unroll
    for (int ks = 0; ks < KS; ++ks) a[ks] = *(const bf16x8*)(X + (size_t)r16 * ldx + ks * 32 + q * 8);
#pragma unroll
    for (int ks = 0; ks < KS; ++ks) {
        const bf16x8 b = *(const LAS bf16x8*)(Y + r16 * ldy + ks * 32 + q * 8);
        acc = __builtin_amdgcn_mfma_f32_16x16x32_bf16(a[ks], b, acc, 0, 0, 0);
    }
    return acc;
}
template <int R, int C> __device__ __forceinline__ void stage_nat(LAS bf16* dst, int lld, const bf16* src, size_t gld, int tid) {
    constexpr int CP = C / 8;
    for (int p = tid; p < R * CP; p += NTHR) { const int r = p / CP, c8 = p % CP; *(LAS v4u*)(dst + r * lld + c8 * 8) = *(const v4u*)(src + (size_t)r * gld + c8 * 8); }
}
template <int R, int C> __device__ __forceinline__ void stage_tr(LAS bf16* dst, int lld, const bf16* src, size_t gld, int tid) {
    constexpr int CP = C / 8;
    for (int p = tid; p < R * CP; p += NTHR) { const int r = p % R, c8 = p / R; const v4u v = *(const v4u*)(src + (size_t)r * gld + c8 * 8);
        LAS bf16* d = dst + (c8 * 8) * lld + r;
        d[0 * lld] = (bf16)(v.x & 0xffffu); d[1 * lld] = (bf16)(v.x >> 16); d[2 * lld] = (bf16)(v.y & 0xffffu); d[3 * lld] = (bf16)(v.y >> 16);
        d[4 * lld] = (bf16)(v.z & 0xffffu); d[5 * lld] = (bf16)(v.z >> 16); d[6 * lld] = (bf16)(v.w & 0xffffu); d[7 * lld] = (bf16)(v.w >> 16); }
}
#define XB_TMO      128
#define XB_XCNT(j)  (256  + 64 * (j))
#define XB_XSUB(j)  (1280 + 64 * (j))
#define XB_XGEN(j)  (2304 + 64 * (j))
#define XB_TOP      3328
#define XB_TOPGEN   3392
#define XCD_BAR_WORDS 3456
#define XB_SPIN_CAP (1u << 18)

__device__ __forceinline__ unsigned xb_ld(unsigned* p)              { return __hip_atomic_load(p, __ATOMIC_RELAXED, __HIP_MEMORY_SCOPE_AGENT); }
__device__ __forceinline__ unsigned xb_add(unsigned* p, unsigned v) { return __hip_atomic_fetch_add(p, v, __ATOMIC_RELAXED, __HIP_MEMORY_SCOPE_AGENT); }
__device__ __forceinline__ unsigned xb_xcc_id() { return (unsigned)__builtin_amdgcn_s_getreg((3 << 11) | 20) & 0xFu; }
#define XB_SPIN(cond, bar) do { unsigned _sp = 0; while (cond) { __builtin_amdgcn_s_sleep(1); \
    if ((++_sp & 255u) == 0u) { if (xb_ld(&(bar)[XB_TMO])) break; if (_sp > XB_SPIN_CAP) { atomicAdd(&(bar)[XB_TMO], 1u); break; } } } } while (0)

struct XcdBarrier {
    unsigned* bar; unsigned x;
    volatile LAS unsigned* st;
};

__device__ __forceinline__ XcdBarrier xcd_barrier_post(unsigned* bar, volatile LAS unsigned* st) {
    XcdBarrier b; b.bar = bar; b.x = xb_xcc_id(); b.st = st;
    if (threadIdx.x == 0) (void)xb_add(&bar[XB_XCNT(b.x)], 1u);
    return b;
}
__device__ __forceinline__ void xcd_barrier_complete(unsigned* bar, unsigned x, unsigned& nloc, unsigned& nx) {
    const unsigned G = gridDim.x * gridDim.y * gridDim.z;
    unsigned sum, cnt, mine, sp = 0u;
    for (;;) {
        sum = 0u; cnt = 0u; mine = 0u;
#pragma unroll
        for (unsigned j = 0; j < 16; ++j) { const unsigned c = xb_ld(&bar[XB_XCNT(j)]); sum += c; cnt += (c > 0u) ? 1u : 0u; mine = (j == x) ? c : mine; }
        if (sum == G) break;
        __builtin_amdgcn_s_sleep(1);
        if ((++sp & 255u) == 0u) { if (xb_ld(&bar[XB_TMO])) break; if (sp > XB_SPIN_CAP) { atomicAdd(&bar[XB_TMO], 1u); break; } }
    }
    nloc = mine > 0u ? mine : 1u; nx = cnt > 0u ? cnt : 1u;
}

__device__ __forceinline__ void xcd_barrier(const XcdBarrier& b) {
    asm volatile("s_waitcnt vmcnt(0)" ::: "memory");
    __syncthreads();
    if (threadIdx.x == 0) {
        unsigned* bar = b.bar;
        __builtin_amdgcn_s_waitcnt(0);
        unsigned nloc = b.st[0], nx = b.st[1];
        if (nloc == 0u) { xcd_barrier_complete(bar, b.x, nloc, nx); b.st[0] = nloc; b.st[1] = nx; }
        const unsigned old = xb_add(&bar[XB_XSUB(b.x)], 1u);
        const unsigned gen = old / nloc;
        if (old + 1u == (gen + 1u) * nloc) {
            __builtin_amdgcn_fence(__ATOMIC_RELEASE, "agent");
            asm volatile("s_waitcnt vmcnt(0)" ::: "memory");
            const unsigned og = xb_add(&bar[XB_TOP], 1u);
            const unsigned tg = og / nx;
            if (og + 1u == (tg + 1u) * nx) xb_add(&bar[XB_TOPGEN], 1u);
            else XB_SPIN(xb_ld(&bar[XB_TOPGEN]) == tg, bar);
            __builtin_amdgcn_fence(__ATOMIC_ACQUIRE, "agent");
            xb_add(&bar[XB_XGEN(b.x)], 1u);
            asm volatile("s_waitcnt vmcnt(0)" ::: "memory");
        } else {
            XB_SPIN(xb_ld(&bar[XB_XGEN(b.x)]) == gen, bar);
            __builtin_amdgcn_fence(__ATOMIC_ACQUIRE, "agent");
            asm volatile("s_waitcnt vmcnt(0)" ::: "memory");
        }
    }
    __syncthreads();
}
struct Frame {
    LAS unsigned char* lds;
    volatile LAS unsigned* MISC;
    unsigned* ctl;
    int tid, lane, wave;
    int vcu, G;
    float* out; unsigned char* ws;
};
#define GW_ID(F) ((F).vcu * NWAVES + (F).wave)
#define GW_N(F) ((F).G * NWAVES)

__device__ __forceinline__ void transpose_item(const float* __restrict__ W, int ldw, int K, bf16* __restrict__ WT, LAS float* scr, int kb, int nb, int sb, int se, float sv, int lane) {
    const int k0 = 64 * kb, n0 = 32 * nb;
#pragma unroll 8
    for (int i = 0; i < 32; ++i) { const int kk = 2 * i + (lane >> 5); scr[kk * 33 + (lane & 31)] = W[(size_t)(k0 + kk) * ldw + n0 + (lane & 31)]; }
    LDS_WAIT(); asm volatile("" ::: "memory");
    const int c = lane & 7;
    const float sc = (n0 >= sb && n0 < se) ? sv : 1.0f;
#pragma unroll
    for (int j = 0; j < 4; ++j) { const int n = (lane >> 3) + 8 * j; const LAS float* s = scr + (8 * c) * 33 + n;
        v4u o; o.x = pk2(s[0 * 33] * sc, s[1 * 33] * sc); o.y = pk2(s[2 * 33] * sc, s[3 * 33] * sc); o.z = pk2(s[4 * 33] * sc, s[5 * 33] * sc); o.w = pk2(s[6 * 33] * sc, s[7 * 33] * sc);
        *(v4u*)(WT + (size_t)(n0 + n) * K + k0 + 8 * c) = o; }
    LDS_WAIT(); asm volatile("" ::: "memory");
}
__device__ __forceinline__ void prep_two(Frame& F, const float* W0, int ldw0, int K0, int N0, bf16* T0, int sb, int se, float sv, const float* W1, int ldw1, int K1, int N1, bf16* T1) {
    LAS float* scr = (LAS float*)(F.lds + F.wave * 16384);
    const int nb0 = N0 / 32, I0 = (K0 / 64) * nb0, nb1 = N1 / 32, I1 = (K1 / 64) * nb1;
    for (int it = GW_ID(F); it < I0 + I1; it += GW_N(F)) {
        if (it < I0) transpose_item(W0, ldw0, K0, T0, scr, it / nb0, it % nb0, sb, se, sv, F.lane);
        else { const int r = it - I0; transpose_item(W1, ldw1, K1, T1, scr, r / nb1, r % nb1, 0, 0, 1.0f, F.lane); }
    }
}

template <bool GATES> __device__ __forceinline__ void norm_rows(Frame& F, const float* xp, const float* xs, float* Xdst, const float* g, bf16* XN, float* gates, const LAS float* WgT) {
    f32x4 gv[4];
#pragma unroll
    for (int j = 0; j < 4; ++j) gv[j] = ((const f32x4*)g)[F.lane + 64 * j];
    for (int m = GW_ID(F); m < M; m += GW_N(F)) {
        const float* xr = (m < MP) ? xp + (size_t)m * D : xs + (size_t)(m - MP) * D;
        f32x4 v[4]; float ss = 0.f;
#pragma unroll
        for (int j = 0; j < 4; ++j) { v[j] = ((const f32x4*)xr)[F.lane + 64 * j]; ss += (v[j].x * v[j].x + v[j].y * v[j].y) + (v[j].z * v[j].z + v[j].w * v[j].w); }
        if (Xdst) {
#pragma unroll
            for (int j = 0; j < 4; ++j) ((f32x4*)(Xdst + (size_t)m * D))[F.lane + 64 * j] = v[j];
        }
        const float rs = 1.0f / sqrtf(wave_sum(ss) * (1.0f / D) + EPS);
        v2u* o8 = (v2u*)(XN + (size_t)m * D);
#pragma unroll
        for (int j = 0; j < 4; ++j) { v[j] = v[j] * rs * gv[j]; v2u w; w.x = pk2(v[j].x, v[j].y); w.y = pk2(v[j].z, v[j].w); o8[F.lane + 64 * j] = w; }
        if (GATES) {
            float s[16];
#pragma unroll
            for (int c = 0; c < 16; ++c) { float a = 0.f;
#pragma unroll
                for (int j = 0; j < 4; ++j) { const f32x4 w = ((const LAS f32x4*)(WgT + c * 1024))[F.lane + 64 * j]; a += (v[j].x * w.x + v[j].y * w.y) + (v[j].z * w.z + v[j].w * w.w); }
                s[c] = a; if ((c & 3) == 3) asm volatile("" ::: "memory"); }
            const bool b5 = (F.lane & 32) != 0, b4 = (F.lane & 16) != 0, b3 = (F.lane & 8) != 0, b2 = (F.lane & 4) != 0;
#pragma unroll
            for (int i = 0; i < 8; ++i) { const float send = b5 ? s[i] : s[i + 8], keep = b5 ? s[i + 8] : s[i]; s[i] = keep + __shfl_xor(send, 32); }
#pragma unroll
            for (int i = 0; i < 4; ++i) { const float send = b4 ? s[i] : s[i + 4], keep = b4 ? s[i + 4] : s[i]; s[i] = keep + __shfl_xor(send, 16); }
#pragma unroll
            for (int i = 0; i < 2; ++i) { const float send = b3 ? s[i] : s[i + 2], keep = b3 ? s[i + 2] : s[i]; s[i] = keep + __shfl_xor(send, 8); }
            { const float send = b2 ? s[0] : s[1], keep = b2 ? s[1] : s[0]; s[0] = keep + __shfl_xor(send, 4); }
            s[0] += __shfl_xor(s[0], 2); s[0] += __shfl_xor(s[0], 1);
            if ((F.lane & 3) == 0) gates[(size_t)m * 16 + (F.lane >> 2)] = s[0];
        }
    }
}
__device__ __forceinline__ void stage_wgT(Frame& F, const float* W, int ldw, int c0, LAS float* WgT) {
    for (int e = F.tid; e < 16 * 1024; e += NTHR) { const int k = e >> 4, c = e & 15; WgT[c * 1024 + k] = W[(size_t)k * ldw + c0 + c]; }
}

__device__ __forceinline__ void unpack8(const v4u v, float (&f)[8]) { f[0] = bflo(v.x); f[1] = bfhi(v.x); f[2] = bflo(v.y); f[3] = bfhi(v.y); f[4] = bflo(v.z); f[5] = bfhi(v.z); f[6] = bflo(v.w); f[7] = bfhi(v.w); }
__device__ __forceinline__ void convact_phase(Frame& F, int layer, const float* conv_state, const float* cw, const float* cb) {
    const bf16* U = (const bf16*)(F.ws + WS_U); bf16* ACT = (bf16*)(F.ws + WS_ACT);
    constexpr int FC = DFF / 8;
    constexpr int RB = 16, NPB = MP / RB;
    const int gt = F.vcu * NTHR + F.tid, GT = F.G * NTHR;
    const float* cwl = cw + (size_t)layer * 3 * DFF; const float* cbl = cb + (size_t)layer * DFF;
    for (int it = gt; it < NPB * FC + BS * FC; it += GT) {
        const bool samp = it >= NPB * FC; const int r2 = samp ? it - NPB * FC : it;
        const int fc = r2 % FC, rb = r2 / FC, f0 = fc * 8;
        float w0[8], w1[8], w2[8], bb[8];
#pragma unroll
        for (int i = 0; i < 8; ++i) { w0[i] = cwl[f0 + i]; w1[i] = cwl[DFF + f0 + i]; w2[i] = cwl[2 * DFF + f0 + i]; bb[i] = cbl[f0 + i]; }
        float g2[8], g1[8];
        int row0, nrows;
        if (!samp) { row0 = rb * RB; nrows = RB; const int t0 = row0 % TP;
            if (t0 == 0) {
#pragma unroll
                for (int i = 0; i < 8; ++i) { g2[i] = 0.f; g1[i] = 0.f; }
            } else { unpack8(*(const v4u*)(U + (size_t)(row0 - 2) * (2 * DFF) + f0), g2); unpack8(*(const v4u*)(U + (size_t)(row0 - 1) * (2 * DFF) + f0), g1); }
        } else { row0 = MP + rb * TS; nrows = TS; const float* cs = conv_state + ((size_t)(layer * BS + rb) * 2) * DFF + f0;
#pragma unroll
            for (int i = 0; i < 8; ++i) { g2[i] = cs[i]; g1[i] = cs[DFF + i]; }
        }
        for (int r = 0; r < nrows; ++r) {
            const size_t row = (size_t)(row0 + r);
            float g0[8], up[8]; unpack8(*(const v4u*)(U + row * (2 * DFF) + f0), g0); unpack8(*(const v4u*)(U + row * (2 * DFF) + DFF + f0), up);
            float o[8];
#pragma unroll
            for (int i = 0; i < 8; ++i) { const float cv = bb[i] + w0[i] * g2[i] + w1[i] * g1[i] + w2[i] * g0[i]; o[i] = cv * sigmoidf_(cv) * up[i]; g2[i] = g1[i]; g1[i] = g0[i]; }
            v4u w; w.x = pk2(o[0], o[1]); w.y = pk2(o[2], o[3]); w.z = pk2(o[4], o[5]); w.w = pk2(o[6], o[7]);
            *(v4u*)(ACT + row * DFF + f0) = w;
        }
        if (samp) { float* o = F.out + O_SF + ((size_t)(layer * BS + rb) * 2) * DFF + f0;
#pragma unroll
            for (int i = 0; i < 8; ++i) { o[i] = g2[i]; o[DFF + i] = g1[i]; }
        } else if ((row0 + RB) % TP == 0) { const int b = row0 / TP; float* o = F.out + O_PF + ((size_t)(layer * BP + b) * 2) * DFF + f0;
#pragma unroll
            for (int i = 0; i < 8; ++i) { o[i] = g2[i]; o[DFF + i] = g1[i]; }
        }
    }
}

__device__ __forceinline__ void ml_gates(const float* GT, int row, int h, float bi, float bf_, int lane, float& a, float& fcum) {
    const float ig = softcapf(GT[(size_t)row * 16 + h] + bi);
    const float lf = logsigmoidf(softcapf(GT[(size_t)row * 16 + 8 + h] + bf_));
    fcum = wave_scan_sum(lf, lane); a = ig - fcum;
}
__device__ __forceinline__ void mlstm_A(Frame& F, const float* bi, const float* bf_) {
    LAS bf16* Kt = (LAS bf16*)F.lds; LAS bf16* Vt = Kt + 64 * 72; LAS float* wv = (LAS float*)(Vt + 128 * 72);
    const bf16* PROJ = (const bf16*)(F.ws + WS_PROJ); const float* GT = (const float*)(F.ws + WS_GATES);
    float* CLOC = (float*)(F.ws + SC_LOC); float* AUX = (float*)(F.ws + SC_AUX);
    for (int item = F.vcu; item < BP * HA * NCH; item += F.G) {
        const int bh = item >> 6, c = item & 63, b = bh >> 3, h = bh & 7, row0 = b * TP + c * LCH;
        if (F.wave == 0) { float a, fc; ml_gates(GT, row0 + F.lane, h, bi[h], bf_[h], F.lane, a, fc); const float amax = wave_max(a), fl = __shfl(fc, 63);
            wv[F.lane] = __expf(a - amax); if (F.lane == 0) { AUX[AX_CHK + 2 * item] = amax; AUX[AX_CHK + 2 * item + 1] = fl; } }
        stage_tr<64, 128>(Vt, 72, PROJ + (size_t)row0 * NPROJ + 1024 + h * 128, NPROJ, F.tid);
        __syncthreads();
        { const int r = F.tid & 63, c8 = F.tid >> 6; const v4u v = *(const v4u*)(PROJ + (size_t)(row0 + r) * NPROJ + 512 + h * 64 + c8 * 8); float e[8]; unpack8(v, e); const float w = wv[r];
            LAS bf16* d = Kt + (c8 * 8) * 72 + r;
#pragma unroll
            for (int i = 0; i < 8; ++i) d[i * 72] = (bf16)f2bf(e[i] * w); }
        __syncthreads();
#pragma unroll
        for (int jj = 0; jj < 4; ++jj) { const int tile = F.wave * 4 + jj, dkt = tile & 3, dvt = tile >> 2;
            const f32x4 acc = mma_ll<2>(Kt + dkt * 16 * 72, 72, Vt + dvt * 16 * 72, 72, (f32x4){0.f, 0.f, 0.f, 0.f}, F.lane);
            *(f32x4*)(CLOC + ((size_t)item * 128 + dvt * 16 + (F.lane & 15)) * 64 + dkt * 16 + 4 * (F.lane >> 4)) = acc; }
        if (F.tid < 64) { float s = 0.f; for (int ss = 0; ss < 64; ++ss) s += bf2f(Kt[F.tid * 72 + ss]); AUX[AX_NLOC + item * 64 + F.tid] = s; }
        __syncthreads();
    }
}
__device__ __forceinline__ void mlstm_B(Frame& F, int j) {
    const float* CLOC = (const float*)(F.ws + SC_LOC); bf16* ST = (bf16*)(F.ws + SC_ST); float* AUX = (float*)(F.ws + SC_AUX);
    for (int slot = F.vcu * NTHR + F.tid; slot < BP * HA * 4096; slot += F.G * NTHR) {
        const int bh = slot >> 12, e = slot & 4095, dv = e >> 5, dk = (e & 31) * 2;
        float m = 0.f, c0 = 0.f, c1 = 0.f, nacc = 0.f;
        for (int c = 0; c < NCH; ++c) { const int item = bh * 64 + c;
            const float amax = AUX[AX_CHK + 2 * item], fl = AUX[AX_CHK + 2 * item + 1];
            const float Mn = fmaxf(m, amax), g = __expf(m - Mn), ee = __expf(amax - Mn);
            const size_t idx = ((size_t)item * 128 + dv) * 64 + dk;
            *(unsigned*)(ST + idx) = pk2(c0, c1);
            if (e < 64) AUX[AX_NST + item * 64 + e] = nacc;
            if (e == 0) AUX[AX_MST + item] = m;
            const f32x2 cl = *(const f32x2*)(CLOC + idx);
            c0 = g * c0 + ee * cl.x; c1 = g * c1 + ee * cl.y;
            if (e < 64) nacc = g * nacc + ee * AUX[AX_NLOC + item * 64 + e];
            m = fl + Mn; }
        const int b = bh >> 3, h = bh & 7;
        float* oc = F.out + O_PAC + (((size_t)(j * BP + b) * HA + h) * DKA) * DVA;
        oc[(size_t)dk * DVA + dv] = c0; oc[(size_t)(dk + 1) * DVA + dv] = c1;
        if (e < 64) F.out[O_PAN + ((size_t)(j * BP + b) * HA + h) * DKA + e] = nacc;
        if (e == 0) F.out[O_PAM + (size_t)(j * BP + b) * HA + h] = m;
    }
}
__device__ __forceinline__ void mlstm_C(Frame& F, int j, const float* bi, const float* bf_, const float* anorm) {
    LAS bf16* Qs = (LAS bf16*)F.lds; LAS bf16* Ks = Qs + 64 * 72; LAS bf16* Vt = Ks + 64 * 72; LAS bf16* Ws = Vt + 128 * 72;
    LAS float* fa = (LAS float*)(Ws + 64 * 72); LAS float* fM = fa + 64; LAS float* fg = fM + 64; LAS float* fe = fg + 64; LAS float* fden = fe + 64; LAS float* ssq = fden + 64;
    const bf16* PROJ = (const bf16*)(F.ws + WS_PROJ); const float* GT = (const float*)(F.ws + WS_GATES);
    const bf16* ST = (const bf16*)(F.ws + SC_ST); const float* AUX = (const float*)(F.ws + SC_AUX); bf16* H = (bf16*)(F.ws + WS_H);
    const int r16 = F.lane & 15, q = F.lane >> 4;
    for (int item = F.vcu; item < BP * HA * NCH; item += F.G) {
        const int bh = item >> 6, c = item & 63, b = bh >> 3, h = bh & 7, row0 = b * TP + c * LCH;
        if (F.wave == 0) { float a, fc; ml_gates(GT, row0 + F.lane, h, bi[h], bf_[h], F.lane, a, fc); const float cm = wave_scan_max(a, F.lane), mc = AUX[AX_MST + item];
            const float Ml = fmaxf(mc, cm); fa[F.lane] = a; fM[F.lane] = Ml; fg[F.lane] = __expf(mc - Ml); fe[F.lane] = __expf(-(fc + Ml)); }
        stage_nat<64, 64>(Qs, 72, PROJ + (size_t)row0 * NPROJ + h * 64, NPROJ, F.tid);
        stage_nat<64, 64>(Ks, 72, PROJ + (size_t)row0 * NPROJ + 512 + h * 64, NPROJ, F.tid);
        stage_tr<64, 128>(Vt, 72, PROJ + (size_t)row0 * NPROJ + 1024 + h * 128, NPROJ, F.tid);
        __syncthreads();
#pragma unroll
        for (int jj = 0; jj < 2; ++jj) { const int tile = F.wave * 2 + jj, tt = tile >> 2, st = tile & 3; f32x4 acc = (f32x4){0.f, 0.f, 0.f, 0.f};
            if (st <= tt) acc = mma_ll<2>(Qs + tt * 16 * 72, 72, Ks + st * 16 * 72, 72, acc, F.lane);
            const int s = st * 16 + r16; const float as = fa[s];
#pragma unroll
            for (int r = 0; r < 4; ++r) { const int t = tt * 16 + 4 * q + r; const float w = (s <= t) ? acc[r] * __expf(as - fM[t]) : 0.f; Ws[t * 72 + s] = (bf16)f2bf(w); } }
        __syncthreads();
        if (F.tid < 64) { const int t = F.tid; float s1 = 0.f, qn = 0.f;
            for (int ss = 0; ss < 64; ss += 8) { float e[8]; unpack8(*(const LAS v4u*)(Ws + t * 72 + ss), e);
#pragma unroll
                for (int i = 0; i < 8; ++i) s1 += e[i]; }
            for (int dd = 0; dd < 64; dd += 8) { float e[8]; unpack8(*(const LAS v4u*)(Qs + t * 72 + dd), e);
#pragma unroll
                for (int i = 0; i < 8; ++i) qn += e[i] * AUX[AX_NST + item * 64 + dd + i]; }
            const float den = s1 + fg[t] * qn; fden[t] = fmaxf(fabsf(den), fe[t]); }
        const int tt = F.wave & 3, half = F.wave >> 2;
        f32x4 a1[4], a2[4];
#pragma unroll
        for (int dl = 0; dl < 4; ++dl) { const int dvt = half * 4 + dl;
            a1[dl] = mma_ll<2>(Vt + dvt * 16 * 72, 72, Ws + tt * 16 * 72, 72, (f32x4){0.f, 0.f, 0.f, 0.f}, F.lane);
            a2[dl] = mma_gl<2>(ST + ((size_t)item * 128 + dvt * 16) * 64, 64, Qs + tt * 16 * 72, 72, (f32x4){0.f, 0.f, 0.f, 0.f}, F.lane); }
        __syncthreads();
        const int t = tt * 16 + r16; const float gt = fg[t], rd = 1.0f / fden[t]; float sq = 0.f;
#pragma unroll
        for (int dl = 0; dl < 4; ++dl)
#pragma unroll
            for (int r = 0; r < 4; ++r) { const float hv = (a1[dl][r] + gt * a2[dl][r]) * rd; a1[dl][r] = hv; sq += hv * hv; }
        sq += __shfl_xor(sq, 16); sq += __shfl_xor(sq, 32);
        if (F.lane < 16) ssq[half * 64 + t] = sq;
        __syncthreads();
        const float rs = 1.0f / sqrtf((ssq[t] + ssq[64 + t]) * (1.0f / DVA) + EPS);
#pragma unroll
        for (int dl = 0; dl < 4; ++dl) { const int col = h * 128 + (half * 4 + dl) * 16 + 4 * q;
            const f32x4 ng = *(const f32x4*)(anorm + j * 1024 + col); const v2u ov = *(const v2u*)(PROJ + (size_t)(row0 + t) * NPROJ + 2048 + col);
            const float o0 = a1[dl][0] * rs * ng.x * sigmoidf_(bflo(ov.x)), o1 = a1[dl][1] * rs * ng.y * sigmoidf_(bfhi(ov.x)), o2 = a1[dl][2] * rs * ng.z * sigmoidf_(bflo(ov.y)), o3 = a1[dl][3] * rs * ng.w * sigmoidf_(bfhi(ov.y));
            v2u w; w.x = pk2(o0, o1); w.y = pk2(o2, o3); *(v2u*)(H + (size_t)(row0 + t) * D + col) = w; }
        __syncthreads();
    }
}
__device__ __forceinline__ void mlstm_S(Frame& F, int j, const float* bi, const float* bf_, const float* anorm, const float* st_c, const float* st_n, const float* st_m) {
    LAS float* qs = (LAS float*)F.lds; LAS float* ks = qs + 256; LAS float* vs = ks + 256; LAS float* qkw = vs + 512; LAS float* qn = qkw + 16; LAS float* part = qn + 16; LAS float* red = part + 2048;
    const bf16* PROJ = (const bf16*)(F.ws + WS_PROJ); const float* GT = (const float*)(F.ws + WS_GATES); bf16* H = (bf16*)(F.ws + WS_H);
    for (int item = F.vcu; item < BS * HA; item += F.G) {
        const int b = item >> 3, h = item & 7, row0 = MP + b * TS;
        float a[4], fc[4], Ml[4], g[4], mt[4]; const float m0 = st_m[(size_t)(j * BS + b) * HA + h];
        { float run = 0.f, cm = -3.0e38f;
#pragma unroll
            for (int t = 0; t < 4; ++t) { const float ig = softcapf(GT[(size_t)(row0 + t) * 16 + h] + bi[h]); const float lf = logsigmoidf(softcapf(GT[(size_t)(row0 + t) * 16 + 8 + h] + bf_[h]));
                run += lf; fc[t] = run; a[t] = ig - run; cm = fmaxf(cm, a[t]); Ml[t] = fmaxf(m0, cm); g[t] = __expf(m0 - Ml[t]); mt[t] = run + Ml[t]; } }
        { const int t = (F.tid >> 6) & 3, d = F.tid & 63; const bf16* pr = PROJ + (size_t)(row0 + t) * NPROJ + h * 64 + d;
            if (F.tid < 256) qs[t * 64 + d] = bf2f(pr[0]); else ks[t * 64 + d] = bf2f(pr[512]);
            const int t2 = F.tid >> 7, dv = F.tid & 127; vs[t2 * 128 + dv] = bf2f(PROJ[(size_t)(row0 + t2) * NPROJ + 1024 + h * 128 + dv]); }
        __syncthreads();
        const float* n0 = st_n + ((size_t)(j * BS + b) * HA + h) * DKA;
        if (F.tid < 16) { const int t = F.tid >> 2, s = F.tid & 3; float dt = 0.f; for (int d = 0; d < 64; ++d) dt += qs[t * 64 + d] * ks[s * 64 + d];
            float as = a[0], Mt = Ml[0];
            as = (s == 1) ? a[1] : as; as = (s == 2) ? a[2] : as; as = (s == 3) ? a[3] : as; Mt = (t == 1) ? Ml[1] : Mt; Mt = (t == 2) ? Ml[2] : Mt; Mt = (t == 3) ? Ml[3] : Mt;
            qkw[F.tid] = (s <= t) ? dt * __expf(as - Mt) : 0.f; }
        else if (F.tid < 20) { const int t = F.tid - 16; float dt = 0.f; for (int d = 0; d < 64; ++d) dt += qs[t * 64 + d] * n0[d]; qn[t] = dt; }
        { const int dv = F.tid & 127, dkq = F.tid >> 7; const float* c0p = st_c + (((size_t)(j * BS + b) * HA + h) * DKA) * DVA; float* cout = F.out + O_SAC + (((size_t)(j * BS + b) * HA + h) * DKA) * DVA;
            float p0 = 0.f, p1 = 0.f, p2 = 0.f, p3 = 0.f; const float gl = g[3];
            float wl[4];
#pragma unroll
            for (int s = 0; s < 4; ++s) wl[s] = __expf(a[s] - Ml[3]) * vs[s * 128 + dv];
            for (int dk = dkq * 16; dk < dkq * 16 + 16; ++dk) { const float cv = c0p[(size_t)dk * DVA + dv];
                p0 += qs[dk] * cv; p1 += qs[64 + dk] * cv; p2 += qs[128 + dk] * cv; p3 += qs[192 + dk] * cv;
                cout[(size_t)dk * DVA + dv] = gl * cv + (wl[0] * ks[dk] + wl[1] * ks[64 + dk]) + (wl[2] * ks[128 + dk] + wl[3] * ks[192 + dk]); }
            part[(dkq * 4 + 0) * 128 + dv] = p0; part[(dkq * 4 + 1) * 128 + dv] = p1; part[(dkq * 4 + 2) * 128 + dv] = p2; part[(dkq * 4 + 3) * 128 + dv] = p3; }
        __syncthreads();
        float hv;
        { const int t = F.tid >> 7, dv = F.tid & 127; float gt = g[0], emt = mt[0];
            gt = (t == 1) ? g[1] : gt; gt = (t == 2) ? g[2] : gt; gt = (t == 3) ? g[3] : gt; emt = (t == 1) ? mt[1] : emt; emt = (t == 2) ? mt[2] : emt; emt = (t == 3) ? mt[3] : emt;
            float num = 0.f, den = 0.f;
#pragma unroll
            for (int s = 0; s < 4; ++s) { const float w = qkw[t * 4 + s]; num += w * vs[s * 128 + dv]; den += w; }
            num += gt * ((part[(0 * 4 + t) * 128 + dv] + part[(1 * 4 + t) * 128 + dv]) + (part[(2 * 4 + t) * 128 + dv] + part[(3 * 4 + t) * 128 + dv]));
            den += gt * qn[t];
            hv = num / fmaxf(fabsf(den), __expf(-emt));
            const float sq = wave_sum(hv * hv); if (F.lane == 0) red[F.wave] = sq; }
        __syncthreads();
        { const int t = F.tid >> 7, dv = F.tid & 127, col = h * 128 + dv; const float rs = 1.0f / sqrtf((red[2 * t] + red[2 * t + 1]) * (1.0f / DVA) + EPS);
            const float o = bf2f(PROJ[(size_t)(row0 + t) * NPROJ + 2048 + col]);
            H[(size_t)(row0 + t) * D + col] = (bf16)f2bf(hv * rs * anorm[j * 1024 + col] * sigmoidf_(o)); }
        if (F.tid < 64) { const int d = F.tid; float nn = g[3] * n0[d];
#pragma unroll
            for (int s = 0; s < 4; ++s) nn += __expf(a[s] - Ml[3]) * ks[s * 64 + d];
            F.out[O_SAN + ((size_t)(j * BS + b) * HA + h) * DKA + d] = nn; }
        if (F.tid == 0) F.out[O_SAM + (size_t)(j * BS + b) * HA + h] = mt[3];
        __syncthreads();
    }
}
__device__ __forceinline__ void gla_bc(Frame& F, int row0, int h, const float* WG, const float* BG, LAS float* zs, LAS float* gsum, LAS float* bc) {
    const float* GT = (const float*)(F.ws + WS_GATES);
    if (F.tid < 256) ((LAS f32x4*)zs)[F.tid] = ((const f32x4*)(GT + (size_t)row0 * 16))[F.tid];
    const int d = F.tid & 127, tq = F.tid >> 7, col = h * 128 + d;
    float wg[16];
#pragma unroll
    for (int r = 0; r < 16; ++r) wg[r] = WG[r * 512 + col];
    const float bgv = BG[col];
    __syncthreads();
    float pr[16]; float run = 0.f;
#pragma unroll
    for (int i = 0; i < 16; ++i) { const LAS float* z = zs + (tq * 16 + i) * 16; float x = bgv;
#pragma unroll
        for (int r = 0; r < 16; ++r) x += z[r] * wg[r];
        run += logsigmoidf(x) * (1.0f / 16.0f); pr[i] = run; }
    gsum[tq * 128 + d] = run;
    __syncthreads();
    float off = 0.f;
    if (tq > 0) off += gsum[d];
    if (tq > 1) off += gsum[128 + d];
    if (tq > 2) off += gsum[256 + d];
#pragma unroll
    for (int i = 0; i < 16; ++i) bc[(tq * 16 + i) * 128 + d] = pr[i] + off;
    __syncthreads();
}
__device__ __forceinline__ void gla_A(Frame& F, const float* WG, const float* BG) {
    LAS float* zs = (LAS float*)F.lds; LAS float* gsum = zs + 1024; LAS float* bc = gsum + 512; LAS bf16* Kt = (LAS bf16*)(bc + 8192); LAS bf16* Vt = Kt + 128 * 72;
    const bf16* PROJ = (const bf16*)(F.ws + WS_PROJ); float* SLOC = (float*)(F.ws + SC_LOC); float* AUX = (float*)(F.ws + SC_AUX);
    for (int item = F.vcu; item < BP * HB * NCH; item += F.G) {
        const int bh = item >> 6, c = item & 63, b = bh >> 2, h = bh & 3, row0 = b * TP + c * LCH;
        gla_bc(F, row0, h, WG, BG, zs, gsum, bc);
        if (F.tid < 128) AUX[AX_BL + item * 128 + F.tid] = bc[63 * 128 + F.tid];
        for (int p = F.tid; p < 64 * 16; p += NTHR) { const int r = p & 63, c8 = p >> 6; float e[8]; unpack8(*(const v4u*)(PROJ + (size_t)(row0 + r) * NPROJ + 512 + h * 128 + c8 * 8), e);
            LAS bf16* dd = Kt + (c8 * 8) * 72 + r;
#pragma unroll
            for (int i = 0; i < 8; ++i) { const int dk = c8 * 8 + i; dd[i * 72] = (bf16)f2bf(e[i] * __expf(bc[63 * 128 + dk] - bc[r * 128 + dk])); } }
        stage_tr<64, 256>(Vt, 72, PROJ + (size_t)row0 * NPROJ + 1024 + h * 256, NPROJ, F.tid);
        __syncthreads();
        for (int jj = 0; jj < 16; ++jj) { const int tile = F.wave * 16 + jj, dkt = tile & 7, dvt = tile >> 3;
            const f32x4 acc = mma_ll<2>(Kt + dkt * 16 * 72, 72, Vt + dvt * 16 * 72, 72, (f32x4){0.f, 0.f, 0.f, 0.f}, F.lane);
            *(f32x4*)(SLOC + ((size_t)item * 256 + dvt * 16 + (F.lane & 15)) * 128 + dkt * 16 + 4 * (F.lane >> 4)) = acc; }
        __syncthreads();
    }
}
__device__ __forceinline__ void gla_B(Frame& F) {
    const float* SLOC = (const float*)(F.ws + SC_LOC); bf16* ST = (bf16*)(F.ws + SC_ST); const float* AUX = (const float*)(F.ws + SC_AUX);
    for (int slot = F.vcu * NTHR + F.tid; slot < BP * HB * 8192; slot += F.G * NTHR) {
        const int bh = slot >> 13, e = slot & 8191, dv = e >> 5, dk0 = (e & 31) * 4;
        f32x4 S = (f32x4){0.f, 0.f, 0.f, 0.f};
        for (int c = 0; c < NCH; ++c) { const int item = bh * 64 + c; const size_t idx = ((size_t)item * 256 + dv) * 128 + dk0;
            v2u w; w.x = pk2(S.x, S.y); w.y = pk2(S.z, S.w); *(v2u*)(ST + idx) = w;
            const f32x4 bl = *(const f32x4*)(AUX + AX_BL + item * 128 + dk0); const f32x4 sl = *(const f32x4*)(SLOC + idx);
            S.x = __expf(bl.x) * S.x + sl.x; S.y = __expf(bl.y) * S.y + sl.y; S.z = __expf(bl.z) * S.z + sl.z; S.w = __expf(bl.w) * S.w + sl.w; }
        float* o = F.out + O_PG + ((size_t)bh * DKB + dk0) * DVB + dv;
        o[0] = S.x; o[DVB] = S.y; o[2 * DVB] = S.z; o[3 * DVB] = S.w;
    }
}
__device__ __forceinline__ void gla_C(Frame& F, const float* WG, const float* BG, const float* bnorm) {
    LAS float* zs = (LAS float*)F.lds; LAS float* gsum = zs + 1024; LAS float* bc = gsum + 512; LAS bf16* Qs = (LAS bf16*)(bc + 8192); LAS bf16* Ks = Qs + 64 * 136; LAS bf16* Vt = Ks + 64 * 136;
    LAS bf16* At = Vt + 256 * 72; LAS float* ssq = (LAS float*)(At + 64 * 72);
    const bf16* PROJ = (const bf16*)(F.ws + WS_PROJ); const bf16* ST = (const bf16*)(F.ws + SC_ST); bf16* H = (bf16*)(F.ws + WS_H);
    const int r16 = F.lane & 15, q = F.lane >> 4;
    for (int item = F.vcu; item < BP * HB * NCH; item += F.G) {
        const int bh = item >> 6, c = item & 63, b = bh >> 2, h = bh & 3, row0 = b * TP + c * LCH;
        gla_bc(F, row0, h, WG, BG, zs, gsum, bc);
        for (int p = F.tid; p < 64 * 16; p += NTHR) { const int r = p >> 4, c8 = p & 15; float e[8], f[8];
            unpack8(*(const v4u*)(PROJ + (size_t)(row0 + r) * NPROJ + h * 128 + c8 * 8), e); unpack8(*(const v4u*)(PROJ + (size_t)(row0 + r) * NPROJ + 512 + h * 128 + c8 * 8), f);
#pragma unroll
            for (int i = 0; i < 8; ++i) { const float bb = bc[r * 128 + c8 * 8 + i]; e[i] *= __expf(bb); f[i] *= __expf(-bb); }
            v4u w; w.x = pk2(e[0], e[1]); w.y = pk2(e[2], e[3]); w.z = pk2(e[4], e[5]); w.w = pk2(e[6], e[7]); *(LAS v4u*)(Qs + r * 136 + c8 * 8) = w;
            w.x = pk2(f[0], f[1]); w.y = pk2(f[2], f[3]); w.z = pk2(f[4], f[5]); w.w = pk2(f[6], f[7]); *(LAS v4u*)(Ks + r * 136 + c8 * 8) = w; }
        stage_tr<64, 256>(Vt, 72, PROJ + (size_t)row0 * NPROJ + 1024 + h * 256, NPROJ, F.tid);
        __syncthreads();
#pragma unroll
        for (int jj = 0; jj < 2; ++jj) { const int tile = F.wave * 2 + jj, tt = tile >> 2, st = tile & 3; f32x4 acc = (f32x4){0.f, 0.f, 0.f, 0.f};
            if (st <= tt) acc = mma_ll<4>(Qs + tt * 16 * 136, 136, Ks + st * 16 * 136, 136, acc, F.lane);
            const int s = st * 16 + r16;
#pragma unroll
            for (int r = 0; r < 4; ++r) { const int t = tt * 16 + 4 * q + r; At[t * 72 + s] = (bf16)f2bf((s <= t) ? acc[r] : 0.f); } }
        __syncthreads();
        f32x4 o[2][4];
#pragma unroll
        for (int dl = 0; dl < 2; ++dl) { const int dvt = F.wave * 2 + dl;
            bf16x8 sa[4];
#pragma unroll
            for (int ks = 0; ks < 4; ++ks) sa[ks] = *(const bf16x8*)(ST + ((size_t)item * 256 + dvt * 16 + r16) * 128 + ks * 32 + q * 8);
#pragma unroll
            for (int tt = 0; tt < 4; ++tt) { f32x4 acc = mma_ll<2>(Vt + dvt * 16 * 72, 72, At + tt * 16 * 72, 72, (f32x4){0.f, 0.f, 0.f, 0.f}, F.lane);
#pragma unroll
                for (int ks = 0; ks < 4; ++ks) { const bf16x8 bq = *(const LAS bf16x8*)(Qs + (tt * 16 + r16) * 136 + ks * 32 + q * 8); acc = __builtin_amdgcn_mfma_f32_16x16x32_bf16(sa[ks], bq, acc, 0, 0, 0); }
                o[dl][tt] = acc; } }
#pragma unroll
        for (int tt = 0; tt < 4; ++tt) { float sq = 0.f;
#pragma unroll
            for (int dl = 0; dl < 2; ++dl)
#pragma unroll
                for (int r = 0; r < 4; ++r) sq += o[dl][tt][r] * o[dl][tt][r];
            sq += __shfl_xor(sq, 16); sq += __shfl_xor(sq, 32);
            if (F.lane < 16) ssq[F.wave * 64 + tt * 16 + r16] = sq; }
        __syncthreads();
#pragma unroll
        for (int tt = 0; tt < 4; ++tt) { const int t = tt * 16 + r16; float tot = 0.f;
#pragma unroll
            for (int w = 0; w < 8; ++w) tot += ssq[w * 64 + t];
            const float rs = 1.0f / sqrtf(tot * (1.0f / DVB) + EPS);
#pragma unroll
            for (int dl = 0; dl < 2; ++dl) { const int col = h * 256 + (F.wave * 2 + dl) * 16 + 4 * q;
                const f32x4 ng = *(const f32x4*)(bnorm + col); const v2u rv = *(const v2u*)(PROJ + (size_t)(row0 + t) * NPROJ + 2048 + col);
                const float r0 = bflo(rv.x), r1 = bfhi(rv.x), r2 = bflo(rv.y), r3 = bfhi(rv.y);
                const float o0 = o[dl][tt][0] * rs * ng.x * r0 * sigmoidf_(r0), o1 = o[dl][tt][1] * rs * ng.y * r1 * sigmoidf_(r1), o2 = o[dl][tt][2] * rs * ng.z * r2 * sigmoidf_(r2), o3 = o[dl][tt][3] * rs * ng.w * r3 * sigmoidf_(r3);
                v2u w; w.x = pk2(o0, o1); w.y = pk2(o2, o3); *(v2u*)(H + (size_t)(row0 + t) * D + col) = w; } }
        __syncthreads();
    }
}
__device__ __forceinline__ void gla_S(Frame& F, const float* WG, const float* BG, const float* bnorm, const float* st_s) {
    LAS float* bcs = (LAS float*)F.lds;
    LAS float* qs = bcs + 512;
    LAS float* kr = qs + 512;
    LAS float* kh = kr + 512;
    LAS float* vs = kh + 512;
    LAS float* att = vs + 1024;
    LAS float* part = att + 16;
    LAS float* red = part + 2048;
    const bf16* PROJ = (const bf16*)(F.ws + WS_PROJ); const float* GT = (const float*)(F.ws + WS_GATES); bf16* H = (bf16*)(F.ws + WS_H);
    for (int item = F.vcu; item < BS * HB; item += F.G) {
        const int b = item >> 2, h = item & 3, row0 = MP + b * TS;
        { const int t = F.tid >> 7, d = F.tid & 127, col = h * 128 + d; float x = BG[col];
#pragma unroll
            for (int r = 0; r < 16; ++r) x += GT[(size_t)(row0 + t) * 16 + r] * WG[r * 512 + col];
            bcs[t * 128 + d] = logsigmoidf(x) * (1.0f / 16.0f);
            kr[t * 128 + d] = bf2f(PROJ[(size_t)(row0 + t) * NPROJ + 512 + col]);
            vs[t * 256 + d] = bf2f(PROJ[(size_t)(row0 + t) * NPROJ + 1024 + h * 256 + d]); vs[t * 256 + 128 + d] = bf2f(PROJ[(size_t)(row0 + t) * NPROJ + 1024 + h * 256 + 128 + d]); }
        __syncthreads();
        if (F.tid < 128) { const int d = F.tid; float run = 0.f;
#pragma unroll
            for (int t = 0; t < 4; ++t) { run += bcs[t * 128 + d]; bcs[t * 128 + d] = run; } }
        __syncthreads();
        { const int t = F.tid >> 7, d = F.tid & 127, col = h * 128 + d; const float bb = bcs[t * 128 + d], bl = bcs[3 * 128 + d];
            qs[t * 128 + d] = bf2f(PROJ[(size_t)(row0 + t) * NPROJ + col]) * __expf(bb); kh[t * 128 + d] = kr[t * 128 + d] * __expf(bl - bb); }
        __syncthreads();
        if (F.tid < 16) { const int t = F.tid >> 2, s = F.tid & 3; float dt = 0.f;
            if (s <= t) for (int d = 0; d < 128; ++d) dt += qs[t * 128 + d] * kr[s * 128 + d] * __expf(-bcs[s * 128 + d]);
            att[F.tid] = dt; }
        { const int dv = F.tid & 255, dkh = F.tid >> 8; const float* s0 = st_s + (((size_t)b * HB + h) * DKB) * DVB; float* so = F.out + O_SG + (((size_t)b * HB + h) * DKB) * DVB;
            float p0 = 0.f, p1 = 0.f, p2 = 0.f, p3 = 0.f; const float v0 = vs[dv], v1 = vs[256 + dv], v2 = vs[512 + dv], v3 = vs[768 + dv];
            for (int dk = dkh * 64; dk < dkh * 64 + 64; ++dk) { const float sv = s0[(size_t)dk * DVB + dv];
                p0 += qs[dk] * sv; p1 += qs[128 + dk] * sv; p2 += qs[256 + dk] * sv; p3 += qs[384 + dk] * sv;
                so[(size_t)dk * DVB + dv] = __expf(bcs[3 * 128 + dk]) * sv + (kh[dk] * v0 + kh[128 + dk] * v1) + (kh[256 + dk] * v2 + kh[384 + dk] * v3); }
            part[(dkh * 4 + 0) * 256 + dv] = p0; part[(dkh * 4 + 1) * 256 + dv] = p1; part[(dkh * 4 + 2) * 256 + dv] = p2; part[(dkh * 4 + 3) * 256 + dv] = p3; }
        __syncthreads();
        float ov[2];
        { const int dv = F.tid & 255, th = F.tid >> 8;
#pragma unroll
            for (int u = 0; u < 2; ++u) { const int t = th + 2 * u; float o = part[t * 256 + dv] + part[(4 + t) * 256 + dv];
#pragma unroll
                for (int s = 0; s < 4; ++s) o += att[t * 4 + s] * vs[s * 256 + dv];
                ov[u] = o; const float sq = wave_sum(o * o); if (F.lane == 0) red[F.wave * 2 + u] = sq; } }
        __syncthreads();
        { const int dv = F.tid & 255, th = F.tid >> 8, col = h * 256 + dv;
#pragma unroll
            for (int u = 0; u < 2; ++u) { const int t = th + 2 * u; const int w0 = th * 4; const float tot = (red[(w0 + 0) * 2 + u] + red[(w0 + 1) * 2 + u]) + (red[(w0 + 2) * 2 + u] + red[(w0 + 3) * 2 + u]);
                const float rs = 1.0f / sqrtf(tot * (1.0f / DVB) + EPS); const float r = bf2f(PROJ[(size_t)(row0 + t) * NPROJ + 2048 + col]);
                H[(size_t)(row0 + t) * D + col] = (bf16)f2bf(ov[u] * rs * bnorm[col] * r * sigmoidf_(r)); } }
        __syncthreads();
    }
}

__device__ __forceinline__ void swa_tile(const LAS bf16* Kw, const LAS bf16* Vt, int ldv, LAS bf16* Pw, int kt0, int jmin, const bf16* qp_r16, bf16* op_r16, const int (&relb)[4], const float (&snk)[4], int lane) {
    const int r16 = lane & 15, q = lane >> 4;
    const bf16x8 qa0 = *(const bf16x8*)(qp_r16 + q * 8), qa1 = *(const bf16x8*)(qp_r16 + 32 + q * 8);
    f32x4 s[9];
#pragma unroll
    for (int kt = 0; kt < 9; ++kt) { const LAS bf16* kp = Kw + ((kt0 + kt) * 16 + r16) * 72 + q * 8;
        f32x4 acc = __builtin_amdgcn_mfma_f32_16x16x32_bf16(qa0, *(const LAS bf16x8*)kp, (f32x4){0.f, 0.f, 0.f, 0.f}, 0, 0, 0);
        s[kt] = __builtin_amdgcn_mfma_f32_16x16x32_bf16(qa1, *(const LAS bf16x8*)(kp + 32), acc, 0, 0, 0); }
    float mx[4] = {-3.0e38f, -3.0e38f, -3.0e38f, -3.0e38f};
#pragma unroll
    for (int kt = 0; kt < 9; ++kt) { const int j = (kt0 + kt) * 16 + r16;
#pragma unroll
        for (int r = 0; r < 4; ++r) { const int rel = relb[r] - j; const bool ok = (rel >= 0) && (rel <= WIN) && (j >= jmin); const float v = ok ? s[kt][r] * 0.125f : -3.0e38f; s[kt][r] = v; mx[r] = fmaxf(mx[r], v); } }
    float sm[4];
#pragma unroll
    for (int r = 0; r < 4; ++r) { float m = mx[r]; m = fmaxf(m, __shfl_xor(m, 1)); m = fmaxf(m, __shfl_xor(m, 2)); m = fmaxf(m, __shfl_xor(m, 4)); m = fmaxf(m, __shfl_xor(m, 8)); mx[r] = fmaxf(m, snk[r]); sm[r] = 0.f; }
#pragma unroll
    for (int kt = 0; kt < 9; ++kt)
#pragma unroll
        for (int r = 0; r < 4; ++r) { const float p = (s[kt][r] > -1.0e38f) ? __expf(s[kt][r] - mx[r]) : 0.f; s[kt][r] = p; sm[r] += p; }
#pragma unroll
    for (int r = 0; r < 4; ++r) { float t = sm[r]; t += __shfl_xor(t, 1); t += __shfl_xor(t, 2); t += __shfl_xor(t, 4); t += __shfl_xor(t, 8); sm[r] = 1.0f / (t + __expf(snk[r] - mx[r])); }
#pragma unroll
    for (int kt = 0; kt < 9; ++kt)
#pragma unroll
        for (int r = 0; r < 4; ++r) Pw[(4 * q + r) * 168 + kt * 16 + r16] = (bf16)f2bf(s[kt][r] * sm[r]);
#pragma unroll
    for (int r = 0; r < 4; ++r) Pw[(4 * q + r) * 168 + 144 + r16] = (bf16)0;
    LDS_WAIT();
#pragma unroll
    for (int dt = 0; dt < 4; ++dt) { f32x4 acc = (f32x4){0.f, 0.f, 0.f, 0.f};
#pragma unroll
        for (int ks = 0; ks < 5; ++ks) { const bf16x8 va = *(const LAS bf16x8*)(Vt + (dt * 16 + r16) * ldv + kt0 * 16 + ks * 32 + q * 8); const bf16x8 pb = *(const LAS bf16x8*)(Pw + r16 * 168 + ks * 32 + q * 8);
            acc = __builtin_amdgcn_mfma_f32_16x16x32_bf16(va, pb, acc, 0, 0, 0); }
        v2u w; w.x = pk2(acc[0], acc[1]); w.y = pk2(acc[2], acc[3]); *(v2u*)(op_r16 + dt * 16 + 4 * q) = w; }
    LDS_WAIT();
}
__device__ __forceinline__ void swa_prompt(Frame& F, const float* sinks) {
    LAS bf16* Kw = (LAS bf16*)F.lds; LAS bf16* Vt = Kw + 256 * 72; LAS bf16* Pw = Vt + 64 * 280 + F.wave * (16 * 168);
    const bf16* PROJ = (const bf16*)(F.ws + WS_PROJ); bf16* H = (bf16*)(F.ws + WS_H);
    const int r16 = F.lane & 15, q = F.lane >> 4;
    for (int item = F.vcu; item < BP * HKV * (TP / WIN); item += F.G) {
        const int qb = item & 31, hkv = (item >> 5) & 3, b = item >> 7;
        const int krow0 = b * TP + (qb - 1) * WIN;
        for (int p = F.tid; p < 256 * 8; p += NTHR) { const int r = p >> 3, c8 = p & 7; v4u v = (v4u){0u, 0u, 0u, 0u};
            if (qb > 0 || r >= WIN) v = *(const v4u*)(PROJ + (size_t)(krow0 + r) * C_IN + 1024 + hkv * 64 + c8 * 8);
            *(LAS v4u*)(Kw + r * 72 + c8 * 8) = v; }
        for (int p = F.tid; p < 256 * 8; p += NTHR) { const int r = p & 255, c8 = p >> 8; v4u v = (v4u){0u, 0u, 0u, 0u};
            if (qb > 0 || r >= WIN) v = *(const v4u*)(PROJ + (size_t)(krow0 + r) * C_IN + 1280 + hkv * 64 + c8 * 8);
            LAS bf16* d = Vt + (c8 * 8) * 280 + r;
            d[0 * 280] = (bf16)(v.x & 0xffffu); d[1 * 280] = (bf16)(v.x >> 16); d[2 * 280] = (bf16)(v.y & 0xffffu); d[3 * 280] = (bf16)(v.y >> 16);
            d[4 * 280] = (bf16)(v.z & 0xffffu); d[5 * 280] = (bf16)(v.z >> 16); d[6 * 280] = (bf16)(v.w & 0xffffu); d[7 * 280] = (bf16)(v.w >> 16); }
        for (int p = F.tid; p < 64 * 24; p += NTHR) { const int r = p / 24, cc = p % 24; Vt[r * 280 + 256 + cc] = (bf16)0; }
        __syncthreads();
        const int g = F.wave >> 1, hq = hkv * 4 + g;
        const float sk = sinks[hq]; const float snk[4] = {sk, sk, sk, sk};
        for (int mt = 0; mt < 4; ++mt) { const int tq0 = (F.wave & 1) * 64 + mt * 16; const int relb[4] = {WIN + tq0 + 4 * q, WIN + tq0 + 4 * q + 1, WIN + tq0 + 4 * q + 2, WIN + tq0 + 4 * q + 3};
            const size_t row = (size_t)b * TP + qb * WIN + tq0 + r16;
            swa_tile(Kw, Vt, 280, Pw, tq0 >> 4, (qb == 0) ? WIN : 0, PROJ + row * C_IN + hq * 64, H + row * D + hq * 64, relb, snk, F.lane); }
        __syncthreads();
    }
    for (int e = F.vcu * NTHR + F.tid; e < BP * WIN * 256; e += F.G * NTHR) { const int d = e & 255, jrow = (e >> 8) & 127, b = e >> 15; const size_t row = (size_t)b * TP + TP - WIN + jrow;
        F.out[O_PSK + ((size_t)b * WIN + jrow) * 256 + d] = bf2f(PROJ[row * C_IN + 1024 + d]); F.out[O_PSV + ((size_t)b * WIN + jrow) * 256 + d] = bf2f(PROJ[row * C_IN + 1280 + d]); }
}
__device__ __forceinline__ void swa_sample(Frame& F, const float* sinks, const float* ck, const float* cv) {
    LAS bf16* Kw = (LAS bf16*)F.lds; LAS bf16* Vt = Kw + 144 * 72; LAS bf16* Pw = Vt + 64 * 168;
    const bf16* PROJ = (const bf16*)(F.ws + WS_PROJ); bf16* H = (bf16*)(F.ws + WS_H);
    const int r16 = F.lane & 15, q = F.lane >> 4;
    for (int item = F.vcu; item < BS * HKV; item += F.G) {
        const int b = item >> 2, hkv = item & 3;
        for (int e = F.tid; e < 144 * 64; e += NTHR) { const int r = e >> 6, d = e & 63; float kx = 0.f, vx = 0.f;
            if (r < WIN) { const size_t ci = (((size_t)b * WIN + r) * HKV + hkv) * HDC + d; kx = ck[ci]; vx = cv[ci]; }
            else if (r < WIN + TS) { const size_t row = (size_t)MP + b * TS + (r - WIN); kx = bf2f(PROJ[row * C_IN + 1024 + hkv * 64 + d]); vx = bf2f(PROJ[row * C_IN + 1280 + hkv * 64 + d]); }
            Kw[r * 72 + d] = (bf16)f2bf(kx); Vt[d * 168 + r] = (bf16)f2bf(vx);
            if (r >= TS && r < WIN + TS) { const size_t oi = (((size_t)b * WIN + (r - TS)) * HKV + hkv) * HDC + d; F.out[O_SSK + oi] = kx; F.out[O_SSV + oi] = vx; } }
        for (int e = F.tid; e < 64 * 16; e += NTHR) { const int d = e >> 4, cc = e & 15; Vt[d * 168 + 144 + cc] = (bf16)0; }
        __syncthreads();
        if (F.wave == 0) { const int gq = r16 >> 2, tq = r16 & 3; const size_t row = (size_t)MP + b * TS + tq; const int hq = hkv * 4 + gq;
            const int relb[4] = {WIN + 0, WIN + 1, WIN + 2, WIN + 3};
            const float sk = sinks[hkv * 4 + q]; const float snk[4] = {sk, sk, sk, sk};
            swa_tile(Kw, Vt, 168, Pw, 0, 0, PROJ + row * C_IN + hq * 64, H + row * D + hq * 64, relb, snk, F.lane); }
        __syncthreads();
    }
}
__device__ __forceinline__ void final_norm(Frame& F, const float* g) {
    f32x4 gv[4];
#pragma unroll
    for (int j = 0; j < 4; ++j) gv[j] = ((const f32x4*)g)[F.lane + 64 * j];
    for (int m = GW_ID(F); m < M; m += GW_N(F)) {
        f32x4* xr = (f32x4*)(F.out + (size_t)m * D); f32x4 v[4]; float ss = 0.f;
#pragma unroll
        for (int j = 0; j < 4; ++j) { v[j] = xr[F.lane + 64 * j]; ss += (v[j].x * v[j].x + v[j].y * v[j].y) + (v[j].z * v[j].z + v[j].w * v[j].w); }
        const float rs = 1.0f / sqrtf(wave_sum(ss) * (1.0f / D) + EPS);
#pragma unroll
        for (int j = 0; j < 4; ++j) xr[F.lane + 64 * j] = v[j] * rs * gv[j];
    }
}

#ifndef MK_ONLY
#define MK_ONLY -1
#endif
#ifndef MK_OFF
#define MK_OFF -2
#endif
#define EN(x) ((MK_ONLY < 0 || MK_ONLY == (x)) && MK_OFF != (x))
#ifndef MK_MULTI
#define MK_MULTI 0
#endif
constexpr int N_PHASES = DEPTH * 10 + 1;
struct Args { const float* in[30]; float* out; unsigned char* ws; int ph_lo, ph_hi; };
__host__ __device__ __forceinline__ bool phase_empty(int ph) { if (ph >= DEPTH * 10) return false; const int layer = ph / 10, st = ph % 10; return (layer % 3 == 2) && (st == 3 || st == 4); }

__global__ void __launch_bounds__(NTHR, 2) trunk_fwd(Args args) {
    extern __shared__ __attribute__((aligned(16))) unsigned char lds[];
    Frame F;
    F.lds = (LAS unsigned char*)lds;
    F.MISC = (volatile LAS unsigned*)(F.lds + MISC_OFF);
    F.tid = threadIdx.x; F.lane = F.tid & 63; F.wave = __builtin_amdgcn_readfirstlane(F.tid >> 6);
    F.G = gridDim.x; { const int bx = blockIdx.x; F.vcu = (F.G % 8 == 0) ? (bx % 8) * (F.G / 8) + bx / 8 : bx; }
    const int vcu0 = F.vcu;
    F.out = args.out; F.ws = args.ws; F.ctl = (unsigned*)(args.ws + WS_CTL);
    for (int u = F.tid; u < (LDS_BYTES - LDSCTL_OFF) / 4; u += NTHR) ((LAS unsigned*)(F.lds + LDSCTL_OFF))[u] = 0u;
    __syncthreads();
    const int lo = args.ph_lo, hi = args.ph_hi;
    XcdBarrier bar; bar.bar = F.ctl + CW_BAR; bar.x = 0; bar.st = nullptr;
    if (hi - lo > 1) bar = xcd_barrier_post(F.ctl + CW_BAR, F.MISC + 8);

    bf16* WT_IN = (bf16*)(F.ws + WS_WIN); bf16* WT_OUT = (bf16*)(F.ws + WS_WOUT); bf16* WT_UP = (bf16*)(F.ws + WS_WUP); bf16* WT_DN = (bf16*)(F.ws + WS_WDN);
    bf16* XN = (bf16*)(F.ws + WS_XN); bf16* HB_ = (bf16*)(F.ws + WS_H); float* GATES = (float*)(F.ws + WS_GATES);

    for (int ph = lo; ph < hi; ++ph) {
        if (phase_empty(ph)) continue;
        { int t_ = threadIdx.x; asm volatile("" : "+v"(t_)); F.tid = t_; F.lane = t_ & 63; F.wave = __builtin_amdgcn_readfirstlane(t_ >> 6);
          int g_ = gridDim.x, v_ = vcu0; asm volatile("" : "+s"(g_), "+s"(v_)); F.G = g_; F.vcu = v_; }
        if (ph == DEPTH * 10) { if (EN(10)) final_norm(F, args.in[11]); continue; }
        const int layer = ph / 10, st = ph % 10, kind = layer % 3, j = layer / 3;
        if (st == 0 && EN(0)) {
            const float* win = (kind == 0) ? args.in[12] + (size_t)j * D * A_IN : (kind == 1) ? args.in[17] : args.in[22];
            const float* wout = (kind == 0) ? args.in[16] + (size_t)j * D * D : (kind == 1) ? args.in[21] : args.in[25];
            const int ldw = (kind == 2) ? C_IN : A_IN, nin = (kind == 2) ? C_IN : NPROJ;
            const int sb = (kind == 0) ? 512 : 0, se = (kind == 0) ? 1024 : (kind == 1) ? 512 : 0; const float sv = (kind == 0) ? 0.125f : 0.08838834764831845f;
            prep_two(F, win, ldw, D, nin, WT_IN, sb, se, sv, wout, D, D, D, WT_OUT);
            const float* xp = (layer == 0) ? args.in[0] : F.out; const float* xs = (layer == 0) ? args.in[1] : F.out + (size_t)MP * D; float* xd = (layer == 0) ? F.out : nullptr;
            const float* g = args.in[9] + (size_t)layer * D;
            if (kind < 2) { __syncthreads(); stage_wgT(F, win, A_IN, NPROJ, (LAS float*)F.lds); __syncthreads();
                norm_rows<true>(F, xp, xs, xd, g, XN, GATES, (const LAS float*)F.lds); }
            else norm_rows<false>(F, xp, xs, xd, g, XN, nullptr, nullptr);
        } else if ((st == 1 || st == 7 || st == 5 || st == 9) && EN(1)) {
            const bool pj = (st == 1 || st == 7);
            const int N = (st == 7) ? 2 * DFF : (st == 1) ? ((kind == 2) ? C_IN : NPROJ) : D, K = (st == 9) ? DFF : D;
            const bf16* A = pj ? XN : (st == 5) ? HB_ : (const bf16*)(F.ws + WS_ACT);
            const bf16* Bt = (st == 1) ? WT_IN : (st == 7) ? WT_UP : (st == 5) ? WT_OUT : WT_DN;
            pg8::Gemm g{A, Bt, M, N, K}; pg8::StaticOrder S; S.init(M, N, F.G, (int)blockIdx.x);
            pg8::EpiDual E{pj, (bf16*)(F.ws + WS_PROJ), F.out, N, (st == 1 && kind == 2) ? args.in[23] : nullptr};
            pg8::gemm_phase<pg8::EpiDual, pg8::StaticOrder, true, true>(F.lds, g, S, E);
        } else if (st == 2) {
            if (kind == 0) { if (EN(20)) mlstm_A(F, args.in[13] + j * HA, args.in[14] + j * HA); if (EN(21)) mlstm_S(F, j, args.in[13] + j * HA, args.in[14] + j * HA, args.in[15], args.in[2], args.in[3], args.in[4]); }
            else if (kind == 1) { if (EN(22)) gla_A(F, args.in[18], args.in[19]); if (EN(23)) gla_S(F, args.in[18], args.in[19], args.in[20], args.in[5]); }
            else { if (EN(24)) swa_prompt(F, args.in[24]); if (EN(25)) swa_sample(F, args.in[24], args.in[6], args.in[7]); }
        } else if (st == 3) {
            if (kind == 0) { if (EN(30)) mlstm_B(F, j); } else { if (EN(31)) gla_B(F); }
        } else if (st == 4) {
            if (kind == 0) { if (EN(40)) mlstm_C(F, j, args.in[13] + j * HA, args.in[14] + j * HA, args.in[15]); } else { if (EN(41)) gla_C(F, args.in[18], args.in[19], args.in[20]); }
        } else if (st == 6 && EN(6)) {
            prep_two(F, args.in[26] + (size_t)layer * D * 2 * DFF, 2 * DFF, D, 2 * DFF, WT_UP, 0, 0, 1.0f, args.in[29] + (size_t)layer * DFF * D, D, DFF, D, WT_DN);
            norm_rows<false>(F, F.out, F.out + (size_t)MP * D, nullptr, args.in[10] + (size_t)layer * D, XN, nullptr, nullptr);
        } else if (st == 8 && EN(8)) {
            convact_phase(F, layer, args.in[8], args.in[27], args.in[28]);
        }
        if (ph + 1 < hi) xcd_barrier(bar);
    }
}

extern "C" void kernel_launch(void* const* d_in, const int* in_sizes, int n_in, void* d_out, int out_size, void* d_ws, size_t ws_size, hipStream_t stream) {
    static int grid = 0;
    if (grid == 0) {
        if (n_in != 30 || (size_t)out_size != O_END || ws_size < WS_END) { fprintf(stderr, "kernel_launch: built for 30 inputs, %zu outputs, >= %zu bytes of workspace; got n_in %d, out %d, ws %zu; nothing launched\n", (size_t)O_END, (size_t)WS_END, n_in, out_size, ws_size); grid = -1; return; }
        int dev = 0, cus = 0, per_cu = 0;
        if (hipGetDevice(&dev) != hipSuccess || hipDeviceGetAttribute(&cus, hipDeviceAttributeMultiprocessorCount, dev) != hipSuccess) { fprintf(stderr, "kernel_launch: device query failed\n"); grid = -1; return; }
        if (hipFuncSetAttribute((const void*)trunk_fwd, hipFuncAttributeMaxDynamicSharedMemorySize, LDS_BYTES) != hipSuccess) { fprintf(stderr, "kernel_launch: hipFuncSetAttribute failed\n"); grid = -1; return; }
        if (hipOccupancyMaxActiveBlocksPerMultiprocessor(&per_cu, (const void*)trunk_fwd, NTHR, LDS_BYTES) != hipSuccess || per_cu < 1) { fprintf(stderr, "kernel_launch: occupancy query says %d workgroups per CU\n", per_cu); }
        (void)hipGetLastError();
        grid = cus;
    }
    if (grid < 0) return;
    if (hipMemsetAsync((char*)d_ws + WS_CTL, 0, CTL_ZERO_BYTES, stream) != hipSuccess) { fprintf(stderr, "kernel_launch: hipMemsetAsync failed\n"); return; }
    Args a{};
    for (int i = 0; i < 30; ++i) a.in[i] = (const float*)d_in[i];
    a.out = (float*)d_out; a.ws = (unsigned char*)d_ws;
#if MK_MULTI
    for (int ph = 0; ph < N_PHASES; ++ph) { if (phase_empty(ph)) continue; a.ph_lo = ph; a.ph_hi = ph + 1;
        hipLaunchKernelGGL(trunk_fwd, dim3(grid), dim3(NTHR), LDS_BYTES, stream, a); }
#else
    a.ph_lo = 0; a.ph_hi = N_PHASES;
    hipLaunchKernelGGL(trunk_fwd, dim3(grid), dim3(NTHR), LDS_BYTES, stream, a);
#endif
    const hipError_t le = hipPeekAtLastError();
    if (le != hipSuccess) fprintf(stderr, "kernel_launch: launch failed: %s\n", hipGetErrorName(le));
}
```

```cpp
#include <hip/hip_runtime.h>
#include <cstdio>
#include <cstdint>
#define MK_MULTI 0
#define MK_REP 0
namespace pg8 {
#define PG8_LAS __attribute__((address_space(3)))
typedef unsigned short bf16_t;
typedef short bf16x8 __attribute__((ext_vector_type(8)));
typedef float f32x4 __attribute__((ext_vector_type(4)));
typedef unsigned u32x4 __attribute__((ext_vector_type(4)));
constexpr int BM = 256, BK = 64, HALF = 128, HTB = HALF * BK * 2  , STAGE_BYTES = 8 * HTB, NXCD = 8, WGM = 8;

__host__ __device__ __forceinline__ int lds_byte(int r, int c) { const int st = (r >> 4) * 2 + (c >> 5), rr = r & 15, cc = c & 31, ob = rr * 64 + cc * 2; return st * 1024 + (ob ^ (((ob >> 9) & 1) << 5)); }
__host__ __device__ __forceinline__ void stage_rc(int b, int& R, int& C) { const int st = b / 1024, sb = b % 1024, swz = sb ^ (((sb >> 9) & 1) << 5); R = (st >> 1) * 16 + swz / 64; C = (st & 1) * 32 + (swz % 64) / 2; }
__host__ __device__ __forceinline__ int perm32(int rho) { const int n = rho >> 4, i = rho & 15; return 8 * (i >> 2) + 4 * n + (i & 3); }

struct Unit { int pm, pn, k0, nt, mode; };
struct Gemm { const bf16_t* A; const bf16_t* Bt; int M, N, K; };

struct StaticOrder {
    int nM, nN, nwg, G, c, ntk, nsub, ks, kl;
    __host__ __device__ __forceinline__ void init(int M, int N, int G_, int c_, int K_, int nsub_ = 0, int ks_ = 1) { nM = M / BM; nN = N / BM; nwg = nM * nN; G = G_; c = c_; ntk = K_ / BK; nsub = nsub_; ks = ks_; kl = K_ / ks_; }
    __host__ __device__ __forceinline__ bool next(int i, Unit& u) const {
        const long L = (long)i * G + c; if (L >= nwg + nsub) return false;
        int pm, pn, k0, nt_, mode;
        if (L >= nwg) { const int e = (int)L - nwg, sl = e % ks, u8 = e / ks; pm = nM + u8 / nN; pn = u8 % nN; k0 = sl * kl; nt_ = kl / BK; mode = 1; }
        else {
            int wgid = (int)L; { const int q = nwg / NXCD, r = nwg % NXCD, xcd = wgid % NXCD, off = wgid / NXCD; wgid = (xcd < r ? xcd * (q + 1) : r * (q + 1) + (xcd - r) * q) + off; }
            const int nig = WGM * nN, gid = wgid / nig, fm = gid * WGM, gsz = (nM - fm) < WGM ? (nM - fm) : WGM;
            pm = fm + ((wgid % nig) % gsz); pn = (wgid % nig) / gsz; k0 = 0; nt_ = ntk; mode = 0; }
        u.pm = pm; u.pn = pn; u.k0 = k0; u.nt = nt_; u.mode = mode; return true;
    }
    __device__ __forceinline__ void a_ready(const Unit&) const {}
    __device__ __forceinline__ void done(const Unit&) const {}
};

__device__ __forceinline__ unsigned cvt_pk_bf16(float lo, float hi) { unsigned r; asm volatile("v_cvt_pk_bf16_f32 %0, %1, %2" : "=v"(r) : "v"(lo), "v"(hi)); return r; }
typedef float f32x2 __attribute__((ext_vector_type(2)));
struct EpiBf16 {
    static constexpr bool PERM = true, AFTER_DRAIN = false;
    bf16_t* O; int ldc; const float* bias;
    __device__ __forceinline__ void operator()(const f32x4 (&acc)[2][2][4][2], const Unit& u, int wr, int wc, int fr, int fq) const {
        const int row0 = u.pm * BM + wr * 64 + fr; const int col0 = u.pn * BM + wc * 32 + 8 * fq;
        f32x4 bv[2][2];
#pragma unroll
        for (int bj = 0; bj < 2; ++bj)
#pragma unroll
            for (int n = 0; n < 2; ++n) bv[bj][n] = bias ? *(const f32x4*)(bias + col0 + bj * HALF + 4 * n) : (f32x4){0.f, 0.f, 0.f, 0.f};
#pragma unroll
        for (int ai = 0; ai < 2; ++ai)
#pragma unroll
            for (int m = 0; m < 4; ++m) { bf16_t* rowp = O + (size_t)(row0 + ai * HALF + m * 16) * ldc + col0;
#pragma unroll
                for (int bj = 0; bj < 2; ++bj) { const f32x4 v0 = acc[ai][bj][m][0] + bv[bj][0], v1 = acc[ai][bj][m][1] + bv[bj][1];
                    u32x4 w; w.x = cvt_pk_bf16(v0[0], v0[1]); w.y = cvt_pk_bf16(v0[2], v0[3]); w.z = cvt_pk_bf16(v1[0], v1[1]); w.w = cvt_pk_bf16(v1[2], v1[3]);
                    *(u32x4*)(rowp + bj * HALF) = w; } }
    }
};
struct EpiRes {
    static constexpr bool PERM = false, AFTER_DRAIN = false;
    float* X; int ldc;
    __device__ __forceinline__ void operator()(const f32x4 (&acc)[2][2][4][2], const Unit& u, int wr, int wc, int fr, int fq) const {
        const int row0 = u.pm * BM + wr * 64 + fr, col0 = u.pn * BM + wc * 32 + 4 * fq;
#pragma unroll
        for (int ai = 0; ai < 2; ++ai)
#pragma unroll
            for (int m = 0; m < 4; ++m) { float* rowp = X + (size_t)(row0 + ai * HALF + m * 16) * ldc + col0;
                f32x4 b[2][2];
#pragma unroll
                for (int bj = 0; bj < 2; ++bj)
#pragma unroll
                    for (int n = 0; n < 2; ++n) b[bj][n] = *(const f32x4*)(rowp + bj * HALF + n * 16);
#pragma unroll
                for (int bj = 0; bj < 2; ++bj)
#pragma unroll
                    for (int n = 0; n < 2; ++n) *(f32x4*)(rowp + bj * HALF + n * 16) = b[bj][n] + acc[ai][bj][m][n];
                asm volatile("" ::: "memory"); }
    }
};
struct EpiConvAct {
    bf16_t* ACT; bf16_t* U; const float* cw; const float* cb; PG8_LAS float* xch; int first_raw_tile;
    __device__ __forceinline__ void operator()(const f32x4 (&acc)[2][2][4][2], const Unit& u, int wr, int wc, int fr, int fq) const {
        constexpr int FF = 2816;
        asm volatile("" : "+v"(fr), "+v"(fq), "+s"(wr), "+s"(wc));
        const int lane = fq * 16 + fr, fb_t = wc * 32 + 8 * fq, fb = u.pn * 128 + fb_t;
        const bool rawtile = u.pm >= first_raw_tile;
        if (fr >= 14) {
#pragma unroll
            for (int ai = 0; ai < 2; ++ai) { PG8_LAS float* xp = xch + ((ai * 2 + wr) * 2 + (fr - 14)) * 128 + fb_t;
#pragma unroll
                for (int n = 0; n < 2; ++n) *(PG8_LAS f32x4*)(xp + 4 * n) = acc[ai][0][3][n]; }
        }
        float w0[8], w1[8], w2[8], bb[8];
#pragma unroll
        for (int n = 0; n < 2; ++n) { const f32x4 a = *(const f32x4*)(cw + fb + 4 * n), b = *(const f32x4*)(cw + FF + fb + 4 * n), c = *(const f32x4*)(cw + 2 * FF + fb + 4 * n), d = *(const f32x4*)(cb + fb + 4 * n);
#pragma unroll
            for (int e = 0; e < 4; ++e) { w0[4 * n + e] = a[e]; w1[4 * n + e] = b[e]; w2[4 * n + e] = c[e]; bb[4 * n + e] = d[e]; } }
        asm volatile("s_waitcnt lgkmcnt(0)" ::: "memory"); __builtin_amdgcn_s_barrier(); asm volatile("" ::: "memory");
        const int s1 = (lane & 48) | ((fr + 15) & 15), s2 = (lane & 48) | ((fr + 14) & 15);
#pragma unroll
        for (int ai = 0; ai < 2; ++ai) {
            float p1[8], p2[8];
            const int pb = ai * 2 + wr - 1;
#pragma unroll
            for (int i = 0; i < 8; ++i) { p1[i] = 0.f; p2[i] = 0.f; }
            if (pb >= 0 && fr < 2) { const PG8_LAS float* x63 = xch + (pb * 2 + 1) * 128 + fb_t; const PG8_LAS float* x62 = xch + (pb * 2 + 0) * 128 + fb_t;
#pragma unroll
                for (int i = 0; i < 8; ++i) { const float a63 = x63[i], a62 = x62[i]; p1[i] = a63; p2[i] = (fr == 0) ? a62 : a63; } }
#pragma unroll
            for (int m = 0; m < 4; ++m) {
                const size_t row = (size_t)u.pm * BM + ai * HALF + wr * 64 + m * 16 + fr;
                float o[8];
#pragma unroll
                for (int n = 0; n < 2; ++n)
#pragma unroll
                    for (int e = 0; e < 4; ++e) { const int i = 4 * n + e; const float g0 = acc[ai][0][m][n][e];
                        const float r1 = __shfl(g0, s1), r2 = __shfl(g0, s2);
                        const float g1 = (fr >= 1) ? r1 : p1[i], g2 = (fr >= 2) ? r2 : p2[i];
                        p1[i] = r1; p2[i] = r2;
                        const float cv = bb[i] + w0[i] * g2 + w1[i] * g1 + w2[i] * g0;
                        o[i] = cv / (1.0f + __expf(-cv)) * acc[ai][1][m][n][e]; }
                if (!rawtile) { u32x4 w; w.x = cvt_pk_bf16(o[0], o[1]); w.y = cvt_pk_bf16(o[2], o[3]); w.z = cvt_pk_bf16(o[4], o[5]); w.w = cvt_pk_bf16(o[6], o[7]); *(u32x4*)(ACT + row * FF + fb) = w; }
                const bool rawrow = rawtile || (ai == 0 && wr == 0 && m == 0 && fr < 2) || (ai == 1 && wr == 1 && m == 3 && fr >= 14);
                if (rawrow) { const f32x4 a0 = acc[ai][0][m][0], a1 = acc[ai][0][m][1], b0 = acc[ai][1][m][0], b1 = acc[ai][1][m][1];
                    u32x4 w; w.x = cvt_pk_bf16(a0[0], a0[1]); w.y = cvt_pk_bf16(a0[2], a0[3]); w.z = cvt_pk_bf16(a1[0], a1[1]); w.w = cvt_pk_bf16(a1[2], a1[3]); *(u32x4*)(U + row * (2 * FF) + fb) = w;
                    w.x = cvt_pk_bf16(b0[0], b0[1]); w.y = cvt_pk_bf16(b0[2], b0[3]); w.z = cvt_pk_bf16(b1[0], b1[1]); w.w = cvt_pk_bf16(b1[2], b1[3]); *(u32x4*)(U + row * (2 * FF) + FF + fb) = w; }
                __builtin_amdgcn_sched_barrier(0);
            }
        }
    }
};
struct EpiDual {
    static constexpr bool AFTER_DRAIN = false;
    bool PERM; bf16_t* O; float* X; int ldc; const float* bias; float* slab; int row_base, kl; bool conv; EpiConvAct ca;
    __device__ __forceinline__ void operator()(const f32x4 (&acc)[2][2][4][2], const Unit& u, int wr, int wc, int fr, int fq) const {
        asm volatile("" : "+v"(fr), "+v"(fq), "+s"(wr), "+s"(wc));
        if (u.mode == 1) {
            float* sb = slab + (size_t)(u.k0 / kl) * 512 * ldc; const int row0 = u.pm * BM - row_base + wr * 64 + fr, col0 = u.pn * BM + wc * 32 + 4 * fq;
#pragma unroll
            for (int ai = 0; ai < 2; ++ai)
#pragma unroll
                for (int m = 0; m < 4; ++m) { float* rowp = sb + (size_t)(row0 + ai * HALF + m * 16) * ldc + col0;
#pragma unroll
                    for (int bj = 0; bj < 2; ++bj)
#pragma unroll
                        for (int n = 0; n < 2; ++n) *(f32x4*)(rowp + bj * HALF + n * 16) = acc[ai][bj][m][n]; }
        } else if (conv) { ca(acc, u, wr, wc, fr, fq);
        } else if (PERM) { EpiBf16 e{O, ldc, bias}; e(acc, u, wr, wc, fr, fq); } else { EpiRes e{X, ldc}; e(acc, u, wr, wc, fr, fq); }
    }
};
template <class Epi, class Sched, bool ALIGN_EPI = false, bool SP2 = false>
__device__ __forceinline__ void gemm_phase(PG8_LAS unsigned char* lds, const Gemm g, const Sched& S, const Epi& E) {
    int tid_ = threadIdx.x; asm volatile("" : "+v"(tid_));
    const int tid = tid_, wid = __builtin_amdgcn_readfirstlane(tid >> 6), lane = tid & 63, wr = wid >> 2, wc = wid & 3, fr = lane & 15, fq = lane >> 4;
    const int K = g.K;
    unsigned voffA[2], voffB[2];
#pragma unroll
    for (int i = 0; i < 2; ++i) { int R, C; stage_rc(tid * 16 + i * 8192, R, C); const int Rb = E.PERM ? ((R & ~31) + perm32(R & 31)) : R;
        voffA[i] = (unsigned)(R * K + C) * 2u; voffB[i] = (unsigned)(Rb * K + C) * 2u; }
    const size_t kstep = (size_t)(BK * 2);
    const size_t hstep = (size_t)HALF * K * 2;
    const size_t tstep = 2 * hstep;
    const unsigned ldsw = (unsigned)wid * 1024u;
    const int aoff = lds_byte(wr * 64 + fr, fq * 8), boff = lds_byte(wc * 32 + fr, fq * 8);
#define PG8_SA(b, h) (((b) * 2 + (h)) * HTB)
#define PG8_SB(b, h) ((4 + (b) * 2 + (h)) * HTB)
#define PG8_STAGE(bufoff, gbase, voff) do { _Pragma("unroll") for (int _i = 0; _i < 2; ++_i) \
        __builtin_amdgcn_global_load_lds((const unsigned*)((const char*)(gbase) + (voff)[_i]), (PG8_LAS unsigned*)(lds + (bufoff) + ldsw + _i * 8192), 16, 0, 0); } while (0)
#define PG8_LDA(dst, b, h) do { _Pragma("unroll") for (int m = 0; m < 4; ++m) _Pragma("unroll") for (int k = 0; k < 2; ++k) dst[m][k] = *(const PG8_LAS bf16x8*)(lds + PG8_SA(b, h) + aoff + m * 2048 + k * 1024); } while (0)
#define PG8_LDB(dst, b, h) do { _Pragma("unroll") for (int n = 0; n < 2; ++n) _Pragma("unroll") for (int k = 0; k < 2; ++k) dst[n][k] = *(const PG8_LAS bf16x8*)(lds + PG8_SB(b, h) + boff + n * 2048 + k * 1024); } while (0)
#define PG8_MMA(ai, bj, At, Bt) do { __builtin_amdgcn_s_setprio(1); _Pragma("unroll") for (int m = 0; m < 4; ++m) _Pragma("unroll") for (int n = 0; n < 2; ++n) _Pragma("unroll") for (int k = 0; k < 2; ++k) \
        acc[ai][bj][m][n] = __builtin_amdgcn_mfma_f32_16x16x32_bf16(Bt[n][k], At[m][k], acc[ai][bj][m][n], 0, 0, 0); __builtin_amdgcn_s_setprio(0); } while (0)
#define PG8_WAIT_V(n) asm volatile("s_waitcnt vmcnt(" #n ")" ::: "memory")
#define PG8_WAIT_L(n) asm volatile("s_waitcnt lgkmcnt(" #n ")" ::: "memory")
#define PG8_BAR __builtin_amdgcn_s_barrier()
#define PG8_SCHED __builtin_amdgcn_sched_barrier(0)
    Unit cur, nxt; int ui = 0;
    if (!S.next(0, cur)) return;
    f32x4 acc[2][2][4][2];
#pragma unroll
    for (int a = 0; a < 2; ++a)
#pragma unroll
        for (int b = 0; b < 2; ++b)
#pragma unroll
            for (int m = 0; m < 4; ++m)
#pragma unroll
                for (int n = 0; n < 2; ++n) acc[a][b][m][n] = (f32x4){0.f, 0.f, 0.f, 0.f};
    bf16x8 At[4][2], B0[2][2], B1[2][2];
    const char* cA = (const char*)g.A + (size_t)cur.pm * tstep + (size_t)cur.k0 * 2; const char* cB = (const char*)g.Bt + (size_t)cur.pn * tstep + (size_t)cur.k0 * 2;
    S.a_ready(cur);
    if constexpr (SP2) {
        PG8_STAGE(PG8_SB(0, 0), cB, voffB); PG8_STAGE(PG8_SB(0, 1), cB + hstep, voffB); PG8_STAGE(PG8_SA(0, 0), cA, voffA); PG8_STAGE(PG8_SA(0, 1), cA + hstep, voffA);
        if (wr == 1) PG8_BAR;
        PG8_WAIT_V(2); PG8_BAR;
        PG8_STAGE(PG8_SB(1, 0), cB + kstep, voffB); PG8_STAGE(PG8_SA(1, 0), cA + kstep, voffA); PG8_STAGE(PG8_SB(1, 1), cB + hstep + kstep, voffB);
        PG8_WAIT_V(6); PG8_BAR;
    } else {
        PG8_STAGE(PG8_SB(0, 0), cB, voffB); PG8_STAGE(PG8_SA(0, 0), cA, voffA); PG8_STAGE(PG8_SB(0, 1), cB + hstep, voffB); PG8_STAGE(PG8_SA(0, 1), cA + hstep, voffA);
        if (wr == 1) PG8_BAR;
        PG8_WAIT_V(4); PG8_BAR;
        PG8_STAGE(PG8_SB(1, 0), cB + kstep, voffB); PG8_STAGE(PG8_SA(1, 0), cA + kstep, voffA); PG8_STAGE(PG8_SB(1, 1), cB + hstep + kstep, voffB);
        PG8_WAIT_V(6); PG8_BAR;
    }
    for (;;) {
        const bool has_next = S.next(ui + 1, nxt);
        const char* nA = has_next ? (const char*)g.A + (size_t)nxt.pm * tstep + (size_t)nxt.k0 * 2 : cA; const char* nB = has_next ? (const char*)g.Bt + (size_t)nxt.pn * tstep + (size_t)nxt.k0 * 2 : cB;
        const int nt = cur.nt;
        for (int t = 0; t < nt; t += 2) {
            const bool last = (t == nt - 2);
            const char* a1 = cA + (size_t)(t + 1) * kstep;
            const char* a2 = last ? nA : cA + (size_t)(t + 2) * kstep; const char* b2 = last ? nB : cB + (size_t)(t + 2) * kstep;
            const char* a3 = a2 + kstep; const char* b3 = b2 + kstep;
            if (last && has_next) S.a_ready(nxt);
            if constexpr (SP2) {
            PG8_LDB(B0, 0, 0); PG8_LDB(B1, 0, 1); PG8_SCHED; PG8_LDA(At, 0, 0); PG8_STAGE(PG8_SA(1, 1), a1 + hstep, voffA);
            PG8_WAIT_V(8); PG8_WAIT_L(0); PG8_BAR; PG8_MMA(0, 0, At, B0); PG8_MMA(0, 1, At, B1); PG8_BAR; PG8_SCHED;
            PG8_LDA(At, 0, 1); PG8_STAGE(PG8_SB(0, 0), b2, voffB); PG8_STAGE(PG8_SB(0, 1), b2 + hstep, voffB); PG8_STAGE(PG8_SA(0, 0), a2, voffA);
            PG8_WAIT_V(8); PG8_WAIT_L(0); PG8_BAR; PG8_MMA(1, 0, At, B0); PG8_MMA(1, 1, At, B1); PG8_BAR; PG8_SCHED;
            PG8_LDB(B0, 1, 0); PG8_LDB(B1, 1, 1); PG8_SCHED; PG8_LDA(At, 1, 0); PG8_STAGE(PG8_SA(0, 1), a2 + hstep, voffA);
            PG8_WAIT_V(8); PG8_WAIT_L(0); PG8_BAR; PG8_MMA(0, 0, At, B0); PG8_MMA(0, 1, At, B1); PG8_BAR; PG8_SCHED;
            PG8_LDA(At, 1, 1); PG8_STAGE(PG8_SB(1, 0), b3, voffB); PG8_STAGE(PG8_SB(1, 1), b3 + hstep, voffB); PG8_STAGE(PG8_SA(1, 0), a3, voffA);
            PG8_WAIT_V(8); PG8_WAIT_L(0); PG8_BAR; PG8_MMA(1, 0, At, B0); PG8_MMA(1, 1, At, B1); PG8_BAR; PG8_SCHED;
            } else {
            PG8_LDB(B0, 0, 0); PG8_SCHED; PG8_LDA(At, 0, 0); PG8_STAGE(PG8_SA(1, 1), a1 + hstep, voffA);
            PG8_WAIT_L(8); PG8_BAR; PG8_WAIT_L(0); PG8_MMA(0, 0, At, B0); PG8_BAR; PG8_SCHED;
            PG8_LDB(B1, 0, 1); PG8_STAGE(PG8_SB(0, 0), b2, voffB);
            PG8_BAR; PG8_WAIT_L(0); PG8_MMA(0, 1, At, B1); PG8_BAR;
            PG8_LDA(At, 0, 1); PG8_STAGE(PG8_SA(0, 0), a2, voffA);
            PG8_BAR; PG8_WAIT_L(0); PG8_MMA(1, 0, At, B0); PG8_BAR; PG8_SCHED;
            PG8_STAGE(PG8_SB(0, 1), b2 + hstep, voffB);
            PG8_WAIT_V(6); PG8_BAR; PG8_MMA(1, 1, At, B1); PG8_BAR;
            PG8_LDB(B0, 1, 0); PG8_SCHED; PG8_LDA(At, 1, 0); PG8_STAGE(PG8_SA(0, 1), a2 + hstep, voffA);
            PG8_WAIT_L(8); PG8_BAR; PG8_WAIT_L(0); PG8_MMA(0, 0, At, B0); PG8_BAR; PG8_SCHED;
            PG8_LDB(B1, 1, 1); PG8_STAGE(PG8_SB(1, 0), b3, voffB);
            PG8_BAR; PG8_WAIT_L(0); PG8_MMA(0, 1, At, B1); PG8_BAR;
            PG8_LDA(At, 1, 1); PG8_STAGE(PG8_SA(1, 0), a3, voffA);
            PG8_BAR; PG8_WAIT_L(0); PG8_MMA(1, 0, At, B0); PG8_BAR; PG8_SCHED;
            PG8_STAGE(PG8_SB(1, 1), b3 + hstep, voffB);
            PG8_WAIT_V(6); PG8_BAR; PG8_MMA(1, 1, At, B1); PG8_BAR;
            }
        }
        if constexpr (ALIGN_EPI) { if (wr == 0) PG8_BAR; }
        if constexpr (!Epi::AFTER_DRAIN) { E(acc, cur, wr, wc, fr, fq); S.done(cur); }
        if (!has_next) break;
#pragma unroll
        for (int a = 0; a < 2; ++a)
#pragma unroll
            for (int b = 0; b < 2; ++b)
#pragma unroll
                for (int m = 0; m < 4; ++m)
#pragma unroll
                    for (int n = 0; n < 2; ++n) acc[a][b][m][n] = (f32x4){0.f, 0.f, 0.f, 0.f};
        cur = nxt; cA = nA; cB = nB; ++ui;
        if constexpr (ALIGN_EPI) { if (wr == 1) PG8_BAR; }
    }
    PG8_WAIT_V(0);
    if constexpr (!ALIGN_EPI) { if (wr == 0) PG8_BAR; }
    PG8_BAR;
    if constexpr (Epi::AFTER_DRAIN) { E.fused(acc, cur, wr, wc, fr, fq, lds, wid, lane); S.done(cur); }
#undef PG8_SA
#undef PG8_SB
#undef PG8_STAGE
#undef PG8_LDA
#undef PG8_LDB
#undef PG8_MMA
#undef PG8_WAIT_V
#undef PG8_WAIT_L
#undef PG8_BAR
#undef PG8_SCHED
}
}
constexpr int NWAVES = 8, NTHR = 512;
constexpr int D = 1024, BP = 4, TP = 4096, MP = BP * TP, BS = 128, TS = 4, MS = BS * TS, M = MP + MS;
constexpr int DEPTH = 4;
constexpr int HA = 8, DKA = 64, DVA = 128;
constexpr int HB = 4, DKB = 128, DVB = 256, RANK = 16;
constexpr int HC = 16, HKV = 4, HDC = 64, GROUP = 4, WIN = 128;
constexpr int DFF = 2816, A_IN = 3088, B_IN = 3088, C_IN = 1536, NPROJ = 3072;
constexpr int NCH = 64, LCH = 64;
constexpr float EPS = 1e-6f, SOFTCAP = 15.0f;

constexpr size_t O_YP = 0, O_YS = O_YP + (size_t)MP * D, O_PAC = O_YS + (size_t)MS * D, O_PAN = O_PAC + 2ull * BP * HA * DKA * DVA, O_PAM = O_PAN + 2ull * BP * HA * DKA,
    O_PG = O_PAM + 2ull * BP * HA, O_PSK = O_PG + (size_t)BP * HB * DKB * DVB, O_PSV = O_PSK + (size_t)BP * WIN * HKV * HDC, O_PF = O_PSV + (size_t)BP * WIN * HKV * HDC,
    O_SAC = O_PF + 4ull * BP * 2 * DFF, O_SAN = O_SAC + 2ull * BS * HA * DKA * DVA, O_SAM = O_SAN + 2ull * BS * HA * DKA, O_SG = O_SAM + 2ull * BS * HA,
    O_SSK = O_SG + (size_t)BS * HB * DKB * DVB, O_SSV = O_SSK + (size_t)BS * WIN * HKV * HDC, O_SF = O_SSV + (size_t)BS * WIN * HKV * HDC, O_END = O_SF + 4ull * BS * 2 * DFF;
static_assert(O_END == 63666240ull, "output size");

constexpr size_t MiB = 1u << 20;
constexpr size_t WS_CTL = 0, CTL_ZERO_BYTES = 1 * MiB;
constexpr size_t WS_WIN = 1 * MiB, WS_WOUT = 7 * MiB, WS_WUP = 9 * MiB, WS_WDN = 20 * MiB;
constexpr size_t WS_GATES = 26 * MiB;
constexpr size_t WS_XN = 28 * MiB;
constexpr size_t WS_H = 61 * MiB;
constexpr size_t WS_R1 = 94 * MiB;
constexpr size_t WS_PROJ = WS_R1;
constexpr size_t WS_SCR = WS_R1 + 99 * MiB;
constexpr size_t SC_LOC = WS_SCR;
constexpr size_t SC_ST = WS_SCR + 128 * MiB;
constexpr size_t SC_AUX = WS_SCR + 192 * MiB;
constexpr size_t WS_U = WS_R1;
constexpr size_t WS_ACT = WS_R1 + 182 * MiB;
constexpr size_t WS_END = WS_R1 + 293 * MiB;
static_assert(WS_WIN + (size_t)NPROJ * D * 2 <= WS_WOUT && WS_WOUT + (size_t)D * D * 2 <= WS_WUP && WS_WUP + 2ull * DFF * D * 2 <= WS_WDN && WS_WDN + (size_t)D * DFF * 2 <= WS_GATES, "ws map: weights");
static_assert(WS_GATES + (size_t)M * 16 * 4 <= WS_XN && WS_XN + (size_t)M * D * 2 <= WS_H && WS_H + (size_t)M * D * 2 <= WS_R1 && WS_PROJ + (size_t)M * NPROJ * 2 <= WS_SCR, "ws map: activations");
static_assert(WS_U + (size_t)M * 2 * DFF * 2 <= WS_ACT && WS_ACT + (size_t)M * DFF * 2 <= WS_END && SC_AUX + 2 * MiB <= WS_END, "ws map: ffn");
constexpr int AX_CHK = 0;
constexpr int AX_MST = 8192;
constexpr int AX_NLOC = 16384;
constexpr int AX_NST = 16384 + 131072;
constexpr int AX_BL = 0;
static_assert((AX_NST + 131072) * 4 <= (int)(2 * MiB), "aux");

constexpr int CW_BAR = 4096;

constexpr int RING_BYTES = 131072;
constexpr int LDSCTL_OFF = RING_BYTES, MISC_OFF = LDSCTL_OFF + 320;
constexpr int XCH_OFF = 132096;
constexpr int LDS_BYTES = 147456;

#define GAS __attribute__((address_space(1)))
#define LAS __attribute__((address_space(3)))
typedef unsigned short bf16;
typedef unsigned v4u __attribute__((ext_vector_type(4)));
typedef unsigned v2u __attribute__((ext_vector_type(2)));
typedef float f32x4 __attribute__((ext_vector_type(4)));
typedef float f32x2 __attribute__((ext_vector_type(2)));
typedef short bf16x8 __attribute__((ext_vector_type(8)));
#define LDS_WAIT() asm volatile("s_waitcnt lgkmcnt(0)" ::: "memory")
#define VM_WAIT() asm volatile("s_waitcnt vmcnt(0)" ::: "memory")
__device__ __forceinline__ unsigned f2bf(float f) { unsigned u = __builtin_bit_cast(unsigned, f); return (u + 0x7fffu + ((u >> 16) & 1u)) >> 16; }
__device__ __forceinline__ unsigned pk2(float lo, float hi) { return f2bf(lo) | (f2bf(hi) << 16); }
__device__ __forceinline__ float bf2f(unsigned h) { return __builtin_bit_cast(float, (h & 0xffffu) << 16); }
__device__ __forceinline__ float bflo(unsigned w) { return __builtin_bit_cast(float, w << 16); }
__device__ __forceinline__ float bfhi(unsigned w) { return __builtin_bit_cast(float, w & 0xffff0000u); }
__device__ __forceinline__ float wave_sum(float v) {
#pragma unroll
    for (int o = 1; o < 64; o <<= 1) v += __shfl_xor(v, o);
    return v;
}
__device__ __forceinline__ float wave_max(float v) {
#pragma unroll
    for (int o = 1; o < 64; o <<= 1) v = fmaxf(v, __shfl_xor(v, o));
    return v;
}
__device__ __forceinline__ float wave_scan_sum(float v, int lane) {
#pragma unroll
    for (int o = 1; o < 64; o <<= 1) { const float y = __shfl_up(v, o); if (lane >= o) v += y; }
    return v;
}
__device__ __forceinline__ float wave_scan_max(float v, int lane) {
#pragma unroll
    for (int o = 1; o < 64; o <<= 1) { const float y = __shfl_up(v, o); if (lane >= o) v = fmaxf(v, y); }
    return v;
}
__device__ __forceinline__ float logsigmoidf(float x) { return fminf(x, 0.f) - log1pf(__expf(-fabsf(x))); }
__device__ __forceinline__ float softcapf(float z) { return SOFTCAP * tanhf(z * (1.0f / SOFTCAP)); }
__device__ __forceinline__ float sigmoidf_(float x) { return 1.0f / (1.0f + __expf(-x)); }

template <int KS> __device__ __forceinline__ f32x4 mma_ll(const LAS bf16* X, int ldx, const LAS bf16* Y, int ldy, f32x4 acc, int lane) {
    const int r16 = lane & 15, q = lane >> 4;
#pragma unroll
    for (int ks = 0; ks < KS; ++ks) {
        const bf16x8 a = *(const LAS bf16x8*)(X + r16 * ldx + ks * 32 + q * 8);
        const bf16x8 b = *(const LAS bf16x8*)(Y + r16 * ldy + ks * 32 + q * 8);
        acc = __builtin_amdgcn_mfma_f32_16x16x32_bf16(a, b, acc, 0, 0, 0);
    }
    return acc;
}
template <int KS> __device__ __forceinline__ f32x4 mma_gl(const bf16* X, int ldx, const LAS bf16* Y, int ldy, f32x4 acc, int lane) {
    const int r16 = lane & 15, q = lane >> 4;
    bf16x8 a[KS];
#pragma unroll
    for (int ks = 0; ks < KS; ++ks) a[ks] = *(const bf16x8*)(X + (size_t)r16 * ldx + ks * 32 + q * 8);
#pragma unroll
    for (int ks = 0; ks < KS; ++ks) {
        const bf16x8 b = *(const LAS bf16x8*)(Y + r16 * ldy + ks * 32 + q * 8);
        acc = __builtin_amdgcn_mfma_f32_16x16x32_bf16(a[ks], b, acc, 0, 0, 0);
    }
    return acc;
}
template <int R, int C> __device__ __forceinline__ void stage_nat(LAS bf16* dst, int lld, const bf16* src, size_t gld, int tid) {
    constexpr int CP = C / 8;
    for (int p = tid; p < R * CP; p += NTHR) { const int r = p / CP, c8 = p % CP; *(LAS v4u*)(dst + r * lld + c8 * 8) = *(const v4u*)(src + (size_t)r * gld + c8 * 8); }
}
template <int R, int C> __device__ __forceinline__ void stage_tr(LAS bf16* dst, int lld, const bf16* src, size_t gld, int tid) {
    constexpr int CP = C / 8;
    for (int p = tid; p < R * CP; p += NTHR) { const int r = p % R, c8 = p / R; const v4u v = *(const v4u*)(src + (size_t)r * gld + c8 * 8);
        LAS bf16* d = dst + (c8 * 8) * lld + r;
        d[0 * lld] = (bf16)(v.x & 0xffffu); d[1 * lld] = (bf16)(v.x >> 16); d[2 * lld] = (bf16)(v.y & 0xffffu); d[3 * lld] = (bf16)(v.y >> 16);
        d[4 * lld] = (bf16)(v.z & 0xffffu); d[5 * lld] = (bf16)(v.z >> 16); d[6 * lld] = (bf16)(v.w & 0xffffu); d[7 * lld] = (bf16)(v.w >> 16); }
}
#define XB_TMO      128
#define XB_XCNT(j)  (256  + 64 * (j))
#define XB_XSUB(j)  (1280 + 64 * (j))
#define XB_XGEN(j)  (2304 + 64 * (j))
#define XB_TOP      3328
#define XB_TOPGEN   3392
#define XCD_BAR_WORDS 3456
#define XB_SPIN_CAP (1u << 18)

__device__ __forceinline__ unsigned xb_ld(unsigned* p)              { return __hip_atomic_load(p, __ATOMIC_RELAXED, __HIP_MEMORY_SCOPE_AGENT); }
__device__ __forceinline__ unsigned xb_add(unsigned* p, unsigned v) { return __hip_atomic_fetch_add(p, v, __ATOMIC_RELAXED, __HIP_MEMORY_SCOPE_AGENT); }
__device__ __forceinline__ unsigned xb_xcc_id() { return (unsigned)__builtin_amdgcn_s_getreg((3 << 11) | 20) & 0xFu; }
#define XB_SPIN(cond, bar) do { unsigned _sp = 0; while (cond) { __builtin_amdgcn_s_sleep(1); \
    if ((++_sp & 255u) == 0u) { if (xb_ld(&(bar)[XB_TMO])) break; if (_sp > XB_SPIN_CAP) { atomicAdd(&(bar)[XB_TMO], 1u); break; } } } } while (0)

struct XcdBarrier {
    unsigned* bar; unsigned x;
    volatile LAS unsigned* st;
};

__device__ __forceinline__ XcdBarrier xcd_barrier_post(unsigned* bar, volatile LAS unsigned* st) {
    XcdBarrier b; b.bar = bar; b.x = xb_xcc_id(); b.st = st;
    if (threadIdx.x == 0) (void)xb_add(&bar[XB_XCNT(b.x)], 1u);
    return b;
}
__device__ __forceinline__ void xcd_barrier_complete(unsigned* bar, unsigned x, unsigned& nloc, unsigned& nx) {
    const unsigned G = gridDim.x * gridDim.y * gridDim.z;
    unsigned sum, cnt, mine, sp = 0u;
    for (;;) {
        sum = 0u; cnt = 0u; mine = 0u;
#pragma unroll
        for (unsigned j = 0; j < 16; ++j) { const unsigned c = xb_ld(&bar[XB_XCNT(j)]); sum += c; cnt += (c > 0u) ? 1u : 0u; mine = (j == x) ? c : mine; }
        if (sum == G) break;
        __builtin_amdgcn_s_sleep(1);
        if ((++sp & 255u) == 0u) { if (xb_ld(&bar[XB_TMO])) break; if (sp > XB_SPIN_CAP) { atomicAdd(&bar[XB_TMO], 1u); break; } }
    }
    nloc = mine > 0u ? mine : 1u; nx = cnt > 0u ? cnt : 1u;
}

__device__ __forceinline__ void xcd_barrier(const XcdBarrier& b) {
    asm volatile("s_waitcnt vmcnt(0)" ::: "memory");
    __syncthreads();
    if (threadIdx.x == 0) {
        unsigned* bar = b.bar;
        __builtin_amdgcn_s_waitcnt(0);
        unsigned nloc = b.st[0], nx = b.st[1];
        if (nloc == 0u) { xcd_barrier_complete(bar, b.x, nloc, nx); b.st[0] = nloc; b.st[1] = nx; }
        const unsigned old = xb_add(&bar[XB_XSUB(b.x)], 1u);
        const unsigned gen = old / nloc;
        if (old + 1u == (gen + 1u) * nloc) {
            __builtin_amdgcn_fence(__ATOMIC_RELEASE, "agent");
            asm volatile("s_waitcnt vmcnt(0)" ::: "memory");
            const unsigned og = xb_add(&bar[XB_TOP], 1u);
            const unsigned tg = og / nx;
            if (og + 1u == (tg + 1u) * nx) xb_add(&bar[XB_TOPGEN], 1u);
            else XB_SPIN(xb_ld(&bar[XB_TOPGEN]) == tg, bar);
            __builtin_amdgcn_fence(__ATOMIC_ACQUIRE, "agent");
            xb_add(&bar[XB_XGEN(b.x)], 1u);
            asm volatile("s_waitcnt vmcnt(0)" ::: "memory");
        } else {
            XB_SPIN(xb_ld(&bar[XB_XGEN(b.x)]) == gen, bar);
            __builtin_amdgcn_fence(__ATOMIC_ACQUIRE, "agent");
            asm volatile("s_waitcnt vmcnt(0)" ::: "memory");
        }
    }
    __syncthreads();
}
struct Frame {
    LAS unsigned char* lds;
    volatile LAS unsigned* MISC;
    unsigned* ctl;
    int tid, lane, wave;
    int vcu, G;
    float* out; unsigned char* ws;
};
#define GW_ID(F) ((F).vcu * NWAVES + (F).wave)
#define GW_N(F) ((F).G * NWAVES)

__device__ __forceinline__ void transpose_item(const float* __restrict__ W, int ldw, int K, bf16* __restrict__ WT, LAS float* scr, int kb, int nb, int sb, int se, float sv, int lane, bool upmap = false) {
    const int k0 = 64 * kb, n0 = 32 * nb;
    const int d0 = !upmap ? n0 : (n0 < DFF ? (n0 >> 7) * 256 + (n0 & 127) : ((n0 - DFF) >> 7) * 256 + 128 + ((n0 - DFF) & 127));
#pragma unroll 8
    for (int i = 0; i < 32; ++i) { const int kk = 2 * i + (lane >> 5); scr[kk * 33 + (lane & 31)] = W[(size_t)(k0 + kk) * ldw + n0 + (lane & 31)]; }
    LDS_WAIT(); asm volatile("" ::: "memory");
    const int c = lane & 7;
    const float sc = (n0 >= sb && n0 < se) ? sv : 1.0f;
#pragma unroll
    for (int j = 0; j < 4; ++j) { const int n = (lane >> 3) + 8 * j; const LAS float* s = scr + (8 * c) * 33 + n;
        v4u o; o.x = pk2(s[0 * 33] * sc, s[1 * 33] * sc); o.y = pk2(s[2 * 33] * sc, s[3 * 33] * sc); o.z = pk2(s[4 * 33] * sc, s[5 * 33] * sc); o.w = pk2(s[6 * 33] * sc, s[7 * 33] * sc);
        *(v4u*)(WT + (size_t)(d0 + n) * K + k0 + 8 * c) = o; }
    LDS_WAIT(); asm volatile("" ::: "memory");
}
__device__ __forceinline__ void prep_two(Frame& F, const float* W0, int ldw0, int K0, int N0, bf16* T0, int sb, int se, float sv, const float* W1, int ldw1, int K1, int N1, bf16* T1, bool upmap0 = false) {
    LAS float* scr = (LAS float*)(F.lds + F.wave * 16384);
    const int nb0 = N0 / 32, I0 = (K0 / 64) * nb0, nb1 = N1 / 32, I1 = (K1 / 64) * nb1;
    for (int it = GW_ID(F); it < I0 + I1; it += GW_N(F)) {
        if (it < I0) transpose_item(W0, ldw0, K0, T0, scr, it / nb0, it % nb0, sb, se, sv, F.lane, upmap0);
        else { const int r = it - I0; transpose_item(W1, ldw1, K1, T1, scr, r / nb1, r % nb1, 0, 0, 1.0f, F.lane); }
    }
}

template <bool GATES> __device__ __forceinline__ void norm_rows(Frame& F, const float* xp, const float* xs, float* Xdst, const float* g, bf16* XN, float* gates, const LAS float* WgT, const float* slab, int nslab) {
    f32x4 gv[4];
#pragma unroll
    for (int j = 0; j < 4; ++j) gv[j] = ((const f32x4*)g)[F.lane + 64 * j];
    for (int m = GW_ID(F); m < M; m += GW_N(F)) {
        const float* xr = (m < MP) ? xp + (size_t)m * D : xs + (size_t)(m - MP) * D;
        f32x4 v[4]; float ss = 0.f;
#pragma unroll
        for (int j = 0; j < 4; ++j) v[j] = ((const f32x4*)xr)[F.lane + 64 * j];
        if (nslab > 0 && m >= MP) {
            for (int sl = 0; sl < nslab; ++sl) { const f32x4* sp = (const f32x4*)(slab + ((size_t)sl * MS + (m - MP)) * D);
#pragma unroll
                for (int j = 0; j < 4; ++j) v[j] = v[j] + sp[F.lane + 64 * j]; }
#pragma unroll
            for (int j = 0; j < 4; ++j) ((f32x4*)(F.out + (size_t)m * D))[F.lane + 64 * j] = v[j];
        }
#pragma unroll
        for (int j = 0; j < 4; ++j) ss += (v[j].x * v[j].x + v[j].y * v[j].y) + (v[j].z * v[j].z + v[j].w * v[j].w);
        if (Xdst) {
#pragma unroll
            for (int j = 0; j < 4; ++j) ((f32x4*)(Xdst + (size_t)m * D))[F.lane + 64 * j] = v[j];
        }
        const float rs = 1.0f / sqrtf(wave_sum(ss) * (1.0f / D) + EPS);
        v2u* o8 = (v2u*)(XN + (size_t)m * D);
#pragma unroll
        for (int j = 0; j < 4; ++j) { v[j] = v[j] * rs * gv[j]; v2u w; w.x = pk2(v[j].x, v[j].y); w.y = pk2(v[j].z, v[j].w); o8[F.lane + 64 * j] = w; }
        if (GATES) {
            float s[16];
#pragma unroll
            for (int c = 0; c < 16; ++c) { float a = 0.f;
#pragma unroll
                for (int j = 0; j < 4; ++j) { const f32x4 w = ((const LAS f32x4*)(WgT + c * 1024))[F.lane + 64 * j]; a += (v[j].x * w.x + v[j].y * w.y) + (v[j].z * w.z + v[j].w * w.w); }
                s[c] = a; if ((c & 3) == 3) asm volatile("" ::: "memory"); }
            const bool b5 = (F.lane & 32) != 0, b4 = (F.lane & 16) != 0, b3 = (F.lane & 8) != 0, b2 = (F.lane & 4) != 0;
#pragma unroll
            for (int i = 0; i < 8; ++i) { const float send = b5 ? s[i] : s[i + 8], keep = b5 ? s[i + 8] : s[i]; s[i] = keep + __shfl_xor(send, 32); }
#pragma unroll
            for (int i = 0; i < 4; ++i) { const float send = b4 ? s[i] : s[i + 4], keep = b4 ? s[i + 4] : s[i]; s[i] = keep + __shfl_xor(send, 16); }
#pragma unroll
            for (int i = 0; i < 2; ++i) { const float send = b3 ? s[i] : s[i + 2], keep = b3 ? s[i + 2] : s[i]; s[i] = keep + __shfl_xor(send, 8); }
            { const float send = b2 ? s[0] : s[1], keep = b2 ? s[1] : s[0]; s[0] = keep + __shfl_xor(send, 4); }
            s[0] += __shfl_xor(s[0], 2); s[0] += __shfl_xor(s[0], 1);
            if ((F.lane & 3) == 0) gates[(size_t)m * 16 + (F.lane >> 2)] = s[0];
        }
    }
}
__device__ __forceinline__ void stage_wgT(Frame& F, const float* W, int ldw, int c0, LAS float* WgT) {
    for (int e = F.tid; e < 16 * 1024; e += NTHR) { const int k = e >> 4, c = e & 15; WgT[c * 1024 + k] = W[(size_t)k * ldw + c0 + c]; }
}

__device__ __forceinline__ void unpack8(const v4u v, float (&f)[8]) { f[0] = bflo(v.x); f[1] = bfhi(v.x); f[2] = bflo(v.y); f[3] = bfhi(v.y); f[4] = bflo(v.z); f[5] = bfhi(v.z); f[6] = bflo(v.w); f[7] = bfhi(v.w); }
__device__ __forceinline__ void convfix_phase(Frame& F, int layer, const float* conv_state, const float* cw, const float* cb) {
    const bf16* U = (const bf16*)(F.ws + WS_U); bf16* ACT = (bf16*)(F.ws + WS_ACT);
    constexpr int FC = DFF / 8, NPT = MP / 256;
    const int gt = F.vcu * NTHR + F.tid, GT = F.G * NTHR;
    const float* cwl = cw + (size_t)layer * 3 * DFF; const float* cbl = cb + (size_t)layer * DFF;
    for (int it = gt; it < (NPT + BS) * FC; it += GT) {
        const bool samp = it >= NPT * FC; const int r2 = samp ? it - NPT * FC : it;
        const int fc = r2 % FC, rb = r2 / FC, f0 = fc * 8;
        float g2[8], g1[8]; int row0, nrows;
        if (!samp) { row0 = rb * 256; nrows = 2;
            if ((rb & 15) == 15) { float a[8], b[8]; unpack8(*(const v4u*)(U + (size_t)(row0 + 254) * (2 * DFF) + f0), a); unpack8(*(const v4u*)(U + (size_t)(row0 + 255) * (2 * DFF) + f0), b);
                float* o = F.out + O_PF + ((size_t)(layer * BP + (rb >> 4)) * 2) * DFF + f0;
#pragma unroll
                for (int i = 0; i < 8; ++i) { o[i] = a[i]; o[DFF + i] = b[i]; } }
            if ((rb & 15) == 0) continue;
            unpack8(*(const v4u*)(U + (size_t)(row0 - 2) * (2 * DFF) + f0), g2); unpack8(*(const v4u*)(U + (size_t)(row0 - 1) * (2 * DFF) + f0), g1);
        } else { row0 = MP + rb * TS; nrows = TS; const float* cs = conv_state + ((size_t)(layer * BS + rb) * 2) * DFF + f0;
#pragma unroll
            for (int i = 0; i < 8; ++i) { g2[i] = cs[i]; g1[i] = cs[DFF + i]; }
        }
        float w0[8], w1[8], w2[8], bb[8];
#pragma unroll
        for (int i = 0; i < 8; ++i) { w0[i] = cwl[f0 + i]; w1[i] = cwl[DFF + f0 + i]; w2[i] = cwl[2 * DFF + f0 + i]; bb[i] = cbl[f0 + i]; }
        for (int r = 0; r < nrows; ++r) {
            const size_t row = (size_t)(row0 + r);
            float g0[8], up[8]; unpack8(*(const v4u*)(U + row * (2 * DFF) + f0), g0); unpack8(*(const v4u*)(U + row * (2 * DFF) + DFF + f0), up);
            float o[8];
#pragma unroll
            for (int i = 0; i < 8; ++i) { const float cv = bb[i] + w0[i] * g2[i] + w1[i] * g1[i] + w2[i] * g0[i]; o[i] = cv * sigmoidf_(cv) * up[i]; g2[i] = g1[i]; g1[i] = g0[i]; }
            v4u w; w.x = pk2(o[0], o[1]); w.y = pk2(o[2], o[3]); w.z = pk2(o[4], o[5]); w.w = pk2(o[6], o[7]);
            *(v4u*)(ACT + row * DFF + f0) = w;
        }
        if (samp) { float* o = F.out + O_SF + ((size_t)(layer * BS + rb) * 2) * DFF + f0;
#pragma unroll
            for (int i = 0; i < 8; ++i) { o[i] = g2[i]; o[DFF + i] = g1[i]; } }
    }
}

__device__ __forceinline__ void ml_gates(const float* GT, int row, int h, float bi, float bf_, int lane, float& a, float& fcum) {
    const float ig = softcapf(GT[(size_t)row * 16 + h] + bi);
    const float lf = logsigmoidf(softcapf(GT[(size_t)row * 16 + 8 + h] + bf_));
    fcum = wave_scan_sum(lf, lane); a = ig - fcum;
}
__device__ __forceinline__ void mlstm_A(Frame& F, const float* bi, const float* bf_) {
    LAS bf16* Kt = (LAS bf16*)F.lds; LAS bf16* Vt = Kt + 64 * 72; LAS float* wv = (LAS float*)(Vt + 128 * 72);
    const bf16* PROJ = (const bf16*)(F.ws + WS_PROJ); const float* GT = (const float*)(F.ws + WS_GATES);
    float* CLOC = (float*)(F.ws + SC_LOC); float* AUX = (float*)(F.ws + SC_AUX);
    for (int item = F.vcu; item < BP * HA * NCH; item += F.G) {
        const int bh = item >> 6, c = item & 63, b = bh >> 3, h = bh & 7, row0 = b * TP + c * LCH;
        if (F.wave == 0) { float a, fc; ml_gates(GT, row0 + F.lane, h, bi[h], bf_[h], F.lane, a, fc); const float amax = wave_max(a), fl = __shfl(fc, 63);
            wv[F.lane] = __expf(a - amax); if (F.lane == 0) { AUX[AX_CHK + 2 * item] = amax; AUX[AX_CHK + 2 * item + 1] = fl; } }
        stage_tr<64, 128>(Vt, 72, PROJ + (size_t)row0 * NPROJ + 1024 + h * 128, NPROJ, F.tid);
        __syncthreads();
        { const int r = F.tid & 63, c8 = F.tid >> 6; const v4u v = *(const v4u*)(PROJ + (size_t)(row0 + r) * NPROJ + 512 + h * 64 + c8 * 8); float e[8]; unpack8(v, e); const float w = wv[r];
            LAS bf16* d = Kt + (c8 * 8) * 72 + r;
#pragma unroll
            for (int i = 0; i < 8; ++i) d[i * 72] = (bf16)f2bf(e[i] * w); }
        __syncthreads();
#pragma unroll
        for (int jj = 0; jj < 4; ++jj) { const int tile = F.wave * 4 + jj, dkt = tile & 3, dvt = tile >> 2;
            const f32x4 acc = mma_ll<2>(Kt + dkt * 16 * 72, 72, Vt + dvt * 16 * 72, 72, (f32x4){0.f, 0.f, 0.f, 0.f}, F.lane);
            *(f32x4*)(CLOC + ((size_t)item * 128 + dvt * 16 + (F.lane & 15)) * 64 + dkt * 16 + 4 * (F.lane >> 4)) = acc; }
        if (F.tid < 64) { float s = 0.f; for (int ss = 0; ss < 64; ++ss) s += bf2f(Kt[F.tid * 72 + ss]); AUX[AX_NLOC + item * 64 + F.tid] = s; }
        __syncthreads();
    }
}
__device__ __forceinline__ void mlstm_B(Frame& F, int j) {
    const float* __restrict__ CLOC = (const float*)(F.ws + SC_LOC); bf16* __restrict__ ST = (bf16*)(F.ws + SC_ST); float* AUX = (float*)(F.ws + SC_AUX);
    for (int slot = F.vcu * NTHR + F.tid; slot < BP * HA * 4096; slot += F.G * NTHR) {
        const int bh = slot >> 12, e = slot & 4095, dv = e >> 5, dk = (e & 31) * 2;
        float m = 0.f, c0 = 0.f, c1 = 0.f, nacc = 0.f;
        for (int cb = 0; cb < NCH; cb += 8) {
            f32x2 cl[8]; float nl[8], am[8], fl[8];
#pragma unroll
            for (int u = 0; u < 8; ++u) { const int item = bh * 64 + cb + u; cl[u] = *(const f32x2*)(CLOC + ((size_t)item * 128 + dv) * 64 + dk); am[u] = AUX[AX_CHK + 2 * item]; fl[u] = AUX[AX_CHK + 2 * item + 1];
                nl[u] = (e < 64) ? AUX[AX_NLOC + item * 64 + e] : 0.f; }
#pragma unroll
            for (int u = 0; u < 8; ++u) { const int item = bh * 64 + cb + u;
                const float Mn = fmaxf(m, am[u]), g = __expf(m - Mn), ee = __expf(am[u] - Mn);
                *(unsigned*)(ST + ((size_t)item * 128 + dv) * 64 + dk) = pk2(c0, c1);
                if (e < 64) AUX[AX_NST + item * 64 + e] = nacc;
                if (e == 0) AUX[AX_MST + item] = m;
                c0 = g * c0 + ee * cl[u].x; c1 = g * c1 + ee * cl[u].y; nacc = g * nacc + ee * nl[u];
                m = fl[u] + Mn; } }
        const int b = bh >> 3, h = bh & 7;
        float* oc = F.out + O_PAC + (((size_t)(j * BP + b) * HA + h) * DKA) * DVA;
        oc[(size_t)dk * DVA + dv] = c0; oc[(size_t)(dk + 1) * DVA + dv] = c1;
        if (e < 64) F.out[O_PAN + ((size_t)(j * BP + b) * HA + h) * DKA + e] = nacc;
        if (e == 0) F.out[O_PAM + (size_t)(j * BP + b) * HA + h] = m;
    }
}
__device__ __forceinline__ void mlstm_C(Frame& F, int j, const float* bi, const float* bf_, const float* anorm) {
    LAS bf16* Qs = (LAS bf16*)F.lds; LAS bf16* Ks = Qs + 64 * 72; LAS bf16* Vt = Ks + 64 * 72; LAS bf16* Ws = Vt + 128 * 72;
    LAS float* fa = (LAS float*)(Ws + 64 * 72); LAS float* fM = fa + 64; LAS float* fg = fM + 64; LAS float* fe = fg + 64; LAS float* fden = fe + 64; LAS float* ssq = fden + 64;
    const bf16* PROJ = (const bf16*)(F.ws + WS_PROJ); const float* GT = (const float*)(F.ws + WS_GATES);
    const bf16* ST = (const bf16*)(F.ws + SC_ST); const float* AUX = (const float*)(F.ws + SC_AUX); bf16* H = (bf16*)(F.ws + WS_H);
    const int r16 = F.lane & 15, q = F.lane >> 4;
    for (int item = F.vcu; item < BP * HA * NCH; item += F.G) {
        const int bh = item >> 6, c = item & 63, b = bh >> 3, h = bh & 7, row0 = b * TP + c * LCH;
        if (F.wave == 0) { float a, fc; ml_gates(GT, row0 + F.lane, h, bi[h], bf_[h], F.lane, a, fc); const float cm = wave_scan_max(a, F.lane), mc = AUX[AX_MST + item];
            const float Ml = fmaxf(mc, cm); fa[F.lane] = a; fM[F.lane] = Ml; fg[F.lane] = __expf(mc - Ml); fe[F.lane] = __expf(-(fc + Ml)); }
        stage_nat<64, 64>(Qs, 72, PROJ + (size_t)row0 * NPROJ + h * 64, NPROJ, F.tid);
        stage_nat<64, 64>(Ks, 72, PROJ + (size_t)row0 * NPROJ + 512 + h * 64, NPROJ, F.tid);
        stage_tr<64, 128>(Vt, 72, PROJ + (size_t)row0 * NPROJ + 1024 + h * 128, NPROJ, F.tid);
        __syncthreads();
#pragma unroll
        for (int jj = 0; jj < 2; ++jj) { const int tile = F.wave * 2 + jj, tt = tile >> 2, st = tile & 3; f32x4 acc = (f32x4){0.f, 0.f, 0.f, 0.f};
            if (st <= tt) acc = mma_ll<2>(Qs + tt * 16 * 72, 72, Ks + st * 16 * 72, 72, acc, F.lane);
            const int s = st * 16 + r16; const float as = fa[s];
#pragma unroll
            for (int r = 0; r < 4; ++r) { const int t = tt * 16 + 4 * q + r; const float w = (s <= t) ? acc[r] * __expf(as - fM[t]) : 0.f; Ws[t * 72 + s] = (bf16)f2bf(w); } }
        __syncthreads();
        if (F.tid < 64) { const int t = F.tid; float s1 = 0.f, qn = 0.f;
            for (int ss = 0; ss < 64; ss += 8) { float e[8]; unpack8(*(const LAS v4u*)(Ws + t * 72 + ss), e);
#pragma unroll
                for (int i = 0; i < 8; ++i) s1 += e[i]; }
            for (int dd = 0; dd < 64; dd += 8) { float e[8]; unpack8(*(const LAS v4u*)(Qs + t * 72 + dd), e);
#pragma unroll
                for (int i = 0; i < 8; ++i) qn += e[i] * AUX[AX_NST + item * 64 + dd + i]; }
            const float den = s1 + fg[t] * qn; fden[t] = fmaxf(fabsf(den), fe[t]); }
        const int tt = F.wave & 3, half = F.wave >> 2;
        f32x4 a1[4], a2[4];
#pragma unroll
        for (int dl = 0; dl < 4; ++dl) { const int dvt = half * 4 + dl;
            a1[dl] = mma_ll<2>(Vt + dvt * 16 * 72, 72, Ws + tt * 16 * 72, 72, (f32x4){0.f, 0.f, 0.f, 0.f}, F.lane);
            a2[dl] = mma_gl<2>(ST + ((size_t)item * 128 + dvt * 16) * 64, 64, Qs + tt * 16 * 72, 72, (f32x4){0.f, 0.f, 0.f, 0.f}, F.lane); }
        __syncthreads();
        const int t = tt * 16 + r16; const float gt = fg[t], rd = 1.0f / fden[t]; float sq = 0.f;
#pragma unroll
        for (int dl = 0; dl < 4; ++dl)
#pragma unroll
            for (int r = 0; r < 4; ++r) { const float hv = (a1[dl][r] + gt * a2[dl][r]) * rd; a1[dl][r] = hv; sq += hv * hv; }
        sq += __shfl_xor(sq, 16); sq += __shfl_xor(sq, 32);
        if (F.lane < 16) ssq[half * 64 + t] = sq;
        __syncthreads();
        const float rs = 1.0f / sqrtf((ssq[t] + ssq[64 + t]) * (1.0f / DVA) + EPS);
#pragma unroll
        for (int dl = 0; dl < 4; ++dl) { const int col = h * 128 + (half * 4 + dl) * 16 + 4 * q;
            const f32x4 ng = *(const f32x4*)(anorm + j * 1024 + col); const v2u ov = *(const v2u*)(PROJ + (size_t)(row0 + t) * NPROJ + 2048 + col);
            const float o0 = a1[dl][0] * rs * ng.x * sigmoidf_(bflo(ov.x)), o1 = a1[dl][1] * rs * ng.y * sigmoidf_(bfhi(ov.x)), o2 = a1[dl][2] * rs * ng.z * sigmoidf_(bflo(ov.y)), o3 = a1[dl][3] * rs * ng.w * sigmoidf_(bfhi(ov.y));
            v2u w; w.x = pk2(o0, o1); w.y = pk2(o2, o3); *(v2u*)(H + (size_t)(row0 + t) * D + col) = w; }
        __syncthreads();
    }
}
__device__ __forceinline__ void mlstm_S(Frame& F, int j, const float* bi, const float* bf_, const float* anorm, const float* st_c, const float* st_n, const float* st_m) {
    LAS float* qs = (LAS float*)F.lds; LAS float* ks = qs + 256; LAS float* vs = ks + 256; LAS float* qkw = vs + 512; LAS float* qn = qkw + 16; LAS float* part = qn + 16; LAS float* red = part + 2048;
    const bf16* PROJ = (const bf16*)(F.ws + WS_PROJ); const float* GT = (const float*)(F.ws + WS_GATES); bf16* H = (bf16*)(F.ws + WS_H);
    for (int item = F.vcu; item < BS * HA; item += F.G) {
        const int b = item >> 3, h = item & 7, row0 = MP + b * TS;
        float a[4], fc[4], Ml[4], g[4], mt[4]; const float m0 = st_m[(size_t)(j * BS + b) * HA + h];
        { float run = 0.f, cm = -3.0e38f;
#pragma unroll
            for (int t = 0; t < 4; ++t) { const float ig = softcapf(GT[(size_t)(row0 + t) * 16 + h] + bi[h]); const float lf = logsigmoidf(softcapf(GT[(size_t)(row0 + t) * 16 + 8 + h] + bf_[h]));
                run += lf; fc[t] = run; a[t] = ig - run; cm = fmaxf(cm, a[t]); Ml[t] = fmaxf(m0, cm); g[t] = __expf(m0 - Ml[t]); mt[t] = run + Ml[t]; } }
        { const int t = (F.tid >> 6) & 3, d = F.tid & 63; const bf16* pr = PROJ + (size_t)(row0 + t) * NPROJ + h * 64 + d;
            if (F.tid < 256) qs[t * 64 + d] = bf2f(pr[0]); else ks[t * 64 + d] = bf2f(pr[512]);
            const int t2 = F.tid >> 7, dv = F.tid & 127; vs[t2 * 128 + dv] = bf2f(PROJ[(size_t)(row0 + t2) * NPROJ + 1024 + h * 128 + dv]); }
        __syncthreads();
        const float* n0 = st_n + ((size_t)(j * BS + b) * HA + h) * DKA;
        if (F.tid < 16) { const int t = F.tid >> 2, s = F.tid & 3; float dt = 0.f; for (int d = 0; d < 64; ++d) dt += qs[t * 64 + d] * ks[s * 64 + d];
            float as = a[0], Mt = Ml[0];
            as = (s == 1) ? a[1] : as; as = (s == 2) ? a[2] : as; as = (s == 3) ? a[3] : as; Mt = (t == 1) ? Ml[1] : Mt; Mt = (t == 2) ? Ml[2] : Mt; Mt = (t == 3) ? Ml[3] : Mt;
            qkw[F.tid] = (s <= t) ? dt * __expf(as - Mt) : 0.f; }
        else if (F.tid < 20) { const int t = F.tid - 16; float dt = 0.f; for (int d = 0; d < 64; ++d) dt += qs[t * 64 + d] * n0[d]; qn[t] = dt; }
        { const int dv = F.tid & 127, dkq = F.tid >> 7; const float* c0p = st_c + (((size_t)(j * BS + b) * HA + h) * DKA) * DVA; float* cout = F.out + O_SAC + (((size_t)(j * BS + b) * HA + h) * DKA) * DVA;
            float p0 = 0.f, p1 = 0.f, p2 = 0.f, p3 = 0.f; const float gl = g[3];
            float wl[4];
#pragma unroll
            for (int s = 0; s < 4; ++s) wl[s] = __expf(a[s] - Ml[3]) * vs[s * 128 + dv];
            for (int dk = dkq * 16; dk < dkq * 16 + 16; ++dk) { const float cv = c0p[(size_t)dk * DVA + dv];
                p0 += qs[dk] * cv; p1 += qs[64 + dk] * cv; p2 += qs[128 + dk] * cv; p3 += qs[192 + dk] * cv;
                cout[(size_t)dk * DVA + dv] = gl * cv + (wl[0] * ks[dk] + wl[1] * ks[64 + dk]) + (wl[2] * ks[128 + dk] + wl[3] * ks[192 + dk]); }
            part[(dkq * 4 + 0) * 128 + dv] = p0; part[(dkq * 4 + 1) * 128 + dv] = p1; part[(dkq * 4 + 2) * 128 + dv] = p2; part[(dkq * 4 + 3) * 128 + dv] = p3; }
        __syncthreads();
        float hv;
        { const int t = F.tid >> 7, dv = F.tid & 127; float gt = g[0], emt = mt[0];
            gt = (t == 1) ? g[1] : gt; gt = (t == 2) ? g[2] : gt; gt = (t == 3) ? g[3] : gt; emt = (t == 1) ? mt[1] : emt; emt = (t == 2) ? mt[2] : emt; emt = (t == 3) ? mt[3] : emt;
            float num = 0.f, den = 0.f;
#pragma unroll
            for (int s = 0; s < 4; ++s) { const float w = qkw[t * 4 + s]; num += w * vs[s * 128 + dv]; den += w; }
            num += gt * ((part[(0 * 4 + t) * 128 + dv] + part[(1 * 4 + t) * 128 + dv]) + (part[(2 * 4 + t) * 128 + dv] + part[(3 * 4 + t) * 128 + dv]));
            den += gt * qn[t];
            hv = num / fmaxf(fabsf(den), __expf(-emt));
            const float sq = wave_sum(hv * hv); if (F.lane == 0) red[F.wave] = sq; }
        __syncthreads();
        { const int t = F.tid >> 7, dv = F.tid & 127, col = h * 128 + dv; const float rs = 1.0f / sqrtf((red[2 * t] + red[2 * t + 1]) * (1.0f / DVA) + EPS);
            const float o = bf2f(PROJ[(size_t)(row0 + t) * NPROJ + 2048 + col]);
            H[(size_t)(row0 + t) * D + col] = (bf16)f2bf(hv * rs * anorm[j * 1024 + col] * sigmoidf_(o)); }
        if (F.tid < 64) { const int d = F.tid; float nn = g[3] * n0[d];
#pragma unroll
            for (int s = 0; s < 4; ++s) nn += __expf(a[s] - Ml[3]) * ks[s * 64 + d];
            F.out[O_SAN + ((size_t)(j * BS + b) * HA + h) * DKA + d] = nn; }
        if (F.tid == 0) F.out[O_SAM + (size_t)(j * BS + b) * HA + h] = mt[3];
        __syncthreads();
    }
}
__device__ __forceinline__ void gla_bc(Frame& F, int row0, int h, const float* WG, const float* BG, LAS float* zs, LAS float* gsum, LAS float* bc) {
    const float* GT = (const float*)(F.ws + WS_GATES);
    if (F.tid < 256) ((LAS f32x4*)zs)[F.tid] = ((const f32x4*)(GT + (size_t)row0 * 16))[F.tid];
    const int d = F.tid & 127, tq = F.tid >> 7, col = h * 128 + d;
    float wg[16];
#pragma unroll
    for (int r = 0; r < 16; ++r) wg[r] = WG[r * 512 + col];
    const float bgv = BG[col];
    __syncthreads();
    float pr[16]; float run = 0.f;
#pragma unroll
    for (int i = 0; i < 16; ++i) { const LAS float* z = zs + (tq * 16 + i) * 16; float x = bgv;
#pragma unroll
        for (int r = 0; r < 16; ++r) x += z[r] * wg[r];
        run += logsigmoidf(x) * (1.0f / 16.0f); pr[i] = run; }
    gsum[tq * 128 + d] = run;
    __syncthreads();
    float off = 0.f;
    if (tq > 0) off += gsum[d];
    if (tq > 1) off += gsum[128 + d];
    if (tq > 2) off += gsum[256 + d];
#pragma unroll
    for (int i = 0; i < 16; ++i) bc[(tq * 16 + i) * 128 + d] = pr[i] + off;
    __syncthreads();
}
__device__ __forceinline__ void gla_A(Frame& F, const float* WG, const float* BG) {
    LAS float* zs = (LAS float*)F.lds; LAS float* gsum = zs + 1024; LAS float* bc = gsum + 512; LAS bf16* Kt = (LAS bf16*)(bc + 8192); LAS bf16* Vt = Kt + 128 * 72;
    const bf16* PROJ = (const bf16*)(F.ws + WS_PROJ); float* SLOC = (float*)(F.ws + SC_LOC); float* AUX = (float*)(F.ws + SC_AUX);
    for (int item = F.vcu; item < BP * HB * NCH; item += F.G) {
        const int bh = item >> 6, c = item & 63, b = bh >> 2, h = bh & 3, row0 = b * TP + c * LCH;
        gla_bc(F, row0, h, WG, BG, zs, gsum, bc);
        if (F.tid < 128) AUX[AX_BL + item * 128 + F.tid] = bc[63 * 128 + F.tid];
        for (int p = F.tid; p < 64 * 16; p += NTHR) { const int r = p & 63, c8 = p >> 6; float e[8]; unpack8(*(const v4u*)(PROJ + (size_t)(row0 + r) * NPROJ + 512 + h * 128 + c8 * 8), e);
            LAS bf16* dd = Kt + (c8 * 8) * 72 + r;
#pragma unroll
            for (int i = 0; i < 8; ++i) { const int dk = c8 * 8 + i; dd[i * 72] = (bf16)f2bf(e[i] * __expf(bc[63 * 128 + dk] - bc[r * 128 + dk])); } }
        stage_tr<64, 256>(Vt, 72, PROJ + (size_t)row0 * NPROJ + 1024 + h * 256, NPROJ, F.tid);
        __syncthreads();
        for (int jj = 0; jj < 16; ++jj) { const int tile = F.wave * 16 + jj, dkt = tile & 7, dvt = tile >> 3;
            const f32x4 acc = mma_ll<2>(Kt + dkt * 16 * 72, 72, Vt + dvt * 16 * 72, 72, (f32x4){0.f, 0.f, 0.f, 0.f}, F.lane);
            *(f32x4*)(SLOC + ((size_t)item * 256 + dvt * 16 + (F.lane & 15)) * 128 + dkt * 16 + 4 * (F.lane >> 4)) = acc; }
        __syncthreads();
    }
}
__device__ __forceinline__ void gla_B(Frame& F) {
    const float* __restrict__ SLOC = (const float*)(F.ws + SC_LOC); bf16* __restrict__ ST = (bf16*)(F.ws + SC_ST); const float* __restrict__ AUX = (const float*)(F.ws + SC_AUX);
    for (int slot = F.vcu * NTHR + F.tid; slot < BP * HB * 8192; slot += F.G * NTHR) {
        const int bh = slot >> 13, e = slot & 8191, dv = e >> 5, dk0 = (e & 31) * 4;
        f32x4 S = (f32x4){0.f, 0.f, 0.f, 0.f};
        for (int cb = 0; cb < NCH; cb += 8) {
            f32x4 bl[8], sl[8];
#pragma unroll
            for (int u = 0; u < 8; ++u) { const int item = bh * 64 + cb + u; bl[u] = *(const f32x4*)(AUX + AX_BL + item * 128 + dk0); sl[u] = *(const f32x4*)(SLOC + ((size_t)item * 256 + dv) * 128 + dk0); }
#pragma unroll
            for (int u = 0; u < 8; ++u) { const int item = bh * 64 + cb + u;
                v2u w; w.x = pk2(S.x, S.y); w.y = pk2(S.z, S.w); *(v2u*)(ST + ((size_t)item * 256 + dv) * 128 + dk0) = w;
                S.x = __expf(bl[u].x) * S.x + sl[u].x; S.y = __expf(bl[u].y) * S.y + sl[u].y; S.z = __expf(bl[u].z) * S.z + sl[u].z; S.w = __expf(bl[u].w) * S.w + sl[u].w; } }
        float* o = F.out + O_PG + ((size_t)bh * DKB + dk0) * DVB + dv;
        o[0] = S.x; o[DVB] = S.y; o[2 * DVB] = S.z; o[3 * DVB] = S.w;
    }
}
__device__ __forceinline__ void gla_C(Frame& F, const float* WG, const float* BG, const float* bnorm) {
    LAS float* zs = (LAS float*)F.lds; LAS float* gsum = zs + 1024; LAS float* bc = gsum + 512; LAS bf16* Qs = (LAS bf16*)(bc + 8192); LAS bf16* Ks = Qs + 64 * 136; LAS bf16* Vt = Ks + 64 * 136;
    LAS bf16* At = Vt + 256 * 72; LAS float* ssq = (LAS float*)(At + 64 * 72);
    const bf16* PROJ = (const bf16*)(F.ws + WS_PROJ); const bf16* ST = (const bf16*)(F.ws + SC_ST); bf16* H = (bf16*)(F.ws + WS_H);
    const int r16 = F.lane & 15, q = F.lane >> 4;
    for (int item = F.vcu; item < BP * HB * NCH; item += F.G) {
        const int bh = item >> 6, c = item & 63, b = bh >> 2, h = bh & 3, row0 = b * TP + c * LCH;
        gla_bc(F, row0, h, WG, BG, zs, gsum, bc);
        for (int p = F.tid; p < 64 * 16; p += NTHR) { const int r = p >> 4, c8 = p & 15; float e[8], f[8];
            unpack8(*(const v4u*)(PROJ + (size_t)(row0 + r) * NPROJ + h * 128 + c8 * 8), e); unpack8(*(const v4u*)(PROJ + (size_t)(row0 + r) * NPROJ + 512 + h * 128 + c8 * 8), f);
#pragma unroll
            for (int i = 0; i < 8; ++i) { const float bb = bc[r * 128 + c8 * 8 + i]; e[i] *= __expf(bb); f[i] *= __expf(-bb); }
            v4u w; w.x = pk2(e[0], e[1]); w.y = pk2(e[2], e[3]); w.z = pk2(e[4], e[5]); w.w = pk2(e[6], e[7]); *(LAS v4u*)(Qs + r * 136 + c8 * 8) = w;
            w.x = pk2(f[0], f[1]); w.y = pk2(f[2], f[3]); w.z = pk2(f[4], f[5]); w.w = pk2(f[6], f[7]); *(LAS v4u*)(Ks + r * 136 + c8 * 8) = w; }
        stage_tr<64, 256>(Vt, 72, PROJ + (size_t)row0 * NPROJ + 1024 + h * 256, NPROJ, F.tid);
        __syncthreads();
#pragma unroll
        for (int jj = 0; jj < 2; ++jj) { const int tile = F.wave * 2 + jj, tt = tile >> 2, st = tile & 3; f32x4 acc = (f32x4){0.f, 0.f, 0.f, 0.f};
            if (st <= tt) acc = mma_ll<4>(Qs + tt * 16 * 136, 136, Ks + st * 16 * 136, 136, acc, F.lane);
            const int s = st * 16 + r16;
#pragma unroll
            for (int r = 0; r < 4; ++r) { const int t = tt * 16 + 4 * q + r; At[t * 72 + s] = (bf16)f2bf((s <= t) ? acc[r] : 0.f); } }
        __syncthreads();
        f32x4 o[2][4];
#pragma unroll
        for (int dl = 0; dl < 2; ++dl) { const int dvt = F.wave * 2 + dl;
            bf16x8 sa[4];
#pragma unroll
            for (int ks = 0; ks < 4; ++ks) sa[ks] = *(const bf16x8*)(ST + ((size_t)item * 256 + dvt * 16 + r16) * 128 + ks * 32 + q * 8);
#pragma unroll
            for (int tt = 0; tt < 4; ++tt) { f32x4 acc = mma_ll<2>(Vt + dvt * 16 * 72, 72, At + tt * 16 * 72, 72, (f32x4){0.f, 0.f, 0.f, 0.f}, F.lane);
#pragma unroll
                for (int ks = 0; ks < 4; ++ks) { const bf16x8 bq = *(const LAS bf16x8*)(Qs + (tt * 16 + r16) * 136 + ks * 32 + q * 8); acc = __builtin_amdgcn_mfma_f32_16x16x32_bf16(sa[ks], bq, acc, 0, 0, 0); }
                o[dl][tt] = acc; } }
#pragma unroll
        for (int tt = 0; tt < 4; ++tt) { float sq = 0.f;
#pragma unroll
            for (int dl = 0; dl < 2; ++dl)
#pragma unroll
                for (int r = 0; r < 4; ++r) sq += o[dl][tt][r] * o[dl][tt][r];
            sq += __shfl_xor(sq, 16); sq += __shfl_xor(sq, 32);
            if (F.lane < 16) ssq[F.wave * 64 + tt * 16 + r16] = sq; }
        __syncthreads();
#pragma unroll
        for (int tt = 0; tt < 4; ++tt) { const int t = tt * 16 + r16; float tot = 0.f;
#pragma unroll
            for (int w = 0; w < 8; ++w) tot += ssq[w * 64 + t];
            const float rs = 1.0f / sqrtf(tot * (1.0f / DVB) + EPS);
#pragma unroll
            for (int dl = 0; dl < 2; ++dl) { const int col = h * 256 + (F.wave * 2 + dl) * 16 + 4 * q;
                const f32x4 ng = *(const f32x4*)(bnorm + col); const v2u rv = *(const v2u*)(PROJ + (size_t)(row0 + t) * NPROJ + 2048 + col);
                const float r0 = bflo(rv.x), r1 = bfhi(rv.x), r2 = bflo(rv.y), r3 = bfhi(rv.y);
                const float o0 = o[dl][tt][0] * rs * ng.x * r0 * sigmoidf_(r0), o1 = o[dl][tt][1] * rs * ng.y * r1 * sigmoidf_(r1), o2 = o[dl][tt][2] * rs * ng.z * r2 * sigmoidf_(r2), o3 = o[dl][tt][3] * rs * ng.w * r3 * sigmoidf_(r3);
                v2u w; w.x = pk2(o0, o1); w.y = pk2(o2, o3); *(v2u*)(H + (size_t)(row0 + t) * D + col) = w; } }
        __syncthreads();
    }
}
__device__ __forceinline__ void gla_S(Frame& F, const float* WG, const float* BG, const float* bnorm, const float* st_s) {
    LAS float* bcs = (LAS float*)F.lds;
    LAS float* qs = bcs + 512;
    LAS float* kr = qs + 512;
    LAS float* kh = kr + 512;
    LAS float* vs = kh + 512;
    LAS float* att = vs + 1024;
    LAS float* part = att + 16;
    LAS float* red = part + 2048;
    const bf16* PROJ = (const bf16*)(F.ws + WS_PROJ); const float* GT = (const float*)(F.ws + WS_GATES); bf16* H = (bf16*)(F.ws + WS_H);
    for (int item = F.vcu; item < BS * HB; item += F.G) {
        const int b = item >> 2, h = item & 3, row0 = MP + b * TS;
        { const int t = F.tid >> 7, d = F.tid & 127, col = h * 128 + d; float x = BG[col];
#pragma unroll
            for (int r = 0; r < 16; ++r) x += GT[(size_t)(row0 + t) * 16 + r] * WG[r * 512 + col];
            bcs[t * 128 + d] = logsigmoidf(x) * (1.0f / 16.0f);
            kr[t * 128 + d] = bf2f(PROJ[(size_t)(row0 + t) * NPROJ + 512 + col]);
            vs[t * 256 + d] = bf2f(PROJ[(size_t)(row0 + t) * NPROJ + 1024 + h * 256 + d]); vs[t * 256 + 128 + d] = bf2f(PROJ[(size_t)(row0 + t) * NPROJ + 1024 + h * 256 + 128 + d]); }
        __syncthreads();
        if (F.tid < 128) { const int d = F.tid; float run = 0.f;
#pragma unroll
            for (int t = 0; t < 4; ++t) { run += bcs[t * 128 + d]; bcs[t * 128 + d] = run; } }
        __syncthreads();
        { const int t = F.tid >> 7, d = F.tid & 127, col = h * 128 + d; const float bb = bcs[t * 128 + d], bl = bcs[3 * 128 + d];
            qs[t * 128 + d] = bf2f(PROJ[(size_t)(row0 + t) * NPROJ + col]) * __expf(bb); kh[t * 128 + d] = kr[t * 128 + d] * __expf(bl - bb); }
        __syncthreads();
        if (F.tid < 16) { const int t = F.tid >> 2, s = F.tid & 3; float dt = 0.f;
            if (s <= t) for (int d = 0; d < 128; ++d) dt += qs[t * 128 + d] * kr[s * 128 + d] * __expf(-bcs[s * 128 + d]);
            att[F.tid] = dt; }
        { const int dv = F.tid & 255, dkh = F.tid >> 8; const float* s0 = st_s + (((size_t)b * HB + h) * DKB) * DVB; float* so = F.out + O_SG + (((size_t)b * HB + h) * DKB) * DVB;
            float p0 = 0.f, p1 = 0.f, p2 = 0.f, p3 = 0.f; const float v0 = vs[dv], v1 = vs[256 + dv], v2 = vs[512 + dv], v3 = vs[768 + dv];
            for (int dk = dkh * 64; dk < dkh * 64 + 64; ++dk) { const float sv = s0[(size_t)dk * DVB + dv];
                p0 += qs[dk] * sv; p1 += qs[128 + dk] * sv; p2 += qs[256 + dk] * sv; p3 += qs[384 + dk] * sv;
                so[(size_t)dk * DVB + dv] = __expf(bcs[3 * 128 + dk]) * sv + (kh[dk] * v0 + kh[128 + dk] * v1) + (kh[256 + dk] * v2 + kh[384 + dk] * v3); }
            part[(dkh * 4 + 0) * 256 + dv] = p0; part[(dkh * 4 + 1) * 256 + dv] = p1; part[(dkh * 4 + 2) * 256 + dv] = p2; part[(dkh * 4 + 3) * 256 + dv] = p3; }
        __syncthreads();
        float ov[2];
        { const int dv = F.tid & 255, th = F.tid >> 8;
#pragma unroll
            for (int u = 0; u < 2; ++u) { const int t = th + 2 * u; float o = part[t * 256 + dv] + part[(4 + t) * 256 + dv];
#pragma unroll
                for (int s = 0; s < 4; ++s) o += att[t * 4 + s] * vs[s * 256 + dv];
                ov[u] = o; const float sq = wave_sum(o * o); if (F.lane == 0) red[F.wave * 2 + u] = sq; } }
        __syncthreads();
        { const int dv = F.tid & 255, th = F.tid >> 8, col = h * 256 + dv;
#pragma unroll
            for (int u = 0; u < 2; ++u) { const int t = th + 2 * u; const int w0 = th * 4; const float tot = (red[(w0 + 0) * 2 + u] + red[(w0 + 1) * 2 + u]) + (red[(w0 + 2) * 2 + u] + red[(w0 + 3) * 2 + u]);
                const float rs = 1.0f / sqrtf(tot * (1.0f / DVB) + EPS); const float r = bf2f(PROJ[(size_t)(row0 + t) * NPROJ + 2048 + col]);
                H[(size_t)(row0 + t) * D + col] = (bf16)f2bf(ov[u] * rs * bnorm[col] * r * sigmoidf_(r)); } }
        __syncthreads();
    }
}

__device__ __forceinline__ void swa_tile(const LAS bf16* Kw, const LAS bf16* Vt, int ldv, LAS bf16* Pw, int kt0, int jmin, const bf16* qp_r16, bf16* op_r16, const int (&relb)[4], const float (&snk)[4], int lane) {
    const int r16 = lane & 15, q = lane >> 4;
    const bf16x8 qa0 = *(const bf16x8*)(qp_r16 + q * 8), qa1 = *(const bf16x8*)(qp_r16 + 32 + q * 8);
    f32x4 s[9];
#pragma unroll
    for (int kt = 0; kt < 9; ++kt) { const LAS bf16* kp = Kw + ((kt0 + kt) * 16 + r16) * 72 + q * 8;
        f32x4 acc = __builtin_amdgcn_mfma_f32_16x16x32_bf16(qa0, *(const LAS bf16x8*)kp, (f32x4){0.f, 0.f, 0.f, 0.f}, 0, 0, 0);
        s[kt] = __builtin_amdgcn_mfma_f32_16x16x32_bf16(qa1, *(const LAS bf16x8*)(kp + 32), acc, 0, 0, 0); }
    float mx[4] = {-3.0e38f, -3.0e38f, -3.0e38f, -3.0e38f};
#pragma unroll
    for (int kt = 0; kt < 9; ++kt) { const int j = (kt0 + kt) * 16 + r16;
#pragma unroll
        for (int r = 0; r < 4; ++r) { const int rel = relb[r] - j; const bool ok = (rel >= 0) && (rel <= WIN) && (j >= jmin); const float v = ok ? s[kt][r] * 0.125f : -3.0e38f; s[kt][r] = v; mx[r] = fmaxf(mx[r], v); } }
    float sm[4];
#pragma unroll
    for (int r = 0; r < 4; ++r) { float m = mx[r]; m = fmaxf(m, __shfl_xor(m, 1)); m = fmaxf(m, __shfl_xor(m, 2)); m = fmaxf(m, __shfl_xor(m, 4)); m = fmaxf(m, __shfl_xor(m, 8)); mx[r] = fmaxf(m, snk[r]); sm[r] = 0.f; }
#pragma unroll
    for (int kt = 0; kt < 9; ++kt)
#pragma unroll
        for (int r = 0; r < 4; ++r) { const float p = (s[kt][r] > -1.0e38f) ? __expf(s[kt][r] - mx[r]) : 0.f; s[kt][r] = p; sm[r] += p; }
#pragma unroll
    for (int r = 0; r < 4; ++r) { float t = sm[r]; t += __shfl_xor(t, 1); t += __shfl_xor(t, 2); t += __shfl_xor(t, 4); t += __shfl_xor(t, 8); sm[r] = 1.0f / (t + __expf(snk[r] - mx[r])); }
#pragma unroll
    for (int kt = 0; kt < 9; ++kt)
#pragma unroll
        for (int r = 0; r < 4; ++r) Pw[(4 * q + r) * 168 + kt * 16 + r16] = (bf16)f2bf(s[kt][r] * sm[r]);
#pragma unroll
    for (int r = 0; r < 4; ++r) Pw[(4 * q + r) * 168 + 144 + r16] = (bf16)0;
    LDS_WAIT();
#pragma unroll
    for (int dt = 0; dt < 4; ++dt) { f32x4 acc = (f32x4){0.f, 0.f, 0.f, 0.f};
#pragma unroll
        for (int ks = 0; ks < 5; ++ks) { const bf16x8 va = *(const LAS bf16x8*)(Vt + (dt * 16 + r16) * ldv + kt0 * 16 + ks * 32 + q * 8); const bf16x8 pb = *(const LAS bf16x8*)(Pw + r16 * 168 + ks * 32 + q * 8);
            acc = __builtin_amdgcn_mfma_f32_16x16x32_bf16(va, pb, acc, 0, 0, 0); }
        v2u w; w.x = pk2(acc[0], acc[1]); w.y = pk2(acc[2], acc[3]); *(v2u*)(op_r16 + dt * 16 + 4 * q) = w; }
    LDS_WAIT();
}
__device__ __forceinline__ void swa_prompt(Frame& F, const float* sinks) {
    LAS bf16* Kw = (LAS bf16*)F.lds; LAS bf16* Vt = Kw + 256 * 72; LAS bf16* Pw = Vt + 64 * 280 + F.wave * (16 * 168);
    const bf16* PROJ = (const bf16*)(F.ws + WS_PROJ); bf16* H = (bf16*)(F.ws + WS_H);
    const int r16 = F.lane & 15, q = F.lane >> 4;
    for (int item = F.vcu; item < BP * HKV * (TP / WIN); item += F.G) {
        const int qb = item & 31, hkv = (item >> 5) & 3, b = item >> 7;
        const int krow0 = b * TP + (qb - 1) * WIN;
        for (int p = F.tid; p < 256 * 8; p += NTHR) { const int r = p >> 3, c8 = p & 7; v4u v = (v4u){0u, 0u, 0u, 0u};
            if (qb > 0 || r >= WIN) v = *(const v4u*)(PROJ + (size_t)(krow0 + r) * C_IN + 1024 + hkv * 64 + c8 * 8);
            *(LAS v4u*)(Kw + r * 72 + c8 * 8) = v; }
        for (int p = F.tid; p < 256 * 8; p += NTHR) { const int r = p & 255, c8 = p >> 8; v4u v = (v4u){0u, 0u, 0u, 0u};
            if (qb > 0 || r >= WIN) v = *(const v4u*)(PROJ + (size_t)(krow0 + r) * C_IN + 1280 + hkv * 64 + c8 * 8);
            LAS bf16* d = Vt + (c8 * 8) * 280 + r;
            d[0 * 280] = (bf16)(v.x & 0xffffu); d[1 * 280] = (bf16)(v.x >> 16); d[2 * 280] = (bf16)(v.y & 0xffffu); d[3 * 280] = (bf16)(v.y >> 16);
            d[4 * 280] = (bf16)(v.z & 0xffffu); d[5 * 280] = (bf16)(v.z >> 16); d[6 * 280] = (bf16)(v.w & 0xffffu); d[7 * 280] = (bf16)(v.w >> 16); }
        for (int p = F.tid; p < 64 * 24; p += NTHR) { const int r = p / 24, cc = p % 24; Vt[r * 280 + 256 + cc] = (bf16)0; }
        __syncthreads();
        const int g = F.wave >> 1, hq = hkv * 4 + g;
        const float sk = sinks[hq]; const float snk[4] = {sk, sk, sk, sk};
        for (int mt = 0; mt < 4; ++mt) { const int tq0 = (F.wave & 1) * 64 + mt * 16; const int relb[4] = {WIN + tq0 + 4 * q, WIN + tq0 + 4 * q + 1, WIN + tq0 + 4 * q + 2, WIN + tq0 + 4 * q + 3};
            const size_t row = (size_t)b * TP + qb * WIN + tq0 + r16;
            swa_tile(Kw, Vt, 280, Pw, tq0 >> 4, (qb == 0) ? WIN : 0, PROJ + row * C_IN + hq * 64, H + row * D + hq * 64, relb, snk, F.lane); }
        __syncthreads();
    }
    for (int e = F.vcu * NTHR + F.tid; e < BP * WIN * 256; e += F.G * NTHR) { const int d = e & 255, jrow = (e >> 8) & 127, b = e >> 15; const size_t row = (size_t)b * TP + TP - WIN + jrow;
        F.out[O_PSK + ((size_t)b * WIN + jrow) * 256 + d] = bf2f(PROJ[row * C_IN + 1024 + d]); F.out[O_PSV + ((size_t)b * WIN + jrow) * 256 + d] = bf2f(PROJ[row * C_IN + 1280 + d]); }
}
__device__ __forceinline__ void swa_sample(Frame& F, const float* sinks, const float* ck, const float* cv) {
    LAS bf16* Kw = (LAS bf16*)F.lds; LAS bf16* Vt = Kw + 144 * 72; LAS bf16* Pw = Vt + 64 * 168;
    const bf16* PROJ = (const bf16*)(F.ws + WS_PROJ); bf16* H = (bf16*)(F.ws + WS_H);
    const int r16 = F.lane & 15, q = F.lane >> 4;
    for (int item = F.vcu; item < BS * HKV; item += F.G) {
        const int b = item >> 2, hkv = item & 3;
        for (int e = F.tid; e < 144 * 64; e += NTHR) { const int r = e >> 6, d = e & 63; float kx = 0.f, vx = 0.f;
            if (r < WIN) { const size_t ci = (((size_t)b * WIN + r) * HKV + hkv) * HDC + d; kx = ck[ci]; vx = cv[ci]; }
            else if (r < WIN + TS) { const size_t row = (size_t)MP + b * TS + (r - WIN); kx = bf2f(PROJ[row * C_IN + 1024 + hkv * 64 + d]); vx = bf2f(PROJ[row * C_IN + 1280 + hkv * 64 + d]); }
            Kw[r * 72 + d] = (bf16)f2bf(kx); Vt[d * 168 + r] = (bf16)f2bf(vx);
            if (r >= TS && r < WIN + TS) { const size_t oi = (((size_t)b * WIN + (r - TS)) * HKV + hkv) * HDC + d; F.out[O_SSK + oi] = kx; F.out[O_SSV + oi] = vx; } }
        for (int e = F.tid; e < 64 * 16; e += NTHR) { const int d = e >> 4, cc = e & 15; Vt[d * 168 + 144 + cc] = (bf16)0; }
        __syncthreads();
        if (F.wave == 0) { const int gq = r16 >> 2, tq = r16 & 3; const size_t row = (size_t)MP + b * TS + tq; const int hq = hkv * 4 + gq;
            const int relb[4] = {WIN + 0, WIN + 1, WIN + 2, WIN + 3};
            const float sk = sinks[hkv * 4 + q]; const float snk[4] = {sk, sk, sk, sk};
            swa_tile(Kw, Vt, 168, Pw, 0, 0, PROJ + row * C_IN + hq * 64, H + row * D + hq * 64, relb, snk, F.lane); }
        __syncthreads();
    }
}

__device__ __forceinline__ void gemm_small(Frame& F, const bf16* A, const bf16* Bt, int K, int N, bool pj, bf16* O, float* X, const float* bias) {
    const int r16 = F.lane & 15, q = F.lane >> 4, nct = N >> 4, ntile = (MS / 16) * nct;
    for (int id = GW_ID(F); id < ntile; id += GW_N(F)) {
        const int ct = id % nct, rt = id / nct;
        const bf16* ap = A + (size_t)(MP + rt * 16 + r16) * K + q * 8; const bf16* bp = Bt + (size_t)(ct * 16 + r16) * K + q * 8;
        f32x4 acc0 = (f32x4){0.f, 0.f, 0.f, 0.f}, acc1 = acc0;
#pragma unroll 2
        for (int k0 = 0; k0 < K; k0 += 256) {
            bf16x8 a[8], b[8];
#pragma unroll
            for (int i = 0; i < 8; ++i) { a[i] = *(const bf16x8*)(ap + k0 + i * 32); b[i] = *(const bf16x8*)(bp + k0 + i * 32); }
#pragma unroll
            for (int i = 0; i < 8; i += 2) { acc0 = __builtin_amdgcn_mfma_f32_16x16x32_bf16(b[i], a[i], acc0, 0, 0, 0); acc1 = __builtin_amdgcn_mfma_f32_16x16x32_bf16(b[i + 1], a[i + 1], acc1, 0, 0, 0); }
        }
        const f32x4 acc = acc0 + acc1; const size_t row = (size_t)(MP + rt * 16 + r16); const int col = ct * 16 + 4 * q;
        if (pj) { f32x4 v = acc; if (bias) v = v + *(const f32x4*)(bias + col); v2u w; w.x = pk2(v.x, v.y); w.y = pk2(v.z, v.w); *(v2u*)(O + row * N + col) = w; }
        else { f32x4* xp = (f32x4*)(X + row * N + col); *xp = *xp + acc; }
    }
}
__device__ __forceinline__ void final_norm(Frame& F, const float* g, const float* slab, int nslab) {
    f32x4 gv[4];
#pragma unroll
    for (int j = 0; j < 4; ++j) gv[j] = ((const f32x4*)g)[F.lane + 64 * j];
    for (int m = GW_ID(F); m < M; m += GW_N(F)) {
        f32x4* xr = (f32x4*)(F.out + (size_t)m * D); f32x4 v[4]; float ss = 0.f;
#pragma unroll
        for (int j = 0; j < 4; ++j) v[j] = xr[F.lane + 64 * j];
        if (m >= MP) for (int sl = 0; sl < nslab; ++sl) { const f32x4* sp = (const f32x4*)(slab + ((size_t)sl * MS + (m - MP)) * D);
#pragma unroll
            for (int j = 0; j < 4; ++j) v[j] = v[j] + sp[F.lane + 64 * j]; }
#pragma unroll
        for (int j = 0; j < 4; ++j) ss += (v[j].x * v[j].x + v[j].y * v[j].y) + (v[j].z * v[j].z + v[j].w * v[j].w);
        const float rs = 1.0f / sqrtf(wave_sum(ss) * (1.0f / D) + EPS);
#pragma unroll
        for (int j = 0; j < 4; ++j) xr[F.lane + 64 * j] = v[j] * rs * gv[j];
    }
}

#ifndef MK_ONLY
#define MK_ONLY -1
#endif
#ifndef MK_OFF
#define MK_OFF -2
#endif
#define EN(x) ((MK_ONLY < 0 || MK_ONLY == (x)) && MK_OFF != (x))
#ifndef MK_REP
#define MK_REP 0
#endif
#ifndef MK_MULTI
#define MK_MULTI 0
#endif
constexpr int N_PHASES = DEPTH * 10 + 1;
constexpr int KS_OUT = 4, KS_DN = 11;
struct Args { const float* in[30]; float* out; unsigned char* ws; int ph_lo, ph_hi; };
__host__ __device__ __forceinline__ bool phase_empty(int ph) { if (ph >= DEPTH * 10) return false; const int layer = ph / 10, st = ph % 10; return (layer % 3 == 2) && (st == 3 || st == 4); }

#define INP(k) ({ int k_ = (k); asm volatile("" : "+s"(k_)); ((const float* const*)__builtin_amdgcn_kernarg_segment_ptr())[k_]; })
__global__ void __launch_bounds__(NTHR, 2) trunk_fwd(Args args) {
    extern __shared__ __attribute__((aligned(16))) unsigned char lds[];
    Frame F;
    F.lds = (LAS unsigned char*)lds;
    F.MISC = (volatile LAS unsigned*)(F.lds + MISC_OFF);
    F.tid = threadIdx.x; F.lane = F.tid & 63; F.wave = __builtin_amdgcn_readfirstlane(F.tid >> 6);
    F.G = gridDim.x; { const int bx = blockIdx.x; F.vcu = (F.G % 8 == 0) ? (bx % 8) * (F.G / 8) + bx / 8 : bx; }
    const int vcu0 = F.vcu;
    F.out = args.out; F.ws = args.ws; F.ctl = (unsigned*)(args.ws + WS_CTL);
    for (int u = F.tid; u < (LDS_BYTES - LDSCTL_OFF) / 4; u += NTHR) ((LAS unsigned*)(F.lds + LDSCTL_OFF))[u] = 0u;
    __syncthreads();
    const int lo = args.ph_lo, hi = args.ph_hi;
    XcdBarrier bar; bar.bar = F.ctl + CW_BAR; bar.x = 0; bar.st = nullptr;
    if (hi - lo > 1) bar = xcd_barrier_post(F.ctl + CW_BAR, F.MISC + 8);

    bool again = false;
    for (int ph = lo; ph < hi; ++ph) {
        if (phase_empty(ph)) continue;
        if (ph == DEPTH * 10) { if (EN(10)) final_norm(F, INP(11), (const float*)(F.ws + WS_R1), KS_DN); continue; }
        const int layer = ph / 10, st = ph % 10, kind = layer % 3, j = layer / 3;
        { int t_ = threadIdx.x; asm volatile("" : "+v"(t_)); F.tid = t_; F.lane = t_ & 63; F.wave = __builtin_amdgcn_readfirstlane(t_ >> 6);
          int g_ = gridDim.x, v_ = vcu0; asm volatile("" : "+s"(g_), "+s"(v_)); F.G = g_; F.vcu = v_;
          unsigned char* w_ = args.ws; float* o_ = args.out; asm volatile("" : "+s"(w_), "+s"(o_)); F.ws = w_; F.out = o_; }
        bf16* WT_IN = (bf16*)(F.ws + WS_WIN); bf16* WT_OUT = (bf16*)(F.ws + WS_WOUT); bf16* WT_UP = (bf16*)(F.ws + WS_WUP); bf16* WT_DN = (bf16*)(F.ws + WS_WDN);
        bf16* XN = (bf16*)(F.ws + WS_XN); bf16* HB_ = (bf16*)(F.ws + WS_H); float* GATES = (float*)(F.ws + WS_GATES);


        if (st == 0 && EN(0)) {
            const float* win = (kind == 0) ? INP(12) + (size_t)j * D * A_IN : (kind == 1) ? INP(17) : INP(22);
            const float* wout = (kind == 0) ? INP(16) + (size_t)j * D * D : (kind == 1) ? INP(21) : INP(25);
            const int ldw = (kind == 2) ? C_IN : A_IN, nin = (kind == 2) ? C_IN : NPROJ;
            const int sb = (kind == 0) ? 512 : 0, se = (kind == 0) ? 1024 : (kind == 1) ? 512 : 0; const float sv = (kind == 0) ? 0.125f : 0.08838834764831845f;
            prep_two(F, win, ldw, D, nin, WT_IN, sb, se, sv, wout, D, D, D, WT_OUT);
            const float* xp = (layer == 0) ? INP(0) : F.out; const float* xs = (layer == 0) ? INP(1) : F.out + (size_t)MP * D; float* xd = (layer == 0) ? F.out : nullptr;
            const float* g = INP(9) + (size_t)layer * D;
            if (kind < 2) { __syncthreads(); stage_wgT(F, win, A_IN, NPROJ, (LAS float*)F.lds); __syncthreads();
                norm_rows<true>(F, xp, xs, xd, g, XN, GATES, (const LAS float*)F.lds, (const float*)(F.ws + WS_R1), (layer == 0) ? 0 : KS_DN); }
            else norm_rows<false>(F, xp, xs, xd, g, XN, nullptr, nullptr, (const float*)(F.ws + WS_R1), (layer == 0) ? 0 : KS_DN);
        } else if ((st == 1 || st == 7 || st == 5 || st == 9) && EN(1)) {
            const bool pj = (st == 1 || st == 7);
            const int N = (st == 7) ? 2 * DFF : (st == 1) ? ((kind == 2) ? C_IN : NPROJ) : D, K = (st == 9) ? DFF : D;
            const bf16* A = pj ? XN : (st == 5) ? HB_ : (const bf16*)(F.ws + WS_ACT);
            const bf16* Bt = (st == 1) ? WT_IN : (st == 7) ? WT_UP : (st == 5) ? WT_OUT : WT_DN;
            const bool rs_ = !pj;
            const int ksl = (st == 5) ? KS_OUT : KS_DN;
            pg8::Gemm g{A, Bt, rs_ ? MP : M, N, K}; pg8::StaticOrder S; S.init(rs_ ? MP : M, N, F.G, (int)blockIdx.x, K, rs_ ? (MS / 256) * (D / 256) * ksl : 0, rs_ ? ksl : 1);
            pg8::EpiDual E{pj, (bf16*)(F.ws + WS_PROJ), again ? (float*)(F.ws + WS_R1 + 32 * MiB) : F.out, N, (st == 1 && kind == 2) ? INP(23) : nullptr, (float*)(F.ws + WS_R1), MP, K / ksl, st == 7,
                pg8::EpiConvAct{(bf16*)(F.ws + WS_ACT), (bf16*)(F.ws + WS_U), INP(27) + (size_t)layer * 3 * DFF, INP(28) + (size_t)layer * DFF, (PG8_LAS float*)(F.lds + XCH_OFF), MP / 256}};
            pg8::gemm_phase<pg8::EpiDual, pg8::StaticOrder, true, true>(F.lds, g, S, E);
        } else if (st == 2) {
            if (kind == 0) { if (EN(20)) mlstm_A(F, INP(13) + j * HA, INP(14) + j * HA); if (EN(21)) mlstm_S(F, j, INP(13) + j * HA, INP(14) + j * HA, INP(15), INP(2), INP(3), INP(4)); }
            else if (kind == 1) { if (EN(22)) gla_A(F, INP(18), INP(19)); if (EN(23)) gla_S(F, INP(18), INP(19), INP(20), INP(5)); }
            else { if (EN(24)) swa_prompt(F, INP(24)); if (EN(25)) swa_sample(F, INP(24), INP(6), INP(7)); }
        } else if (st == 3) {
            if (kind == 0) { if (EN(30)) mlstm_B(F, j); } else { if (EN(31)) gla_B(F); }
        } else if (st == 4) {
            if (kind == 0) { if (EN(40)) mlstm_C(F, j, INP(13) + j * HA, INP(14) + j * HA, INP(15)); } else { if (EN(41)) gla_C(F, INP(18), INP(19), INP(20)); }
        } else if (st == 6 && EN(6)) {
            prep_two(F, INP(26) + (size_t)layer * D * 2 * DFF, 2 * DFF, D, 2 * DFF, WT_UP, 0, 0, 1.0f, INP(29) + (size_t)layer * DFF * D, D, DFF, D, WT_DN, true);
            norm_rows<false>(F, F.out, F.out + (size_t)MP * D, nullptr, INP(10) + (size_t)layer * D, XN, nullptr, nullptr, (const float*)(F.ws + WS_R1), KS_OUT);
        } else if (st == 8 && EN(8)) {
            convfix_phase(F, layer, INP(8), INP(27), INP(28));
        }
        if (((MK_REP >> st) & 1) && !again) { again = true; --ph; __syncthreads(); continue; }
        again = false;
        if (ph + 1 < hi) { xcd_barrier(bar);
#if defined(MK_BAR2)
            xcd_barrier(bar);
#endif
        }
    }
}

extern "C" void kernel_launch(void* const* d_in, const int* in_sizes, int n_in, void* d_out, int out_size, void* d_ws, size_t ws_size, hipStream_t stream) {
    static int grid = 0;
    if (grid == 0) {
        if (n_in != 30 || (size_t)out_size != O_END || ws_size < WS_END) { fprintf(stderr, "kernel_launch: built for 30 inputs, %zu outputs, >= %zu bytes of workspace; got n_in %d, out %d, ws %zu; nothing launched\n", (size_t)O_END, (size_t)WS_END, n_in, out_size, ws_size); grid = -1; return; }
        int dev = 0, cus = 0, per_cu = 0;
        if (hipGetDevice(&dev) != hipSuccess || hipDeviceGetAttribute(&cus, hipDeviceAttributeMultiprocessorCount, dev) != hipSuccess) { fprintf(stderr, "kernel_launch: device query failed\n"); grid = -1; return; }
        if (hipFuncSetAttribute((const void*)trunk_fwd, hipFuncAttributeMaxDynamicSharedMemorySize, LDS_BYTES) != hipSuccess) { fprintf(stderr, "kernel_launch: hipFuncSetAttribute failed\n"); grid = -1; return; }
        if (hipOccupancyMaxActiveBlocksPerMultiprocessor(&per_cu, (const void*)trunk_fwd, NTHR, LDS_BYTES) != hipSuccess || per_cu < 1) { fprintf(stderr, "kernel_launch: occupancy query says %d workgroups per CU\n", per_cu); }
        (void)hipGetLastError();
        grid = cus;
    }
    if (grid < 0) return;
    if (hipMemsetAsync((char*)d_ws + WS_CTL, 0, CTL_ZERO_BYTES, stream) != hipSuccess) { fprintf(stderr, "kernel_launch: hipMemsetAsync failed\n"); return; }
    Args a{};
    for (int i = 0; i < 30; ++i) a.in[i] = (const float*)d_in[i];
    a.out = (float*)d_out; a.ws = (unsigned char*)d_ws;
#if MK_MULTI
    for (int ph = 0; ph < N_PHASES; ++ph) { if (phase_empty(ph)) continue; a.ph_lo = ph; a.ph_hi = ph + 1;
        hipLaunchKernelGGL(trunk_fwd, dim3(grid), dim3(NTHR), LDS_BYTES, stream, a); }
#else
    a.ph_lo = 0; a.ph_hi = N_PHASES;
    hipLaunchKernelGGL(trunk_fwd, dim3(grid), dim3(NTHR), LDS_BYTES, stream, a);
#endif
    const hipError_t le = hipPeekAtLastError();
    if (le != hipSuccess) fprintf(stderr, "kernel_launch: launch failed: %s\n", hipGetErrorName(le));
}
```

```cpp
#include <hip/hip_runtime.h>
#include <cstdio>
#include <cstdint>
#define MK_MULTI 0
#define MK_REP 0
namespace pg8 {
#define PG8_LAS __attribute__((address_space(3)))
typedef unsigned short bf16_t;
typedef short bf16x8 __attribute__((ext_vector_type(8)));
typedef float f32x4 __attribute__((ext_vector_type(4)));
typedef unsigned u32x4 __attribute__((ext_vector_type(4)));
typedef unsigned u32x2 __attribute__((ext_vector_type(2)));
constexpr int BM = 256, BK = 64, HALF = 128, HTB = HALF * BK * 2  , STAGE_BYTES = 8 * HTB, NXCD = 8, WGM = 8;

__host__ __device__ __forceinline__ int lds_byte(int r, int c) { const int st = (r >> 4) * 2 + (c >> 5), rr = r & 15, cc = c & 31, ob = rr * 64 + cc * 2; return st * 1024 + (ob ^ (((ob >> 9) & 1) << 5)); }
__host__ __device__ __forceinline__ void stage_rc(int b, int& R, int& C) { const int st = b / 1024, sb = b % 1024, swz = sb ^ (((sb >> 9) & 1) << 5); R = (st >> 1) * 16 + swz / 64; C = (st & 1) * 32 + (swz % 64) / 2; }
__host__ __device__ __forceinline__ int perm32(int rho) { const int n = rho >> 4, i = rho & 15; return 8 * (i >> 2) + 4 * n + (i & 3); }

struct Unit { int pm, pn, k0, nt, mode; };
struct Gemm { const bf16_t* A; const bf16_t* Bt; int M, N, K; };

struct StaticOrder {
    int nM, nN, nwg, G, c, ntk, nsub, ks, kl;
    __host__ __device__ __forceinline__ void init(int M, int N, int G_, int c_, int K_, int nsub_ = 0, int ks_ = 1) { nM = M / BM; nN = N / BM; nwg = nM * nN; G = G_; c = c_; ntk = K_ / BK; nsub = nsub_; ks = ks_; kl = K_ / ks_; }
    __host__ __device__ __forceinline__ bool next(int i, Unit& u) const {
        const long L = (long)i * G + c; if (L >= nwg + nsub) return false;
        int pm, pn, k0, nt_, mode;
        if (L >= nwg) { const int e = (int)L - nwg, sl = e % ks, u8 = e / ks; pm = nM + u8 / nN; pn = u8 % nN; k0 = sl * kl; nt_ = kl / BK; mode = 1; }
        else {
            int wgid = (int)L; { const int q = nwg / NXCD, r = nwg % NXCD, xcd = wgid % NXCD, off = wgid / NXCD; wgid = (xcd < r ? xcd * (q + 1) : r * (q + 1) + (xcd - r) * q) + off; }
            const int nig = WGM * nN, gid = wgid / nig, fm = gid * WGM, gsz = (nM - fm) < WGM ? (nM - fm) : WGM;
            pm = fm + ((wgid % nig) % gsz); pn = (wgid % nig) / gsz; k0 = 0; nt_ = ntk; mode = 0; }
        u.pm = pm; u.pn = pn; u.k0 = k0; u.nt = nt_; u.mode = mode; return true;
    }
    __device__ __forceinline__ void a_ready(const Unit&) const {}
    __device__ __forceinline__ void done(const Unit&) const {}
};

__device__ __forceinline__ unsigned cvt_pk_bf16(float lo, float hi) { unsigned r; asm volatile("v_cvt_pk_bf16_f32 %0, %1, %2" : "=v"(r) : "v"(lo), "v"(hi)); return r; }
typedef float f32x2 __attribute__((ext_vector_type(2)));
struct EpiBf16 {
    static constexpr bool PERM = true, AFTER_DRAIN = false;
    bf16_t* O; int ldc; const float* bias;
    __device__ __forceinline__ void operator()(const f32x4 (&acc)[2][2][4][2], const Unit& u, int wr, int wc, int fr, int fq) const {
        const int row0 = u.pm * BM + wr * 64 + fr; const int col0 = u.pn * BM + wc * 32 + 8 * fq;
        f32x4 bv[2][2];
#pragma unroll
        for (int bj = 0; bj < 2; ++bj)
#pragma unroll
            for (int n = 0; n < 2; ++n) bv[bj][n] = bias ? *(const f32x4*)(bias + col0 + bj * HALF + 4 * n) : (f32x4){0.f, 0.f, 0.f, 0.f};
#pragma unroll
        for (int ai = 0; ai < 2; ++ai)
#pragma unroll
            for (int m = 0; m < 4; ++m) { bf16_t* rowp = O + (size_t)(row0 + ai * HALF + m * 16) * ldc + col0;
#pragma unroll
                for (int bj = 0; bj < 2; ++bj) { const f32x4 v0 = acc[ai][bj][m][0] + bv[bj][0], v1 = acc[ai][bj][m][1] + bv[bj][1];
                    u32x4 w; w.x = cvt_pk_bf16(v0[0], v0[1]); w.y = cvt_pk_bf16(v0[2], v0[3]); w.z = cvt_pk_bf16(v1[0], v1[1]); w.w = cvt_pk_bf16(v1[2], v1[3]);
                    *(u32x4*)(rowp + bj * HALF) = w; } }
    }
};
struct EpiRes {
    static constexpr bool PERM = false, AFTER_DRAIN = false;
    float* X; int ldc;
    __device__ __forceinline__ void operator()(const f32x4 (&acc)[2][2][4][2], const Unit& u, int wr, int wc, int fr, int fq) const {
        const int row0 = u.pm * BM + wr * 64 + fr, col0 = u.pn * BM + wc * 32 + 4 * fq;
#pragma unroll
        for (int ai = 0; ai < 2; ++ai)
#pragma unroll
            for (int m = 0; m < 4; ++m) { float* rowp = X + (size_t)(row0 + ai * HALF + m * 16) * ldc + col0;
                f32x4 b[2][2];
#pragma unroll
                for (int bj = 0; bj < 2; ++bj)
#pragma unroll
                    for (int n = 0; n < 2; ++n) b[bj][n] = *(const f32x4*)(rowp + bj * HALF + n * 16);
#pragma unroll
                for (int bj = 0; bj < 2; ++bj)
#pragma unroll
                    for (int n = 0; n < 2; ++n) *(f32x4*)(rowp + bj * HALF + n * 16) = b[bj][n] + acc[ai][bj][m][n];
                asm volatile("" ::: "memory"); }
    }
};
struct EpiConvAct {
    bf16_t* ACT; bf16_t* U; const float* cw; const float* cb; PG8_LAS float* xch; int first_raw_tile;
    __device__ __forceinline__ void operator()(const f32x4 (&acc)[2][2][4][2], const Unit& u, int wr, int wc, int fr, int fq) const {
        constexpr int FF = 2816;
        asm volatile("" : "+v"(fr), "+v"(fq), "+s"(wr), "+s"(wc));
        const int lane = fq * 16 + fr, fb_t = wc * 32 + 8 * fq, fb = u.pn * 128 + fb_t;
        const bool rawtile = u.pm >= first_raw_tile;
        if (fr >= 14) {
#pragma unroll
            for (int ai = 0; ai < 2; ++ai) { PG8_LAS float* xp = xch + ((ai * 2 + wr) * 2 + (fr - 14)) * 128 + fb_t;
#pragma unroll
                for (int n = 0; n < 2; ++n) *(PG8_LAS f32x4*)(xp + 4 * n) = acc[ai][0][3][n]; }
        }
        float w0[8], w1[8], w2[8], bb[8];
#pragma unroll
        for (int n = 0; n < 2; ++n) { const f32x4 a = *(const f32x4*)(cw + fb + 4 * n), b = *(const f32x4*)(cw + FF + fb + 4 * n), c = *(const f32x4*)(cw + 2 * FF + fb + 4 * n), d = *(const f32x4*)(cb + fb + 4 * n);
#pragma unroll
            for (int e = 0; e < 4; ++e) { w0[4 * n + e] = a[e]; w1[4 * n + e] = b[e]; w2[4 * n + e] = c[e]; bb[4 * n + e] = d[e]; } }
        asm volatile("s_waitcnt lgkmcnt(0)" ::: "memory"); __builtin_amdgcn_s_barrier(); asm volatile("" ::: "memory");
        const int s1 = (lane & 48) | ((fr + 15) & 15), s2 = (lane & 48) | ((fr + 14) & 15);
#pragma unroll
        for (int ai = 0; ai < 2; ++ai) {
            float p1[8], p2[8];
            const int pb = ai * 2 + wr - 1;
#pragma unroll
            for (int i = 0; i < 8; ++i) { p1[i] = 0.f; p2[i] = 0.f; }
            if (pb >= 0 && fr < 2) { const PG8_LAS float* x63 = xch + (pb * 2 + 1) * 128 + fb_t; const PG8_LAS float* x62 = xch + (pb * 2 + 0) * 128 + fb_t;
#pragma unroll
                for (int i = 0; i < 8; ++i) { const float a63 = x63[i], a62 = x62[i]; p1[i] = a63; p2[i] = (fr == 0) ? a62 : a63; } }
#pragma unroll
            for (int m = 0; m < 4; ++m) {
                const size_t row = (size_t)u.pm * BM + ai * HALF + wr * 64 + m * 16 + fr;
                float o[8];
#pragma unroll
                for (int n = 0; n < 2; ++n)
#pragma unroll
                    for (int e = 0; e < 4; ++e) { const int i = 4 * n + e; const float g0 = acc[ai][0][m][n][e];
                        const float r1 = __shfl(g0, s1), r2 = __shfl(g0, s2);
                        const float g1 = (fr >= 1) ? r1 : p1[i], g2 = (fr >= 2) ? r2 : p2[i];
                        p1[i] = r1; p2[i] = r2;
                        const float cv = bb[i] + w0[i] * g2 + w1[i] * g1 + w2[i] * g0;
                        o[i] = cv / (1.0f + __expf(-cv)) * acc[ai][1][m][n][e]; }
                if (!rawtile) { u32x4 w; w.x = cvt_pk_bf16(o[0], o[1]); w.y = cvt_pk_bf16(o[2], o[3]); w.z = cvt_pk_bf16(o[4], o[5]); w.w = cvt_pk_bf16(o[6], o[7]); *(u32x4*)(ACT + row * FF + fb) = w; }
                const bool rawrow = rawtile || (ai == 0 && wr == 0 && m == 0 && fr < 2) || (ai == 1 && wr == 1 && m == 3 && fr >= 14);
                if (rawrow) { const f32x4 a0 = acc[ai][0][m][0], a1 = acc[ai][0][m][1], b0 = acc[ai][1][m][0], b1 = acc[ai][1][m][1];
                    u32x4 w; w.x = cvt_pk_bf16(a0[0], a0[1]); w.y = cvt_pk_bf16(a0[2], a0[3]); w.z = cvt_pk_bf16(a1[0], a1[1]); w.w = cvt_pk_bf16(a1[2], a1[3]); *(u32x4*)(U + row * (2 * FF) + fb) = w;
                    w.x = cvt_pk_bf16(b0[0], b0[1]); w.y = cvt_pk_bf16(b0[2], b0[3]); w.z = cvt_pk_bf16(b1[0], b1[1]); w.w = cvt_pk_bf16(b1[2], b1[3]); *(u32x4*)(U + row * (2 * FF) + FF + fb) = w; }
                __builtin_amdgcn_sched_barrier(0);
            }
        }
    }
};
struct EpiDual {
    static constexpr bool AFTER_DRAIN = false;
    bool PERM; bf16_t* O; float* X; int ldc; const float* bias; float* slab; int row_base, kl; bool conv; EpiConvAct ca;
    __device__ __forceinline__ void operator()(const f32x4 (&acc)[2][2][4][2], const Unit& u, int wr, int wc, int fr, int fq) const {
        asm volatile("" : "+v"(fr), "+v"(fq), "+s"(wr), "+s"(wc));
        if (u.mode == 1) {
            float* sb = slab + (size_t)(u.k0 / kl) * 512 * ldc; const int row0 = u.pm * BM - row_base + wr * 64 + fr, col0 = u.pn * BM + wc * 32 + 4 * fq;
#pragma unroll
            for (int ai = 0; ai < 2; ++ai)
#pragma unroll
                for (int m = 0; m < 4; ++m) { float* rowp = sb + (size_t)(row0 + ai * HALF + m * 16) * ldc + col0;
#pragma unroll
                    for (int bj = 0; bj < 2; ++bj)
#pragma unroll
                        for (int n = 0; n < 2; ++n) *(f32x4*)(rowp + bj * HALF + n * 16) = acc[ai][bj][m][n]; }
        } else if (conv) { ca(acc, u, wr, wc, fr, fq);
        } else if (PERM) { EpiBf16 e{O, ldc, bias}; e(acc, u, wr, wc, fr, fq); } else { EpiRes e{X, ldc}; e(acc, u, wr, wc, fr, fq); }
    }
};
template <class Epi, class Sched, bool ALIGN_EPI = false, bool SP2 = false>
__device__ __forceinline__ void gemm_phase(PG8_LAS unsigned char* lds, const Gemm g, const Sched& S, const Epi& E) {
    int tid_ = threadIdx.x; asm volatile("" : "+v"(tid_));
    const int tid = tid_, wid = __builtin_amdgcn_readfirstlane(tid >> 6), lane = tid & 63, wr = wid >> 2, wc = wid & 3, fr = lane & 15, fq = lane >> 4;
    const int K = g.K;
    unsigned voffA[2], voffB[2];
#pragma unroll
    for (int i = 0; i < 2; ++i) { int R, C; stage_rc(tid * 16 + i * 8192, R, C); const int Rb = E.PERM ? ((R & ~31) + perm32(R & 31)) : R;
        voffA[i] = (unsigned)(R * K + C) * 2u; voffB[i] = (unsigned)(Rb * K + C) * 2u; }
    const size_t kstep = (size_t)(BK * 2);
    const size_t hstep = (size_t)HALF * K * 2;
    const size_t tstep = 2 * hstep;
    const unsigned ldsw = (unsigned)wid * 1024u;
    const int aoff = lds_byte(wr * 64 + fr, fq * 8), boff = lds_byte(wc * 32 + fr, fq * 8);
#define PG8_SA(b, h) (((b) * 2 + (h)) * HTB)
#define PG8_SB(b, h) ((4 + (b) * 2 + (h)) * HTB)
#define PG8_STAGE(bufoff, gbase, voff) do { _Pragma("unroll") for (int _i = 0; _i < 2; ++_i) \
        __builtin_amdgcn_global_load_lds((const unsigned*)((const char*)(gbase) + (voff)[_i]), (PG8_LAS unsigned*)(lds + (bufoff) + ldsw + _i * 8192), 16, 0, 0); } while (0)
#define PG8_LDA(dst, b, h) do { _Pragma("unroll") for (int m = 0; m < 4; ++m) _Pragma("unroll") for (int k = 0; k < 2; ++k) dst[m][k] = *(const PG8_LAS bf16x8*)(lds + PG8_SA(b, h) + aoff + m * 2048 + k * 1024); } while (0)
#define PG8_LDB(dst, b, h) do { _Pragma("unroll") for (int n = 0; n < 2; ++n) _Pragma("unroll") for (int k = 0; k < 2; ++k) dst[n][k] = *(const PG8_LAS bf16x8*)(lds + PG8_SB(b, h) + boff + n * 2048 + k * 1024); } while (0)
#define PG8_MMA(ai, bj, At, Bt) do { __builtin_amdgcn_s_setprio(1); _Pragma("unroll") for (int m = 0; m < 4; ++m) _Pragma("unroll") for (int n = 0; n < 2; ++n) _Pragma("unroll") for (int k = 0; k < 2; ++k) \
        acc[ai][bj][m][n] = __builtin_amdgcn_mfma_f32_16x16x32_bf16(Bt[n][k], At[m][k], acc[ai][bj][m][n], 0, 0, 0); __builtin_amdgcn_s_setprio(0); } while (0)
#define PG8_WAIT_V(n) asm volatile("s_waitcnt vmcnt(" #n ")" ::: "memory")
#define PG8_WAIT_L(n) asm volatile("s_waitcnt lgkmcnt(" #n ")" ::: "memory")
#define PG8_BAR __builtin_amdgcn_s_barrier()
#define PG8_SCHED __builtin_amdgcn_sched_barrier(0)
    Unit cur, nxt; int ui = 0;
    if (!S.next(0, cur)) return;
    f32x4 acc[2][2][4][2];
#pragma unroll
    for (int a = 0; a < 2; ++a)
#pragma unroll
        for (int b = 0; b < 2; ++b)
#pragma unroll
            for (int m = 0; m < 4; ++m)
#pragma unroll
                for (int n = 0; n < 2; ++n) acc[a][b][m][n] = (f32x4){0.f, 0.f, 0.f, 0.f};
    bf16x8 At[4][2], B0[2][2], B1[2][2];
    const char* cA = (const char*)g.A + (size_t)cur.pm * tstep + (size_t)cur.k0 * 2; const char* cB = (const char*)g.Bt + (size_t)cur.pn * tstep + (size_t)cur.k0 * 2;
    S.a_ready(cur);
    if constexpr (SP2) {
        PG8_STAGE(PG8_SB(0, 0), cB, voffB); PG8_STAGE(PG8_SB(0, 1), cB + hstep, voffB); PG8_STAGE(PG8_SA(0, 0), cA, voffA); PG8_STAGE(PG8_SA(0, 1), cA + hstep, voffA);
        if (wr == 1) PG8_BAR;
        PG8_WAIT_V(2); PG8_BAR;
        PG8_STAGE(PG8_SB(1, 0), cB + kstep, voffB); PG8_STAGE(PG8_SA(1, 0), cA + kstep, voffA); PG8_STAGE(PG8_SB(1, 1), cB + hstep + kstep, voffB);
        PG8_WAIT_V(6); PG8_BAR;
    } else {
        PG8_STAGE(PG8_SB(0, 0), cB, voffB); PG8_STAGE(PG8_SA(0, 0), cA, voffA); PG8_STAGE(PG8_SB(0, 1), cB + hstep, voffB); PG8_STAGE(PG8_SA(0, 1), cA + hstep, voffA);
        if (wr == 1) PG8_BAR;
        PG8_WAIT_V(4); PG8_BAR;
        PG8_STAGE(PG8_SB(1, 0), cB + kstep, voffB); PG8_STAGE(PG8_SA(1, 0), cA + kstep, voffA); PG8_STAGE(PG8_SB(1, 1), cB + hstep + kstep, voffB);
        PG8_WAIT_V(6); PG8_BAR;
    }
    for (;;) {
        const bool has_next = S.next(ui + 1, nxt);
        const char* nA = has_next ? (const char*)g.A + (size_t)nxt.pm * tstep + (size_t)nxt.k0 * 2 : cA; const char* nB = has_next ? (const char*)g.Bt + (size_t)nxt.pn * tstep + (size_t)nxt.k0 * 2 : cB;
        const int nt = cur.nt;
        for (int t = 0; t < nt; t += 2) {
            const bool last = (t == nt - 2);
            const char* a1 = cA + (size_t)(t + 1) * kstep;
            const char* a2 = last ? nA : cA + (size_t)(t + 2) * kstep; const char* b2 = last ? nB : cB + (size_t)(t + 2) * kstep;
            const char* a3 = a2 + kstep; const char* b3 = b2 + kstep;
            if (last && has_next) S.a_ready(nxt);
            if constexpr (SP2) {
            PG8_LDB(B0, 0, 0); PG8_LDB(B1, 0, 1); PG8_SCHED; PG8_LDA(At, 0, 0); PG8_STAGE(PG8_SA(1, 1), a1 + hstep, voffA);
            PG8_WAIT_V(8); PG8_WAIT_L(0); PG8_BAR; PG8_MMA(0, 0, At, B0); PG8_MMA(0, 1, At, B1); PG8_BAR; PG8_SCHED;
            PG8_LDA(At, 0, 1); PG8_STAGE(PG8_SB(0, 0), b2, voffB); PG8_STAGE(PG8_SB(0, 1), b2 + hstep, voffB); PG8_STAGE(PG8_SA(0, 0), a2, voffA);
            PG8_WAIT_V(8); PG8_WAIT_L(0); PG8_BAR; PG8_MMA(1, 0, At, B0); PG8_MMA(1, 1, At, B1); PG8_BAR; PG8_SCHED;
            PG8_LDB(B0, 1, 0); PG8_LDB(B1, 1, 1); PG8_SCHED; PG8_LDA(At, 1, 0); PG8_STAGE(PG8_SA(0, 1), a2 + hstep, voffA);
            PG8_WAIT_V(8); PG8_WAIT_L(0); PG8_BAR; PG8_MMA(0, 0, At, B0); PG8_MMA(0, 1, At, B1); PG8_BAR; PG8_SCHED;
            PG8_LDA(At, 1, 1); PG8_STAGE(PG8_SB(1, 0), b3, voffB); PG8_STAGE(PG8_SB(1, 1), b3 + hstep, voffB); PG8_STAGE(PG8_SA(1, 0), a3, voffA);
            PG8_WAIT_V(8); PG8_WAIT_L(0); PG8_BAR; PG8_MMA(1, 0, At, B0); PG8_MMA(1, 1, At, B1); PG8_BAR; PG8_SCHED;
            } else {
            PG8_LDB(B0, 0, 0); PG8_SCHED; PG8_LDA(At, 0, 0); PG8_STAGE(PG8_SA(1, 1), a1 + hstep, voffA);
            PG8_WAIT_L(8); PG8_BAR; PG8_WAIT_L(0); PG8_MMA(0, 0, At, B0); PG8_BAR; PG8_SCHED;
            PG8_LDB(B1, 0, 1); PG8_STAGE(PG8_SB(0, 0), b2, voffB);
            PG8_BAR; PG8_WAIT_L(0); PG8_MMA(0, 1, At, B1); PG8_BAR;
            PG8_LDA(At, 0, 1); PG8_STAGE(PG8_SA(0, 0), a2, voffA);
            PG8_BAR; PG8_WAIT_L(0); PG8_MMA(1, 0, At, B0); PG8_BAR; PG8_SCHED;
            PG8_STAGE(PG8_SB(0, 1), b2 + hstep, voffB);
            PG8_WAIT_V(6); PG8_BAR; PG8_MMA(1, 1, At, B1); PG8_BAR;
            PG8_LDB(B0, 1, 0); PG8_SCHED; PG8_LDA(At, 1, 0); PG8_STAGE(PG8_SA(0, 1), a2 + hstep, voffA);
            PG8_WAIT_L(8); PG8_BAR; PG8_WAIT_L(0); PG8_MMA(0, 0, At, B0); PG8_BAR; PG8_SCHED;
            PG8_LDB(B1, 1, 1); PG8_STAGE(PG8_SB(1, 0), b3, voffB);
            PG8_BAR; PG8_WAIT_L(0); PG8_MMA(0, 1, At, B1); PG8_BAR;
            PG8_LDA(At, 1, 1); PG8_STAGE(PG8_SA(1, 0), a3, voffA);
            PG8_BAR; PG8_WAIT_L(0); PG8_MMA(1, 0, At, B0); PG8_BAR; PG8_SCHED;
            PG8_STAGE(PG8_SB(1, 1), b3 + hstep, voffB);
            PG8_WAIT_V(6); PG8_BAR; PG8_MMA(1, 1, At, B1); PG8_BAR;
            }
        }
        if constexpr (ALIGN_EPI) { if (wr == 0) PG8_BAR; }
        if constexpr (!Epi::AFTER_DRAIN) { E(acc, cur, wr, wc, fr, fq); S.done(cur); }
        if (!has_next) break;
#pragma unroll
        for (int a = 0; a < 2; ++a)
#pragma unroll
            for (int b = 0; b < 2; ++b)
#pragma unroll
                for (int m = 0; m < 4; ++m)
#pragma unroll
                    for (int n = 0; n < 2; ++n) acc[a][b][m][n] = (f32x4){0.f, 0.f, 0.f, 0.f};
        cur = nxt; cA = nA; cB = nB; ++ui;
        if constexpr (ALIGN_EPI) { if (wr == 1) PG8_BAR; }
    }
    PG8_WAIT_V(0);
    if constexpr (!ALIGN_EPI) { if (wr == 0) PG8_BAR; }
    PG8_BAR;
    if constexpr (Epi::AFTER_DRAIN) { E.fused(acc, cur, wr, wc, fr, fq, lds, wid, lane); S.done(cur); }
#undef PG8_SA
#undef PG8_SB
#undef PG8_STAGE
#undef PG8_LDA
#undef PG8_LDB
#undef PG8_MMA
#undef PG8_WAIT_V
#undef PG8_WAIT_L
#undef PG8_BAR
#undef PG8_SCHED
}
}
constexpr int NWAVES = 8, NTHR = 512;
constexpr int D = 1024, BP = 4, TP = 4096, MP = BP * TP, BS = 128, TS = 4, MS = BS * TS, M = MP + MS;
constexpr int DEPTH = 4;
constexpr int HA = 8, DKA = 64, DVA = 128;
constexpr int HB = 4, DKB = 128, DVB = 256, RANK = 16;
constexpr int HC = 16, HKV = 4, HDC = 64, GROUP = 4, WIN = 128;
constexpr int DFF = 2816, A_IN = 3088, B_IN = 3088, C_IN = 1536, NPROJ = 3072;
constexpr int NCH = 64, LCH = 64;
constexpr float EPS = 1e-6f, SOFTCAP = 15.0f;

constexpr size_t O_YP = 0, O_YS = O_YP + (size_t)MP * D, O_PAC = O_YS + (size_t)MS * D, O_PAN = O_PAC + 2ull * BP * HA * DKA * DVA, O_PAM = O_PAN + 2ull * BP * HA * DKA,
    O_PG = O_PAM + 2ull * BP * HA, O_PSK = O_PG + (size_t)BP * HB * DKB * DVB, O_PSV = O_PSK + (size_t)BP * WIN * HKV * HDC, O_PF = O_PSV + (size_t)BP * WIN * HKV * HDC,
    O_SAC = O_PF + 4ull * BP * 2 * DFF, O_SAN = O_SAC + 2ull * BS * HA * DKA * DVA, O_SAM = O_SAN + 2ull * BS * HA * DKA, O_SG = O_SAM + 2ull * BS * HA,
    O_SSK = O_SG + (size_t)BS * HB * DKB * DVB, O_SSV = O_SSK + (size_t)BS * WIN * HKV * HDC, O_SF = O_SSV + (size_t)BS * WIN * HKV * HDC, O_END = O_SF + 4ull * BS * 2 * DFF;
static_assert(O_END == 63666240ull, "output size");

constexpr size_t MiB = 1u << 20;
constexpr size_t WS_CTL = 0, CTL_ZERO_BYTES = 1 * MiB;
constexpr size_t WS_WIN = 1 * MiB, WS_WOUT = 7 * MiB, WS_WUP = 9 * MiB, WS_WDN = 20 * MiB;
constexpr size_t WS_GATES = 26 * MiB;
constexpr size_t WS_XN = 28 * MiB;
constexpr size_t WS_H = 61 * MiB;
constexpr size_t WS_R1 = 94 * MiB;
constexpr size_t WS_PROJ = WS_R1;
constexpr size_t WS_SCR = WS_R1 + 99 * MiB;
constexpr size_t SC_LOC = WS_SCR;
constexpr size_t SC_ST = WS_SCR + 128 * MiB;
constexpr size_t SC_AUX = WS_SCR + 192 * MiB;
constexpr size_t WS_U = WS_R1;
constexpr size_t WS_ACT = WS_R1 + 182 * MiB;
constexpr size_t WS_END = WS_R1 + 293 * MiB;
static_assert(WS_WIN + (size_t)NPROJ * D * 2 <= WS_WOUT && WS_WOUT + (size_t)D * D * 2 <= WS_WUP && WS_WUP + 2ull * DFF * D * 2 <= WS_WDN && WS_WDN + (size_t)D * DFF * 2 <= WS_GATES, "ws map: weights");
static_assert(WS_GATES + (size_t)M * 16 * 4 <= WS_XN && WS_XN + (size_t)M * D * 2 <= WS_H && WS_H + (size_t)M * D * 2 <= WS_R1 && WS_PROJ + (size_t)M * NPROJ * 2 <= WS_SCR, "ws map: activations");
static_assert(WS_U + (size_t)M * 2 * DFF * 2 <= WS_ACT && WS_ACT + (size_t)M * DFF * 2 <= WS_END && SC_AUX + 2 * MiB <= WS_END, "ws map: ffn");
constexpr int AX_CHK = 0;
constexpr int AX_MST = 8192;
constexpr int AX_NLOC = 16384;
constexpr int AX_NST = 16384 + 131072;
constexpr int AX_BL = 0;
static_assert((AX_NST + 131072) * 4 <= (int)(2 * MiB), "aux");

constexpr int CW_BAR = 4096;

constexpr int RING_BYTES = 131072;
constexpr int LDSCTL_OFF = RING_BYTES, MISC_OFF = LDSCTL_OFF + 320;
constexpr int XCH_OFF = 132096;
constexpr int LDS_BYTES = 147456;

#define GAS __attribute__((address_space(1)))
#define LAS __attribute__((address_space(3)))
typedef unsigned short bf16;
typedef unsigned v4u __attribute__((ext_vector_type(4)));
typedef unsigned v2u __attribute__((ext_vector_type(2)));
typedef float f32x4 __attribute__((ext_vector_type(4)));
typedef float f32x2 __attribute__((ext_vector_type(2)));
typedef short bf16x8 __attribute__((ext_vector_type(8)));
#define LDS_WAIT() asm volatile("s_waitcnt lgkmcnt(0)" ::: "memory")
#define VM_WAIT() asm volatile("s_waitcnt vmcnt(0)" ::: "memory")
__device__ __forceinline__ unsigned f2bf(float f) { unsigned u = __builtin_bit_cast(unsigned, f); return (u + 0x7fffu + ((u >> 16) & 1u)) >> 16; }
__device__ __forceinline__ unsigned pk2(float lo, float hi) { return f2bf(lo) | (f2bf(hi) << 16); }
__device__ __forceinline__ float bf2f(unsigned h) { return __builtin_bit_cast(float, (h & 0xffffu) << 16); }
__device__ __forceinline__ float bflo(unsigned w) { return __builtin_bit_cast(float, w << 16); }
__device__ __forceinline__ float bfhi(unsigned w) { return __builtin_bit_cast(float, w & 0xffff0000u); }
__device__ __forceinline__ float wave_sum(float v) {
#pragma unroll
    for (int o = 1; o < 64; o <<= 1) v += __shfl_xor(v, o);
    return v;
}
__device__ __forceinline__ float wave_max(float v) {
#pragma unroll
    for (int o = 1; o < 64; o <<= 1) v = fmaxf(v, __shfl_xor(v, o));
    return v;
}
__device__ __forceinline__ float wave_scan_sum(float v, int lane) {
#pragma unroll
    for (int o = 1; o < 64; o <<= 1) { const float y = __shfl_up(v, o); if (lane >= o) v += y; }
    return v;
}
__device__ __forceinline__ float wave_scan_max(float v, int lane) {
#pragma unroll
    for (int o = 1; o < 64; o <<= 1) { const float y = __shfl_up(v, o); if (lane >= o) v = fmaxf(v, y); }
    return v;
}
__device__ __forceinline__ float logsigmoidf(float x) { return fminf(x, 0.f) - __logf(1.0f + __expf(-fabsf(x))); }
__device__ __forceinline__ float softcapf(float z) { const float e = __expf(z * (2.0f / SOFTCAP)); return SOFTCAP * (1.0f - 2.0f / (e + 1.0f)); }
__device__ __forceinline__ float sigmoidf_(float x) { return 1.0f / (1.0f + __expf(-x)); }

template <int KS> __device__ __forceinline__ f32x4 mma_ll(const LAS bf16* X, int ldx, const LAS bf16* Y, int ldy, f32x4 acc, int lane) {
    const int r16 = lane & 15, q = lane >> 4;
#pragma unroll
    for (int ks = 0; ks < KS; ++ks) {
        const bf16x8 a = *(const LAS bf16x8*)(X + r16 * ldx + ks * 32 + q * 8);
        const bf16x8 b = *(const LAS bf16x8*)(Y + r16 * ldy + ks * 32 + q * 8);
        acc = __builtin_amdgcn_mfma_f32_16x16x32_bf16(a, b, acc, 0, 0, 0);
    }
    return acc;
}
template <int KS> __device__ __forceinline__ f32x4 mma_gl(const bf16* X, int ldx, const LAS bf16* Y, int ldy, f32x4 acc, int lane) {
    const int r16 = lane & 15, q = lane >> 4;
    bf16x8 a[KS];
#pragma unroll
    for (int ks = 0; ks < KS; ++ks) a[ks] = *(const bf16x8*)(X + (size_t)r16 * ldx + ks * 32 + q * 8);
#pragma unroll
    for (int ks = 0; ks < KS; ++ks) {
        const bf16x8 b = *(const LAS bf16x8*)(Y + r16 * ldy + ks * 32 + q * 8);
        acc = __builtin_amdgcn_mfma_f32_16x16x32_bf16(a[ks], b, acc, 0, 0, 0);
    }
    return acc;
}
template <int R, int C> __device__ __forceinline__ void stage_nat(LAS bf16* dst, int lld, const bf16* src, size_t gld, int tid) {
    constexpr int CP = C / 8;
    for (int p = tid; p < R * CP; p += NTHR) { const int r = p / CP, c8 = p % CP; *(LAS v4u*)(dst + r * lld + c8 * 8) = *(const v4u*)(src + (size_t)r * gld + c8 * 8); }
}
template <int R, int C> __device__ __forceinline__ void stage_tr(LAS bf16* dst, int lld, const bf16* src, size_t gld, int tid) {
    constexpr int CP = C / 8;
    for (int p = tid; p < R * CP; p += NTHR) { const int r = p % R, c8 = p / R; const v4u v = *(const v4u*)(src + (size_t)r * gld + c8 * 8);
        LAS bf16* d = dst + (c8 * 8) * lld + r;
        d[0 * lld] = (bf16)(v.x & 0xffffu); d[1 * lld] = (bf16)(v.x >> 16); d[2 * lld] = (bf16)(v.y & 0xffffu); d[3 * lld] = (bf16)(v.y >> 16);
        d[4 * lld] = (bf16)(v.z & 0xffffu); d[5 * lld] = (bf16)(v.z >> 16); d[6 * lld] = (bf16)(v.w & 0xffffu); d[7 * lld] = (bf16)(v.w >> 16); }
}
#define XB_TMO      128
#define XB_XCNT(j)  (256  + 64 * (j))
#define XB_XSUB(j)  (1280 + 64 * (j))
#define XB_XGEN(j)  (2304 + 64 * (j))
#define XB_TOP      3328
#define XB_TOPGEN   3392
#define XCD_BAR_WORDS 3456
#define XB_SPIN_CAP (1u << 18)

__device__ __forceinline__ unsigned xb_ld(unsigned* p)              { return __hip_atomic_load(p, __ATOMIC_RELAXED, __HIP_MEMORY_SCOPE_AGENT); }
__device__ __forceinline__ unsigned xb_add(unsigned* p, unsigned v) { return __hip_atomic_fetch_add(p, v, __ATOMIC_RELAXED, __HIP_MEMORY_SCOPE_AGENT); }
__device__ __forceinline__ unsigned xb_xcc_id() { return (unsigned)__builtin_amdgcn_s_getreg((3 << 11) | 20) & 0xFu; }
#define XB_SPIN(cond, bar) do { unsigned _sp = 0; while (cond) { __builtin_amdgcn_s_sleep(1); \
    if ((++_sp & 255u) == 0u) { if (xb_ld(&(bar)[XB_TMO])) break; if (_sp > XB_SPIN_CAP) { atomicAdd(&(bar)[XB_TMO], 1u); break; } } } } while (0)

struct XcdBarrier {
    unsigned* bar; unsigned x;
    volatile LAS unsigned* st;
};

__device__ __forceinline__ XcdBarrier xcd_barrier_post(unsigned* bar, volatile LAS unsigned* st) {
    XcdBarrier b; b.bar = bar; b.x = xb_xcc_id(); b.st = st;
    if (threadIdx.x == 0) (void)xb_add(&bar[XB_XCNT(b.x)], 1u);
    return b;
}
__device__ __forceinline__ void xcd_barrier_complete(unsigned* bar, unsigned x, unsigned& nloc, unsigned& nx) {
    const unsigned G = gridDim.x * gridDim.y * gridDim.z;
    unsigned sum, cnt, mine, sp = 0u;
    for (;;) {
        sum = 0u; cnt = 0u; mine = 0u;
#pragma unroll
        for (unsigned j = 0; j < 16; ++j) { const unsigned c = xb_ld(&bar[XB_XCNT(j)]); sum += c; cnt += (c > 0u) ? 1u : 0u; mine = (j == x) ? c : mine; }
        if (sum == G) break;
        __builtin_amdgcn_s_sleep(1);
        if ((++sp & 255u) == 0u) { if (xb_ld(&bar[XB_TMO])) break; if (sp > XB_SPIN_CAP) { atomicAdd(&bar[XB_TMO], 1u); break; } }
    }
    nloc = mine > 0u ? mine : 1u; nx = cnt > 0u ? cnt : 1u;
}

__device__ __forceinline__ void xcd_barrier(const XcdBarrier& b) {
    asm volatile("s_waitcnt vmcnt(0)" ::: "memory");
    __syncthreads();
    if (threadIdx.x == 0) {
        unsigned* bar = b.bar;
        __builtin_amdgcn_s_waitcnt(0);
        unsigned nloc = b.st[0], nx = b.st[1];
        if (nloc == 0u) { xcd_barrier_complete(bar, b.x, nloc, nx); b.st[0] = nloc; b.st[1] = nx; }
        const unsigned old = xb_add(&bar[XB_XSUB(b.x)], 1u);
        const unsigned gen = old / nloc;
        if (old + 1u == (gen + 1u) * nloc) {
            __builtin_amdgcn_fence(__ATOMIC_RELEASE, "agent");
            asm volatile("s_waitcnt vmcnt(0)" ::: "memory");
            const unsigned og = xb_add(&bar[XB_TOP], 1u);
            const unsigned tg = og / nx;
            if (og + 1u == (tg + 1u) * nx) xb_add(&bar[XB_TOPGEN], 1u);
            else XB_SPIN(xb_ld(&bar[XB_TOPGEN]) == tg, bar);
            __builtin_amdgcn_fence(__ATOMIC_ACQUIRE, "agent");
            xb_add(&bar[XB_XGEN(b.x)], 1u);
            asm volatile("s_waitcnt vmcnt(0)" ::: "memory");
        } else {
            XB_SPIN(xb_ld(&bar[XB_XGEN(b.x)]) == gen, bar);
            __builtin_amdgcn_fence(__ATOMIC_ACQUIRE, "agent");
            asm volatile("s_waitcnt vmcnt(0)" ::: "memory");
        }
    }
    __syncthreads();
}
struct Frame {
    LAS unsigned char* lds;
    volatile LAS unsigned* MISC;
    unsigned* ctl;
    int tid, lane, wave;
    int vcu, G;
    float* out; unsigned char* ws;
};
#define GW_ID(F) ((F).vcu * NWAVES + (F).wave)
#define GW_N(F) ((F).G * NWAVES)
#ifndef MK_TSEG
#define MK_TSEG 0
#endif
#if MK_TSEG
#define TS_MARK(F, id) do { if (blockIdx.x == 0 && (F).tid == 0) { const unsigned long long t__ = __builtin_amdgcn_s_memrealtime(); volatile LAS unsigned long long* T__ = (volatile LAS unsigned long long*)((F).MISC + 16); \
    if ((F).MISC[22] == (unsigned)MK_TSEG) T__[1] += t__ - T__[0]; T__[0] = t__; (F).MISC[22] = (unsigned)(id); } } while (0)
#else
#define TS_MARK(F, id) do { } while (0)
#endif

__device__ __forceinline__ void transpose_item(const float* __restrict__ W, int ldw, int K, bf16* __restrict__ WT, LAS float* scr, int kb, int nb, int sb, int se, float sv, int lane, bool upmap = false) {
    const int k0 = 64 * kb, n0 = 32 * nb;
    const int d0 = !upmap ? n0 : (n0 < DFF ? (n0 >> 7) * 256 + (n0 & 127) : ((n0 - DFF) >> 7) * 256 + 128 + ((n0 - DFF) & 127));
    f32x4 v[8];
#pragma unroll
    for (int i = 0; i < 8; ++i) v[i] = *(const f32x4*)(W + (size_t)(k0 + i * 8 + (lane >> 3)) * ldw + n0 + (lane & 7) * 4);
#pragma unroll
    for (int i = 0; i < 8; ++i) { LAS float* d = scr + (i * 8 + (lane >> 3)) * 33 + (lane & 7) * 4; d[0] = v[i].x; d[1] = v[i].y; d[2] = v[i].z; d[3] = v[i].w; }
    LDS_WAIT(); asm volatile("" ::: "memory");
    const int c = lane & 7;
    const float sc = (n0 >= sb && n0 < se) ? sv : 1.0f;
#pragma unroll
    for (int j = 0; j < 4; ++j) { const int n = (lane >> 3) + 8 * j; const LAS float* s = scr + (8 * c) * 33 + n;
        v4u o; o.x = pk2(s[0 * 33] * sc, s[1 * 33] * sc); o.y = pk2(s[2 * 33] * sc, s[3 * 33] * sc); o.z = pk2(s[4 * 33] * sc, s[5 * 33] * sc); o.w = pk2(s[6 * 33] * sc, s[7 * 33] * sc);
        *(v4u*)(WT + (size_t)(d0 + n) * K + k0 + 8 * c) = o; }
    LDS_WAIT(); asm volatile("" ::: "memory");
}
__device__ __forceinline__ void prep_two(Frame& F, const float* W0, int ldw0, int K0, int N0, bf16* T0, int sb, int se, float sv, const float* W1, int ldw1, int K1, int N1, bf16* T1, bool upmap0 = false, int cu_lo = 0) {
    if ((int)blockIdx.x < cu_lo) return;
    LAS float* scr = (LAS float*)(F.lds + F.wave * 16384);
    const int nb0 = N0 / 32, I0 = (K0 / 64) * nb0, nb1 = N1 / 32, I1 = (K1 / 64) * nb1;
    for (int it = ((int)blockIdx.x - cu_lo) * NWAVES + F.wave; it < I0 + I1; it += (F.G - cu_lo) * NWAVES) {
        if (it < I0) transpose_item(W0, ldw0, K0, T0, scr, it / nb0, it % nb0, sb, se, sv, F.lane, upmap0);
        else { const int r = it - I0; transpose_item(W1, ldw1, K1, T1, scr, r / nb1, r % nb1, 0, 0, 1.0f, F.lane); }
    }
}

template <bool GATES> __device__ __forceinline__ void norm_rows(Frame& F, const float* xp, const float* xs, float* Xdst, const float* g, bf16* XN, float* gates, const LAS float* WgT, const float* slab, int nslab) {
    f32x4 gv[4];
#pragma unroll
    for (int j = 0; j < 4; ++j) gv[j] = ((const f32x4*)g)[F.lane + 64 * j];
    f32x4 nx[4];
    { const int m0 = GW_ID(F); if (m0 < M) { const float* xr = (m0 < MP) ? xp + (size_t)m0 * D : xs + (size_t)(m0 - MP) * D;
#pragma unroll
        for (int j = 0; j < 4; ++j) nx[j] = ((const f32x4*)xr)[F.lane + 64 * j]; } }
    for (int m = GW_ID(F); m < M; m += GW_N(F)) {
        f32x4 v[4]; float ss = 0.f;
#pragma unroll
        for (int j = 0; j < 4; ++j) v[j] = nx[j];
        { const int mn = m + GW_N(F); if (mn < M) { const float* xr = (mn < MP) ? xp + (size_t)mn * D : xs + (size_t)(mn - MP) * D;
#pragma unroll
            for (int j = 0; j < 4; ++j) nx[j] = ((const f32x4*)xr)[F.lane + 64 * j]; } }
        if (nslab > 0 && m >= MP) {
            for (int sl = 0; sl < nslab; ++sl) { const f32x4* sp = (const f32x4*)(slab + ((size_t)sl * MS + (m - MP)) * D);
#pragma unroll
                for (int j = 0; j < 4; ++j) v[j] = v[j] + sp[F.lane + 64 * j]; }
#pragma unroll
            for (int j = 0; j < 4; ++j) ((f32x4*)(F.out + (size_t)m * D))[F.lane + 64 * j] = v[j];
        }
#pragma unroll
        for (int j = 0; j < 4; ++j) ss += (v[j].x * v[j].x + v[j].y * v[j].y) + (v[j].z * v[j].z + v[j].w * v[j].w);
        if (Xdst) {
#pragma unroll
            for (int j = 0; j < 4; ++j) ((f32x4*)(Xdst + (size_t)m * D))[F.lane + 64 * j] = v[j];
        }
        const float rs = 1.0f / sqrtf(wave_sum(ss) * (1.0f / D) + EPS);
        v2u* o8 = (v2u*)(XN + (size_t)m * D);
#pragma unroll
        for (int j = 0; j < 4; ++j) { v[j] = v[j] * rs * gv[j]; v2u w; w.x = pk2(v[j].x, v[j].y); w.y = pk2(v[j].z, v[j].w); o8[F.lane + 64 * j] = w; }
        if (GATES) {
            float s[16];
#pragma unroll
            for (int c = 0; c < 16; ++c) { float a = 0.f;
#pragma unroll
                for (int j = 0; j < 4; ++j) { const f32x4 w = ((const LAS f32x4*)(WgT + c * 1024))[F.lane + 64 * j]; a += (v[j].x * w.x + v[j].y * w.y) + (v[j].z * w.z + v[j].w * w.w); }
                s[c] = a; if ((c & 3) == 3) asm volatile("" ::: "memory"); }
            const bool b5 = (F.lane & 32) != 0, b4 = (F.lane & 16) != 0, b3 = (F.lane & 8) != 0, b2 = (F.lane & 4) != 0;
#pragma unroll
            for (int i = 0; i < 8; ++i) { const float send = b5 ? s[i] : s[i + 8], keep = b5 ? s[i + 8] : s[i]; s[i] = keep + __shfl_xor(send, 32); }
#pragma unroll
            for (int i = 0; i < 4; ++i) { const float send = b4 ? s[i] : s[i + 4], keep = b4 ? s[i + 4] : s[i]; s[i] = keep + __shfl_xor(send, 16); }
#pragma unroll
            for (int i = 0; i < 2; ++i) { const float send = b3 ? s[i] : s[i + 2], keep = b3 ? s[i + 2] : s[i]; s[i] = keep + __shfl_xor(send, 8); }
            { const float send = b2 ? s[0] : s[1], keep = b2 ? s[1] : s[0]; s[0] = keep + __shfl_xor(send, 4); }
            s[0] += __shfl_xor(s[0], 2); s[0] += __shfl_xor(s[0], 1);
            if ((F.lane & 3) == 0) gates[(size_t)m * 16 + (F.lane >> 2)] = s[0];
        }
    }
}
__device__ __forceinline__ void stage_wgT(Frame& F, const float* W, int ldw, int c0, LAS float* WgT) {
    for (int e = F.tid; e < 16 * 1024; e += NTHR) { const int k = e >> 4, c = e & 15; WgT[c * 1024 + k] = W[(size_t)k * ldw + c0 + c]; }
}

__device__ __forceinline__ void unpack8(const v4u v, float (&f)[8]) { f[0] = bflo(v.x); f[1] = bfhi(v.x); f[2] = bflo(v.y); f[3] = bfhi(v.y); f[4] = bflo(v.z); f[5] = bfhi(v.z); f[6] = bflo(v.w); f[7] = bfhi(v.w); }
__device__ __forceinline__ void convfix_unit(Frame& F, int layer, int pm, int pn, int k0, int kw, const float* __restrict__ conv_state, const float* __restrict__ cw, const float* __restrict__ cb) {
    const bf16* __restrict__ U = (const bf16*)(F.ws + WS_U); bf16* ACT = (bf16*)(F.ws + WS_ACT);
    const float* cwl = cw + (size_t)layer * 3 * DFF; const float* cbl = cb + (size_t)layer * DFF;
    if (pm < MP / 256) {
        const int row0 = pm * 256;
        for (int fc = F.tid; fc < DFF / 8; fc += NTHR) { const int f0 = fc * 8;
            if ((pm & 15) == 15 && pn == 0) { float a[8], b[8]; unpack8(*(const v4u*)(U + (size_t)(row0 + 254) * (2 * DFF) + f0), a); unpack8(*(const v4u*)(U + (size_t)(row0 + 255) * (2 * DFF) + f0), b);
                float* o = F.out + O_PF + ((size_t)(layer * BP + (pm >> 4)) * 2) * DFF + f0;
#pragma unroll
                for (int i = 0; i < 8; ++i) { o[i] = a[i]; o[DFF + i] = b[i]; } }
            if ((pm & 15) != 0) {
                const v4u ug2 = *(const v4u*)(U + (size_t)(row0 - 2) * (2 * DFF) + f0), ug1 = *(const v4u*)(U + (size_t)(row0 - 1) * (2 * DFF) + f0);
                const v4u ua0 = *(const v4u*)(U + (size_t)row0 * (2 * DFF) + f0), ua1 = *(const v4u*)(U + (size_t)(row0 + 1) * (2 * DFF) + f0);
                const v4u uu0 = *(const v4u*)(U + (size_t)row0 * (2 * DFF) + DFF + f0), uu1 = *(const v4u*)(U + (size_t)(row0 + 1) * (2 * DFF) + DFF + f0);
                float g2[8], g1[8], ga[8], gb[8], u0[8], u1[8]; unpack8(ug2, g2); unpack8(ug1, g1); unpack8(ua0, ga); unpack8(ua1, gb); unpack8(uu0, u0); unpack8(uu1, u1);
                float oa[8], ob[8];
#pragma unroll
                for (int i = 0; i < 8; ++i) { const float w0 = cwl[f0 + i], w1 = cwl[DFF + f0 + i], w2 = cwl[2 * DFF + f0 + i], bb = cbl[f0 + i];
                    const float c0 = bb + w0 * g2[i] + w1 * g1[i] + w2 * ga[i], c1 = bb + w0 * g1[i] + w1 * ga[i] + w2 * gb[i];
                    oa[i] = c0 * sigmoidf_(c0) * u0[i]; ob[i] = c1 * sigmoidf_(c1) * u1[i]; }
                v4u w; w.x = pk2(oa[0], oa[1]); w.y = pk2(oa[2], oa[3]); w.z = pk2(oa[4], oa[5]); w.w = pk2(oa[6], oa[7]); *(v4u*)(ACT + (size_t)row0 * DFF + f0) = w;
                w.x = pk2(ob[0], ob[1]); w.y = pk2(ob[2], ob[3]); w.z = pk2(ob[4], ob[5]); w.w = pk2(ob[6], ob[7]); *(v4u*)(ACT + (size_t)(row0 + 1) * DFF + f0) = w; }
        }
    } else {
        const int nch = kw >> 3, b0 = (pm - MP / 256) * 64;
        for (int it = F.tid; it < 64 * nch; it += NTHR) { const int fc = it % nch, bi = it / nch, b = b0 + bi, f0 = k0 + fc * 8, row0 = MP + b * TS;
            const float* cs = conv_state + ((size_t)(layer * BS + b) * 2) * DFF + f0;
            float g2[8], g1[8];
            { const f32x4 a0 = *(const f32x4*)cs, a1 = *(const f32x4*)(cs + 4), b0v = *(const f32x4*)(cs + DFF), b1v = *(const f32x4*)(cs + DFF + 4);
#pragma unroll
                for (int i = 0; i < 4; ++i) { g2[i] = a0[i]; g2[4 + i] = a1[i]; g1[i] = b0v[i]; g1[4 + i] = b1v[i]; } }
            v4u ug[4], uu[4];
#pragma unroll
            for (int r = 0; r < 4; ++r) { ug[r] = *(const v4u*)(U + (size_t)(row0 + r) * (2 * DFF) + f0); uu[r] = *(const v4u*)(U + (size_t)(row0 + r) * (2 * DFF) + DFF + f0); }
            float w0[8], w1[8], w2[8], bb[8];
#pragma unroll
            for (int i = 0; i < 8; ++i) { w0[i] = cwl[f0 + i]; w1[i] = cwl[DFF + f0 + i]; w2[i] = cwl[2 * DFF + f0 + i]; bb[i] = cbl[f0 + i]; }
#pragma unroll
            for (int r = 0; r < 4; ++r) { float g0[8], up[8]; unpack8(ug[r], g0); unpack8(uu[r], up); float o[8];
#pragma unroll
                for (int i = 0; i < 8; ++i) { const float cv = bb[i] + w0[i] * g2[i] + w1[i] * g1[i] + w2[i] * g0[i]; o[i] = cv * sigmoidf_(cv) * up[i]; g2[i] = g1[i]; g1[i] = g0[i]; }
                v4u w; w.x = pk2(o[0], o[1]); w.y = pk2(o[2], o[3]); w.z = pk2(o[4], o[5]); w.w = pk2(o[6], o[7]); *(v4u*)(ACT + (size_t)(row0 + r) * DFF + f0) = w; }
            if (pn == 0) { float* o = F.out + O_SF + ((size_t)(layer * BS + b) * 2) * DFF + f0;
#pragma unroll
                for (int i = 0; i < 8; ++i) { o[i] = g2[i]; o[DFF + i] = g1[i]; } }
        }
    }
}

constexpr int MLC = 128, MNCH = TP / MLC, MITEMS = BP * HA * MNCH;
constexpr int ST_ROWS = 144;
__device__ __forceinline__ void ml_gates(const float* GT, int row0, int h, int lane, float& a0, float& a1, float& fc0, float& fc1) {
    const float ig0 = GT[(size_t)(row0 + lane) * 16 + h], lf0 = GT[(size_t)(row0 + lane) * 16 + 8 + h];
    const float ig1 = GT[(size_t)(row0 + 64 + lane) * 16 + h], lf1 = GT[(size_t)(row0 + 64 + lane) * 16 + 8 + h];
    fc0 = wave_scan_sum(lf0, lane); const float tot0 = __shfl(fc0, 63); fc1 = tot0 + wave_scan_sum(lf1, lane);
    a0 = ig0 - fc0; a1 = ig1 - fc1;
}
__device__ __forceinline__ void mlstm_A(Frame& F) {
    LAS bf16* Kt = (LAS bf16*)F.lds; LAS bf16* Vt = Kt + 64 * 136; LAS float* wv = (LAS float*)(Vt + 128 * 136);
    const bf16* PROJ = (const bf16*)(F.ws + WS_PROJ); const float* GT = (const float*)(F.ws + WS_GATES);
    float* CLOC = (float*)(F.ws + SC_LOC); float* AUX = (float*)(F.ws + SC_AUX);
    for (int item = F.vcu; item < MITEMS; item += F.G) {
        const int bh = item >> 5, c = item & 31, b = bh >> 3, h = bh & 7, row0 = b * TP + c * MLC;
        TS_MARK(F, 21);
        v4u vv[4];
#pragma unroll
        for (int u = 0; u < 4; ++u) { const int p = F.tid + u * NTHR, r = p & 127, c8 = p >> 7; vv[u] = *(const v4u*)(PROJ + (size_t)(row0 + r) * NPROJ + 1024 + h * 128 + c8 * 8); }
        v4u kv[2];
#pragma unroll
        for (int u = 0; u < 2; ++u) { const int p = F.tid + u * NTHR, r = p & 127, c8 = p >> 7; kv[u] = *(const v4u*)(PROJ + (size_t)(row0 + r) * NPROJ + 512 + h * 64 + c8 * 8); }
        if (F.wave == 0) { float a0, a1, f0, f1; ml_gates(GT, row0, h, F.lane, a0, a1, f0, f1); const float amax = wave_max(fmaxf(a0, a1)), fl = __shfl(f1, 63);
            wv[F.lane] = __expf(a0 - amax); wv[64 + F.lane] = __expf(a1 - amax); if (F.lane == 0) { AUX[AX_CHK + 2 * item] = amax; AUX[AX_CHK + 2 * item + 1] = fl; } }
#pragma unroll
        for (int u = 0; u < 4; ++u) { const int p = F.tid + u * NTHR, r = p & 127, c8 = p >> 7; const v4u v = vv[u]; LAS bf16* d = Vt + (c8 * 8) * 136 + r;
            d[0 * 136] = (bf16)(v.x & 0xffffu); d[1 * 136] = (bf16)(v.x >> 16); d[2 * 136] = (bf16)(v.y & 0xffffu); d[3 * 136] = (bf16)(v.y >> 16);
            d[4 * 136] = (bf16)(v.z & 0xffffu); d[5 * 136] = (bf16)(v.z >> 16); d[6 * 136] = (bf16)(v.w & 0xffffu); d[7 * 136] = (bf16)(v.w >> 16); }
        __syncthreads();
        TS_MARK(F, 22);
#pragma unroll
        for (int u = 0; u < 2; ++u) { const int p = F.tid + u * NTHR, r = p & 127, c8 = p >> 7; float e[8]; unpack8(kv[u], e); const float w = wv[r]; LAS bf16* d = Kt + (c8 * 8) * 136 + r;
#pragma unroll
            for (int i = 0; i < 8; ++i) d[i * 136] = (bf16)f2bf(e[i] * w); }
        __syncthreads();
        TS_MARK(F, 23);
#pragma unroll
        for (int jj = 0; jj < 4; ++jj) { const int tile = F.wave * 4 + jj, dkt = tile & 3, dvt = tile >> 2;
            const f32x4 acc = mma_ll<4>(Kt + dkt * 16 * 136, 136, Vt + dvt * 16 * 136, 136, (f32x4){0.f, 0.f, 0.f, 0.f}, F.lane);
            *(f32x4*)(CLOC + ((size_t)item * 128 + dvt * 16 + (F.lane & 15)) * 64 + dkt * 16 + 4 * (F.lane >> 4)) = acc; }
        if (F.tid < 64) { float sm = 0.f; for (int ss = 0; ss < MLC; ss += 8) { float e[8]; unpack8(*(const LAS v4u*)(Kt + F.tid * 136 + ss), e);
#pragma unroll
                for (int i = 0; i < 8; ++i) sm += e[i]; }
            AUX[AX_NLOC + item * 64 + F.tid] = sm; }
        __syncthreads();
        TS_MARK(F, 24);
    }
}
__device__ __forceinline__ void mlstm_B(Frame& F, int j) {
    const float* __restrict__ CLOC = (const float*)(F.ws + SC_LOC); bf16* __restrict__ ST = (bf16*)(F.ws + SC_ST); float* AUX = (float*)(F.ws + SC_AUX);
    for (int slot = F.vcu * NTHR + F.tid; slot < BP * HA * 4096; slot += F.G * NTHR) {
        const int bh = slot >> 12, e = slot & 4095, dv = e >> 5, dk = (e & 31) * 2;
        float m = 0.f, c0 = 0.f, c1 = 0.f, nacc = 0.f;
        for (int cb = 0; cb < MNCH; cb += 8) {
            f32x2 cl[8]; float nl[8], am[8], fl[8];
#pragma unroll
            for (int u = 0; u < 8; ++u) { const int item = bh * MNCH + cb + u; cl[u] = *(const f32x2*)(CLOC + ((size_t)item * 128 + dv) * 64 + dk); am[u] = AUX[AX_CHK + 2 * item]; fl[u] = AUX[AX_CHK + 2 * item + 1];
                nl[u] = (e < 64) ? AUX[AX_NLOC + item * 64 + e] : 0.f; }
#pragma unroll
            for (int u = 0; u < 8; ++u) { const int item = bh * MNCH + cb + u;
                const float Mn = fmaxf(m, am[u]), g = __expf(m - Mn), ee = __expf(am[u] - Mn);
                bf16* sti = ST + (size_t)item * ST_ROWS * 64;
                *(unsigned*)(sti + dv * 64 + dk) = pk2(c0, c1);
                if (e < 64) sti[128 * 64 + e] = (bf16)f2bf(nacc);
                else if (e < 64 + 15 * 32) { const int z = e - 64; *(unsigned*)(sti + (129 + (z >> 5)) * 64 + (z & 31) * 2) = 0u; }
                if (e == 0) AUX[AX_MST + item] = m;
                c0 = g * c0 + ee * cl[u].x; c1 = g * c1 + ee * cl[u].y; nacc = g * nacc + ee * nl[u];
                m = fl[u] + Mn; } }
        const int b = bh >> 3, h = bh & 7;
        float* oc = F.out + O_PAC + (((size_t)(j * BP + b) * HA + h) * DKA) * DVA;
        oc[(size_t)dk * DVA + dv] = c0; oc[(size_t)(dk + 1) * DVA + dv] = c1;
        if (e < 64) F.out[O_PAN + ((size_t)(j * BP + b) * HA + h) * DKA + e] = nacc;
        if (e == 0) F.out[O_PAM + (size_t)(j * BP + b) * HA + h] = m;
    }
}
__device__ __forceinline__ void mlstm_C(Frame& F, int j, const float* anorm) {
    LAS bf16* Qs = (LAS bf16*)F.lds; LAS bf16* Ks = Qs + 128 * 72; LAS bf16* Vt = Ks + 128 * 72; LAS bf16* Ws = Vt + ST_ROWS * 136;
    LAS float* fa = (LAS float*)(Ws + 128 * 136); LAS float* fM = fa + 128; LAS float* fg = fM + 128; LAS float* fe = fg + 128;
    const bf16* PROJ = (const bf16*)(F.ws + WS_PROJ); const float* GT = (const float*)(F.ws + WS_GATES);
    const bf16* ST = (const bf16*)(F.ws + SC_ST); const float* AUX = (const float*)(F.ws + SC_AUX); bf16* H = (bf16*)(F.ws + WS_H);
    const int r16 = F.lane & 15, q = F.lane >> 4;
    for (int p = F.tid; p < 16 * 136; p += NTHR) Vt[128 * 136 + p] = (bf16)((p < 128) ? 0x3f80u : 0u);
    for (int item = F.vcu; item < MITEMS; item += F.G) {
        const int bh = item >> 5, c = item & 31, b = bh >> 3, h = bh & 7, row0 = b * TP + c * MLC;
        TS_MARK(F, 41);
        v4u vv[4], qv[2], kv[2];
#pragma unroll
        for (int u = 0; u < 4; ++u) { const int p = F.tid + u * NTHR, r = p & 127, c8 = p >> 7; vv[u] = *(const v4u*)(PROJ + (size_t)(row0 + r) * NPROJ + 1024 + h * 128 + c8 * 8); }
#pragma unroll
        for (int u = 0; u < 2; ++u) { const int p = F.tid + u * NTHR, r = p >> 3, c8 = p & 7; qv[u] = *(const v4u*)(PROJ + (size_t)(row0 + r) * NPROJ + h * 64 + c8 * 8); kv[u] = *(const v4u*)(PROJ + (size_t)(row0 + r) * NPROJ + 512 + h * 64 + c8 * 8); }
        if (F.wave == 0) { float a0, a1, f0, f1; ml_gates(GT, row0, h, F.lane, a0, a1, f0, f1); const float mc = AUX[AX_MST + item];
            const float cm0 = wave_scan_max(a0, F.lane), cm1 = fmaxf(__shfl(cm0, 63), wave_scan_max(a1, F.lane)); const float M0 = fmaxf(mc, cm0), M1 = fmaxf(mc, cm1);
            fa[F.lane] = a0; fa[64 + F.lane] = a1; fM[F.lane] = M0; fM[64 + F.lane] = M1; fg[F.lane] = __expf(mc - M0); fg[64 + F.lane] = __expf(mc - M1);
            fe[F.lane] = __expf(-(f0 + M0)); fe[64 + F.lane] = __expf(-(f1 + M1)); }
#pragma unroll
        for (int u = 0; u < 2; ++u) { const int p = F.tid + u * NTHR, r = p >> 3, c8 = p & 7; *(LAS v4u*)(Qs + r * 72 + c8 * 8) = qv[u]; *(LAS v4u*)(Ks + r * 72 + c8 * 8) = kv[u]; }
#pragma unroll
        for (int u = 0; u < 4; ++u) { const int p = F.tid + u * NTHR, r = p & 127, c8 = p >> 7; const v4u v = vv[u]; LAS bf16* d = Vt + (c8 * 8) * 136 + r;
            d[0 * 136] = (bf16)(v.x & 0xffffu); d[1 * 136] = (bf16)(v.x >> 16); d[2 * 136] = (bf16)(v.y & 0xffffu); d[3 * 136] = (bf16)(v.y >> 16);
            d[4 * 136] = (bf16)(v.z & 0xffffu); d[5 * 136] = (bf16)(v.z >> 16); d[6 * 136] = (bf16)(v.w & 0xffffu); d[7 * 136] = (bf16)(v.w >> 16); }
        __syncthreads();
        TS_MARK(F, 42);
#pragma unroll
        for (int tt = 0; tt < 8; ++tt) { const int st = (F.wave - tt) & 7; f32x4 acc = (f32x4){0.f, 0.f, 0.f, 0.f};
            if (st <= tt) acc = mma_ll<2>(Qs + tt * 16 * 72, 72, Ks + st * 16 * 72, 72, acc, F.lane);
            const int sx = st * 16 + r16; const float as = fa[sx];
#pragma unroll
            for (int r = 0; r < 4; ++r) { const int t = tt * 16 + 4 * q + r; const float w = (sx <= t) ? acc[r] * __expf(as - fM[t]) : 0.f; Ws[t * 136 + sx] = (bf16)f2bf(w); } }
        __syncthreads();
        TS_MARK(F, 43);
        const int tt = F.wave, t = tt * 16 + r16, nks = (tt + 2) >> 1;
        f32x4 ngv[8]; v2u ovv[8];
#pragma unroll
        for (int dvt = 0; dvt < 8; ++dvt) { const int col = h * 128 + dvt * 16 + 4 * q; ngv[dvt] = *(const f32x4*)(anorm + j * 1024 + col); ovv[dvt] = *(const v2u*)(PROJ + (size_t)(row0 + t) * NPROJ + 2048 + col); }
        f32x4 a1[9], a2[9];
#pragma unroll
        for (int dvt = 0; dvt < 9; ++dvt) {
            a2[dvt] = mma_gl<2>(ST + ((size_t)item * ST_ROWS + dvt * 16) * 64, 64, Qs + tt * 16 * 72, 72, (f32x4){0.f, 0.f, 0.f, 0.f}, F.lane);
            f32x4 acc = (f32x4){0.f, 0.f, 0.f, 0.f};
            for (int ks = 0; ks < nks; ++ks) { const bf16x8 av = *(const LAS bf16x8*)(Vt + (dvt * 16 + r16) * 136 + ks * 32 + q * 8); const bf16x8 bw = *(const LAS bf16x8*)(Ws + (tt * 16 + r16) * 136 + ks * 32 + q * 8);
                acc = __builtin_amdgcn_mfma_f32_16x16x32_bf16(av, bw, acc, 0, 0, 0); }
            a1[dvt] = acc; }
        TS_MARK(F, 44);
        const float gt = fg[t]; const float den = __shfl(a1[8][0], r16) + gt * __shfl(a2[8][0], r16); const float rd = 1.0f / fmaxf(fabsf(den), fe[t]);
        float sq = 0.f;
#pragma unroll
        for (int dvt = 0; dvt < 8; ++dvt)
#pragma unroll
            for (int r = 0; r < 4; ++r) { const float hv = (a1[dvt][r] + gt * a2[dvt][r]) * rd; a1[dvt][r] = hv; sq += hv * hv; }
        sq += __shfl_xor(sq, 16); sq += __shfl_xor(sq, 32);
        const float rs = 1.0f / sqrtf(sq * (1.0f / DVA) + EPS);
#pragma unroll
        for (int dvt = 0; dvt < 8; ++dvt) { const int col = h * 128 + dvt * 16 + 4 * q;
            const f32x4 ng = ngv[dvt]; const v2u ov = ovv[dvt];
            const float o0 = a1[dvt][0] * rs * ng.x * sigmoidf_(bflo(ov.x)), o1 = a1[dvt][1] * rs * ng.y * sigmoidf_(bfhi(ov.x)), o2 = a1[dvt][2] * rs * ng.z * sigmoidf_(bflo(ov.y)), o3 = a1[dvt][3] * rs * ng.w * sigmoidf_(bfhi(ov.y));
            v2u w; w.x = pk2(o0, o1); w.y = pk2(o2, o3); *(v2u*)(H + (size_t)(row0 + t) * D + col) = w; }
        __syncthreads();
        TS_MARK(F, 45);
    }
}
struct MlsPre { float m0, gi[4], gf[4], qk, v, cvv[16], o, an, n0v; };
#define MLS_LOAD(P, it_) do { const int b_ = (it_) >> 3, h_ = (it_) & 7, row_ = MP + b_ * TS; \
    (P).m0 = st_m[(size_t)(j * BS + b_) * HA + h_]; \
    _Pragma("unroll") for (int t_ = 0; t_ < 4; ++t_) { (P).gi[t_] = GT[(size_t)(row_ + t_) * 16 + h_]; (P).gf[t_] = GT[(size_t)(row_ + t_) * 16 + 8 + h_]; } \
    { const int t_ = (F.tid >> 6) & 3, d_ = F.tid & 63; (P).qk = bf2f(PROJ[(size_t)(row_ + t_) * NPROJ + ((F.tid < 256) ? 0 : 512) + h_ * 64 + d_]); } \
    { const int t2_ = F.tid >> 7, dv_ = F.tid & 127; (P).v = bf2f(PROJ[(size_t)(row_ + t2_) * NPROJ + 1024 + h_ * 128 + dv_]); (P).o = bf2f(PROJ[(size_t)(row_ + t2_) * NPROJ + 2048 + h_ * 128 + dv_]); (P).an = anorm[j * 1024 + h_ * 128 + dv_]; \
      const float* c0p_ = st_c + (((size_t)(j * BS + b_) * HA + h_) * DKA) * DVA; \
      _Pragma("unroll") for (int i_ = 0; i_ < 16; ++i_) (P).cvv[i_] = c0p_[(size_t)(t2_ * 16 + i_) * DVA + dv_]; } \
    (P).n0v = st_n[((size_t)(j * BS + b_) * HA + h_) * DKA + (F.tid & 63)]; } while (0)
__device__ __forceinline__ void mlstm_S(Frame& F, int j, const float* __restrict__ anorm, const float* __restrict__ st_c, const float* __restrict__ st_n, const float* __restrict__ st_m) {
    LAS float* qs = (LAS float*)F.lds; LAS float* ks = qs + 256; LAS float* vs = ks + 256; LAS float* qkw = vs + 512; LAS float* qn = qkw + 16; LAS float* part = qn + 16; LAS float* red = part + 2048; LAS float* ns = red + 16;
    const bf16* __restrict__ PROJ = (const bf16*)(F.ws + WS_PROJ); const float* __restrict__ GT = (const float*)(F.ws + WS_GATES); bf16* H = (bf16*)(F.ws + WS_H);
    MlsPre nx;
    if (F.vcu < BS * HA) MLS_LOAD(nx, F.vcu);
    for (int item = F.vcu; item < BS * HA; item += F.G) {
        const int b = item >> 3, h = item & 7, row0 = MP + b * TS;
        TS_MARK(F, 51);
        const MlsPre P = nx;
        if (item + F.G < BS * HA) MLS_LOAD(nx, item + F.G);
        float a[4], fc[4], Ml[4], g[4], mt[4]; const float m0 = P.m0;
        { float run = 0.f, cm = -3.0e38f;
#pragma unroll
            for (int t = 0; t < 4; ++t) { run += P.gf[t]; fc[t] = run; a[t] = P.gi[t] - run; cm = fmaxf(cm, a[t]); Ml[t] = fmaxf(m0, cm); g[t] = __expf(m0 - Ml[t]); mt[t] = run + Ml[t]; } }
        { const int t = (F.tid >> 6) & 3, d = F.tid & 63; if (F.tid < 256) qs[t * 64 + d] = P.qk; else ks[t * 64 + d] = P.qk;
            vs[F.tid] = P.v; if (F.tid < 64) ns[F.tid] = P.n0v; }
        __syncthreads();
        TS_MARK(F, 52);
        if (F.tid < 512) { const int pr = F.tid >> 4, l16 = F.tid & 15;
            const int t = (pr < 16) ? (pr >> 2) : (pr & 3), s = pr & 3; float dt = 0.f;
            if (pr < 20) { const LAS float* y = (pr < 16) ? ks + s * 64 : ns;
#pragma unroll
                for (int i = 0; i < 4; ++i) dt += qs[t * 64 + l16 * 4 + i] * y[l16 * 4 + i]; }
            dt += __shfl_xor(dt, 8); dt += __shfl_xor(dt, 4); dt += __shfl_xor(dt, 2); dt += __shfl_xor(dt, 1);
            if (l16 == 0 && pr < 16) { float as = a[0], Mt = Ml[0];
                as = (s == 1) ? a[1] : as; as = (s == 2) ? a[2] : as; as = (s == 3) ? a[3] : as; Mt = (t == 1) ? Ml[1] : Mt; Mt = (t == 2) ? Ml[2] : Mt; Mt = (t == 3) ? Ml[3] : Mt;
                qkw[pr] = (s <= t) ? dt * __expf(as - Mt) : 0.f; }
            else if (l16 == 0 && pr < 20) qn[pr - 16] = dt; }
        { const int dv = F.tid & 127, dkq = F.tid >> 7; float* cout = F.out + O_SAC + (((size_t)(j * BS + b) * HA + h) * DKA) * DVA;
            float p0 = 0.f, p1 = 0.f, p2 = 0.f, p3 = 0.f; const float gl = g[3];
            float wl[4];
#pragma unroll
            for (int s = 0; s < 4; ++s) wl[s] = __expf(a[s] - Ml[3]) * vs[s * 128 + dv];
#pragma unroll
            for (int i4 = 0; i4 < 4; ++i4) { const int dk0 = dkq * 16 + i4 * 4;
                const f32x4 q0 = *(const LAS f32x4*)(qs + dk0), q1 = *(const LAS f32x4*)(qs + 64 + dk0), q2 = *(const LAS f32x4*)(qs + 128 + dk0), q3 = *(const LAS f32x4*)(qs + 192 + dk0);
                const f32x4 k0 = *(const LAS f32x4*)(ks + dk0), k1 = *(const LAS f32x4*)(ks + 64 + dk0), k2 = *(const LAS f32x4*)(ks + 128 + dk0), k3 = *(const LAS f32x4*)(ks + 192 + dk0);
#pragma unroll
                for (int e = 0; e < 4; ++e) { const float cv = P.cvv[i4 * 4 + e];
                    p0 += q0[e] * cv; p1 += q1[e] * cv; p2 += q2[e] * cv; p3 += q3[e] * cv;
                    cout[(size_t)(dk0 + e) * DVA + dv] = gl * cv + (wl[0] * k0[e] + wl[1] * k1[e]) + (wl[2] * k2[e] + wl[3] * k3[e]); } }
            part[(dkq * 4 + 0) * 128 + dv] = p0; part[(dkq * 4 + 1) * 128 + dv] = p1; part[(dkq * 4 + 2) * 128 + dv] = p2; part[(dkq * 4 + 3) * 128 + dv] = p3; }
        __syncthreads();
        TS_MARK(F, 53);
        float hv;
        { const int t = F.tid >> 7, dv = F.tid & 127; float gt = g[0], emt = mt[0];
            gt = (t == 1) ? g[1] : gt; gt = (t == 2) ? g[2] : gt; gt = (t == 3) ? g[3] : gt; emt = (t == 1) ? mt[1] : emt; emt = (t == 2) ? mt[2] : emt; emt = (t == 3) ? mt[3] : emt;
            float num = 0.f, den = 0.f;
#pragma unroll
            for (int s = 0; s < 4; ++s) { const float w = qkw[t * 4 + s]; num += w * vs[s * 128 + dv]; den += w; }
            num += gt * ((part[(0 * 4 + t) * 128 + dv] + part[(1 * 4 + t) * 128 + dv]) + (part[(2 * 4 + t) * 128 + dv] + part[(3 * 4 + t) * 128 + dv]));
            den += gt * qn[t];
            hv = num / fmaxf(fabsf(den), __expf(-emt));
            const float sq = wave_sum(hv * hv); if (F.lane == 0) red[F.wave] = sq; }
        __syncthreads();
        TS_MARK(F, 54);
        { const int t = F.tid >> 7, dv = F.tid & 127, col = h * 128 + dv; const float rs = 1.0f / sqrtf((red[2 * t] + red[2 * t + 1]) * (1.0f / DVA) + EPS);
            H[(size_t)(row0 + t) * D + col] = (bf16)f2bf(hv * rs * P.an * sigmoidf_(P.o)); }
        if (F.tid < 64) { const int d = F.tid; float nn = g[3] * ns[d];
#pragma unroll
            for (int s = 0; s < 4; ++s) nn += __expf(a[s] - Ml[3]) * ks[s * 64 + d];
            F.out[O_SAN + ((size_t)(j * BS + b) * HA + h) * DKA + d] = nn; }
        if (F.tid == 0) F.out[O_SAM + (size_t)(j * BS + b) * HA + h] = mt[3];
        __syncthreads();
        TS_MARK(F, 55);
    }
}
__device__ __forceinline__ void gla_bc(Frame& F, int row0, int h, const float* WG, const float* BG, LAS float* zs, LAS float* gsum, LAS float* bc) {
    const float* GT = (const float*)(F.ws + WS_GATES);
    if (F.tid < 256) ((LAS f32x4*)zs)[F.tid] = ((const f32x4*)(GT + (size_t)row0 * 16))[F.tid];
    const int d = F.tid & 127, tq = F.tid >> 7, col = h * 128 + d;
    float wg[16];
#pragma unroll
    for (int r = 0; r < 16; ++r) wg[r] = WG[r * 512 + col];
    const float bgv = BG[col];
    __syncthreads();
    float pr[16]; float run = 0.f;
#pragma unroll
    for (int i = 0; i < 16; ++i) { const LAS float* z = zs + (tq * 16 + i) * 16; float x = bgv;
#pragma unroll
        for (int r = 0; r < 16; ++r) x += z[r] * wg[r];
        run += logsigmoidf(x) * (1.0f / 16.0f); pr[i] = run; }
    gsum[tq * 128 + d] = run;
    __syncthreads();
    float off = 0.f;
    if (tq > 0) off += gsum[d];
    if (tq > 1) off += gsum[128 + d];
    if (tq > 2) off += gsum[256 + d];
#pragma unroll
    for (int i = 0; i < 16; ++i) bc[(tq * 16 + i) * 128 + d] = pr[i] + off;
    __syncthreads();
}
__device__ __forceinline__ void gla_A(Frame& F, const float* WG, const float* BG) {
    LAS float* zs = (LAS float*)F.lds; LAS float* gsum = zs + 1024; LAS float* bc = gsum + 512; LAS bf16* Kt = (LAS bf16*)(bc + 8192); LAS bf16* Vt = Kt + 128 * 72;
    const bf16* PROJ = (const bf16*)(F.ws + WS_PROJ); float* SLOC = (float*)(F.ws + SC_LOC); float* AUX = (float*)(F.ws + SC_AUX);
    for (int item = F.vcu; item < BP * HB * NCH; item += F.G) {
        const int bh = item >> 6, c = item & 63, b = bh >> 2, h = bh & 3, row0 = b * TP + c * LCH;
        gla_bc(F, row0, h, WG, BG, zs, gsum, bc);
        if (F.tid < 128) AUX[AX_BL + item * 128 + F.tid] = bc[63 * 128 + F.tid];
        for (int p = F.tid; p < 64 * 16; p += NTHR) { const int r = p & 63, c8 = p >> 6; float e[8]; unpack8(*(const v4u*)(PROJ + (size_t)(row0 + r) * NPROJ + 512 + h * 128 + c8 * 8), e);
            LAS bf16* dd = Kt + (c8 * 8) * 72 + r;
#pragma unroll
            for (int i = 0; i < 8; ++i) { const int dk = c8 * 8 + i; dd[i * 72] = (bf16)f2bf(e[i] * __expf(bc[63 * 128 + dk] - bc[r * 128 + dk])); } }
        stage_tr<64, 256>(Vt, 72, PROJ + (size_t)row0 * NPROJ + 1024 + h * 256, NPROJ, F.tid);
        __syncthreads();
        for (int jj = 0; jj < 16; ++jj) { const int tile = F.wave * 16 + jj, dkt = tile & 7, dvt = tile >> 3;
            const f32x4 acc = mma_ll<2>(Kt + dkt * 16 * 72, 72, Vt + dvt * 16 * 72, 72, (f32x4){0.f, 0.f, 0.f, 0.f}, F.lane);
            *(f32x4*)(SLOC + ((size_t)item * 256 + dvt * 16 + (F.lane & 15)) * 128 + dkt * 16 + 4 * (F.lane >> 4)) = acc; }
        __syncthreads();
    }
}
__device__ __forceinline__ void gla_B(Frame& F) {
    const float* __restrict__ SLOC = (const float*)(F.ws + SC_LOC); bf16* __restrict__ ST = (bf16*)(F.ws + SC_ST); const float* __restrict__ AUX = (const float*)(F.ws + SC_AUX);
    for (int slot = F.vcu * NTHR + F.tid; slot < BP * HB * 8192; slot += F.G * NTHR) {
        const int bh = slot >> 13, e = slot & 8191, dv = e >> 5, dk0 = (e & 31) * 4;
        f32x4 S = (f32x4){0.f, 0.f, 0.f, 0.f};
        for (int cb = 0; cb < NCH; cb += 8) {
            f32x4 bl[8], sl[8];
#pragma unroll
            for (int u = 0; u < 8; ++u) { const int item = bh * 64 + cb + u; bl[u] = *(const f32x4*)(AUX + AX_BL + item * 128 + dk0); sl[u] = *(const f32x4*)(SLOC + ((size_t)item * 256 + dv) * 128 + dk0); }
#pragma unroll
            for (int u = 0; u < 8; ++u) { const int item = bh * 64 + cb + u;
                v2u w; w.x = pk2(S.x, S.y); w.y = pk2(S.z, S.w); *(v2u*)(ST + ((size_t)item * 256 + dv) * 128 + dk0) = w;
                S.x = __expf(bl[u].x) * S.x + sl[u].x; S.y = __expf(bl[u].y) * S.y + sl[u].y; S.z = __expf(bl[u].z) * S.z + sl[u].z; S.w = __expf(bl[u].w) * S.w + sl[u].w; } }
        float* o = F.out + O_PG + ((size_t)bh * DKB + dk0) * DVB + dv;
        o[0] = S.x; o[DVB] = S.y; o[2 * DVB] = S.z; o[3 * DVB] = S.w;
    }
}
__device__ __forceinline__ void gla_C(Frame& F, const float* WG, const float* BG, const float* bnorm) {
    LAS float* zs = (LAS float*)F.lds; LAS float* gsum = zs + 1024; LAS float* bc = gsum + 512; LAS bf16* Qs = (LAS bf16*)(bc + 8192); LAS bf16* Ks = Qs + 64 * 136; LAS bf16* Vt = Ks + 64 * 136;
    LAS bf16* At = Vt + 256 * 72; LAS float* ssq = (LAS float*)(At + 64 * 72);
    const bf16* PROJ = (const bf16*)(F.ws + WS_PROJ); const bf16* ST = (const bf16*)(F.ws + SC_ST); bf16* H = (bf16*)(F.ws + WS_H);
    const int r16 = F.lane & 15, q = F.lane >> 4;
    for (int item = F.vcu; item < BP * HB * NCH; item += F.G) {
        const int bh = item >> 6, c = item & 63, b = bh >> 2, h = bh & 3, row0 = b * TP + c * LCH;
        gla_bc(F, row0, h, WG, BG, zs, gsum, bc);
        for (int p = F.tid; p < 64 * 16; p += NTHR) { const int r = p >> 4, c8 = p & 15; float e[8], f[8];
            unpack8(*(const v4u*)(PROJ + (size_t)(row0 + r) * NPROJ + h * 128 + c8 * 8), e); unpack8(*(const v4u*)(PROJ + (size_t)(row0 + r) * NPROJ + 512 + h * 128 + c8 * 8), f);
#pragma unroll
            for (int i = 0; i < 8; ++i) { const float bb = bc[r * 128 + c8 * 8 + i]; e[i] *= __expf(bb); f[i] *= __expf(-bb); }
            v4u w; w.x = pk2(e[0], e[1]); w.y = pk2(e[2], e[3]); w.z = pk2(e[4], e[5]); w.w = pk2(e[6], e[7]); *(LAS v4u*)(Qs + r * 136 + c8 * 8) = w;
            w.x = pk2(f[0], f[1]); w.y = pk2(f[2], f[3]); w.z = pk2(f[4], f[5]); w.w = pk2(f[6], f[7]); *(LAS v4u*)(Ks + r * 136 + c8 * 8) = w; }
        stage_tr<64, 256>(Vt, 72, PROJ + (size_t)row0 * NPROJ + 1024 + h * 256, NPROJ, F.tid);
        __syncthreads();
#pragma unroll
        for (int jj = 0; jj < 2; ++jj) { const int tile = F.wave * 2 + jj, tt = tile >> 2, st = tile & 3; f32x4 acc = (f32x4){0.f, 0.f, 0.f, 0.f};
            if (st <= tt) acc = mma_ll<4>(Qs + tt * 16 * 136, 136, Ks + st * 16 * 136, 136, acc, F.lane);
            const int s = st * 16 + r16;
#pragma unroll
            for (int r = 0; r < 4; ++r) { const int t = tt * 16 + 4 * q + r; At[t * 72 + s] = (bf16)f2bf((s <= t) ? acc[r] : 0.f); } }
        __syncthreads();
        f32x4 o[2][4];
#pragma unroll
        for (int dl = 0; dl < 2; ++dl) { const int dvt = F.wave * 2 + dl;
            bf16x8 sa[4];
#pragma unroll
            for (int ks = 0; ks < 4; ++ks) sa[ks] = *(const bf16x8*)(ST + ((size_t)item * 256 + dvt * 16 + r16) * 128 + ks * 32 + q * 8);
#pragma unroll
            for (int tt = 0; tt < 4; ++tt) { f32x4 acc = mma_ll<2>(Vt + dvt * 16 * 72, 72, At + tt * 16 * 72, 72, (f32x4){0.f, 0.f, 0.f, 0.f}, F.lane);
#pragma unroll
                for (int ks = 0; ks < 4; ++ks) { const bf16x8 bq = *(const LAS bf16x8*)(Qs + (tt * 16 + r16) * 136 + ks * 32 + q * 8); acc = __builtin_amdgcn_mfma_f32_16x16x32_bf16(sa[ks], bq, acc, 0, 0, 0); }
                o[dl][tt] = acc; } }
#pragma unroll
        for (int tt = 0; tt < 4; ++tt) { float sq = 0.f;
#pragma unroll
            for (int dl = 0; dl < 2; ++dl)
#pragma unroll
                for (int r = 0; r < 4; ++r) sq += o[dl][tt][r] * o[dl][tt][r];
            sq += __shfl_xor(sq, 16); sq += __shfl_xor(sq, 32);
            if (F.lane < 16) ssq[F.wave * 64 + tt * 16 + r16] = sq; }
        __syncthreads();
        f32x4 ngv[2]; v2u rvv[2][4];
#pragma unroll
        for (int dl = 0; dl < 2; ++dl) { const int col = h * 256 + (F.wave * 2 + dl) * 16 + 4 * q; ngv[dl] = *(const f32x4*)(bnorm + col);
#pragma unroll
            for (int tt = 0; tt < 4; ++tt) rvv[dl][tt] = *(const v2u*)(PROJ + (size_t)(row0 + tt * 16 + r16) * NPROJ + 2048 + col); }
#pragma unroll
        for (int tt = 0; tt < 4; ++tt) { const int t = tt * 16 + r16; float tot = 0.f;
#pragma unroll
            for (int w = 0; w < 8; ++w) tot += ssq[w * 64 + t];
            const float rs = 1.0f / sqrtf(tot * (1.0f / DVB) + EPS);
#pragma unroll
            for (int dl = 0; dl < 2; ++dl) { const int col = h * 256 + (F.wave * 2 + dl) * 16 + 4 * q;
                const f32x4 ng = ngv[dl]; const v2u rv = rvv[dl][tt];
                const float r0 = bflo(rv.x), r1 = bfhi(rv.x), r2 = bflo(rv.y), r3 = bfhi(rv.y);
                const float o0 = o[dl][tt][0] * rs * ng.x * r0 * sigmoidf_(r0), o1 = o[dl][tt][1] * rs * ng.y * r1 * sigmoidf_(r1), o2 = o[dl][tt][2] * rs * ng.z * r2 * sigmoidf_(r2), o3 = o[dl][tt][3] * rs * ng.w * r3 * sigmoidf_(r3);
                v2u w; w.x = pk2(o0, o1); w.y = pk2(o2, o3); *(v2u*)(H + (size_t)(row0 + t) * D + col) = w; } }
        __syncthreads();
    }
}
__device__ __forceinline__ void gla_S(Frame& F, const float* WG, const float* BG, const float* bnorm, const float* st_s) {
    LAS float* bcs = (LAS float*)F.lds;
    LAS float* qs = bcs + 512;
    LAS float* kr = qs + 512;
    LAS float* kh = kr + 512;
    LAS float* vs = kh + 512;
    LAS float* att = vs + 1024;
    LAS float* part = att + 16;
    LAS float* red = part + 2048;
    const bf16* PROJ = (const bf16*)(F.ws + WS_PROJ); const float* GT = (const float*)(F.ws + WS_GATES); bf16* H = (bf16*)(F.ws + WS_H);
    for (int item = F.vcu; item < BS * HB; item += F.G) {
        const int b = item >> 2, h = item & 3, row0 = MP + b * TS;
        { const int t = F.tid >> 7, d = F.tid & 127, col = h * 128 + d; float x = BG[col];
#pragma unroll
            for (int r = 0; r < 16; ++r) x += GT[(size_t)(row0 + t) * 16 + r] * WG[r * 512 + col];
            bcs[t * 128 + d] = logsigmoidf(x) * (1.0f / 16.0f);
            kr[t * 128 + d] = bf2f(PROJ[(size_t)(row0 + t) * NPROJ + 512 + col]);
            vs[t * 256 + d] = bf2f(PROJ[(size_t)(row0 + t) * NPROJ + 1024 + h * 256 + d]); vs[t * 256 + 128 + d] = bf2f(PROJ[(size_t)(row0 + t) * NPROJ + 1024 + h * 256 + 128 + d]); }
        __syncthreads();
        if (F.tid < 128) { const int d = F.tid; float run = 0.f;
#pragma unroll
            for (int t = 0; t < 4; ++t) { run += bcs[t * 128 + d]; bcs[t * 128 + d] = run; } }
        __syncthreads();
        { const int t = F.tid >> 7, d = F.tid & 127, col = h * 128 + d; const float bb = bcs[t * 128 + d], bl = bcs[3 * 128 + d];
            qs[t * 128 + d] = bf2f(PROJ[(size_t)(row0 + t) * NPROJ + col]) * __expf(bb); kh[t * 128 + d] = kr[t * 128 + d] * __expf(bl - bb); }
        __syncthreads();
        { const int pr = F.tid >> 5, l32 = F.tid & 31, t = pr >> 2, s = pr & 3; float dt = 0.f;
            if (s <= t) {
#pragma unroll
                for (int i = 0; i < 4; ++i) { const int d = l32 * 4 + i; dt += qs[t * 128 + d] * kr[s * 128 + d] * __expf(-bcs[s * 128 + d]); } }
            dt += __shfl_xor(dt, 16); dt += __shfl_xor(dt, 8); dt += __shfl_xor(dt, 4); dt += __shfl_xor(dt, 2); dt += __shfl_xor(dt, 1);
            if (l32 == 0) att[pr] = dt; }
        { const int dv = F.tid & 255, dkh = F.tid >> 8; const float* s0 = st_s + (((size_t)b * HB + h) * DKB) * DVB; float* so = F.out + O_SG + (((size_t)b * HB + h) * DKB) * DVB;
            float p0 = 0.f, p1 = 0.f, p2 = 0.f, p3 = 0.f; const float v0 = vs[dv], v1 = vs[256 + dv], v2 = vs[512 + dv], v3 = vs[768 + dv];
            for (int d0 = dkh * 64; d0 < dkh * 64 + 64; d0 += 16) {
                float svv[16];
#pragma unroll
                for (int i = 0; i < 16; ++i) svv[i] = s0[(size_t)(d0 + i) * DVB + dv];
#pragma unroll
                for (int i4 = 0; i4 < 4; ++i4) { const int dk0 = d0 + i4 * 4;
                    const f32x4 q0 = *(const LAS f32x4*)(qs + dk0), q1 = *(const LAS f32x4*)(qs + 128 + dk0), q2 = *(const LAS f32x4*)(qs + 256 + dk0), q3 = *(const LAS f32x4*)(qs + 384 + dk0);
                    const f32x4 k0 = *(const LAS f32x4*)(kh + dk0), k1 = *(const LAS f32x4*)(kh + 128 + dk0), k2 = *(const LAS f32x4*)(kh + 256 + dk0), k3 = *(const LAS f32x4*)(kh + 384 + dk0);
                    const f32x4 bl = *(const LAS f32x4*)(bcs + 3 * 128 + dk0);
#pragma unroll
                    for (int e = 0; e < 4; ++e) { const float sv = svv[i4 * 4 + e];
                        p0 += q0[e] * sv; p1 += q1[e] * sv; p2 += q2[e] * sv; p3 += q3[e] * sv;
                        so[(size_t)(dk0 + e) * DVB + dv] = __expf(bl[e]) * sv + (k0[e] * v0 + k1[e] * v1) + (k2[e] * v2 + k3[e] * v3); } } }
            part[(dkh * 4 + 0) * 256 + dv] = p0; part[(dkh * 4 + 1) * 256 + dv] = p1; part[(dkh * 4 + 2) * 256 + dv] = p2; part[(dkh * 4 + 3) * 256 + dv] = p3; }
        __syncthreads();
        float ov[2];
        { const int dv = F.tid & 255, th = F.tid >> 8;
#pragma unroll
            for (int u = 0; u < 2; ++u) { const int t = th + 2 * u; float o = part[t * 256 + dv] + part[(4 + t) * 256 + dv];
#pragma unroll
                for (int s = 0; s < 4; ++s) o += att[t * 4 + s] * vs[s * 256 + dv];
                ov[u] = o; const float sq = wave_sum(o * o); if (F.lane == 0) red[F.wave * 2 + u] = sq; } }
        __syncthreads();
        { const int dv = F.tid & 255, th = F.tid >> 8, col = h * 256 + dv;
#pragma unroll
            for (int u = 0; u < 2; ++u) { const int t = th + 2 * u; const int w0 = th * 4; const float tot = (red[(w0 + 0) * 2 + u] + red[(w0 + 1) * 2 + u]) + (red[(w0 + 2) * 2 + u] + red[(w0 + 3) * 2 + u]);
                const float rs = 1.0f / sqrtf(tot * (1.0f / DVB) + EPS); const float r = bf2f(PROJ[(size_t)(row0 + t) * NPROJ + 2048 + col]);
                H[(size_t)(row0 + t) * D + col] = (bf16)f2bf(ov[u] * rs * bnorm[col] * r * sigmoidf_(r)); } }
        __syncthreads();
    }
}

__device__ __forceinline__ void swa_tile(const LAS bf16* Kw, const LAS bf16* Vt, int ldv, LAS bf16* Pw, int kt0, int jmin, const bf16* qp_r16, bf16* op_r16, const int (&relb)[4], const float (&snk)[4], int lane) {
    const int r16 = lane & 15, q = lane >> 4;
    const bf16x8 qa0 = *(const bf16x8*)(qp_r16 + q * 8), qa1 = *(const bf16x8*)(qp_r16 + 32 + q * 8);
    f32x4 s[9];
#pragma unroll
    for (int kt = 0; kt < 9; ++kt) { const LAS bf16* kp = Kw + ((kt0 + kt) * 16 + r16) * 72 + q * 8;
        f32x4 acc = __builtin_amdgcn_mfma_f32_16x16x32_bf16(qa0, *(const LAS bf16x8*)kp, (f32x4){0.f, 0.f, 0.f, 0.f}, 0, 0, 0);
        s[kt] = __builtin_amdgcn_mfma_f32_16x16x32_bf16(qa1, *(const LAS bf16x8*)(kp + 32), acc, 0, 0, 0); }
    float mx[4] = {-3.0e38f, -3.0e38f, -3.0e38f, -3.0e38f};
#pragma unroll
    for (int kt = 0; kt < 9; ++kt) { const int j = (kt0 + kt) * 16 + r16;
#pragma unroll
        for (int r = 0; r < 4; ++r) { const int rel = relb[r] - j; const bool ok = (rel >= 0) && (rel <= WIN) && (j >= jmin); const float v = ok ? s[kt][r] * 0.125f : -3.0e38f; s[kt][r] = v; mx[r] = fmaxf(mx[r], v); } }
    float sm[4];
#pragma unroll
    for (int r = 0; r < 4; ++r) { float m = mx[r]; m = fmaxf(m, __shfl_xor(m, 1)); m = fmaxf(m, __shfl_xor(m, 2)); m = fmaxf(m, __shfl_xor(m, 4)); m = fmaxf(m, __shfl_xor(m, 8)); mx[r] = fmaxf(m, snk[r]); sm[r] = 0.f; }
#pragma unroll
    for (int kt = 0; kt < 9; ++kt)
#pragma unroll
        for (int r = 0; r < 4; ++r) { const float p = (s[kt][r] > -1.0e38f) ? __expf(s[kt][r] - mx[r]) : 0.f; s[kt][r] = p; sm[r] += p; }
#pragma unroll
    for (int r = 0; r < 4; ++r) { float t = sm[r]; t += __shfl_xor(t, 1); t += __shfl_xor(t, 2); t += __shfl_xor(t, 4); t += __shfl_xor(t, 8); sm[r] = 1.0f / (t + __expf(snk[r] - mx[r])); }
#pragma unroll
    for (int kt = 0; kt < 9; ++kt)
#pragma unroll
        for (int r = 0; r < 4; ++r) Pw[(4 * q + r) * 168 + kt * 16 + r16] = (bf16)f2bf(s[kt][r] * sm[r]);
#pragma unroll
    for (int r = 0; r < 4; ++r) Pw[(4 * q + r) * 168 + 144 + r16] = (bf16)0;
    LDS_WAIT();
#pragma unroll
    for (int dt = 0; dt < 4; ++dt) { f32x4 acc = (f32x4){0.f, 0.f, 0.f, 0.f};
#pragma unroll
        for (int ks = 0; ks < 5; ++ks) { const bf16x8 va = *(const LAS bf16x8*)(Vt + (dt * 16 + r16) * ldv + kt0 * 16 + ks * 32 + q * 8); const bf16x8 pb = *(const LAS bf16x8*)(Pw + r16 * 168 + ks * 32 + q * 8);
            acc = __builtin_amdgcn_mfma_f32_16x16x32_bf16(va, pb, acc, 0, 0, 0); }
        v2u w; w.x = pk2(acc[0], acc[1]); w.y = pk2(acc[2], acc[3]); *(v2u*)(op_r16 + dt * 16 + 4 * q) = w; }
    LDS_WAIT();
}
__device__ __forceinline__ void swa_prompt(Frame& F, const float* sinks) {
    LAS bf16* Kw = (LAS bf16*)F.lds; LAS bf16* Vt = Kw + 256 * 72; LAS bf16* Pw = Vt + 64 * 280 + F.wave * (16 * 168);
    const bf16* PROJ = (const bf16*)(F.ws + WS_PROJ); bf16* H = (bf16*)(F.ws + WS_H);
    const int r16 = F.lane & 15, q = F.lane >> 4;
    for (int item = F.vcu; item < BP * HKV * (TP / WIN); item += F.G) {
        const int qb = item & 31, hkv = (item >> 5) & 3, b = item >> 7;
        const int krow0 = b * TP + (qb - 1) * WIN;
        for (int p = F.tid; p < 256 * 8; p += NTHR) { const int r = p >> 3, c8 = p & 7; v4u v = (v4u){0u, 0u, 0u, 0u};
            if (qb > 0 || r >= WIN) v = *(const v4u*)(PROJ + (size_t)(krow0 + r) * C_IN + 1024 + hkv * 64 + c8 * 8);
            *(LAS v4u*)(Kw + r * 72 + c8 * 8) = v; }
        for (int p = F.tid; p < 256 * 8; p += NTHR) { const int r = p & 255, c8 = p >> 8; v4u v = (v4u){0u, 0u, 0u, 0u};
            if (qb > 0 || r >= WIN) v = *(const v4u*)(PROJ + (size_t)(krow0 + r) * C_IN + 1280 + hkv * 64 + c8 * 8);
            LAS bf16* d = Vt + (c8 * 8) * 280 + r;
            d[0 * 280] = (bf16)(v.x & 0xffffu); d[1 * 280] = (bf16)(v.x >> 16); d[2 * 280] = (bf16)(v.y & 0xffffu); d[3 * 280] = (bf16)(v.y >> 16);
            d[4 * 280] = (bf16)(v.z & 0xffffu); d[5 * 280] = (bf16)(v.z >> 16); d[6 * 280] = (bf16)(v.w & 0xffffu); d[7 * 280] = (bf16)(v.w >> 16); }
        for (int p = F.tid; p < 64 * 24; p += NTHR) { const int r = p / 24, cc = p % 24; Vt[r * 280 + 256 + cc] = (bf16)0; }
        __syncthreads();
        const int g = F.wave >> 1, hq = hkv * 4 + g;
        const float sk = sinks[hq]; const float snk[4] = {sk, sk, sk, sk};
        for (int mt = 0; mt < 4; ++mt) { const int tq0 = (F.wave & 1) * 64 + mt * 16; const int relb[4] = {WIN + tq0 + 4 * q, WIN + tq0 + 4 * q + 1, WIN + tq0 + 4 * q + 2, WIN + tq0 + 4 * q + 3};
            const size_t row = (size_t)b * TP + qb * WIN + tq0 + r16;
            swa_tile(Kw, Vt, 280, Pw, tq0 >> 4, (qb == 0) ? WIN : 0, PROJ + row * C_IN + hq * 64, H + row * D + hq * 64, relb, snk, F.lane); }
        __syncthreads();
    }
    for (int e = F.vcu * NTHR + F.tid; e < BP * WIN * 256; e += F.G * NTHR) { const int d = e & 255, jrow = (e >> 8) & 127, b = e >> 15; const size_t row = (size_t)b * TP + TP - WIN + jrow;
        F.out[O_PSK + ((size_t)b * WIN + jrow) * 256 + d] = bf2f(PROJ[row * C_IN + 1024 + d]); F.out[O_PSV + ((size_t)b * WIN + jrow) * 256 + d] = bf2f(PROJ[row * C_IN + 1280 + d]); }
}
__device__ __forceinline__ void swa_sample(Frame& F, const float* sinks, const float* ck, const float* cv) {
    LAS bf16* Kw = (LAS bf16*)F.lds; LAS bf16* Vt = Kw + 144 * 72; LAS bf16* Pw = Vt + 64 * 168;
    const bf16* PROJ = (const bf16*)(F.ws + WS_PROJ); bf16* H = (bf16*)(F.ws + WS_H);
    const int r16 = F.lane & 15, q = F.lane >> 4;
    for (int item = F.vcu; item < BS * HKV; item += F.G) {
        const int b = item >> 2, hkv = item & 3;
        { float kxs[18], vxs[18];
#pragma unroll
            for (int u = 0; u < 18; ++u) { const int e = F.tid + u * NTHR, r = e >> 6, d = e & 63; float kx = 0.f, vx = 0.f;
                if (r < WIN) { const size_t ci = (((size_t)b * WIN + r) * HKV + hkv) * HDC + d; kx = ck[ci]; vx = cv[ci]; }
                else if (r < WIN + TS) { const size_t row = (size_t)MP + b * TS + (r - WIN); kx = bf2f(PROJ[row * C_IN + 1024 + hkv * 64 + d]); vx = bf2f(PROJ[row * C_IN + 1280 + hkv * 64 + d]); }
                kxs[u] = kx; vxs[u] = vx; }
#pragma unroll
            for (int u = 0; u < 18; ++u) { const int e = F.tid + u * NTHR, r = e >> 6, d = e & 63; const float kx = kxs[u], vx = vxs[u];
                Kw[r * 72 + d] = (bf16)f2bf(kx); Vt[d * 168 + r] = (bf16)f2bf(vx);
                if (r >= TS && r < WIN + TS) { const size_t oi = (((size_t)b * WIN + (r - TS)) * HKV + hkv) * HDC + d; F.out[O_SSK + oi] = kx; F.out[O_SSV + oi] = vx; } } }
        for (int e = F.tid; e < 64 * 16; e += NTHR) { const int d = e >> 4, cc = e & 15; Vt[d * 168 + 144 + cc] = (bf16)0; }
        __syncthreads();
        if (F.wave == 0) { const int gq = r16 >> 2, tq = r16 & 3; const size_t row = (size_t)MP + b * TS + tq; const int hq = hkv * 4 + gq;
            const int relb[4] = {WIN + 0, WIN + 1, WIN + 2, WIN + 3};
            const float sk = sinks[hkv * 4 + q]; const float snk[4] = {sk, sk, sk, sk};
            swa_tile(Kw, Vt, 168, Pw, 0, 0, PROJ + row * C_IN + hq * 64, H + row * D + hq * 64, relb, snk, F.lane); }
        __syncthreads();
    }
}

__device__ __forceinline__ void gemm_small(Frame& F, const bf16* A, const bf16* Bt, int K, int N, bool pj, bf16* O, float* X, const float* bias) {
    const int r16 = F.lane & 15, q = F.lane >> 4, nct = N >> 4, ntile = (MS / 16) * nct;
    for (int id = GW_ID(F); id < ntile; id += GW_N(F)) {
        const int ct = id % nct, rt = id / nct;
        const bf16* ap = A + (size_t)(MP + rt * 16 + r16) * K + q * 8; const bf16* bp = Bt + (size_t)(ct * 16 + r16) * K + q * 8;
        f32x4 acc0 = (f32x4){0.f, 0.f, 0.f, 0.f}, acc1 = acc0;
#pragma unroll 2
        for (int k0 = 0; k0 < K; k0 += 256) {
            bf16x8 a[8], b[8];
#pragma unroll
            for (int i = 0; i < 8; ++i) { a[i] = *(const bf16x8*)(ap + k0 + i * 32); b[i] = *(const bf16x8*)(bp + k0 + i * 32); }
#pragma unroll
            for (int i = 0; i < 8; i += 2) { acc0 = __builtin_amdgcn_mfma_f32_16x16x32_bf16(b[i], a[i], acc0, 0, 0, 0); acc1 = __builtin_amdgcn_mfma_f32_16x16x32_bf16(b[i + 1], a[i + 1], acc1, 0, 0, 0); }
        }
        const f32x4 acc = acc0 + acc1; const size_t row = (size_t)(MP + rt * 16 + r16); const int col = ct * 16 + 4 * q;
        if (pj) { f32x4 v = acc; if (bias) v = v + *(const f32x4*)(bias + col); v2u w; w.x = pk2(v.x, v.y); w.y = pk2(v.z, v.w); *(v2u*)(O + row * N + col) = w; }
        else { f32x4* xp = (f32x4*)(X + row * N + col); *xp = *xp + acc; }
    }
}

__device__ __forceinline__ void gates_small(Frame& F, const bf16* XN, const bf16* WgT, float* GT, int cu_lo, bool act, const float* bi, const float* bf_) {
    const int r16 = F.lane & 15, q = F.lane >> 4, bx = (int)blockIdx.x;
    if (bx < cu_lo) return;
    for (int id = (bx - cu_lo) * NWAVES + F.wave; id < M / 16; id += (F.G - cu_lo) * NWAVES) {
        const bf16* ap = WgT + (size_t)r16 * D + q * 8; const bf16* bp = XN + (size_t)(id * 16 + r16) * D + q * 8;
        f32x4 acc0 = (f32x4){0.f, 0.f, 0.f, 0.f}, acc1 = acc0;
#pragma unroll
        for (int k0 = 0; k0 < D; k0 += 256) {
            bf16x8 a[8], b[8];
#pragma unroll
            for (int i = 0; i < 8; ++i) { a[i] = *(const bf16x8*)(ap + k0 + i * 32); b[i] = *(const bf16x8*)(bp + k0 + i * 32); }
#pragma unroll
            for (int i = 0; i < 8; i += 2) { acc0 = __builtin_amdgcn_mfma_f32_16x16x32_bf16(a[i], b[i], acc0, 0, 0, 0); acc1 = __builtin_amdgcn_mfma_f32_16x16x32_bf16(a[i + 1], b[i + 1], acc1, 0, 0, 0); }
        }
        f32x4 v = acc0 + acc1;
        if (act) { const f32x4 bb = (q < 2) ? *(const f32x4*)(bi + 4 * q) : *(const f32x4*)(bf_ + 4 * (q - 2));
#pragma unroll
            for (int r = 0; r < 4; ++r) { const float z = softcapf(v[r] + bb[r]); v[r] = (q < 2) ? z : logsigmoidf(z); } }
        *(f32x4*)(GT + (size_t)(id * 16 + r16) * 16 + 4 * q) = v;
    }
}
__device__ __forceinline__ void final_norm(Frame& F, const float* g, const float* slab, int nslab) {
    f32x4 gv[4];
#pragma unroll
    for (int j = 0; j < 4; ++j) gv[j] = ((const f32x4*)g)[F.lane + 64 * j];
    f32x4 nx[4];
    { const int m0 = GW_ID(F); if (m0 < M) {
#pragma unroll
        for (int j = 0; j < 4; ++j) nx[j] = ((const f32x4*)(F.out + (size_t)m0 * D))[F.lane + 64 * j]; } }
    for (int m = GW_ID(F); m < M; m += GW_N(F)) {
        f32x4* xr = (f32x4*)(F.out + (size_t)m * D); f32x4 v[4]; float ss = 0.f;
#pragma unroll
        for (int j = 0; j < 4; ++j) v[j] = nx[j];
        { const int mn = m + GW_N(F); if (mn < M) {
#pragma unroll
            for (int j = 0; j < 4; ++j) nx[j] = ((const f32x4*)(F.out + (size_t)mn * D))[F.lane + 64 * j]; } }
        if (m >= MP) for (int sl = 0; sl < nslab; ++sl) { const f32x4* sp = (const f32x4*)(slab + ((size_t)sl * MS + (m - MP)) * D);
#pragma unroll
            for (int j = 0; j < 4; ++j) v[j] = v[j] + sp[F.lane + 64 * j]; }
#pragma unroll
        for (int j = 0; j < 4; ++j) ss += (v[j].x * v[j].x + v[j].y * v[j].y) + (v[j].z * v[j].z + v[j].w * v[j].w);
        const float rs = 1.0f / sqrtf(wave_sum(ss) * (1.0f / D) + EPS);
#pragma unroll
        for (int j = 0; j < 4; ++j) xr[F.lane + 64 * j] = v[j] * rs * gv[j];
    }
}

#ifndef MK_ONLY
#define MK_ONLY -1
#endif
#ifndef MK_OFF
#define MK_OFF -2
#endif
#define EN(x) ((MK_ONLY < 0 || MK_ONLY == (x)) && MK_OFF != (x))
#ifndef MK_REP
#define MK_REP 0
#endif
#ifndef MK_TMASK
#define MK_TMASK 0
#endif
#ifndef MK_MULTI
#define MK_MULTI 0
#endif
constexpr int N_PHASES = DEPTH * 10 + 1;
constexpr int KS_OUT = 4, KS_DN = 11;
struct Args { const float* in[30]; float* out; unsigned char* ws; int ph_lo, ph_hi; };
__host__ __device__ __forceinline__ bool phase_empty(int ph) { if (ph >= DEPTH * 10) return false; const int layer = ph / 10, st = ph % 10; return st == 8 || ((layer % 3 == 2) && (st == 3 || st == 4)); }

#define INP(k) ({ int k_ = (k); asm volatile("" : "+s"(k_)); ((const float* const*)__builtin_amdgcn_kernarg_segment_ptr())[k_]; })
__global__ void __launch_bounds__(NTHR, 2) trunk_fwd(Args args) {
    extern __shared__ __attribute__((aligned(16))) unsigned char lds[];
    Frame F;
    F.lds = (LAS unsigned char*)lds;
    F.MISC = (volatile LAS unsigned*)(F.lds + MISC_OFF);
    F.tid = threadIdx.x; F.lane = F.tid & 63; F.wave = __builtin_amdgcn_readfirstlane(F.tid >> 6);
    F.G = gridDim.x; { const int bx = blockIdx.x; F.vcu = (F.G % 8 == 0) ? (bx % 8) * (F.G / 8) + bx / 8 : bx; }
    const int vcu0 = F.vcu;
    F.out = args.out; F.ws = args.ws; F.ctl = (unsigned*)(args.ws + WS_CTL);
    for (int u = F.tid; u < (LDS_BYTES - LDSCTL_OFF) / 4; u += NTHR) ((LAS unsigned*)(F.lds + LDSCTL_OFF))[u] = 0u;
    __syncthreads();
    const int lo = args.ph_lo, hi = args.ph_hi;
    XcdBarrier bar; bar.bar = F.ctl + CW_BAR; bar.x = 0; bar.st = nullptr;
    if (hi - lo > 1) bar = xcd_barrier_post(F.ctl + CW_BAR, F.MISC + 8);

    bool again = false;
#if MK_TMASK
    unsigned long long tsum_ = 0, t0p_ = 0; const bool tmr_ = (blockIdx.x == 0);
#endif
    for (int ph = lo; ph < hi; ++ph) {
        if (phase_empty(ph)) continue;
#if MK_TMASK
        if (tmr_ && !again) t0p_ = __builtin_amdgcn_s_memrealtime();
#endif
        if (ph == DEPTH * 10) { if (EN(10)) final_norm(F, INP(11), (const float*)(F.ws + WS_R1), KS_DN);
#if MK_TMASK
            if (tmr_ && ((MK_TMASK >> 10) & 1)) tsum_ += __builtin_amdgcn_s_memrealtime() - t0p_;
#endif
            continue; }
        const int layer = ph / 10, st = ph % 10, kind = layer % 3, j = layer / 3;
        { int t_ = threadIdx.x; asm volatile("" : "+v"(t_)); F.tid = t_; F.lane = t_ & 63; F.wave = __builtin_amdgcn_readfirstlane(t_ >> 6);
          int g_ = gridDim.x, v_ = vcu0; asm volatile("" : "+s"(g_), "+s"(v_)); F.G = g_; F.vcu = v_;
          unsigned char* w_ = args.ws; float* o_ = args.out; asm volatile("" : "+s"(w_), "+s"(o_)); F.ws = w_; F.out = o_; }
        bf16* WT_IN = (bf16*)(F.ws + WS_WIN); bf16* WT_OUT = (bf16*)(F.ws + WS_WOUT); bf16* WT_UP = (bf16*)(F.ws + WS_WUP); bf16* WT_DN = (bf16*)(F.ws + WS_WDN);
        bf16* XN = (bf16*)(F.ws + WS_XN); bf16* HB_ = (bf16*)(F.ws + WS_H); float* GATES = (float*)(F.ws + WS_GATES);


        if (st == 0 && EN(0)) {
            const float* win = (kind == 0) ? INP(12) + (size_t)j * D * A_IN : (kind == 1) ? INP(17) : INP(22);
            const float* wout = (kind == 0) ? INP(16) + (size_t)j * D * D : (kind == 1) ? INP(21) : INP(25);
            const int ldw = (kind == 2) ? C_IN : A_IN, nin = (kind == 2) ? C_IN : NPROJ;
            const int sb = (kind == 0) ? 512 : 0, se = (kind == 0) ? 1024 : (kind == 1) ? 512 : 0; const float sv = (kind == 0) ? 0.125f : 0.08838834764831845f;
            if (layer == 0) prep_two(F, win, ldw, D, nin, WT_IN, sb, se, sv, wout, D, D, D, WT_OUT);
            const float* xp = (layer == 0) ? INP(0) : F.out; const float* xs = (layer == 0) ? INP(1) : F.out + (size_t)MP * D; float* xd = (layer == 0) ? F.out : nullptr;
            const float* g = INP(9) + (size_t)layer * D;
            if (kind < 2) {
                bf16* WgT = (bf16*)(F.ws + WS_GATES + 3 * MiB / 2);
                for (int e = F.vcu * NTHR + F.tid; e < 16 * D; e += F.G * NTHR) { const int k = e >> 4, c = e & 15; WgT[c * D + k] = (bf16)f2bf(win[(size_t)k * A_IN + NPROJ + c]); } }
            norm_rows<false>(F, xp, xs, xd, g, XN, nullptr, nullptr, (const float*)(F.ws + WS_R1), (layer == 0) ? 0 : KS_DN);
        } else if ((st == 1 || st == 7 || st == 5 || st == 9) && EN(1)) {
            const bool pj = (st == 1 || st == 7);
            const int N = (st == 7) ? 2 * DFF : (st == 1) ? ((kind == 2) ? C_IN : NPROJ) : D, K = (st == 9) ? DFF : D;
            const bf16* A = pj ? XN : (st == 5) ? HB_ : (const bf16*)(F.ws + WS_ACT);
            const bf16* Bt = (st == 1) ? WT_IN : (st == 7) ? WT_UP : (st == 5) ? WT_OUT : WT_DN;
            const bool rs_ = !pj;
            const int ksl = (st == 5) ? KS_OUT : KS_DN;
            pg8::Gemm g{A, Bt, rs_ ? MP : M, N, K}; pg8::StaticOrder S; S.init(rs_ ? MP : M, N, F.G, (int)blockIdx.x, K, rs_ ? (MS / 256) * (D / 256) * ksl : 0, rs_ ? ksl : 1);
            pg8::EpiDual E{pj, (bf16*)(F.ws + WS_PROJ), again ? (float*)(F.ws + WS_R1 + 32 * MiB) : F.out, N, (st == 1 && kind == 2) ? INP(23) : nullptr, (float*)(F.ws + WS_R1), MP, K / ksl, st == 7,
                pg8::EpiConvAct{(bf16*)(F.ws + WS_ACT), (bf16*)(F.ws + WS_U), INP(27) + (size_t)layer * 3 * DFF, INP(28) + (size_t)layer * DFF, (PG8_LAS float*)(F.lds + XCH_OFF), MP / 256}};
            if (st == 9) {
                pg8::Unit u0; for (int ui = 0; S.next(ui, u0); ++ui) convfix_unit(F, layer, u0.pm, u0.pn, u0.k0, u0.nt * 64, INP(8), INP(27), INP(28));
                asm volatile("s_waitcnt vmcnt(0)" ::: "memory"); __syncthreads(); }
            pg8::gemm_phase<pg8::EpiDual, pg8::StaticOrder, true, true>(F.lds, g, S, E);
            { const int nun = (rs_ ? MP / 256 : M / 256) * (N / 256), ex0 = nun % F.G, exu = (F.G - ex0 >= 64) ? ex0 : 0;
                if (st == 1) { __syncthreads(); prep_two(F, INP(26) + (size_t)layer * D * 2 * DFF, 2 * DFF, D, 2 * DFF, WT_UP, 0, 0, 1.0f, INP(29) + (size_t)layer * DFF * D, D, DFF, D, WT_DN, true, exu); }
                if (st == 7 && layer + 1 < DEPTH) { const int k2 = (layer + 1) % 3, j2 = (layer + 1) / 3;
                    const float* win2 = (k2 == 0) ? INP(12) + (size_t)j2 * D * A_IN : (k2 == 1) ? INP(17) : INP(22);
                    const float* wout2 = (k2 == 0) ? INP(16) + (size_t)j2 * D * D : (k2 == 1) ? INP(21) : INP(25);
                    const int ldw2 = (k2 == 2) ? C_IN : A_IN, nin2 = (k2 == 2) ? C_IN : NPROJ;
                    const int sb2 = (k2 == 0) ? 512 : 0, se2 = (k2 == 0) ? 1024 : (k2 == 1) ? 512 : 0; const float sv2 = (k2 == 0) ? 0.125f : 0.08838834764831845f;
                    __syncthreads(); prep_two(F, win2, ldw2, D, nin2, WT_IN, sb2, se2, sv2, wout2, D, D, D, WT_OUT, false, exu); } }
            if (st == 1 && kind < 2) { const int ex = ((M / 256) * (NPROJ / 256)) % F.G; gates_small(F, XN, (const bf16*)(F.ws + WS_GATES + 3 * MiB / 2), GATES, (ex < F.G / 2) ? ex : 0, kind == 0, INP(13) + j * HA, INP(14) + j * HA); }
        } else if (st == 2) {
            if (kind == 0) { if (EN(20)) mlstm_A(F); TS_MARK(F, 25); if (EN(21)) mlstm_S(F, j, INP(15), INP(2), INP(3), INP(4)); TS_MARK(F, 1); }
            else if (kind == 1) { TS_MARK(F, 26); if (EN(22)) gla_A(F, INP(18), INP(19)); TS_MARK(F, 27); if (EN(23)) gla_S(F, INP(18), INP(19), INP(20), INP(5)); TS_MARK(F, 1); }
            else { TS_MARK(F, 28); if (EN(24)) swa_prompt(F, INP(24)); TS_MARK(F, 29); if (EN(25)) swa_sample(F, INP(24), INP(6), INP(7)); TS_MARK(F, 1); }
        } else if (st == 3) {
            if (kind == 0) { if (EN(30)) mlstm_B(F, j); } else { if (EN(31)) gla_B(F); }
        } else if (st == 4) {
            if (kind == 0) { if (EN(40)) mlstm_C(F, j, INP(15)); } else { TS_MARK(F, 46); if (EN(41)) gla_C(F, INP(18), INP(19), INP(20)); TS_MARK(F, 1); }
        } else if (st == 6 && EN(6)) {
            norm_rows<false>(F, F.out, F.out + (size_t)MP * D, nullptr, INP(10) + (size_t)layer * D, XN, nullptr, nullptr, (const float*)(F.ws + WS_R1), KS_OUT);
        }
        if (((MK_REP >> st) & 1) && !again) { again = true; --ph; __syncthreads(); continue; }
        again = false;
        if (ph + 1 < hi) { xcd_barrier(bar);
#if defined(MK_BAR2)
            xcd_barrier(bar);
#endif
        }
#if MK_TMASK
        if (tmr_ && ((MK_TMASK >> st) & 1)) tsum_ += __builtin_amdgcn_s_memrealtime() - t0p_;
#endif
    }
#if MK_TSEG
    if (blockIdx.x == 0 && threadIdx.x == 0) { const unsigned long long ts_ = ((volatile LAS unsigned long long*)(F.MISC + 16))[1]; const unsigned long long tw_ = __builtin_amdgcn_s_memrealtime(); while (__builtin_amdgcn_s_memrealtime() - tw_ < ts_ * 4ull) __builtin_amdgcn_s_sleep(8); }
#endif
#if MK_TMASK
    if (tmr_) { const unsigned long long tw_ = __builtin_amdgcn_s_memrealtime(); while (__builtin_amdgcn_s_memrealtime() - tw_ < tsum_ * 4ull) __builtin_amdgcn_s_sleep(8); }
#endif
}

extern "C" void kernel_launch(void* const* d_in, const int* in_sizes, int n_in, void* d_out, int out_size, void* d_ws, size_t ws_size, hipStream_t stream) {
    static int grid = 0;
    if (grid == 0) {
        if (n_in != 30 || (size_t)out_size != O_END || ws_size < WS_END) { fprintf(stderr, "kernel_launch: built for 30 inputs, %zu outputs, >= %zu bytes of workspace; got n_in %d, out %d, ws %zu; nothing launched\n", (size_t)O_END, (size_t)WS_END, n_in, out_size, ws_size); grid = -1; return; }
        int dev = 0, cus = 0, per_cu = 0;
        if (hipGetDevice(&dev) != hipSuccess || hipDeviceGetAttribute(&cus, hipDeviceAttributeMultiprocessorCount, dev) != hipSuccess) { fprintf(stderr, "kernel_launch: device query failed\n"); grid = -1; return; }
        if (hipFuncSetAttribute((const void*)trunk_fwd, hipFuncAttributeMaxDynamicSharedMemorySize, LDS_BYTES) != hipSuccess) { fprintf(stderr, "kernel_launch: hipFuncSetAttribute failed\n"); grid = -1; return; }
        if (hipOccupancyMaxActiveBlocksPerMultiprocessor(&per_cu, (const void*)trunk_fwd, NTHR, LDS_BYTES) != hipSuccess || per_cu < 1) { fprintf(stderr, "kernel_launch: occupancy query says %d workgroups per CU\n", per_cu); }
        (void)hipGetLastError();
        grid = cus;
    }
    if (grid < 0) return;
    if (hipMemsetAsync((char*)d_ws + WS_CTL, 0, CTL_ZERO_BYTES, stream) != hipSuccess) { fprintf(stderr, "kernel_launch: hipMemsetAsync failed\n"); return; }
    Args a{};
    for (int i = 0; i < 30; ++i) a.in[i] = (const float*)d_in[i];
    a.out = (float*)d_out; a.ws = (unsigned char*)d_ws;
#if MK_MULTI
    for (int ph = 0; ph < N_PHASES; ++ph) { if (phase_empty(ph)) continue; a.ph_lo = ph; a.ph_hi = ph + 1;
        hipLaunchKernelGGL(trunk_fwd, dim3(grid), dim3(NTHR), LDS_BYTES, stream, a); }
#else
    a.ph_lo = 0; a.ph_hi = N_PHASES;
    hipLaunchKernelGGL(trunk_fwd, dim3(grid), dim3(NTHR), LDS_BYTES, stream, a);
#endif
    const hipError_t le = hipPeekAtLastError();
    if (le != hipSuccess) fprintf(stderr, "kernel_launch: launch failed: %s\n", hipGetErrorName(le));
}
```

```cpp
#include <hip/hip_runtime.h>
#include <cstdio>
#include <cstdint>
#define MK_MULTI 0
#define MK_REP 0
namespace pg8 {
#define PG8_LAS __attribute__((address_space(3)))
typedef unsigned short bf16_t;
typedef short bf16x8 __attribute__((ext_vector_type(8)));
typedef float f32x4 __attribute__((ext_vector_type(4)));
typedef unsigned u32x4 __attribute__((ext_vector_type(4)));
typedef unsigned u32x2 __attribute__((ext_vector_type(2)));
constexpr int BM = 256, BK = 64, HALF = 128, HTB = HALF * BK * 2  , STAGE_BYTES = 8 * HTB, NXCD = 8, WGM = 8;

__host__ __device__ __forceinline__ int lds_byte(int r, int c) { const int st = (r >> 4) * 2 + (c >> 5), rr = r & 15, cc = c & 31, ob = rr * 64 + cc * 2; return st * 1024 + (ob ^ (((ob >> 9) & 1) << 5)); }
__host__ __device__ __forceinline__ void stage_rc(int b, int& R, int& C) { const int st = b / 1024, sb = b % 1024, swz = sb ^ (((sb >> 9) & 1) << 5); R = (st >> 1) * 16 + swz / 64; C = (st & 1) * 32 + (swz % 64) / 2; }
__host__ __device__ __forceinline__ int perm32(int rho) { const int n = rho >> 4, i = rho & 15; return 8 * (i >> 2) + 4 * n + (i & 3); }

struct Unit { int pm, pn, k0, nt, mode; };
struct Gemm { const bf16_t* A; const bf16_t* Bt; int M, N, K; };

struct StaticOrder {
    int nM, nN, nwg, G, c, ntk, nsub, ks, kl;
    __host__ __device__ __forceinline__ void init(int M, int N, int G_, int c_, int K_, int nsub_ = 0, int ks_ = 1) { nM = M / BM; nN = N / BM; nwg = nM * nN; G = G_; c = c_; ntk = K_ / BK; nsub = nsub_; ks = ks_; kl = K_ / ks_; }
    __host__ __device__ __forceinline__ bool next(int i, Unit& u) const {
        const long L = (long)i * G + c; if (L >= nwg + nsub) return false;
        int pm, pn, k0, nt_, mode;
        if (L >= nwg) { const int e = (int)L - nwg, sl = e % ks, u8 = e / ks; pm = nM + u8 / nN; pn = u8 % nN; k0 = sl * kl; nt_ = kl / BK; mode = 1; }
        else {
            int wgid = (int)L; { const int q = nwg / NXCD, r = nwg % NXCD, xcd = wgid % NXCD, off = wgid / NXCD; wgid = (xcd < r ? xcd * (q + 1) : r * (q + 1) + (xcd - r) * q) + off; }
            const int nig = WGM * nN, gid = wgid / nig, fm = gid * WGM, gsz = (nM - fm) < WGM ? (nM - fm) : WGM;
            pm = fm + ((wgid % nig) % gsz); pn = (wgid % nig) / gsz; k0 = 0; nt_ = ntk; mode = 0; }
        u.pm = pm; u.pn = pn; u.k0 = k0; u.nt = nt_; u.mode = mode; return true;
    }
    __device__ __forceinline__ void a_ready(const Unit&) const {}
    __device__ __forceinline__ void done(const Unit&) const {}
};

__device__ __forceinline__ unsigned cvt_pk_bf16(float lo, float hi) { unsigned r; asm volatile("v_cvt_pk_bf16_f32 %0, %1, %2" : "=v"(r) : "v"(lo), "v"(hi)); return r; }
typedef float f32x2 __attribute__((ext_vector_type(2)));
struct EpiBf16 {
    static constexpr bool PERM = true, AFTER_DRAIN = false;
    bf16_t* O; int ldc; const float* bias;
    __device__ __forceinline__ void operator()(const f32x4 (&acc)[2][2][4][2], const Unit& u, int wr, int wc, int fr, int fq) const {
        const int row0 = u.pm * BM + wr * 64 + fr; const int col0 = u.pn * BM + wc * 32 + 8 * fq;
        f32x4 bv[2][2];
#pragma unroll
        for (int bj = 0; bj < 2; ++bj)
#pragma unroll
            for (int n = 0; n < 2; ++n) bv[bj][n] = bias ? *(const f32x4*)(bias + col0 + bj * HALF + 4 * n) : (f32x4){0.f, 0.f, 0.f, 0.f};
#pragma unroll
        for (int ai = 0; ai < 2; ++ai)
#pragma unroll
            for (int m = 0; m < 4; ++m) { bf16_t* rowp = O + (size_t)(row0 + ai * HALF + m * 16) * ldc + col0;
#pragma unroll
                for (int bj = 0; bj < 2; ++bj) { const f32x4 v0 = acc[ai][bj][m][0] + bv[bj][0], v1 = acc[ai][bj][m][1] + bv[bj][1];
                    u32x4 w; w.x = cvt_pk_bf16(v0[0], v0[1]); w.y = cvt_pk_bf16(v0[2], v0[3]); w.z = cvt_pk_bf16(v1[0], v1[1]); w.w = cvt_pk_bf16(v1[2], v1[3]);
                    *(u32x4*)(rowp + bj * HALF) = w; } }
    }
};
struct EpiRes {
    static constexpr bool PERM = false, AFTER_DRAIN = false;
    float* X; int ldc;
    __device__ __forceinline__ void operator()(const f32x4 (&acc)[2][2][4][2], const Unit& u, int wr, int wc, int fr, int fq) const {
        const int row0 = u.pm * BM + wr * 64 + fr, col0 = u.pn * BM + wc * 32 + 4 * fq;
        f32x4 nb[2][2];
#pragma unroll
        for (int bj = 0; bj < 2; ++bj)
#pragma unroll
            for (int n = 0; n < 2; ++n) nb[bj][n] = *(const f32x4*)(X + (size_t)row0 * ldc + col0 + bj * HALF + n * 16);
#pragma unroll
        for (int it = 0; it < 8; ++it) { const int ai = it >> 2, m = it & 3; float* rowp = X + (size_t)(row0 + ai * HALF + m * 16) * ldc + col0;
            f32x4 b[2][2];
#pragma unroll
            for (int bj = 0; bj < 2; ++bj)
#pragma unroll
                for (int n = 0; n < 2; ++n) b[bj][n] = nb[bj][n];
            if (it < 7) { const int a2 = (it + 1) >> 2, m2 = (it + 1) & 3; const float* np = X + (size_t)(row0 + a2 * HALF + m2 * 16) * ldc + col0;
#pragma unroll
                for (int bj = 0; bj < 2; ++bj)
#pragma unroll
                    for (int n = 0; n < 2; ++n) nb[bj][n] = *(const f32x4*)(np + bj * HALF + n * 16); }
#pragma unroll
            for (int bj = 0; bj < 2; ++bj)
#pragma unroll
                for (int n = 0; n < 2; ++n) *(f32x4*)(rowp + bj * HALF + n * 16) = b[bj][n] + acc[ai][bj][m][n];
        }
    }
};
struct EpiConvAct {
    bf16_t* ACT; bf16_t* U; const float* cw; const float* cb; PG8_LAS float* xch; int first_raw_tile;
    __device__ __forceinline__ void operator()(const f32x4 (&acc)[2][2][4][2], const Unit& u, int wr, int wc, int fr, int fq) const {
        constexpr int FF = 2816;
        asm volatile("" : "+v"(fr), "+v"(fq), "+s"(wr), "+s"(wc));
        const int lane = fq * 16 + fr, fb_t = wc * 32 + 8 * fq, fb = u.pn * 128 + fb_t;
        const bool rawtile = u.pm >= first_raw_tile;
        if (fr >= 14) {
#pragma unroll
            for (int ai = 0; ai < 2; ++ai) { PG8_LAS float* xp = xch + ((ai * 2 + wr) * 2 + (fr - 14)) * 128 + fb_t;
#pragma unroll
                for (int n = 0; n < 2; ++n) *(PG8_LAS f32x4*)(xp + 4 * n) = acc[ai][0][3][n]; }
        }
        float w0[8], w1[8], w2[8], bb[8];
#pragma unroll
        for (int n = 0; n < 2; ++n) { const f32x4 a = *(const f32x4*)(cw + fb + 4 * n), b = *(const f32x4*)(cw + FF + fb + 4 * n), c = *(const f32x4*)(cw + 2 * FF + fb + 4 * n), d = *(const f32x4*)(cb + fb + 4 * n);
#pragma unroll
            for (int e = 0; e < 4; ++e) { w0[4 * n + e] = a[e]; w1[4 * n + e] = b[e]; w2[4 * n + e] = c[e]; bb[4 * n + e] = d[e]; } }
        asm volatile("s_waitcnt lgkmcnt(0)" ::: "memory"); __builtin_amdgcn_s_barrier(); asm volatile("" ::: "memory");
#pragma unroll
        for (int ai = 0; ai < 2; ++ai) {
            float p1[8], p2[8];
            const int pb = ai * 2 + wr - 1;
#pragma unroll
            for (int i = 0; i < 8; ++i) { p1[i] = 0.f; p2[i] = 0.f; }
            if (pb >= 0 && fr < 2) { const PG8_LAS float* x63 = xch + (pb * 2 + 1) * 128 + fb_t; const PG8_LAS float* x62 = xch + (pb * 2 + 0) * 128 + fb_t;
#pragma unroll
                for (int i = 0; i < 8; ++i) { const float a63 = x63[i], a62 = x62[i]; p1[i] = a63; p2[i] = (fr == 0) ? a62 : a63; } }
#pragma unroll
            for (int m = 0; m < 4; ++m) {
                const size_t row = (size_t)u.pm * BM + ai * HALF + wr * 64 + m * 16 + fr;
                float o[8];
#pragma unroll
                for (int n = 0; n < 2; ++n)
#pragma unroll
                    for (int e = 0; e < 4; ++e) { const int i = 4 * n + e; const float g0 = acc[ai][0][m][n][e];
                        const float r1 = __builtin_bit_cast(float, __builtin_amdgcn_update_dpp(0, __builtin_bit_cast(int, g0), 0x121, 0xf, 0xf, false));
                        const float r2 = __builtin_bit_cast(float, __builtin_amdgcn_update_dpp(0, __builtin_bit_cast(int, g0), 0x122, 0xf, 0xf, false));
                        const float g1 = (fr >= 1) ? r1 : p1[i], g2 = (fr >= 2) ? r2 : p2[i];
                        p1[i] = r1; p2[i] = r2;
                        const float cv = bb[i] + w0[i] * g2 + w1[i] * g1 + w2[i] * g0;
                        o[i] = cv / (1.0f + __expf(-cv)) * acc[ai][1][m][n][e]; }
                if (!rawtile) { u32x4 w; w.x = cvt_pk_bf16(o[0], o[1]); w.y = cvt_pk_bf16(o[2], o[3]); w.z = cvt_pk_bf16(o[4], o[5]); w.w = cvt_pk_bf16(o[6], o[7]); *(u32x4*)(ACT + row * FF + fb) = w; }
                const bool rawrow = rawtile || (ai == 0 && wr == 0 && m == 0 && fr < 2) || (ai == 1 && wr == 1 && m == 3 && fr >= 14);
                if (rawrow) { const f32x4 a0 = acc[ai][0][m][0], a1 = acc[ai][0][m][1], b0 = acc[ai][1][m][0], b1 = acc[ai][1][m][1];
                    u32x4 w; w.x = cvt_pk_bf16(a0[0], a0[1]); w.y = cvt_pk_bf16(a0[2], a0[3]); w.z = cvt_pk_bf16(a1[0], a1[1]); w.w = cvt_pk_bf16(a1[2], a1[3]); *(u32x4*)(U + row * (2 * FF) + fb) = w;
                    w.x = cvt_pk_bf16(b0[0], b0[1]); w.y = cvt_pk_bf16(b0[2], b0[3]); w.z = cvt_pk_bf16(b1[0], b1[1]); w.w = cvt_pk_bf16(b1[2], b1[3]); *(u32x4*)(U + row * (2 * FF) + FF + fb) = w; }
                __builtin_amdgcn_sched_barrier(0);
            }
        }
    }
};
struct EpiDual {
    static constexpr bool AFTER_DRAIN = false;
    bool PERM; bf16_t* O; float* X; int ldc; const float* bias; float* slab; int row_base, kl; bool conv; EpiConvAct ca;
    __device__ __forceinline__ void operator()(const f32x4 (&acc)[2][2][4][2], const Unit& u, int wr, int wc, int fr, int fq) const {
        asm volatile("" : "+v"(fr), "+v"(fq), "+s"(wr), "+s"(wc));
        if (u.mode == 1) {
            float* sb = slab + (size_t)(u.k0 / kl) * 512 * ldc; const int row0 = u.pm * BM - row_base + wr * 64 + fr, col0 = u.pn * BM + wc * 32 + 4 * fq;
#pragma unroll
            for (int ai = 0; ai < 2; ++ai)
#pragma unroll
                for (int m = 0; m < 4; ++m) { float* rowp = sb + (size_t)(row0 + ai * HALF + m * 16) * ldc + col0;
#pragma unroll
                    for (int bj = 0; bj < 2; ++bj)
#pragma unroll
                        for (int n = 0; n < 2; ++n) *(f32x4*)(rowp + bj * HALF + n * 16) = acc[ai][bj][m][n]; }
        } else if (conv) { ca(acc, u, wr, wc, fr, fq);
        } else if (PERM) { EpiBf16 e{O, ldc, bias}; e(acc, u, wr, wc, fr, fq); } else { EpiRes e{X, ldc}; e(acc, u, wr, wc, fr, fq); }
    }
};
template <class Epi, class Sched, bool ALIGN_EPI = false, bool SP2 = false>
__device__ __forceinline__ void gemm_phase(PG8_LAS unsigned char* lds, const Gemm g, const Sched& S, const Epi& E) {
    int tid_ = threadIdx.x; asm volatile("" : "+v"(tid_));
    const int tid = tid_, wid = __builtin_amdgcn_readfirstlane(tid >> 6), lane = tid & 63, wr = wid >> 2, wc = wid & 3, fr = lane & 15, fq = lane >> 4;
    const int K = g.K;
    unsigned voffA[2], voffB[2];
#pragma unroll
    for (int i = 0; i < 2; ++i) { int R, C; stage_rc(tid * 16 + i * 8192, R, C); const int Rb = E.PERM ? ((R & ~31) + perm32(R & 31)) : R;
        voffA[i] = (unsigned)(R * K + C) * 2u; voffB[i] = (unsigned)(Rb * K + C) * 2u; }
    const size_t kstep = (size_t)(BK * 2);
    const size_t hstep = (size_t)HALF * K * 2;
    const size_t tstep = 2 * hstep;
    const unsigned ldsw = (unsigned)wid * 1024u;
    const int aoff = lds_byte(wr * 64 + fr, fq * 8), boff = lds_byte(wc * 32 + fr, fq * 8);
#define PG8_SA(b, h) (((b) * 2 + (h)) * HTB)
#define PG8_SB(b, h) ((4 + (b) * 2 + (h)) * HTB)
#define PG8_STAGE(bufoff, gbase, voff) do { _Pragma("unroll") for (int _i = 0; _i < 2; ++_i) \
        __builtin_amdgcn_global_load_lds((const unsigned*)((const char*)(gbase) + (voff)[_i]), (PG8_LAS unsigned*)(lds + (bufoff) + ldsw + _i * 8192), 16, 0, 0); } while (0)
#define PG8_LDA(dst, b, h) do { _Pragma("unroll") for (int m = 0; m < 4; ++m) _Pragma("unroll") for (int k = 0; k < 2; ++k) dst[m][k] = *(const PG8_LAS bf16x8*)(lds + PG8_SA(b, h) + aoff + m * 2048 + k * 1024); } while (0)
#define PG8_LDB(dst, b, h) do { _Pragma("unroll") for (int n = 0; n < 2; ++n) _Pragma("unroll") for (int k = 0; k < 2; ++k) dst[n][k] = *(const PG8_LAS bf16x8*)(lds + PG8_SB(b, h) + boff + n * 2048 + k * 1024); } while (0)
#define PG8_MMA(ai, bj, At, Bt) do { __builtin_amdgcn_s_setprio(1); _Pragma("unroll") for (int m = 0; m < 4; ++m) _Pragma("unroll") for (int n = 0; n < 2; ++n) _Pragma("unroll") for (int k = 0; k < 2; ++k) \
        acc[ai][bj][m][n] = __builtin_amdgcn_mfma_f32_16x16x32_bf16(Bt[n][k], At[m][k], acc[ai][bj][m][n], 0, 0, 0); __builtin_amdgcn_s_setprio(0); } while (0)
#define PG8_WAIT_V(n) asm volatile("s_waitcnt vmcnt(" #n ")" ::: "memory")
#define PG8_WAIT_L(n) asm volatile("s_waitcnt lgkmcnt(" #n ")" ::: "memory")
#define PG8_BAR __builtin_amdgcn_s_barrier()
#define PG8_SCHED __builtin_amdgcn_sched_barrier(0)
    Unit cur, nxt; int ui = 0;
    if (!S.next(0, cur)) return;
    f32x4 acc[2][2][4][2];
#pragma unroll
    for (int a = 0; a < 2; ++a)
#pragma unroll
        for (int b = 0; b < 2; ++b)
#pragma unroll
            for (int m = 0; m < 4; ++m)
#pragma unroll
                for (int n = 0; n < 2; ++n) acc[a][b][m][n] = (f32x4){0.f, 0.f, 0.f, 0.f};
    bf16x8 At[4][2], B0[2][2], B1[2][2];
    const char* cA = (const char*)g.A + (size_t)cur.pm * tstep + (size_t)cur.k0 * 2; const char* cB = (const char*)g.Bt + (size_t)cur.pn * tstep + (size_t)cur.k0 * 2;
    S.a_ready(cur);
    if constexpr (SP2) {
        PG8_STAGE(PG8_SB(0, 0), cB, voffB); PG8_STAGE(PG8_SB(0, 1), cB + hstep, voffB); PG8_STAGE(PG8_SA(0, 0), cA, voffA); PG8_STAGE(PG8_SA(0, 1), cA + hstep, voffA);
        if (wr == 1) PG8_BAR;
        PG8_WAIT_V(2); PG8_BAR;
        PG8_STAGE(PG8_SB(1, 0), cB + kstep, voffB); PG8_STAGE(PG8_SA(1, 0), cA + kstep, voffA); PG8_STAGE(PG8_SB(1, 1), cB + hstep + kstep, voffB);
        PG8_WAIT_V(6); PG8_BAR;
    } else {
        PG8_STAGE(PG8_SB(0, 0), cB, voffB); PG8_STAGE(PG8_SA(0, 0), cA, voffA); PG8_STAGE(PG8_SB(0, 1), cB + hstep, voffB); PG8_STAGE(PG8_SA(0, 1), cA + hstep, voffA);
        if (wr == 1) PG8_BAR;
        PG8_WAIT_V(4); PG8_BAR;
        PG8_STAGE(PG8_SB(1, 0), cB + kstep, voffB); PG8_STAGE(PG8_SA(1, 0), cA + kstep, voffA); PG8_STAGE(PG8_SB(1, 1), cB + hstep + kstep, voffB);
        PG8_WAIT_V(6); PG8_BAR;
    }
    for (;;) {
        const bool has_next = S.next(ui + 1, nxt);
        const char* nA = has_next ? (const char*)g.A + (size_t)nxt.pm * tstep + (size_t)nxt.k0 * 2 : cA; const char* nB = has_next ? (const char*)g.Bt + (size_t)nxt.pn * tstep + (size_t)nxt.k0 * 2 : cB;
        const int nt = cur.nt;
        for (int t = 0; t < nt; t += 2) {
            const bool last = (t == nt - 2);
            const char* a1 = cA + (size_t)(t + 1) * kstep;
            const char* a2 = last ? nA : cA + (size_t)(t + 2) * kstep; const char* b2 = last ? nB : cB + (size_t)(t + 2) * kstep;
            const char* a3 = a2 + kstep; const char* b3 = b2 + kstep;
            if (last && has_next) S.a_ready(nxt);
            if constexpr (SP2) {
            PG8_LDB(B0, 0, 0); PG8_LDB(B1, 0, 1); PG8_SCHED; PG8_LDA(At, 0, 0); PG8_STAGE(PG8_SA(1, 1), a1 + hstep, voffA);
            PG8_WAIT_V(8); PG8_WAIT_L(0); PG8_BAR; PG8_MMA(0, 0, At, B0); PG8_MMA(0, 1, At, B1); PG8_BAR; PG8_SCHED;
            PG8_LDA(At, 0, 1); PG8_STAGE(PG8_SB(0, 0), b2, voffB); PG8_STAGE(PG8_SB(0, 1), b2 + hstep, voffB); PG8_STAGE(PG8_SA(0, 0), a2, voffA);
            PG8_WAIT_V(8); PG8_WAIT_L(0); PG8_BAR; PG8_MMA(1, 0, At, B0); PG8_MMA(1, 1, At, B1); PG8_BAR; PG8_SCHED;
            PG8_LDB(B0, 1, 0); PG8_LDB(B1, 1, 1); PG8_SCHED; PG8_LDA(At, 1, 0); PG8_STAGE(PG8_SA(0, 1), a2 + hstep, voffA);
            PG8_WAIT_V(8); PG8_WAIT_L(0); PG8_BAR; PG8_MMA(0, 0, At, B0); PG8_MMA(0, 1, At, B1); PG8_BAR; PG8_SCHED;
            PG8_LDA(At, 1, 1); PG8_STAGE(PG8_SB(1, 0), b3, voffB); PG8_STAGE(PG8_SB(1, 1), b3 + hstep, voffB); PG8_STAGE(PG8_SA(1, 0), a3, voffA);
            PG8_WAIT_V(8); PG8_WAIT_L(0); PG8_BAR; PG8_MMA(1, 0, At, B0); PG8_MMA(1, 1, At, B1); PG8_BAR; PG8_SCHED;
            } else {
            PG8_LDB(B0, 0, 0); PG8_SCHED; PG8_LDA(At, 0, 0); PG8_STAGE(PG8_SA(1, 1), a1 + hstep, voffA);
            PG8_WAIT_L(8); PG8_BAR; PG8_WAIT_L(0); PG8_MMA(0, 0, At, B0); PG8_BAR; PG8_SCHED;
            PG8_LDB(B1, 0, 1); PG8_STAGE(PG8_SB(0, 0), b2, voffB);
            PG8_BAR; PG8_WAIT_L(0); PG8_MMA(0, 1, At, B1); PG8_BAR;
            PG8_LDA(At, 0, 1); PG8_STAGE(PG8_SA(0, 0), a2, voffA);
            PG8_BAR; PG8_WAIT_L(0); PG8_MMA(1, 0, At, B0); PG8_BAR; PG8_SCHED;
            PG8_STAGE(PG8_SB(0, 1), b2 + hstep, voffB);
            PG8_WAIT_V(6); PG8_BAR; PG8_MMA(1, 1, At, B1); PG8_BAR;
            PG8_LDB(B0, 1, 0); PG8_SCHED; PG8_LDA(At, 1, 0); PG8_STAGE(PG8_SA(0, 1), a2 + hstep, voffA);
            PG8_WAIT_L(8); PG8_BAR; PG8_WAIT_L(0); PG8_MMA(0, 0, At, B0); PG8_BAR; PG8_SCHED;
            PG8_LDB(B1, 1, 1); PG8_STAGE(PG8_SB(1, 0), b3, voffB);
            PG8_BAR; PG8_WAIT_L(0); PG8_MMA(0, 1, At, B1); PG8_BAR;
            PG8_LDA(At, 1, 1); PG8_STAGE(PG8_SA(1, 0), a3, voffA);
            PG8_BAR; PG8_WAIT_L(0); PG8_MMA(1, 0, At, B0); PG8_BAR; PG8_SCHED;
            PG8_STAGE(PG8_SB(1, 1), b3 + hstep, voffB);
            PG8_WAIT_V(6); PG8_BAR; PG8_MMA(1, 1, At, B1); PG8_BAR;
            }
        }
        if constexpr (ALIGN_EPI) { if (wr == 0) PG8_BAR; }
        if constexpr (!Epi::AFTER_DRAIN) { E(acc, cur, wr, wc, fr, fq); S.done(cur); }
        if (!has_next) break;
#pragma unroll
        for (int a = 0; a < 2; ++a)
#pragma unroll
            for (int b = 0; b < 2; ++b)
#pragma unroll
                for (int m = 0; m < 4; ++m)
#pragma unroll
                    for (int n = 0; n < 2; ++n) acc[a][b][m][n] = (f32x4){0.f, 0.f, 0.f, 0.f};
        cur = nxt; cA = nA; cB = nB; ++ui;
        if constexpr (ALIGN_EPI) { if (wr == 1) PG8_BAR; }
    }
    PG8_WAIT_V(0);
    if constexpr (!ALIGN_EPI) { if (wr == 0) PG8_BAR; }
    PG8_BAR;
    if constexpr (Epi::AFTER_DRAIN) { E.fused(acc, cur, wr, wc, fr, fq, lds, wid, lane); S.done(cur); }
#undef PG8_SA
#undef PG8_SB
#undef PG8_STAGE
#undef PG8_LDA
#undef PG8_LDB
#undef PG8_MMA
#undef PG8_WAIT_V
#undef PG8_WAIT_L
#undef PG8_BAR
#undef PG8_SCHED
}
}
constexpr int NWAVES = 8, NTHR = 512;
constexpr int D = 1024, BP = 4, TP = 4096, MP = BP * TP, BS = 128, TS = 4, MS = BS * TS, M = MP + MS;
constexpr int DEPTH = 4;
constexpr int HA = 8, DKA = 64, DVA = 128;
constexpr int HB = 4, DKB = 128, DVB = 256, RANK = 16;
constexpr int HC = 16, HKV = 4, HDC = 64, GROUP = 4, WIN = 128;
constexpr int DFF = 2816, A_IN = 3088, B_IN = 3088, C_IN = 1536, NPROJ = 3072;
constexpr int NCH = 64, LCH = 64;
constexpr float EPS = 1e-6f, SOFTCAP = 15.0f;

constexpr size_t O_YP = 0, O_YS = O_YP + (size_t)MP * D, O_PAC = O_YS + (size_t)MS * D, O_PAN = O_PAC + 2ull * BP * HA * DKA * DVA, O_PAM = O_PAN + 2ull * BP * HA * DKA,
    O_PG = O_PAM + 2ull * BP * HA, O_PSK = O_PG + (size_t)BP * HB * DKB * DVB, O_PSV = O_PSK + (size_t)BP * WIN * HKV * HDC, O_PF = O_PSV + (size_t)BP * WIN * HKV * HDC,
    O_SAC = O_PF + 4ull * BP * 2 * DFF, O_SAN = O_SAC + 2ull * BS * HA * DKA * DVA, O_SAM = O_SAN + 2ull * BS * HA * DKA, O_SG = O_SAM + 2ull * BS * HA,
    O_SSK = O_SG + (size_t)BS * HB * DKB * DVB, O_SSV = O_SSK + (size_t)BS * WIN * HKV * HDC, O_SF = O_SSV + (size_t)BS * WIN * HKV * HDC, O_END = O_SF + 4ull * BS * 2 * DFF;
static_assert(O_END == 63666240ull, "output size");

constexpr size_t MiB = 1u << 20;
constexpr size_t WS_CTL = 0, CTL_ZERO_BYTES = 1 * MiB;
constexpr size_t WS_WIN = 1 * MiB, WS_WOUT = 7 * MiB, WS_WUP = 9 * MiB, WS_WDN = 20 * MiB;
constexpr size_t WS_GATES = 26 * MiB;
constexpr size_t WS_XN = 28 * MiB;
constexpr size_t WS_H = 61 * MiB;
constexpr size_t WS_R1 = 94 * MiB;
constexpr size_t WS_PROJ = WS_R1;
constexpr size_t WS_SCR = WS_R1 + 99 * MiB;
constexpr size_t SC_LOC = WS_SCR;
constexpr size_t SC_ST = WS_SCR + 128 * MiB;
constexpr size_t SC_AUX = WS_SCR + 192 * MiB;
constexpr size_t WS_U = WS_R1;
constexpr size_t WS_ACT = WS_R1 + 182 * MiB;
constexpr size_t WS_END = WS_R1 + 293 * MiB;
static_assert(WS_WIN + (size_t)NPROJ * D * 2 <= WS_WOUT && WS_WOUT + (size_t)D * D * 2 <= WS_WUP && WS_WUP + 2ull * DFF * D * 2 <= WS_WDN && WS_WDN + (size_t)D * DFF * 2 <= WS_GATES, "ws map: weights");
static_assert(WS_GATES + (size_t)M * 16 * 4 <= WS_XN && WS_XN + (size_t)M * D * 2 <= WS_H && WS_H + (size_t)M * D * 2 <= WS_R1 && WS_PROJ + (size_t)M * NPROJ * 2 <= WS_SCR, "ws map: activations");
static_assert(WS_U + (size_t)M * 2 * DFF * 2 <= WS_ACT && WS_ACT + (size_t)M * DFF * 2 <= WS_END && SC_AUX + 2 * MiB <= WS_END, "ws map: ffn");
constexpr int AX_CHK = 0;
constexpr int AX_MST = 8192;
constexpr int AX_NLOC = 16384;
constexpr int AX_NST = 16384 + 131072;
constexpr int AX_BL = 0;
static_assert((AX_NST + 131072) * 4 <= (int)(2 * MiB), "aux");

constexpr int CW_BAR = 4096;

constexpr int RING_BYTES = 131072;
constexpr int LDSCTL_OFF = RING_BYTES, MISC_OFF = LDSCTL_OFF + 320;
constexpr int XCH_OFF = 132096;
constexpr int LDS_BYTES = 147456;

#define GAS __attribute__((address_space(1)))
#define LAS __attribute__((address_space(3)))
typedef unsigned short bf16;
typedef unsigned v4u __attribute__((ext_vector_type(4)));
typedef unsigned v2u __attribute__((ext_vector_type(2)));
typedef float f32x4 __attribute__((ext_vector_type(4)));
typedef float f32x2 __attribute__((ext_vector_type(2)));
typedef short bf16x8 __attribute__((ext_vector_type(8)));
#define LDS_WAIT() asm volatile("s_waitcnt lgkmcnt(0)" ::: "memory")
#define VM_WAIT() asm volatile("s_waitcnt vmcnt(0)" ::: "memory")
__device__ __forceinline__ unsigned f2bf(float f) { unsigned u = __builtin_bit_cast(unsigned, f); return (u + 0x7fffu + ((u >> 16) & 1u)) >> 16; }
__device__ __forceinline__ unsigned pk2(float lo, float hi) { return f2bf(lo) | (f2bf(hi) << 16); }
__device__ __forceinline__ float bf2f(unsigned h) { return __builtin_bit_cast(float, (h & 0xffffu) << 16); }
__device__ __forceinline__ float bflo(unsigned w) { return __builtin_bit_cast(float, w << 16); }
__device__ __forceinline__ float bfhi(unsigned w) { return __builtin_bit_cast(float, w & 0xffff0000u); }
__device__ __forceinline__ float wave_sum(float v) {
#pragma unroll
    for (int o = 1; o < 64; o <<= 1) v += __shfl_xor(v, o);
    return v;
}
__device__ __forceinline__ float wave_max(float v) {
#pragma unroll
    for (int o = 1; o < 64; o <<= 1) v = fmaxf(v, __shfl_xor(v, o));
    return v;
}
__device__ __forceinline__ float wave_scan_sum(float v, int lane) {
#pragma unroll
    for (int o = 1; o < 64; o <<= 1) { const float y = __shfl_up(v, o); if (lane >= o) v += y; }
    return v;
}
__device__ __forceinline__ float wave_scan_max(float v, int lane) {
#pragma unroll
    for (int o = 1; o < 64; o <<= 1) { const float y = __shfl_up(v, o); if (lane >= o) v = fmaxf(v, y); }
    return v;
}
__device__ __forceinline__ float logsigmoidf(float x) { return fminf(x, 0.f) - __logf(1.0f + __expf(-fabsf(x))); }
__device__ __forceinline__ float softcapf(float z) { const float e = __expf(z * (2.0f / SOFTCAP)); return SOFTCAP * (1.0f - 2.0f / (e + 1.0f)); }
__device__ __forceinline__ float sigmoidf_(float x) { return 1.0f / (1.0f + __expf(-x)); }

template <int KS> __device__ __forceinline__ f32x4 mma_ll(const LAS bf16* X, int ldx, const LAS bf16* Y, int ldy, f32x4 acc, int lane) {
    const int r16 = lane & 15, q = lane >> 4;
#pragma unroll
    for (int ks = 0; ks < KS; ++ks) {
        const bf16x8 a = *(const LAS bf16x8*)(X + r16 * ldx + ks * 32 + q * 8);
        const bf16x8 b = *(const LAS bf16x8*)(Y + r16 * ldy + ks * 32 + q * 8);
        acc = __builtin_amdgcn_mfma_f32_16x16x32_bf16(a, b, acc, 0, 0, 0);
    }
    return acc;
}
template <int KS> __device__ __forceinline__ f32x4 mma_gl(const bf16* X, int ldx, const LAS bf16* Y, int ldy, f32x4 acc, int lane) {
    const int r16 = lane & 15, q = lane >> 4;
    bf16x8 a[KS];
#pragma unroll
    for (int ks = 0; ks < KS; ++ks) a[ks] = *(const bf16x8*)(X + (size_t)r16 * ldx + ks * 32 + q * 8);
#pragma unroll
    for (int ks = 0; ks < KS; ++ks) {
        const bf16x8 b = *(const LAS bf16x8*)(Y + r16 * ldy + ks * 32 + q * 8);
        acc = __builtin_amdgcn_mfma_f32_16x16x32_bf16(a[ks], b, acc, 0, 0, 0);
    }
    return acc;
}
template <int R, int C> __device__ __forceinline__ void stage_nat(LAS bf16* dst, int lld, const bf16* src, size_t gld, int tid) {
    constexpr int CP = C / 8;
    for (int p = tid; p < R * CP; p += NTHR) { const int r = p / CP, c8 = p % CP; *(LAS v4u*)(dst + r * lld + c8 * 8) = *(const v4u*)(src + (size_t)r * gld + c8 * 8); }
}
template <int R, int C> __device__ __forceinline__ void stage_tr(LAS bf16* dst, int lld, const bf16* src, size_t gld, int tid) {
    constexpr int CP = C / 8;
    for (int p = tid; p < R * CP; p += NTHR) { const int r = p % R, c8 = p / R; const v4u v = *(const v4u*)(src + (size_t)r * gld + c8 * 8);
        LAS bf16* d = dst + (c8 * 8) * lld + r;
        d[0 * lld] = (bf16)(v.x & 0xffffu); d[1 * lld] = (bf16)(v.x >> 16); d[2 * lld] = (bf16)(v.y & 0xffffu); d[3 * lld] = (bf16)(v.y >> 16);
        d[4 * lld] = (bf16)(v.z & 0xffffu); d[5 * lld] = (bf16)(v.z >> 16); d[6 * lld] = (bf16)(v.w & 0xffffu); d[7 * lld] = (bf16)(v.w >> 16); }
}
#define XB_TMO      128
#define XB_XCNT(j)  (256  + 64 * (j))
#define XB_XSUB(j)  (1280 + 64 * (j))
#define XB_XGEN(j)  (2304 + 64 * (j))
#define XB_TOP      3328
#define XB_TOPGEN   3392
#define XCD_BAR_WORDS 3456
#define XB_SPIN_CAP (1u << 18)

__device__ __forceinline__ unsigned xb_ld(unsigned* p)              { return __hip_atomic_load(p, __ATOMIC_RELAXED, __HIP_MEMORY_SCOPE_AGENT); }
__device__ __forceinline__ unsigned xb_add(unsigned* p, unsigned v) { return __hip_atomic_fetch_add(p, v, __ATOMIC_RELAXED, __HIP_MEMORY_SCOPE_AGENT); }
__device__ __forceinline__ unsigned xb_xcc_id() { return (unsigned)__builtin_amdgcn_s_getreg((3 << 11) | 20) & 0xFu; }
#define XB_SPIN(cond, bar) do { unsigned _sp = 0; while (cond) { __builtin_amdgcn_s_sleep(1); \
    if ((++_sp & 255u) == 0u) { if (xb_ld(&(bar)[XB_TMO])) break; if (_sp > XB_SPIN_CAP) { atomicAdd(&(bar)[XB_TMO], 1u); break; } } } } while (0)

struct XcdBarrier {
    unsigned* bar; unsigned x;
    volatile LAS unsigned* st;
};

__device__ __forceinline__ XcdBarrier xcd_barrier_post(unsigned* bar, volatile LAS unsigned* st) {
    XcdBarrier b; b.bar = bar; b.x = xb_xcc_id(); b.st = st;
    if (threadIdx.x == 0) (void)xb_add(&bar[XB_XCNT(b.x)], 1u);
    return b;
}
__device__ __forceinline__ void xcd_barrier_complete(unsigned* bar, unsigned x, unsigned& nloc, unsigned& nx) {
    const unsigned G = gridDim.x * gridDim.y * gridDim.z;
    unsigned sum, cnt, mine, sp = 0u;
    for (;;) {
        sum = 0u; cnt = 0u; mine = 0u;
#pragma unroll
        for (unsigned j = 0; j < 16; ++j) { const unsigned c = xb_ld(&bar[XB_XCNT(j)]); sum += c; cnt += (c > 0u) ? 1u : 0u; mine = (j == x) ? c : mine; }
        if (sum == G) break;
        __builtin_amdgcn_s_sleep(1);
        if ((++sp & 255u) == 0u) { if (xb_ld(&bar[XB_TMO])) break; if (sp > XB_SPIN_CAP) { atomicAdd(&bar[XB_TMO], 1u); break; } }
    }
    nloc = mine > 0u ? mine : 1u; nx = cnt > 0u ? cnt : 1u;
}

__device__ __forceinline__ void xcd_barrier(const XcdBarrier& b) {
    asm volatile("s_waitcnt vmcnt(0)" ::: "memory");
    __syncthreads();
    if (threadIdx.x == 0) {
        unsigned* bar = b.bar;
        __builtin_amdgcn_s_waitcnt(0);
        unsigned nloc = b.st[0], nx = b.st[1];
        if (nloc == 0u) { xcd_barrier_complete(bar, b.x, nloc, nx); b.st[0] = nloc; b.st[1] = nx; }
        const unsigned old = xb_add(&bar[XB_XSUB(b.x)], 1u);
        const unsigned gen = old / nloc;
        if (old + 1u == (gen + 1u) * nloc) {
            __builtin_amdgcn_fence(__ATOMIC_RELEASE, "agent");
            asm volatile("s_waitcnt vmcnt(0)" ::: "memory");
            const unsigned og = xb_add(&bar[XB_TOP], 1u);
            const unsigned tg = og / nx;
            if (og + 1u == (tg + 1u) * nx) xb_add(&bar[XB_TOPGEN], 1u);
            else XB_SPIN(xb_ld(&bar[XB_TOPGEN]) == tg, bar);
            __builtin_amdgcn_fence(__ATOMIC_ACQUIRE, "agent");
            xb_add(&bar[XB_XGEN(b.x)], 1u);
            asm volatile("s_waitcnt vmcnt(0)" ::: "memory");
        } else {
            XB_SPIN(xb_ld(&bar[XB_XGEN(b.x)]) == gen, bar);
            __builtin_amdgcn_fence(__ATOMIC_ACQUIRE, "agent");
            asm volatile("s_waitcnt vmcnt(0)" ::: "memory");
        }
    }
    __syncthreads();
}
struct Frame {
    LAS unsigned char* lds;
    volatile LAS unsigned* MISC;
    unsigned* ctl;
    int tid, lane, wave;
    int vcu, G;
    float* out; unsigned char* ws;
};
#define GW_ID(F) ((F).vcu * NWAVES + (F).wave)
#define GW_N(F) ((F).G * NWAVES)
#ifndef MK_TSEG
#define MK_TSEG 0
#endif
#if MK_TSEG
#define TS_MARK(F, id) do { if (blockIdx.x == 0 && (F).tid == 0) { const unsigned long long t__ = __builtin_amdgcn_s_memrealtime(); volatile LAS unsigned long long* T__ = (volatile LAS unsigned long long*)((F).MISC + 16); \
    if ((F).MISC[22] == (unsigned)MK_TSEG) T__[1] += t__ - T__[0]; T__[0] = t__; (F).MISC[22] = (unsigned)(id); } } while (0)
#else
#define TS_MARK(F, id) do { } while (0)
#endif

__device__ __forceinline__ void transpose_item(const float* __restrict__ W, int ldw, int K, bf16* __restrict__ WT, LAS float* scr, int kb, int nb, int sb, int se, float sv, int lane, bool upmap = false) {
    const int k0 = 64 * kb, n0 = 32 * nb;
    const int d0 = !upmap ? n0 : (n0 < DFF ? (n0 >> 7) * 256 + (n0 & 127) : ((n0 - DFF) >> 7) * 256 + 128 + ((n0 - DFF) & 127));
    f32x4 v[8];
#pragma unroll
    for (int i = 0; i < 8; ++i) v[i] = *(const f32x4*)(W + (size_t)(k0 + i * 8 + (lane >> 3)) * ldw + n0 + (lane & 7) * 4);
#pragma unroll
    for (int i = 0; i < 8; ++i) { LAS float* d = scr + (i * 8 + (lane >> 3)) * 33 + (lane & 7) * 4; d[0] = v[i].x; d[1] = v[i].y; d[2] = v[i].z; d[3] = v[i].w; }
    LDS_WAIT(); asm volatile("" ::: "memory");
    const int c = lane & 7;
    const float sc = (n0 >= sb && n0 < se) ? sv : 1.0f;
#pragma unroll
    for (int j = 0; j < 4; ++j) { const int n = (lane >> 3) + 8 * j; const LAS float* s = scr + (8 * c) * 33 + n;
        v4u o; o.x = pk2(s[0 * 33] * sc, s[1 * 33] * sc); o.y = pk2(s[2 * 33] * sc, s[3 * 33] * sc); o.z = pk2(s[4 * 33] * sc, s[5 * 33] * sc); o.w = pk2(s[6 * 33] * sc, s[7 * 33] * sc);
        *(v4u*)(WT + (size_t)(d0 + n) * K + k0 + 8 * c) = o; }
    LDS_WAIT(); asm volatile("" ::: "memory");
}
__device__ __forceinline__ void prep_two(Frame& F, const float* W0, int ldw0, int K0, int N0, bf16* T0, int sb, int se, float sv, const float* W1, int ldw1, int K1, int N1, bf16* T1, bool upmap0 = false, int cu_lo = 0) {
    if ((int)blockIdx.x < cu_lo) return;
    LAS float* scr = (LAS float*)(F.lds + F.wave * 16384);
    const int nb0 = N0 / 32, I0 = (K0 / 64) * nb0, nb1 = N1 / 32, I1 = (K1 / 64) * nb1;
    for (int it = ((int)blockIdx.x - cu_lo) * NWAVES + F.wave; it < I0 + I1; it += (F.G - cu_lo) * NWAVES) {
        if (it < I0) transpose_item(W0, ldw0, K0, T0, scr, it / nb0, it % nb0, sb, se, sv, F.lane, upmap0);
        else { const int r = it - I0; transpose_item(W1, ldw1, K1, T1, scr, r / nb1, r % nb1, 0, 0, 1.0f, F.lane); }
    }
}

template <bool GATES> __device__ __forceinline__ void norm_rows(Frame& F, const float* xp, const float* xs, float* Xdst, const float* g, bf16* XN, float* gates, const LAS float* WgT, const float* slab, int nslab) {
    f32x4 gv[4];
#pragma unroll
    for (int j = 0; j < 4; ++j) gv[j] = ((const f32x4*)g)[F.lane + 64 * j];
    f32x4 nx[4];
    { const int m0 = GW_ID(F); if (m0 < M) { const float* xr = (m0 < MP) ? xp + (size_t)m0 * D : xs + (size_t)(m0 - MP) * D;
#pragma unroll
        for (int j = 0; j < 4; ++j) nx[j] = ((const f32x4*)xr)[F.lane + 64 * j]; } }
    for (int m = GW_ID(F); m < M; m += GW_N(F)) {
        f32x4 v[4]; float ss = 0.f;
#pragma unroll
        for (int j = 0; j < 4; ++j) v[j] = nx[j];
        { const int mn = m + GW_N(F); if (mn < M) { const float* xr = (mn < MP) ? xp + (size_t)mn * D : xs + (size_t)(mn - MP) * D;
#pragma unroll
            for (int j = 0; j < 4; ++j) nx[j] = ((const f32x4*)xr)[F.lane + 64 * j]; } }
        if (nslab > 0 && m >= MP) {
            for (int sl = 0; sl < nslab; ++sl) { const f32x4* sp = (const f32x4*)(slab + ((size_t)sl * MS + (m - MP)) * D);
#pragma unroll
                for (int j = 0; j < 4; ++j) v[j] = v[j] + sp[F.lane + 64 * j]; }
#pragma unroll
            for (int j = 0; j < 4; ++j) ((f32x4*)(F.out + (size_t)m * D))[F.lane + 64 * j] = v[j];
        }
#pragma unroll
        for (int j = 0; j < 4; ++j) ss += (v[j].x * v[j].x + v[j].y * v[j].y) + (v[j].z * v[j].z + v[j].w * v[j].w);
        if (Xdst) {
#pragma unroll
            for (int j = 0; j < 4; ++j) ((f32x4*)(Xdst + (size_t)m * D))[F.lane + 64 * j] = v[j];
        }
        const float rs = 1.0f / sqrtf(wave_sum(ss) * (1.0f / D) + EPS);
        v2u* o8 = (v2u*)(XN + (size_t)m * D);
#pragma unroll
        for (int j = 0; j < 4; ++j) { v[j] = v[j] * rs * gv[j]; v2u w; w.x = pk2(v[j].x, v[j].y); w.y = pk2(v[j].z, v[j].w); o8[F.lane + 64 * j] = w; }
        if (GATES) {
            float s[16];
#pragma unroll
            for (int c = 0; c < 16; ++c) { float a = 0.f;
#pragma unroll
                for (int j = 0; j < 4; ++j) { const f32x4 w = ((const LAS f32x4*)(WgT + c * 1024))[F.lane + 64 * j]; a += (v[j].x * w.x + v[j].y * w.y) + (v[j].z * w.z + v[j].w * w.w); }
                s[c] = a; if ((c & 3) == 3) asm volatile("" ::: "memory"); }
            const bool b5 = (F.lane & 32) != 0, b4 = (F.lane & 16) != 0, b3 = (F.lane & 8) != 0, b2 = (F.lane & 4) != 0;
#pragma unroll
            for (int i = 0; i < 8; ++i) { const float send = b5 ? s[i] : s[i + 8], keep = b5 ? s[i + 8] : s[i]; s[i] = keep + __shfl_xor(send, 32); }
#pragma unroll
            for (int i = 0; i < 4; ++i) { const float send = b4 ? s[i] : s[i + 4], keep = b4 ? s[i + 4] : s[i]; s[i] = keep + __shfl_xor(send, 16); }
#pragma unroll
            for (int i = 0; i < 2; ++i) { const float send = b3 ? s[i] : s[i + 2], keep = b3 ? s[i + 2] : s[i]; s[i] = keep + __shfl_xor(send, 8); }
            { const float send = b2 ? s[0] : s[1], keep = b2 ? s[1] : s[0]; s[0] = keep + __shfl_xor(send, 4); }
            s[0] += __shfl_xor(s[0], 2); s[0] += __shfl_xor(s[0], 1);
            if ((F.lane & 3) == 0) gates[(size_t)m * 16 + (F.lane >> 2)] = s[0];
        }
    }
}
#define NR_LOAD(buf, mm) do { if ((mm) < M) { const float* xr_ = ((mm) < MP) ? xp + (size_t)(mm) * D : xs + (size_t)((mm) - MP) * D; \
    _Pragma("unroll") for (int j_ = 0; j_ < 4; ++j_) buf[j_] = ((const f32x4*)xr_)[F.lane + 64 * j_]; } } while (0)
#define NR_PROC(buf, mm) do { if ((mm) < M) { f32x4 v_[4]; float ss_ = 0.f; \
    _Pragma("unroll") for (int j_ = 0; j_ < 4; ++j_) v_[j_] = buf[j_]; \
    NR_LOAD(buf, (mm) + 3 * GW_N(F)); \
    if (nslab > 0 && (mm) >= MP) { for (int sl_ = 0; sl_ < nslab; ++sl_) { const f32x4* sp_ = (const f32x4*)(slab + ((size_t)sl_ * MS + ((mm) - MP)) * D); \
            _Pragma("unroll") for (int j_ = 0; j_ < 4; ++j_) v_[j_] = v_[j_] + sp_[F.lane + 64 * j_]; } \
        _Pragma("unroll") for (int j_ = 0; j_ < 4; ++j_) ((f32x4*)(F.out + (size_t)(mm) * D))[F.lane + 64 * j_] = v_[j_]; } \
    _Pragma("unroll") for (int j_ = 0; j_ < 4; ++j_) ss_ += (v_[j_].x * v_[j_].x + v_[j_].y * v_[j_].y) + (v_[j_].z * v_[j_].z + v_[j_].w * v_[j_].w); \
    if (Xdst) { _Pragma("unroll") for (int j_ = 0; j_ < 4; ++j_) ((f32x4*)(Xdst + (size_t)(mm) * D))[F.lane + 64 * j_] = v_[j_]; } \
    const float rs_ = 1.0f / sqrtf(wave_sum(ss_) * (1.0f / D) + EPS); v2u* o8_ = (v2u*)(XN + (size_t)(mm) * D); \
    _Pragma("unroll") for (int j_ = 0; j_ < 4; ++j_) { const f32x4 y_ = v_[j_] * rs_ * gv[j_]; v2u w_; w_.x = pk2(y_.x, y_.y); w_.y = pk2(y_.z, y_.w); o8_[F.lane + 64 * j_] = w_; } } } while (0)
__device__ __forceinline__ void norm_rows3(Frame& F, const float* xp, const float* xs, float* Xdst, const float* g, bf16* XN, const float* slab, int nslab) {
    f32x4 gv[4];
#pragma unroll
    for (int j = 0; j < 4; ++j) gv[j] = ((const f32x4*)g)[F.lane + 64 * j];
    f32x4 ba[4], bb[4], bc[4]; const int S = GW_N(F), m0 = GW_ID(F);
    NR_LOAD(ba, m0); NR_LOAD(bb, m0 + S); NR_LOAD(bc, m0 + 2 * S);
    for (int m = m0; m < M; m += 3 * S) { NR_PROC(ba, m); NR_PROC(bb, m + S); NR_PROC(bc, m + 2 * S); }
}
__device__ __forceinline__ void stage_wgT(Frame& F, const float* W, int ldw, int c0, LAS float* WgT) {
    for (int e = F.tid; e < 16 * 1024; e += NTHR) { const int k = e >> 4, c = e & 15; WgT[c * 1024 + k] = W[(size_t)k * ldw + c0 + c]; }
}

__device__ __forceinline__ void unpack8(const v4u v, float (&f)[8]) { f[0] = bflo(v.x); f[1] = bfhi(v.x); f[2] = bflo(v.y); f[3] = bfhi(v.y); f[4] = bflo(v.z); f[5] = bfhi(v.z); f[6] = bflo(v.w); f[7] = bfhi(v.w); }
__device__ __forceinline__ void convfix_unit(Frame& F, int layer, int pm, int pn, int k0, int kw, const float* __restrict__ conv_state, const float* __restrict__ cw, const float* __restrict__ cb) {
    const bf16* __restrict__ U = (const bf16*)(F.ws + WS_U); bf16* ACT = (bf16*)(F.ws + WS_ACT);
    const float* cwl = cw + (size_t)layer * 3 * DFF; const float* cbl = cb + (size_t)layer * DFF;
    if (pm < MP / 256) {
        const int row0 = pm * 256;
        for (int fc = F.tid; fc < DFF / 8; fc += NTHR) { const int f0 = fc * 8;
            if ((pm & 15) == 15 && pn == 0) { float a[8], b[8]; unpack8(*(const v4u*)(U + (size_t)(row0 + 254) * (2 * DFF) + f0), a); unpack8(*(const v4u*)(U + (size_t)(row0 + 255) * (2 * DFF) + f0), b);
                float* o = F.out + O_PF + ((size_t)(layer * BP + (pm >> 4)) * 2) * DFF + f0;
#pragma unroll
                for (int i = 0; i < 8; ++i) { o[i] = a[i]; o[DFF + i] = b[i]; } }
            if ((pm & 15) != 0) {
                const v4u ug2 = *(const v4u*)(U + (size_t)(row0 - 2) * (2 * DFF) + f0), ug1 = *(const v4u*)(U + (size_t)(row0 - 1) * (2 * DFF) + f0);
                const v4u ua0 = *(const v4u*)(U + (size_t)row0 * (2 * DFF) + f0), ua1 = *(const v4u*)(U + (size_t)(row0 + 1) * (2 * DFF) + f0);
                const v4u uu0 = *(const v4u*)(U + (size_t)row0 * (2 * DFF) + DFF + f0), uu1 = *(const v4u*)(U + (size_t)(row0 + 1) * (2 * DFF) + DFF + f0);
                float g2[8], g1[8], ga[8], gb[8], u0[8], u1[8]; unpack8(ug2, g2); unpack8(ug1, g1); unpack8(ua0, ga); unpack8(ua1, gb); unpack8(uu0, u0); unpack8(uu1, u1);
                float oa[8], ob[8];
#pragma unroll
                for (int i = 0; i < 8; ++i) { const float w0 = cwl[f0 + i], w1 = cwl[DFF + f0 + i], w2 = cwl[2 * DFF + f0 + i], bb = cbl[f0 + i];
                    const float c0 = bb + w0 * g2[i] + w1 * g1[i] + w2 * ga[i], c1 = bb + w0 * g1[i] + w1 * ga[i] + w2 * gb[i];
                    oa[i] = c0 * sigmoidf_(c0) * u0[i]; ob[i] = c1 * sigmoidf_(c1) * u1[i]; }
                v4u w; w.x = pk2(oa[0], oa[1]); w.y = pk2(oa[2], oa[3]); w.z = pk2(oa[4], oa[5]); w.w = pk2(oa[6], oa[7]); *(v4u*)(ACT + (size_t)row0 * DFF + f0) = w;
                w.x = pk2(ob[0], ob[1]); w.y = pk2(ob[2], ob[3]); w.z = pk2(ob[4], ob[5]); w.w = pk2(ob[6], ob[7]); *(v4u*)(ACT + (size_t)(row0 + 1) * DFF + f0) = w; }
        }
    } else {
        const int nch = kw >> 3, b0 = (pm - MP / 256) * 64;
        for (int it = F.tid; it < 64 * nch; it += NTHR) { const int fc = it % nch, bi = it / nch, b = b0 + bi, f0 = k0 + fc * 8, row0 = MP + b * TS;
            const float* cs = conv_state + ((size_t)(layer * BS + b) * 2) * DFF + f0;
            float g2[8], g1[8];
            { const f32x4 a0 = *(const f32x4*)cs, a1 = *(const f32x4*)(cs + 4), b0v = *(const f32x4*)(cs + DFF), b1v = *(const f32x4*)(cs + DFF + 4);
#pragma unroll
                for (int i = 0; i < 4; ++i) { g2[i] = a0[i]; g2[4 + i] = a1[i]; g1[i] = b0v[i]; g1[4 + i] = b1v[i]; } }
            v4u ug[4], uu[4];
#pragma unroll
            for (int r = 0; r < 4; ++r) { ug[r] = *(const v4u*)(U + (size_t)(row0 + r) * (2 * DFF) + f0); uu[r] = *(const v4u*)(U + (size_t)(row0 + r) * (2 * DFF) + DFF + f0); }
            float w0[8], w1[8], w2[8], bb[8];
#pragma unroll
            for (int i = 0; i < 8; ++i) { w0[i] = cwl[f0 + i]; w1[i] = cwl[DFF + f0 + i]; w2[i] = cwl[2 * DFF + f0 + i]; bb[i] = cbl[f0 + i]; }
#pragma unroll
            for (int r = 0; r < 4; ++r) { float g0[8], up[8]; unpack8(ug[r], g0); unpack8(uu[r], up); float o[8];
#pragma unroll
                for (int i = 0; i < 8; ++i) { const float cv = bb[i] + w0[i] * g2[i] + w1[i] * g1[i] + w2[i] * g0[i]; o[i] = cv * sigmoidf_(cv) * up[i]; g2[i] = g1[i]; g1[i] = g0[i]; }
                v4u w; w.x = pk2(o[0], o[1]); w.y = pk2(o[2], o[3]); w.z = pk2(o[4], o[5]); w.w = pk2(o[6], o[7]); *(v4u*)(ACT + (size_t)(row0 + r) * DFF + f0) = w; }
            if (pn == 0) { float* o = F.out + O_SF + ((size_t)(layer * BS + b) * 2) * DFF + f0;
#pragma unroll
                for (int i = 0; i < 8; ++i) { o[i] = g2[i]; o[DFF + i] = g1[i]; } }
        }
    }
}

__device__ __forceinline__ void convfix_phase(Frame& F, int layer, const float* conv_state, const float* cw, const float* cb) {
    const bf16* U = (const bf16*)(F.ws + WS_U); bf16* ACT = (bf16*)(F.ws + WS_ACT);
    constexpr int FC = DFF / 8, NPT = MP / 256;
    const int gt = F.vcu * NTHR + F.tid, GT = F.G * NTHR;
    const float* cwl = cw + (size_t)layer * 3 * DFF; const float* cbl = cb + (size_t)layer * DFF;
    for (int it = gt; it < (NPT + BS) * FC; it += GT) {
        const bool samp = it >= NPT * FC; const int r2 = samp ? it - NPT * FC : it;
        const int fc = r2 % FC, rb = r2 / FC, f0 = fc * 8;
        float g2[8], g1[8]; int row0, nrows;
        if (!samp) { row0 = rb * 256; nrows = 2;
            if ((rb & 15) == 15) { float a[8], b[8]; unpack8(*(const v4u*)(U + (size_t)(row0 + 254) * (2 * DFF) + f0), a); unpack8(*(const v4u*)(U + (size_t)(row0 + 255) * (2 * DFF) + f0), b);
                float* o = F.out + O_PF + ((size_t)(layer * BP + (rb >> 4)) * 2) * DFF + f0;
#pragma unroll
                for (int i = 0; i < 8; ++i) { o[i] = a[i]; o[DFF + i] = b[i]; } }
            if ((rb & 15) == 0) continue;
            unpack8(*(const v4u*)(U + (size_t)(row0 - 2) * (2 * DFF) + f0), g2); unpack8(*(const v4u*)(U + (size_t)(row0 - 1) * (2 * DFF) + f0), g1);
        } else { row0 = MP + rb * TS; nrows = TS; const float* cs = conv_state + ((size_t)(layer * BS + rb) * 2) * DFF + f0;
#pragma unroll
            for (int i = 0; i < 8; ++i) { g2[i] = cs[i]; g1[i] = cs[DFF + i]; }
        }
        float w0[8], w1[8], w2[8], bb[8];
#pragma unroll
        for (int i = 0; i < 8; ++i) { w0[i] = cwl[f0 + i]; w1[i] = cwl[DFF + f0 + i]; w2[i] = cwl[2 * DFF + f0 + i]; bb[i] = cbl[f0 + i]; }
        for (int r = 0; r < nrows; ++r) {
            const size_t row = (size_t)(row0 + r);
            float g0[8], up[8]; unpack8(*(const v4u*)(U + row * (2 * DFF) + f0), g0); unpack8(*(const v4u*)(U + row * (2 * DFF) + DFF + f0), up);
            float o[8];
#pragma unroll
            for (int i = 0; i < 8; ++i) { const float cv = bb[i] + w0[i] * g2[i] + w1[i] * g1[i] + w2[i] * g0[i]; o[i] = cv * sigmoidf_(cv) * up[i]; g2[i] = g1[i]; g1[i] = g0[i]; }
            v4u w; w.x = pk2(o[0], o[1]); w.y = pk2(o[2], o[3]); w.z = pk2(o[4], o[5]); w.w = pk2(o[6], o[7]);
            *(v4u*)(ACT + row * DFF + f0) = w;
        }
        if (samp) { float* o = F.out + O_SF + ((size_t)(layer * BS + rb) * 2) * DFF + f0;
#pragma unroll
            for (int i = 0; i < 8; ++i) { o[i] = g2[i]; o[DFF + i] = g1[i]; } }
    }
}

constexpr int MLC = 128, MNCH = TP / MLC, MITEMS = BP * HA * MNCH;
constexpr int ST_ROWS = 144;
__device__ __forceinline__ void ml_gates(const float* GT, int row0, int h, int lane, float& a0, float& a1, float& fc0, float& fc1) {
    const float ig0 = GT[(size_t)(row0 + lane) * 16 + h], lf0 = GT[(size_t)(row0 + lane) * 16 + 8 + h];
    const float ig1 = GT[(size_t)(row0 + 64 + lane) * 16 + h], lf1 = GT[(size_t)(row0 + 64 + lane) * 16 + 8 + h];
    fc0 = wave_scan_sum(lf0, lane); const float tot0 = __shfl(fc0, 63); fc1 = tot0 + wave_scan_sum(lf1, lane);
    a0 = ig0 - fc0; a1 = ig1 - fc1;
}
__device__ __forceinline__ void mlstm_A(Frame& F) {
    LAS bf16* Kt = (LAS bf16*)F.lds; LAS bf16* Vt = Kt + 64 * 136; LAS float* wv = (LAS float*)(Vt + 128 * 136);
    const bf16* PROJ = (const bf16*)(F.ws + WS_PROJ); const float* GT = (const float*)(F.ws + WS_GATES);
    float* CLOC = (float*)(F.ws + SC_LOC); float* AUX = (float*)(F.ws + SC_AUX);
    for (int item = F.vcu; item < MITEMS; item += F.G) {
        const int bh = item >> 5, c = item & 31, b = bh >> 3, h = bh & 7, row0 = b * TP + c * MLC;
        TS_MARK(F, 21);
        v4u vv[4];
#pragma unroll
        for (int u = 0; u < 4; ++u) { const int p = F.tid + u * NTHR, r = p & 127, c8 = p >> 7; vv[u] = *(const v4u*)(PROJ + (size_t)(row0 + r) * NPROJ + 1024 + h * 128 + c8 * 8); }
        v4u kv[2];
#pragma unroll
        for (int u = 0; u < 2; ++u) { const int p = F.tid + u * NTHR, r = p & 127, c8 = p >> 7; kv[u] = *(const v4u*)(PROJ + (size_t)(row0 + r) * NPROJ + 512 + h * 64 + c8 * 8); }
        if (F.wave == 0) { float a0, a1, f0, f1; ml_gates(GT, row0, h, F.lane, a0, a1, f0, f1); const float amax = wave_max(fmaxf(a0, a1)), fl = __shfl(f1, 63);
            wv[F.lane] = __expf(a0 - amax); wv[64 + F.lane] = __expf(a1 - amax); if (F.lane == 0) { AUX[AX_CHK + 2 * item] = amax; AUX[AX_CHK + 2 * item + 1] = fl; } }
#pragma unroll
        for (int u = 0; u < 4; ++u) { const int p = F.tid + u * NTHR, r = p & 127, c8 = p >> 7; const v4u v = vv[u]; LAS bf16* d = Vt + (c8 * 8) * 136 + r;
            d[0 * 136] = (bf16)(v.x & 0xffffu); d[1 * 136] = (bf16)(v.x >> 16); d[2 * 136] = (bf16)(v.y & 0xffffu); d[3 * 136] = (bf16)(v.y >> 16);
            d[4 * 136] = (bf16)(v.z & 0xffffu); d[5 * 136] = (bf16)(v.z >> 16); d[6 * 136] = (bf16)(v.w & 0xffffu); d[7 * 136] = (bf16)(v.w >> 16); }
        __syncthreads();
        TS_MARK(F, 22);
#pragma unroll
        for (int u = 0; u < 2; ++u) { const int p = F.tid + u * NTHR, r = p & 127, c8 = p >> 7; float e[8]; unpack8(kv[u], e); const float w = wv[r]; LAS bf16* d = Kt + (c8 * 8) * 136 + r;
#pragma unroll
            for (int i = 0; i < 8; ++i) d[i * 136] = (bf16)f2bf(e[i] * w); }
        __syncthreads();
        TS_MARK(F, 23);
#pragma unroll
        for (int jj = 0; jj < 4; ++jj) { const int tile = F.wave * 4 + jj, dkt = tile & 3, dvt = tile >> 2;
            const f32x4 acc = mma_ll<4>(Kt + dkt * 16 * 136, 136, Vt + dvt * 16 * 136, 136, (f32x4){0.f, 0.f, 0.f, 0.f}, F.lane);
            *(f32x4*)(CLOC + ((size_t)item * 128 + dvt * 16 + (F.lane & 15)) * 64 + dkt * 16 + 4 * (F.lane >> 4)) = acc; }
        if (F.tid < 64) { float sm = 0.f; for (int ss = 0; ss < MLC; ss += 8) { float e[8]; unpack8(*(const LAS v4u*)(Kt + F.tid * 136 + ss), e);
#pragma unroll
                for (int i = 0; i < 8; ++i) sm += e[i]; }
            AUX[AX_NLOC + item * 64 + F.tid] = sm; }
        __syncthreads();
        TS_MARK(F, 24);
    }
}
__device__ __forceinline__ void mlstm_B(Frame& F, int j) {
    const float* __restrict__ CLOC = (const float*)(F.ws + SC_LOC); bf16* __restrict__ ST = (bf16*)(F.ws + SC_ST); float* AUX = (float*)(F.ws + SC_AUX);
    for (int slot = F.vcu * NTHR + F.tid; slot < BP * HA * 4096; slot += F.G * NTHR) {
        const int bh = slot >> 12, e = slot & 4095, dv = e >> 5, dk = (e & 31) * 2;
        float m = 0.f, c0 = 0.f, c1 = 0.f, nacc = 0.f;
        for (int cb = 0; cb < MNCH; cb += 8) {
            f32x2 cl[8]; float nl[8], am[8], fl[8];
#pragma unroll
            for (int u = 0; u < 8; ++u) { const int item = bh * MNCH + cb + u; cl[u] = *(const f32x2*)(CLOC + ((size_t)item * 128 + dv) * 64 + dk); am[u] = AUX[AX_CHK + 2 * item]; fl[u] = AUX[AX_CHK + 2 * item + 1];
                nl[u] = (e < 64) ? AUX[AX_NLOC + item * 64 + e] : 0.f; }
#pragma unroll
            for (int u = 0; u < 8; ++u) { const int item = bh * MNCH + cb + u;
                const float Mn = fmaxf(m, am[u]), g = __expf(m - Mn), ee = __expf(am[u] - Mn);
                bf16* sti = ST + (size_t)item * ST_ROWS * 64;
                *(unsigned*)(sti + dv * 64 + dk) = pk2(c0, c1);
                if (e < 64) sti[128 * 64 + e] = (bf16)f2bf(nacc);
                else if (e < 64 + 15 * 32) { const int z = e - 64; *(unsigned*)(sti + (129 + (z >> 5)) * 64 + (z & 31) * 2) = 0u; }
                if (e == 0) AUX[AX_MST + item] = m;
                c0 = g * c0 + ee * cl[u].x; c1 = g * c1 + ee * cl[u].y; nacc = g * nacc + ee * nl[u];
                m = fl[u] + Mn; } }
        const int b = bh >> 3, h = bh & 7;
        float* oc = F.out + O_PAC + (((size_t)(j * BP + b) * HA + h) * DKA) * DVA;
        oc[(size_t)dk * DVA + dv] = c0; oc[(size_t)(dk + 1) * DVA + dv] = c1;
        if (e < 64) F.out[O_PAN + ((size_t)(j * BP + b) * HA + h) * DKA + e] = nacc;
        if (e == 0) F.out[O_PAM + (size_t)(j * BP + b) * HA + h] = m;
    }
}
__device__ __forceinline__ void mlstm_C(Frame& F, int j, const float* anorm) {
    LAS bf16* Qs = (LAS bf16*)F.lds; LAS bf16* Ks = Qs + 128 * 72; LAS bf16* Vt = Ks + 128 * 72; LAS bf16* Ws = Vt + ST_ROWS * 136;
    LAS float* fa = (LAS float*)(Ws + 128 * 136); LAS float* fM = fa + 128; LAS float* fg = fM + 128; LAS float* fe = fg + 128;
    const bf16* PROJ = (const bf16*)(F.ws + WS_PROJ); const float* GT = (const float*)(F.ws + WS_GATES);
    const bf16* ST = (const bf16*)(F.ws + SC_ST); const float* AUX = (const float*)(F.ws + SC_AUX); bf16* H = (bf16*)(F.ws + WS_H);
    const int r16 = F.lane & 15, q = F.lane >> 4;
    for (int p = F.tid; p < 16 * 136; p += NTHR) Vt[128 * 136 + p] = (bf16)((p < 128) ? 0x3f80u : 0u);
    for (int item = F.vcu; item < MITEMS; item += F.G) {
        const int bh = item >> 5, c = item & 31, b = bh >> 3, h = bh & 7, row0 = b * TP + c * MLC;
        TS_MARK(F, 41);
        v4u vv[4], qv[2], kv[2];
#pragma unroll
        for (int u = 0; u < 4; ++u) { const int p = F.tid + u * NTHR, r = p & 127, c8 = p >> 7; vv[u] = *(const v4u*)(PROJ + (size_t)(row0 + r) * NPROJ + 1024 + h * 128 + c8 * 8); }
#pragma unroll
        for (int u = 0; u < 2; ++u) { const int p = F.tid + u * NTHR, r = p >> 3, c8 = p & 7; qv[u] = *(const v4u*)(PROJ + (size_t)(row0 + r) * NPROJ + h * 64 + c8 * 8); kv[u] = *(const v4u*)(PROJ + (size_t)(row0 + r) * NPROJ + 512 + h * 64 + c8 * 8); }
        if (F.wave == 0) { float a0, a1, f0, f1; ml_gates(GT, row0, h, F.lane, a0, a1, f0, f1); const float mc = AUX[AX_MST + item];
            const float cm0 = wave_scan_max(a0, F.lane), cm1 = fmaxf(__shfl(cm0, 63), wave_scan_max(a1, F.lane)); const float M0 = fmaxf(mc, cm0), M1 = fmaxf(mc, cm1);
            fa[F.lane] = a0; fa[64 + F.lane] = a1; fM[F.lane] = M0; fM[64 + F.lane] = M1; fg[F.lane] = __expf(mc - M0); fg[64 + F.lane] = __expf(mc - M1);
            fe[F.lane] = __expf(-(f0 + M0)); fe[64 + F.lane] = __expf(-(f1 + M1)); }
#pragma unroll
        for (int u = 0; u < 2; ++u) { const int p = F.tid + u * NTHR, r = p >> 3, c8 = p & 7; *(LAS v4u*)(Qs + r * 72 + c8 * 8) = qv[u]; *(LAS v4u*)(Ks + r * 72 + c8 * 8) = kv[u]; }
#pragma unroll
        for (int u = 0; u < 4; ++u) { const int p = F.tid + u * NTHR, r = p & 127, c8 = p >> 7; const v4u v = vv[u]; LAS bf16* d = Vt + (c8 * 8) * 136 + r;
            d[0 * 136] = (bf16)(v.x & 0xffffu); d[1 * 136] = (bf16)(v.x >> 16); d[2 * 136] = (bf16)(v.y & 0xffffu); d[3 * 136] = (bf16)(v.y >> 16);
            d[4 * 136] = (bf16)(v.z & 0xffffu); d[5 * 136] = (bf16)(v.z >> 16); d[6 * 136] = (bf16)(v.w & 0xffffu); d[7 * 136] = (bf16)(v.w >> 16); }
        __syncthreads();
        TS_MARK(F, 42);
#pragma unroll
        for (int tt = 0; tt < 8; ++tt) { const int st = (F.wave - tt) & 7; f32x4 acc = (f32x4){0.f, 0.f, 0.f, 0.f};
            if (st <= tt) acc = mma_ll<2>(Qs + tt * 16 * 72, 72, Ks + st * 16 * 72, 72, acc, F.lane);
            const int sx = st * 16 + r16; const float as = fa[sx];
#pragma unroll
            for (int r = 0; r < 4; ++r) { const int t = tt * 16 + 4 * q + r; const float w = (sx <= t) ? acc[r] * __expf(as - fM[t]) : 0.f; Ws[t * 136 + sx] = (bf16)f2bf(w); } }
        __syncthreads();
        TS_MARK(F, 43);
        const int tt = F.wave, t = tt * 16 + r16, nks = (tt + 2) >> 1;
        f32x4 ngv[8]; v2u ovv[8];
#pragma unroll
        for (int dvt = 0; dvt < 8; ++dvt) { const int col = h * 128 + dvt * 16 + 4 * q; ngv[dvt] = *(const f32x4*)(anorm + j * 1024 + col); ovv[dvt] = *(const v2u*)(PROJ + (size_t)(row0 + t) * NPROJ + 2048 + col); }
        f32x4 a1[9], a2[9];
#pragma unroll
        for (int dvt = 0; dvt < 9; ++dvt) {
            a2[dvt] = mma_gl<2>(ST + ((size_t)item * ST_ROWS + dvt * 16) * 64, 64, Qs + tt * 16 * 72, 72, (f32x4){0.f, 0.f, 0.f, 0.f}, F.lane);
            f32x4 acc = (f32x4){0.f, 0.f, 0.f, 0.f};
            for (int ks = 0; ks < nks; ++ks) { const bf16x8 av = *(const LAS bf16x8*)(Vt + (dvt * 16 + r16) * 136 + ks * 32 + q * 8); const bf16x8 bw = *(const LAS bf16x8*)(Ws + (tt * 16 + r16) * 136 + ks * 32 + q * 8);
                acc = __builtin_amdgcn_mfma_f32_16x16x32_bf16(av, bw, acc, 0, 0, 0); }
            a1[dvt] = acc; }
        TS_MARK(F, 44);
        const float gt = fg[t]; const float den = __shfl(a1[8][0], r16) + gt * __shfl(a2[8][0], r16); const float rd = 1.0f / fmaxf(fabsf(den), fe[t]);
        float sq = 0.f;
#pragma unroll
        for (int dvt = 0; dvt < 8; ++dvt)
#pragma unroll
            for (int r = 0; r < 4; ++r) { const float hv = (a1[dvt][r] + gt * a2[dvt][r]) * rd; a1[dvt][r] = hv; sq += hv * hv; }
        sq += __shfl_xor(sq, 16); sq += __shfl_xor(sq, 32);
        const float rs = 1.0f / sqrtf(sq * (1.0f / DVA) + EPS);
#pragma unroll
        for (int dvt = 0; dvt < 8; ++dvt) { const int col = h * 128 + dvt * 16 + 4 * q;
            const f32x4 ng = ngv[dvt]; const v2u ov = ovv[dvt];
            const float o0 = a1[dvt][0] * rs * ng.x * sigmoidf_(bflo(ov.x)), o1 = a1[dvt][1] * rs * ng.y * sigmoidf_(bfhi(ov.x)), o2 = a1[dvt][2] * rs * ng.z * sigmoidf_(bflo(ov.y)), o3 = a1[dvt][3] * rs * ng.w * sigmoidf_(bfhi(ov.y));
            v2u w; w.x = pk2(o0, o1); w.y = pk2(o2, o3); *(v2u*)(H + (size_t)(row0 + t) * D + col) = w; }
        __syncthreads();
        TS_MARK(F, 45);
    }
}
struct MlsPre { float m0, gi[4], gf[4], qk, v, cvv[16], o, an, n0v; };
#define MLS_LOAD(P, it_) do { const int b_ = (it_) >> 3, h_ = (it_) & 7, row_ = MP + b_ * TS; \
    (P).m0 = st_m[(size_t)(j * BS + b_) * HA + h_]; \
    _Pragma("unroll") for (int t_ = 0; t_ < 4; ++t_) { (P).gi[t_] = GT[(size_t)(row_ + t_) * 16 + h_]; (P).gf[t_] = GT[(size_t)(row_ + t_) * 16 + 8 + h_]; } \
    { const int t_ = (F.tid >> 6) & 3, d_ = F.tid & 63; (P).qk = bf2f(PROJ[(size_t)(row_ + t_) * NPROJ + ((F.tid < 256) ? 0 : 512) + h_ * 64 + d_]); } \
    { const int t2_ = F.tid >> 7, dv_ = F.tid & 127; (P).v = bf2f(PROJ[(size_t)(row_ + t2_) * NPROJ + 1024 + h_ * 128 + dv_]); (P).o = bf2f(PROJ[(size_t)(row_ + t2_) * NPROJ + 2048 + h_ * 128 + dv_]); (P).an = anorm[j * 1024 + h_ * 128 + dv_]; \
      const float* c0p_ = st_c + (((size_t)(j * BS + b_) * HA + h_) * DKA) * DVA; \
      _Pragma("unroll") for (int i_ = 0; i_ < 16; ++i_) (P).cvv[i_] = c0p_[(size_t)(t2_ * 16 + i_) * DVA + dv_]; } \
    (P).n0v = st_n[((size_t)(j * BS + b_) * HA + h_) * DKA + (F.tid & 63)]; } while (0)
__device__ __forceinline__ void mlstm_S(Frame& F, int j, const float* __restrict__ anorm, const float* __restrict__ st_c, const float* __restrict__ st_n, const float* __restrict__ st_m) {
    LAS float* qs = (LAS float*)F.lds; LAS float* ks = qs + 256; LAS float* vs = ks + 256; LAS float* qkw = vs + 512; LAS float* qn = qkw + 16; LAS float* part = qn + 16; LAS float* red = part + 2048; LAS float* ns = red + 16;
    const bf16* __restrict__ PROJ = (const bf16*)(F.ws + WS_PROJ); const float* __restrict__ GT = (const float*)(F.ws + WS_GATES); bf16* H = (bf16*)(F.ws + WS_H);
    MlsPre nx;
    if (F.vcu < BS * HA) MLS_LOAD(nx, F.vcu);
    for (int item = F.vcu; item < BS * HA; item += F.G) {
        const int b = item >> 3, h = item & 7, row0 = MP + b * TS;
        TS_MARK(F, 51);
        const MlsPre P = nx;
        if (item + F.G < BS * HA) MLS_LOAD(nx, item + F.G);
        float a[4], fc[4], Ml[4], g[4], mt[4]; const float m0 = P.m0;
        { float run = 0.f, cm = -3.0e38f;
#pragma unroll
            for (int t = 0; t < 4; ++t) { run += P.gf[t]; fc[t] = run; a[t] = P.gi[t] - run; cm = fmaxf(cm, a[t]); Ml[t] = fmaxf(m0, cm); g[t] = __expf(m0 - Ml[t]); mt[t] = run + Ml[t]; } }
        { const int t = (F.tid >> 6) & 3, d = F.tid & 63; if (F.tid < 256) qs[t * 64 + d] = P.qk; else ks[t * 64 + d] = P.qk;
            vs[F.tid] = P.v; if (F.tid < 64) ns[F.tid] = P.n0v; }
        __syncthreads();
        TS_MARK(F, 52);
        if (F.tid < 512) { const int pr = F.tid >> 4, l16 = F.tid & 15;
            const int t = (pr < 16) ? (pr >> 2) : (pr & 3), s = pr & 3; float dt = 0.f;
            if (pr < 20) { const LAS float* y = (pr < 16) ? ks + s * 64 : ns;
#pragma unroll
                for (int i = 0; i < 4; ++i) dt += qs[t * 64 + l16 * 4 + i] * y[l16 * 4 + i]; }
            dt += __shfl_xor(dt, 8); dt += __shfl_xor(dt, 4); dt += __shfl_xor(dt, 2); dt += __shfl_xor(dt, 1);
            if (l16 == 0 && pr < 16) { float as = a[0], Mt = Ml[0];
                as = (s == 1) ? a[1] : as; as = (s == 2) ? a[2] : as; as = (s == 3) ? a[3] : as; Mt = (t == 1) ? Ml[1] : Mt; Mt = (t == 2) ? Ml[2] : Mt; Mt = (t == 3) ? Ml[3] : Mt;
                qkw[pr] = (s <= t) ? dt * __expf(as - Mt) : 0.f; }
            else if (l16 == 0 && pr < 20) qn[pr - 16] = dt; }
        { const int dv = F.tid & 127, dkq = F.tid >> 7; float* cout = F.out + O_SAC + (((size_t)(j * BS + b) * HA + h) * DKA) * DVA;
            float p0 = 0.f, p1 = 0.f, p2 = 0.f, p3 = 0.f; const float gl = g[3];
            float wl[4];
#pragma unroll
            for (int s = 0; s < 4; ++s) wl[s] = __expf(a[s] - Ml[3]) * vs[s * 128 + dv];
#pragma unroll
            for (int i4 = 0; i4 < 4; ++i4) { const int dk0 = dkq * 16 + i4 * 4;
                const f32x4 q0 = *(const LAS f32x4*)(qs + dk0), q1 = *(const LAS f32x4*)(qs + 64 + dk0), q2 = *(const LAS f32x4*)(qs + 128 + dk0), q3 = *(const LAS f32x4*)(qs + 192 + dk0);
                const f32x4 k0 = *(const LAS f32x4*)(ks + dk0), k1 = *(const LAS f32x4*)(ks + 64 + dk0), k2 = *(const LAS f32x4*)(ks + 128 + dk0), k3 = *(const LAS f32x4*)(ks + 192 + dk0);
#pragma unroll
                for (int e = 0; e < 4; ++e) { const float cv = P.cvv[i4 * 4 + e];
                    p0 += q0[e] * cv; p1 += q1[e] * cv; p2 += q2[e] * cv; p3 += q3[e] * cv;
                    cout[(size_t)(dk0 + e) * DVA + dv] = gl * cv + (wl[0] * k0[e] + wl[1] * k1[e]) + (wl[2] * k2[e] + wl[3] * k3[e]); } }
            part[(dkq * 4 + 0) * 128 + dv] = p0; part[(dkq * 4 + 1) * 128 + dv] = p1; part[(dkq * 4 + 2) * 128 + dv] = p2; part[(dkq * 4 + 3) * 128 + dv] = p3; }
        __syncthreads();
        TS_MARK(F, 53);
        float hv;
        { const int t = F.tid >> 7, dv = F.tid & 127; float gt = g[0], emt = mt[0];
            gt = (t == 1) ? g[1] : gt; gt = (t == 2) ? g[2] : gt; gt = (t == 3) ? g[3] : gt; emt = (t == 1) ? mt[1] : emt; emt = (t == 2) ? mt[2] : emt; emt = (t == 3) ? mt[3] : emt;
            float num = 0.f, den = 0.f;
#pragma unroll
            for (int s = 0; s < 4; ++s) { const float w = qkw[t * 4 + s]; num += w * vs[s * 128 + dv]; den += w; }
            num += gt * ((part[(0 * 4 + t) * 128 + dv] + part[(1 * 4 + t) * 128 + dv]) + (part[(2 * 4 + t) * 128 + dv] + part[(3 * 4 + t) * 128 + dv]));
            den += gt * qn[t];
            hv = num / fmaxf(fabsf(den), __expf(-emt));
            const float sq = wave_sum(hv * hv); if (F.lane == 0) red[F.wave] = sq; }
        __syncthreads();
        TS_MARK(F, 54);
        { const int t = F.tid >> 7, dv = F.tid & 127, col = h * 128 + dv; const float rs = 1.0f / sqrtf((red[2 * t] + red[2 * t + 1]) * (1.0f / DVA) + EPS);
            H[(size_t)(row0 + t) * D + col] = (bf16)f2bf(hv * rs * P.an * sigmoidf_(P.o)); }
        if (F.tid < 64) { const int d = F.tid; float nn = g[3] * ns[d];
#pragma unroll
            for (int s = 0; s < 4; ++s) nn += __expf(a[s] - Ml[3]) * ks[s * 64 + d];
            F.out[O_SAN + ((size_t)(j * BS + b) * HA + h) * DKA + d] = nn; }
        if (F.tid == 0) F.out[O_SAM + (size_t)(j * BS + b) * HA + h] = mt[3];
        __syncthreads();
        TS_MARK(F, 55);
    }
}
__device__ __forceinline__ void gla_bc(Frame& F, const f32x4 zv, const float (&wg)[16], float bgv, LAS float* zs, LAS float* gsum, LAS float* bc) {
    if (F.tid < 256) ((LAS f32x4*)zs)[F.tid] = zv;
    const int d = F.tid & 127, tq = F.tid >> 7;
    __syncthreads();
    float pr[16]; float run = 0.f;
#pragma unroll
    for (int i = 0; i < 16; ++i) { const LAS float* z = zs + (tq * 16 + i) * 16; float x = bgv;
#pragma unroll
        for (int r = 0; r < 16; ++r) x += z[r] * wg[r];
        run += logsigmoidf(x) * (1.0f / 16.0f); pr[i] = run; }
    gsum[tq * 128 + d] = run;
    __syncthreads();
    float off = 0.f;
    if (tq > 0) off += gsum[d];
    if (tq > 1) off += gsum[128 + d];
    if (tq > 2) off += gsum[256 + d];
#pragma unroll
    for (int i = 0; i < 16; ++i) bc[(tq * 16 + i) * 128 + d] = pr[i] + off;
    __syncthreads();
}
#define GLA_WG(h_) do { if ((h_) != hcur) { hcur = (h_); const int col_ = (h_) * 128 + (F.tid & 127); _Pragma("unroll") for (int r_ = 0; r_ < 16; ++r_) wg[r_] = WG[r_ * 512 + col_]; bgv = BG[col_]; } } while (0)
__device__ __forceinline__ void gla_A(Frame& F, const float* __restrict__ WG, const float* __restrict__ BG) {
    LAS float* zs = (LAS float*)F.lds; LAS float* gsum = zs + 1024; LAS float* bc = gsum + 512; LAS bf16* Kt = (LAS bf16*)(bc + 8192); LAS bf16* Vt = Kt + 128 * 72;
    const bf16* __restrict__ PROJ = (const bf16*)(F.ws + WS_PROJ); const float* __restrict__ GT = (const float*)(F.ws + WS_GATES); float* SLOC = (float*)(F.ws + SC_LOC); float* AUX = (float*)(F.ws + SC_AUX);
    float wg[16], bgv = 0.f; int hcur = -1;
    for (int item = F.vcu; item < BP * HB * NCH; item += F.G) {
        const int bh = item >> 6, c = item & 63, b = bh >> 2, h = bh & 3, row0 = b * TP + c * LCH;
        f32x4 zv = (f32x4){0.f, 0.f, 0.f, 0.f}; if (F.tid < 256) zv = ((const f32x4*)(GT + (size_t)row0 * 16))[F.tid];
        v4u kv[2], vv[4];
#pragma unroll
        for (int u = 0; u < 2; ++u) { const int p = F.tid + u * NTHR, r = p & 63, c8 = p >> 6; kv[u] = *(const v4u*)(PROJ + (size_t)(row0 + r) * NPROJ + 512 + h * 128 + c8 * 8); }
#pragma unroll
        for (int u = 0; u < 4; ++u) { const int p = F.tid + u * NTHR, r = p & 63, c8 = p >> 6; vv[u] = *(const v4u*)(PROJ + (size_t)(row0 + r) * NPROJ + 1024 + h * 256 + c8 * 8); }
        GLA_WG(h);
        gla_bc(F, zv, wg, bgv, zs, gsum, bc);
        if (F.tid < 128) AUX[AX_BL + item * 128 + F.tid] = bc[63 * 128 + F.tid];
#pragma unroll
        for (int u = 0; u < 2; ++u) { const int p = F.tid + u * NTHR, r = p & 63, c8 = p >> 6; float e[8]; unpack8(kv[u], e);
            LAS bf16* dd = Kt + (c8 * 8) * 72 + r;
#pragma unroll
            for (int i = 0; i < 8; ++i) { const int dk = c8 * 8 + i; dd[i * 72] = (bf16)f2bf(e[i] * __expf(bc[63 * 128 + dk] - bc[r * 128 + dk])); } }
#pragma unroll
        for (int u = 0; u < 4; ++u) { const int p = F.tid + u * NTHR, r = p & 63, c8 = p >> 6; const v4u v = vv[u]; LAS bf16* d = Vt + (c8 * 8) * 72 + r;
            d[0 * 72] = (bf16)(v.x & 0xffffu); d[1 * 72] = (bf16)(v.x >> 16); d[2 * 72] = (bf16)(v.y & 0xffffu); d[3 * 72] = (bf16)(v.y >> 16);
            d[4 * 72] = (bf16)(v.z & 0xffffu); d[5 * 72] = (bf16)(v.z >> 16); d[6 * 72] = (bf16)(v.w & 0xffffu); d[7 * 72] = (bf16)(v.w >> 16); }
        __syncthreads();
        for (int jj = 0; jj < 16; ++jj) { const int tile = F.wave * 16 + jj, dkt = tile & 7, dvt = tile >> 3;
            const f32x4 acc = mma_ll<2>(Kt + dkt * 16 * 72, 72, Vt + dvt * 16 * 72, 72, (f32x4){0.f, 0.f, 0.f, 0.f}, F.lane);
            *(f32x4*)(SLOC + ((size_t)item * 256 + dvt * 16 + (F.lane & 15)) * 128 + dkt * 16 + 4 * (F.lane >> 4)) = acc; }
        __syncthreads();
    }
}
__device__ __forceinline__ void gla_B(Frame& F) {
    const float* __restrict__ SLOC = (const float*)(F.ws + SC_LOC); bf16* __restrict__ ST = (bf16*)(F.ws + SC_ST); const float* __restrict__ AUX = (const float*)(F.ws + SC_AUX);
    for (int slot = F.vcu * NTHR + F.tid; slot < BP * HB * 8192; slot += F.G * NTHR) {
        const int bh = slot >> 13, e = slot & 8191, dv = e >> 5, dk0 = (e & 31) * 4;
        f32x4 S = (f32x4){0.f, 0.f, 0.f, 0.f};
        for (int cb = 0; cb < NCH; cb += 8) {
            f32x4 bl[8], sl[8];
#pragma unroll
            for (int u = 0; u < 8; ++u) { const int item = bh * 64 + cb + u; bl[u] = *(const f32x4*)(AUX + AX_BL + item * 128 + dk0); sl[u] = *(const f32x4*)(SLOC + ((size_t)item * 256 + dv) * 128 + dk0); }
#pragma unroll
            for (int u = 0; u < 8; ++u) { const int item = bh * 64 + cb + u;
                v2u w; w.x = pk2(S.x, S.y); w.y = pk2(S.z, S.w); *(v2u*)(ST + ((size_t)item * 256 + dv) * 128 + dk0) = w;
                S.x = __expf(bl[u].x) * S.x + sl[u].x; S.y = __expf(bl[u].y) * S.y + sl[u].y; S.z = __expf(bl[u].z) * S.z + sl[u].z; S.w = __expf(bl[u].w) * S.w + sl[u].w; } }
        float* o = F.out + O_PG + ((size_t)bh * DKB + dk0) * DVB + dv;
        o[0] = S.x; o[DVB] = S.y; o[2 * DVB] = S.z; o[3 * DVB] = S.w;
    }
}
__device__ __forceinline__ void gla_C(Frame& F, const float* __restrict__ WG, const float* __restrict__ BG, const float* __restrict__ bnorm) {
    LAS float* zs = (LAS float*)F.lds; LAS float* gsum = zs + 1024; LAS float* bc = gsum + 512; LAS bf16* Qs = (LAS bf16*)(bc + 8192); LAS bf16* Ks = Qs + 64 * 136; LAS bf16* Vt = Ks + 64 * 136;
    LAS bf16* At = Vt + 256 * 72; LAS float* ssq = (LAS float*)(At + 64 * 72);
    const bf16* __restrict__ PROJ = (const bf16*)(F.ws + WS_PROJ); const float* __restrict__ GT = (const float*)(F.ws + WS_GATES); const bf16* __restrict__ ST = (const bf16*)(F.ws + SC_ST); bf16* H = (bf16*)(F.ws + WS_H);
    const int r16 = F.lane & 15, q = F.lane >> 4;
    for (int item = F.vcu; item < BP * HB * NCH; item += F.G) {
        const int bh = item >> 6, c = item & 63, b = bh >> 2, h = bh & 3, row0 = b * TP + c * LCH;
        TS_MARK(F, 61);
        float wg[16], bgv = 0.f; int hcur = -1;
        f32x4 zv = (f32x4){0.f, 0.f, 0.f, 0.f}; if (F.tid < 256) zv = ((const f32x4*)(GT + (size_t)row0 * 16))[F.tid];
        v4u qv[2], kv[2], vv[4];
#pragma unroll
        for (int u = 0; u < 2; ++u) { const int p = F.tid + u * NTHR, r = p >> 4, c8 = p & 15; qv[u] = *(const v4u*)(PROJ + (size_t)(row0 + r) * NPROJ + h * 128 + c8 * 8); kv[u] = *(const v4u*)(PROJ + (size_t)(row0 + r) * NPROJ + 512 + h * 128 + c8 * 8); }
        GLA_WG(h);
        gla_bc(F, zv, wg, bgv, zs, gsum, bc);
        TS_MARK(F, 62);
#pragma unroll
        for (int u = 0; u < 4; ++u) { const int p = F.tid + u * NTHR, r = p & 63, c8 = p >> 6; vv[u] = *(const v4u*)(PROJ + (size_t)(row0 + r) * NPROJ + 1024 + h * 256 + c8 * 8); }
#pragma unroll
        for (int u = 0; u < 2; ++u) { const int p = F.tid + u * NTHR, r = p >> 4, c8 = p & 15; float e[8], f[8]; unpack8(qv[u], e); unpack8(kv[u], f);
#pragma unroll
            for (int i = 0; i < 8; ++i) { const float bb = bc[r * 128 + c8 * 8 + i]; e[i] *= __expf(bb); f[i] *= __expf(-bb); }
            v4u w; w.x = pk2(e[0], e[1]); w.y = pk2(e[2], e[3]); w.z = pk2(e[4], e[5]); w.w = pk2(e[6], e[7]); *(LAS v4u*)(Qs + r * 136 + c8 * 8) = w;
            w.x = pk2(f[0], f[1]); w.y = pk2(f[2], f[3]); w.z = pk2(f[4], f[5]); w.w = pk2(f[6], f[7]); *(LAS v4u*)(Ks + r * 136 + c8 * 8) = w; }
#pragma unroll
        for (int u = 0; u < 4; ++u) { const int p = F.tid + u * NTHR, r = p & 63, c8 = p >> 6; const v4u v = vv[u]; LAS bf16* d = Vt + (c8 * 8) * 72 + r;
            d[0 * 72] = (bf16)(v.x & 0xffffu); d[1 * 72] = (bf16)(v.x >> 16); d[2 * 72] = (bf16)(v.y & 0xffffu); d[3 * 72] = (bf16)(v.y >> 16);
            d[4 * 72] = (bf16)(v.z & 0xffffu); d[5 * 72] = (bf16)(v.z >> 16); d[6 * 72] = (bf16)(v.w & 0xffffu); d[7 * 72] = (bf16)(v.w >> 16); }
        f32x4 ngv[2]; v2u rvv[2][4];
#pragma unroll
        for (int dl = 0; dl < 2; ++dl) { const int dvt = F.wave * 2 + dl, col = h * 256 + dvt * 16 + 4 * q; ngv[dl] = *(const f32x4*)(bnorm + col);
#pragma unroll
            for (int tt = 0; tt < 4; ++tt) rvv[dl][tt] = *(const v2u*)(PROJ + (size_t)(row0 + tt * 16 + r16) * NPROJ + 2048 + col); }
        __syncthreads();
        TS_MARK(F, 63);
        bf16x8 sa[2][4];
#pragma unroll
        for (int dl = 0; dl < 2; ++dl)
#pragma unroll
            for (int ks = 0; ks < 4; ++ks) sa[dl][ks] = *(const bf16x8*)(ST + ((size_t)item * 256 + (F.wave * 2 + dl) * 16 + r16) * 128 + ks * 32 + q * 8);
#pragma unroll
        for (int jj = 0; jj < 2; ++jj) { const int tile = F.wave * 2 + jj, tt = tile >> 2, st = tile & 3; f32x4 acc = (f32x4){0.f, 0.f, 0.f, 0.f};
            if (st <= tt) acc = mma_ll<4>(Qs + tt * 16 * 136, 136, Ks + st * 16 * 136, 136, acc, F.lane);
            const int sx = st * 16 + r16;
#pragma unroll
            for (int r = 0; r < 4; ++r) { const int t = tt * 16 + 4 * q + r; At[t * 72 + sx] = (bf16)f2bf((sx <= t) ? acc[r] : 0.f); } }
        __syncthreads();
        TS_MARK(F, 64);
        f32x4 o[2][4];
#pragma unroll
        for (int dl = 0; dl < 2; ++dl) { const int dvt = F.wave * 2 + dl;
#pragma unroll
            for (int tt = 0; tt < 4; ++tt) { f32x4 acc = mma_ll<2>(Vt + dvt * 16 * 72, 72, At + tt * 16 * 72, 72, (f32x4){0.f, 0.f, 0.f, 0.f}, F.lane);
#pragma unroll
                for (int ks = 0; ks < 4; ++ks) { const bf16x8 bq = *(const LAS bf16x8*)(Qs + (tt * 16 + r16) * 136 + ks * 32 + q * 8); acc = __builtin_amdgcn_mfma_f32_16x16x32_bf16(sa[dl][ks], bq, acc, 0, 0, 0); }
                o[dl][tt] = acc; } }
#pragma unroll
        for (int tt = 0; tt < 4; ++tt) { float sq = 0.f;
#pragma unroll
            for (int dl = 0; dl < 2; ++dl)
#pragma unroll
                for (int r = 0; r < 4; ++r) sq += o[dl][tt][r] * o[dl][tt][r];
            sq += __shfl_xor(sq, 16); sq += __shfl_xor(sq, 32);
            if (F.lane < 16) ssq[F.wave * 64 + tt * 16 + r16] = sq; }
        TS_MARK(F, 65);
        __syncthreads();
        TS_MARK(F, 66);
#pragma unroll
        for (int tt = 0; tt < 4; ++tt) { const int t = tt * 16 + r16; float tot = 0.f;
#pragma unroll
            for (int w = 0; w < 8; ++w) tot += ssq[w * 64 + t];
            const float rs = 1.0f / sqrtf(tot * (1.0f / DVB) + EPS);
#pragma unroll
            for (int dl = 0; dl < 2; ++dl) { const int col = h * 256 + (F.wave * 2 + dl) * 16 + 4 * q;
                const f32x4 ng = ngv[dl]; const v2u rv = rvv[dl][tt];
                const float r0 = bflo(rv.x), r1 = bfhi(rv.x), r2 = bflo(rv.y), r3 = bfhi(rv.y);
                const float o0 = o[dl][tt][0] * rs * ng.x * r0 * sigmoidf_(r0), o1 = o[dl][tt][1] * rs * ng.y * r1 * sigmoidf_(r1), o2 = o[dl][tt][2] * rs * ng.z * r2 * sigmoidf_(r2), o3 = o[dl][tt][3] * rs * ng.w * r3 * sigmoidf_(r3);
                v2u w; w.x = pk2(o0, o1); w.y = pk2(o2, o3); *(v2u*)(H + (size_t)(row0 + t) * D + col) = w; } }
        __syncthreads();
    }
}
__device__ __forceinline__ void gla_S(Frame& F, const float* WG, const float* BG, const float* bnorm, const float* st_s) {
    LAS float* bcs = (LAS float*)F.lds;
    LAS float* qs = bcs + 512;
    LAS float* kr = qs + 512;
    LAS float* kh = kr + 512;
    LAS float* vs = kh + 512;
    LAS float* att = vs + 1024;
    LAS float* part = att + 16;
    LAS float* red = part + 2048;
    const bf16* PROJ = (const bf16*)(F.ws + WS_PROJ); const float* GT = (const float*)(F.ws + WS_GATES); bf16* H = (bf16*)(F.ws + WS_H);
    for (int item = F.vcu; item < BS * HB; item += F.G) {
        const int b = item >> 2, h = item & 3, row0 = MP + b * TS;
        { const int t = F.tid >> 7, d = F.tid & 127, col = h * 128 + d; float x = BG[col];
#pragma unroll
            for (int r = 0; r < 16; ++r) x += GT[(size_t)(row0 + t) * 16 + r] * WG[r * 512 + col];
            bcs[t * 128 + d] = logsigmoidf(x) * (1.0f / 16.0f);
            kr[t * 128 + d] = bf2f(PROJ[(size_t)(row0 + t) * NPROJ + 512 + col]);
            vs[t * 256 + d] = bf2f(PROJ[(size_t)(row0 + t) * NPROJ + 1024 + h * 256 + d]); vs[t * 256 + 128 + d] = bf2f(PROJ[(size_t)(row0 + t) * NPROJ + 1024 + h * 256 + 128 + d]); }
        __syncthreads();
        if (F.tid < 128) { const int d = F.tid; float run = 0.f;
#pragma unroll
            for (int t = 0; t < 4; ++t) { run += bcs[t * 128 + d]; bcs[t * 128 + d] = run; } }
        __syncthreads();
        { const int t = F.tid >> 7, d = F.tid & 127, col = h * 128 + d; const float bb = bcs[t * 128 + d], bl = bcs[3 * 128 + d];
            qs[t * 128 + d] = bf2f(PROJ[(size_t)(row0 + t) * NPROJ + col]) * __expf(bb); kh[t * 128 + d] = kr[t * 128 + d] * __expf(bl - bb); }
        __syncthreads();
        { const int pr = F.tid >> 5, l32 = F.tid & 31, t = pr >> 2, s = pr & 3; float dt = 0.f;
            if (s <= t) {
#pragma unroll
                for (int i = 0; i < 4; ++i) { const int d = l32 * 4 + i; dt += qs[t * 128 + d] * kr[s * 128 + d] * __expf(-bcs[s * 128 + d]); } }
            dt += __shfl_xor(dt, 16); dt += __shfl_xor(dt, 8); dt += __shfl_xor(dt, 4); dt += __shfl_xor(dt, 2); dt += __shfl_xor(dt, 1);
            if (l32 == 0) att[pr] = dt; }
        { const int dv = F.tid & 255, dkh = F.tid >> 8; const float* s0 = st_s + (((size_t)b * HB + h) * DKB) * DVB; float* so = F.out + O_SG + (((size_t)b * HB + h) * DKB) * DVB;
            float p0 = 0.f, p1 = 0.f, p2 = 0.f, p3 = 0.f; const float v0 = vs[dv], v1 = vs[256 + dv], v2 = vs[512 + dv], v3 = vs[768 + dv];
            for (int d0 = dkh * 64; d0 < dkh * 64 + 64; d0 += 16) {
                float svv[16];
#pragma unroll
                for (int i = 0; i < 16; ++i) svv[i] = s0[(size_t)(d0 + i) * DVB + dv];
#pragma unroll
                for (int i4 = 0; i4 < 4; ++i4) { const int dk0 = d0 + i4 * 4;
                    const f32x4 q0 = *(const LAS f32x4*)(qs + dk0), q1 = *(const LAS f32x4*)(qs + 128 + dk0), q2 = *(const LAS f32x4*)(qs + 256 + dk0), q3 = *(const LAS f32x4*)(qs + 384 + dk0);
                    const f32x4 k0 = *(const LAS f32x4*)(kh + dk0), k1 = *(const LAS f32x4*)(kh + 128 + dk0), k2 = *(const LAS f32x4*)(kh + 256 + dk0), k3 = *(const LAS f32x4*)(kh + 384 + dk0);
                    const f32x4 bl = *(const LAS f32x4*)(bcs + 3 * 128 + dk0);
#pragma unroll
                    for (int e = 0; e < 4; ++e) { const float sv = svv[i4 * 4 + e];
                        p0 += q0[e] * sv; p1 += q1[e] * sv; p2 += q2[e] * sv; p3 += q3[e] * sv;
                        so[(size_t)(dk0 + e) * DVB + dv] = __expf(bl[e]) * sv + (k0[e] * v0 + k1[e] * v1) + (k2[e] * v2 + k3[e] * v3); } } }
            part[(dkh * 4 + 0) * 256 + dv] = p0; part[(dkh * 4 + 1) * 256 + dv] = p1; part[(dkh * 4 + 2) * 256 + dv] = p2; part[(dkh * 4 + 3) * 256 + dv] = p3; }
        __syncthreads();
        float ov[2];
        { const int dv = F.tid & 255, th = F.tid >> 8;
#pragma unroll
            for (int u = 0; u < 2; ++u) { const int t = th + 2 * u; float o = part[t * 256 + dv] + part[(4 + t) * 256 + dv];
#pragma unroll
                for (int s = 0; s < 4; ++s) o += att[t * 4 + s] * vs[s * 256 + dv];
                ov[u] = o; const float sq = wave_sum(o * o); if (F.lane == 0) red[F.wave * 2 + u] = sq; } }
        __syncthreads();
        { const int dv = F.tid & 255, th = F.tid >> 8, col = h * 256 + dv;
#pragma unroll
            for (int u = 0; u < 2; ++u) { const int t = th + 2 * u; const int w0 = th * 4; const float tot = (red[(w0 + 0) * 2 + u] + red[(w0 + 1) * 2 + u]) + (red[(w0 + 2) * 2 + u] + red[(w0 + 3) * 2 + u]);
                const float rs = 1.0f / sqrtf(tot * (1.0f / DVB) + EPS); const float r = bf2f(PROJ[(size_t)(row0 + t) * NPROJ + 2048 + col]);
                H[(size_t)(row0 + t) * D + col] = (bf16)f2bf(ov[u] * rs * bnorm[col] * r * sigmoidf_(r)); } }
        __syncthreads();
    }
}

__device__ __forceinline__ void swa_tile(const LAS bf16* Kw, const LAS bf16* Vt, int ldv, LAS bf16* Pw, int kt0, int jmin, const bf16* qp_r16, bf16* op_r16, const int (&relb)[4], const float (&snk)[4], int lane) {
    const int r16 = lane & 15, q = lane >> 4;
    const bf16x8 qa0 = *(const bf16x8*)(qp_r16 + q * 8), qa1 = *(const bf16x8*)(qp_r16 + 32 + q * 8);
    f32x4 s[9];
#pragma unroll
    for (int kt = 0; kt < 9; ++kt) { const LAS bf16* kp = Kw + ((kt0 + kt) * 16 + r16) * 72 + q * 8;
        f32x4 acc = __builtin_amdgcn_mfma_f32_16x16x32_bf16(qa0, *(const LAS bf16x8*)kp, (f32x4){0.f, 0.f, 0.f, 0.f}, 0, 0, 0);
        s[kt] = __builtin_amdgcn_mfma_f32_16x16x32_bf16(qa1, *(const LAS bf16x8*)(kp + 32), acc, 0, 0, 0); }
    float mx[4] = {-3.0e38f, -3.0e38f, -3.0e38f, -3.0e38f};
#pragma unroll
    for (int kt = 0; kt < 9; ++kt) { const int j = (kt0 + kt) * 16 + r16;
#pragma unroll
        for (int r = 0; r < 4; ++r) { const int rel = relb[r] - j; const bool ok = (rel >= 0) && (rel <= WIN) && (j >= jmin); const float v = ok ? s[kt][r] * 0.125f : -3.0e38f; s[kt][r] = v; mx[r] = fmaxf(mx[r], v); } }
    float sm[4];
#pragma unroll
    for (int r = 0; r < 4; ++r) { float m = mx[r]; m = fmaxf(m, __shfl_xor(m, 1)); m = fmaxf(m, __shfl_xor(m, 2)); m = fmaxf(m, __shfl_xor(m, 4)); m = fmaxf(m, __shfl_xor(m, 8)); mx[r] = fmaxf(m, snk[r]); sm[r] = 0.f; }
#pragma unroll
    for (int kt = 0; kt < 9; ++kt)
#pragma unroll
        for (int r = 0; r < 4; ++r) { const float p = (s[kt][r] > -1.0e38f) ? __expf(s[kt][r] - mx[r]) : 0.f; s[kt][r] = p; sm[r] += p; }
#pragma unroll
    for (int r = 0; r < 4; ++r) { float t = sm[r]; t += __shfl_xor(t, 1); t += __shfl_xor(t, 2); t += __shfl_xor(t, 4); t += __shfl_xor(t, 8); sm[r] = 1.0f / (t + __expf(snk[r] - mx[r])); }
#pragma unroll
    for (int kt = 0; kt < 9; ++kt)
#pragma unroll
        for (int r = 0; r < 4; ++r) Pw[(4 * q + r) * 168 + kt * 16 + r16] = (bf16)f2bf(s[kt][r] * sm[r]);
#pragma unroll
    for (int r = 0; r < 4; ++r) Pw[(4 * q + r) * 168 + 144 + r16] = (bf16)0;
    LDS_WAIT();
#pragma unroll
    for (int dt = 0; dt < 4; ++dt) { f32x4 acc = (f32x4){0.f, 0.f, 0.f, 0.f};
#pragma unroll
        for (int ks = 0; ks < 5; ++ks) { const bf16x8 va = *(const LAS bf16x8*)(Vt + (dt * 16 + r16) * ldv + kt0 * 16 + ks * 32 + q * 8); const bf16x8 pb = *(const LAS bf16x8*)(Pw + r16 * 168 + ks * 32 + q * 8);
            acc = __builtin_amdgcn_mfma_f32_16x16x32_bf16(va, pb, acc, 0, 0, 0); }
        v2u w; w.x = pk2(acc[0], acc[1]); w.y = pk2(acc[2], acc[3]); *(v2u*)(op_r16 + dt * 16 + 4 * q) = w; }
    LDS_WAIT();
}
__device__ __forceinline__ void swa_prompt(Frame& F, const float* sinks) {
    LAS bf16* Kw = (LAS bf16*)F.lds; LAS bf16* Vt = Kw + 256 * 72; LAS bf16* Pw = Vt + 64 * 280 + F.wave * (16 * 168);
    const bf16* PROJ = (const bf16*)(F.ws + WS_PROJ); bf16* H = (bf16*)(F.ws + WS_H);
    const int r16 = F.lane & 15, q = F.lane >> 4;
    for (int item = F.vcu; item < BP * HKV * (TP / WIN); item += F.G) {
        const int qb = item & 31, hkv = (item >> 5) & 3, b = item >> 7;
        const int krow0 = b * TP + (qb - 1) * WIN;
        for (int p = F.tid; p < 256 * 8; p += NTHR) { const int r = p >> 3, c8 = p & 7; v4u v = (v4u){0u, 0u, 0u, 0u};
            if (qb > 0 || r >= WIN) v = *(const v4u*)(PROJ + (size_t)(krow0 + r) * C_IN + 1024 + hkv * 64 + c8 * 8);
            *(LAS v4u*)(Kw + r * 72 + c8 * 8) = v; }
        for (int p = F.tid; p < 256 * 8; p += NTHR) { const int r = p & 255, c8 = p >> 8; v4u v = (v4u){0u, 0u, 0u, 0u};
            if (qb > 0 || r >= WIN) v = *(const v4u*)(PROJ + (size_t)(krow0 + r) * C_IN + 1280 + hkv * 64 + c8 * 8);
            LAS bf16* d = Vt + (c8 * 8) * 280 + r;
            d[0 * 280] = (bf16)(v.x & 0xffffu); d[1 * 280] = (bf16)(v.x >> 16); d[2 * 280] = (bf16)(v.y & 0xffffu); d[3 * 280] = (bf16)(v.y >> 16);
            d[4 * 280] = (bf16)(v.z & 0xffffu); d[5 * 280] = (bf16)(v.z >> 16); d[6 * 280] = (bf16)(v.w & 0xffffu); d[7 * 280] = (bf16)(v.w >> 16); }
        for (int p = F.tid; p < 64 * 24; p += NTHR) { const int r = p / 24, cc = p % 24; Vt[r * 280 + 256 + cc] = (bf16)0; }
        __syncthreads();
        const int g = F.wave >> 1, hq = hkv * 4 + g;
        const float sk = sinks[hq]; const float snk[4] = {sk, sk, sk, sk};
        for (int mt = 0; mt < 4; ++mt) { const int tq0 = (F.wave & 1) * 64 + mt * 16; const int relb[4] = {WIN + tq0 + 4 * q, WIN + tq0 + 4 * q + 1, WIN + tq0 + 4 * q + 2, WIN + tq0 + 4 * q + 3};
            const size_t row = (size_t)b * TP + qb * WIN + tq0 + r16;
            swa_tile(Kw, Vt, 280, Pw, tq0 >> 4, (qb == 0) ? WIN : 0, PROJ + row * C_IN + hq * 64, H + row * D + hq * 64, relb, snk, F.lane); }
        __syncthreads();
    }
    for (int e = F.vcu * NTHR + F.tid; e < BP * WIN * 256; e += F.G * NTHR) { const int d = e & 255, jrow = (e >> 8) & 127, b = e >> 15; const size_t row = (size_t)b * TP + TP - WIN + jrow;
        F.out[O_PSK + ((size_t)b * WIN + jrow) * 256 + d] = bf2f(PROJ[row * C_IN + 1024 + d]); F.out[O_PSV + ((size_t)b * WIN + jrow) * 256 + d] = bf2f(PROJ[row * C_IN + 1280 + d]); }
}
__device__ __forceinline__ void swa_sample(Frame& F, const float* sinks, const float* ck, const float* cv) {
    LAS bf16* Kw = (LAS bf16*)F.lds; LAS bf16* Vt = Kw + 144 * 72; LAS bf16* Pw = Vt + 64 * 168;
    const bf16* PROJ = (const bf16*)(F.ws + WS_PROJ); bf16* H = (bf16*)(F.ws + WS_H);
    const int r16 = F.lane & 15, q = F.lane >> 4;
    for (int item = F.vcu; item < BS * HKV; item += F.G) {
        const int b = item >> 2, hkv = item & 3;
        { float kxs[18], vxs[18];
#pragma unroll
            for (int u = 0; u < 18; ++u) { const int e = F.tid + u * NTHR, r = e >> 6, d = e & 63; float kx = 0.f, vx = 0.f;
                if (r < WIN) { const size_t ci = (((size_t)b * WIN + r) * HKV + hkv) * HDC + d; kx = ck[ci]; vx = cv[ci]; }
                else if (r < WIN + TS) { const size_t row = (size_t)MP + b * TS + (r - WIN); kx = bf2f(PROJ[row * C_IN + 1024 + hkv * 64 + d]); vx = bf2f(PROJ[row * C_IN + 1280 + hkv * 64 + d]); }
                kxs[u] = kx; vxs[u] = vx; }
#pragma unroll
            for (int u = 0; u < 18; ++u) { const int e = F.tid + u * NTHR, r = e >> 6, d = e & 63; const float kx = kxs[u], vx = vxs[u];
                Kw[r * 72 + d] = (bf16)f2bf(kx); Vt[d * 168 + r] = (bf16)f2bf(vx);
                if (r >= TS && r < WIN + TS) { const size_t oi = (((size_t)b * WIN + (r - TS)) * HKV + hkv) * HDC + d; F.out[O_SSK + oi] = kx; F.out[O_SSV + oi] = vx; } } }
        for (int e = F.tid; e < 64 * 16; e += NTHR) { const int d = e >> 4, cc = e & 15; Vt[d * 168 + 144 + cc] = (bf16)0; }
        __syncthreads();
        if (F.wave == 0) { const int gq = r16 >> 2, tq = r16 & 3; const size_t row = (size_t)MP + b * TS + tq; const int hq = hkv * 4 + gq;
            const int relb[4] = {WIN + 0, WIN + 1, WIN + 2, WIN + 3};
            const float sk = sinks[hkv * 4 + q]; const float snk[4] = {sk, sk, sk, sk};
            swa_tile(Kw, Vt, 168, Pw, 0, 0, PROJ + row * C_IN + hq * 64, H + row * D + hq * 64, relb, snk, F.lane); }
        __syncthreads();
    }
}

__device__ __forceinline__ void gemm_small(Frame& F, const bf16* A, const bf16* Bt, int K, int N, bool pj, bf16* O, float* X, const float* bias) {
    const int r16 = F.lane & 15, q = F.lane >> 4, nct = N >> 4, ntile = (MS / 16) * nct;
    for (int id = GW_ID(F); id < ntile; id += GW_N(F)) {
        const int ct = id % nct, rt = id / nct;
        const bf16* ap = A + (size_t)(MP + rt * 16 + r16) * K + q * 8; const bf16* bp = Bt + (size_t)(ct * 16 + r16) * K + q * 8;
        f32x4 acc0 = (f32x4){0.f, 0.f, 0.f, 0.f}, acc1 = acc0;
#pragma unroll 2
        for (int k0 = 0; k0 < K; k0 += 256) {
            bf16x8 a[8], b[8];
#pragma unroll
            for (int i = 0; i < 8; ++i) { a[i] = *(const bf16x8*)(ap + k0 + i * 32); b[i] = *(const bf16x8*)(bp + k0 + i * 32); }
#pragma unroll
            for (int i = 0; i < 8; i += 2) { acc0 = __builtin_amdgcn_mfma_f32_16x16x32_bf16(b[i], a[i], acc0, 0, 0, 0); acc1 = __builtin_amdgcn_mfma_f32_16x16x32_bf16(b[i + 1], a[i + 1], acc1, 0, 0, 0); }
        }
        const f32x4 acc = acc0 + acc1; const size_t row = (size_t)(MP + rt * 16 + r16); const int col = ct * 16 + 4 * q;
        if (pj) { f32x4 v = acc; if (bias) v = v + *(const f32x4*)(bias + col); v2u w; w.x = pk2(v.x, v.y); w.y = pk2(v.z, v.w); *(v2u*)(O + row * N + col) = w; }
        else { f32x4* xp = (f32x4*)(X + row * N + col); *xp = *xp + acc; }
    }
}

__device__ __forceinline__ void gates_small(Frame& F, const bf16* XN, const bf16* WgT, float* GT, int cu_lo, bool act, const float* bi, const float* bf_) {
    const int r16 = F.lane & 15, q = F.lane >> 4, bx = (int)blockIdx.x;
    if (bx < cu_lo) return;
    for (int id = (bx - cu_lo) * NWAVES + F.wave; id < M / 16; id += (F.G - cu_lo) * NWAVES) {
        const bf16* ap = WgT + (size_t)r16 * D + q * 8; const bf16* bp = XN + (size_t)(id * 16 + r16) * D + q * 8;
        f32x4 acc0 = (f32x4){0.f, 0.f, 0.f, 0.f}, acc1 = acc0;
#pragma unroll
        for (int k0 = 0; k0 < D; k0 += 256) {
            bf16x8 a[8], b[8];
#pragma unroll
            for (int i = 0; i < 8; ++i) { a[i] = *(const bf16x8*)(ap + k0 + i * 32); b[i] = *(const bf16x8*)(bp + k0 + i * 32); }
#pragma unroll
            for (int i = 0; i < 8; i += 2) { acc0 = __builtin_amdgcn_mfma_f32_16x16x32_bf16(a[i], b[i], acc0, 0, 0, 0); acc1 = __builtin_amdgcn_mfma_f32_16x16x32_bf16(a[i + 1], b[i + 1], acc1, 0, 0, 0); }
        }
        f32x4 v = acc0 + acc1;
        if (act) { const f32x4 bb = (q < 2) ? *(const f32x4*)(bi + 4 * q) : *(const f32x4*)(bf_ + 4 * (q - 2));
#pragma unroll
            for (int r = 0; r < 4; ++r) { const float z = softcapf(v[r] + bb[r]); v[r] = (q < 2) ? z : logsigmoidf(z); } }
        *(f32x4*)(GT + (size_t)(id * 16 + r16) * 16 + 4 * q) = v;
    }
}
__device__ __forceinline__ void final_norm(Frame& F, const float* g, const float* slab, int nslab) {
    f32x4 gv[4];
#pragma unroll
    for (int j = 0; j < 4; ++j) gv[j] = ((const f32x4*)g)[F.lane + 64 * j];
    f32x4 nx[4];
    { const int m0 = GW_ID(F); if (m0 < M) {
#pragma unroll
        for (int j = 0; j < 4; ++j) nx[j] = ((const f32x4*)(F.out + (size_t)m0 * D))[F.lane + 64 * j]; } }
    for (int m = GW_ID(F); m < M; m += GW_N(F)) {
        f32x4* xr = (f32x4*)(F.out + (size_t)m * D); f32x4 v[4]; float ss = 0.f;
#pragma unroll
        for (int j = 0; j < 4; ++j) v[j] = nx[j];
        { const int mn = m + GW_N(F); if (mn < M) {
#pragma unroll
            for (int j = 0; j < 4; ++j) nx[j] = ((const f32x4*)(F.out + (size_t)mn * D))[F.lane + 64 * j]; } }
        if (m >= MP) for (int sl = 0; sl < nslab; ++sl) { const f32x4* sp = (const f32x4*)(slab + ((size_t)sl * MS + (m - MP)) * D);
#pragma unroll
            for (int j = 0; j < 4; ++j) v[j] = v[j] + sp[F.lane + 64 * j]; }
#pragma unroll
        for (int j = 0; j < 4; ++j) ss += (v[j].x * v[j].x + v[j].y * v[j].y) + (v[j].z * v[j].z + v[j].w * v[j].w);
        const float rs = 1.0f / sqrtf(wave_sum(ss) * (1.0f / D) + EPS);
#pragma unroll
        for (int j = 0; j < 4; ++j) xr[F.lane + 64 * j] = v[j] * rs * gv[j];
    }
}

#ifndef MK_ONLY
#define MK_ONLY -1
#endif
#ifndef MK_OFF
#define MK_OFF -2
#endif
#define EN(x) ((MK_ONLY < 0 || MK_ONLY == (x)) && MK_OFF != (x))
#ifndef MK_REP
#define MK_REP 0
#endif
#ifndef MK_TMASK
#define MK_TMASK 0
#endif
#ifndef MK_MULTI
#define MK_MULTI 0
#endif
constexpr int N_PHASES = DEPTH * 10 + 1;
constexpr int KS_OUT = 4, KS_DN = 11;
struct Args { const float* in[30]; float* out; unsigned char* ws; int ph_lo, ph_hi; };
__host__ __device__ __forceinline__ bool phase_empty(int ph) { if (ph >= DEPTH * 10) return false; const int layer = ph / 10, st = ph % 10; return (layer % 3 == 2) && (st == 3 || st == 4); }

#define INP(k) ({ int k_ = (k); asm volatile("" : "+s"(k_)); ((const float* const*)__builtin_amdgcn_kernarg_segment_ptr())[k_]; })
__global__ void __launch_bounds__(NTHR, 2) trunk_fwd(Args args) {
    extern __shared__ __attribute__((aligned(16))) unsigned char lds[];
    Frame F;
    F.lds = (LAS unsigned char*)lds;
    F.MISC = (volatile LAS unsigned*)(F.lds + MISC_OFF);
    F.tid = threadIdx.x; F.lane = F.tid & 63; F.wave = __builtin_amdgcn_readfirstlane(F.tid >> 6);
    F.G = gridDim.x; { const int bx = blockIdx.x; F.vcu = (F.G % 8 == 0) ? (bx % 8) * (F.G / 8) + bx / 8 : bx; }
    const int vcu0 = F.vcu;
    F.out = args.out; F.ws = args.ws; F.ctl = (unsigned*)(args.ws + WS_CTL);
    for (int u = F.tid; u < (LDS_BYTES - LDSCTL_OFF) / 4; u += NTHR) ((LAS unsigned*)(F.lds + LDSCTL_OFF))[u] = 0u;
    __syncthreads();
    const int lo = args.ph_lo, hi = args.ph_hi;
    XcdBarrier bar; bar.bar = F.ctl + CW_BAR; bar.x = 0; bar.st = nullptr;
    if (hi - lo > 1) bar = xcd_barrier_post(F.ctl + CW_BAR, F.MISC + 8);

    bool again = false;
#if MK_TMASK
    unsigned long long tsum_ = 0, t0p_ = 0; const bool tmr_ = (blockIdx.x == 0);
#endif
    for (int ph = lo; ph < hi; ++ph) {
        if (phase_empty(ph)) continue;
#if MK_TMASK
        if (tmr_ && !again) t0p_ = __builtin_amdgcn_s_memrealtime();
#endif
        if (ph == DEPTH * 10) { if (EN(10)) final_norm(F, INP(11), (const float*)(F.ws + WS_R1), KS_DN);
#if MK_TMASK
            if (tmr_ && ((MK_TMASK >> 10) & 1)) tsum_ += __builtin_amdgcn_s_memrealtime() - t0p_;
#endif
            continue; }
        const int layer = ph / 10, st = ph % 10, kind = layer % 3, j = layer / 3;
        { int t_ = threadIdx.x; asm volatile("" : "+v"(t_)); F.tid = t_; F.lane = t_ & 63; F.wave = __builtin_amdgcn_readfirstlane(t_ >> 6);
          int g_ = gridDim.x, v_ = vcu0; asm volatile("" : "+s"(g_), "+s"(v_)); F.G = g_; F.vcu = v_;
          unsigned char* w_ = args.ws; float* o_ = args.out; asm volatile("" : "+s"(w_), "+s"(o_)); F.ws = w_; F.out = o_; }
        bf16* WT_IN = (bf16*)(F.ws + WS_WIN); bf16* WT_OUT = (bf16*)(F.ws + WS_WOUT); bf16* WT_UP = (bf16*)(F.ws + WS_WUP); bf16* WT_DN = (bf16*)(F.ws + WS_WDN);
        bf16* XN = (bf16*)(F.ws + WS_XN); bf16* HB_ = (bf16*)(F.ws + WS_H); float* GATES = (float*)(F.ws + WS_GATES);


        if (st == 0 && EN(0)) {
            const float* win = (kind == 0) ? INP(12) + (size_t)j * D * A_IN : (kind == 1) ? INP(17) : INP(22);
            const float* wout = (kind == 0) ? INP(16) + (size_t)j * D * D : (kind == 1) ? INP(21) : INP(25);
            const int ldw = (kind == 2) ? C_IN : A_IN, nin = (kind == 2) ? C_IN : NPROJ;
            const int sb = (kind == 0) ? 512 : 0, se = (kind == 0) ? 1024 : (kind == 1) ? 512 : 0; const float sv = (kind == 0) ? 0.125f : 0.08838834764831845f;
            if (layer == 0) prep_two(F, win, ldw, D, nin, WT_IN, sb, se, sv, wout, D, D, D, WT_OUT);
            const float* xp = (layer == 0) ? INP(0) : F.out; const float* xs = (layer == 0) ? INP(1) : F.out + (size_t)MP * D; float* xd = (layer == 0) ? F.out : nullptr;
            const float* g = INP(9) + (size_t)layer * D;
            if (kind < 2) {
                bf16* WgT = (bf16*)(F.ws + WS_GATES + 3 * MiB / 2);
                for (int e = F.vcu * NTHR + F.tid; e < 16 * D; e += F.G * NTHR) { const int k = e >> 4, c = e & 15; WgT[c * D + k] = (bf16)f2bf(win[(size_t)k * A_IN + NPROJ + c]); } }
            norm_rows<false>(F, xp, xs, xd, g, XN, nullptr, nullptr, (const float*)(F.ws + WS_R1), (layer == 0) ? 0 : KS_DN);
        } else if ((st == 1 || st == 7 || st == 5 || st == 9) && EN(1)) {
            const bool pj = (st == 1 || st == 7);
            const int N = (st == 7) ? 2 * DFF : (st == 1) ? ((kind == 2) ? C_IN : NPROJ) : D, K = (st == 9) ? DFF : D;
            const bf16* A = pj ? XN : (st == 5) ? HB_ : (const bf16*)(F.ws + WS_ACT);
            const bf16* Bt = (st == 1) ? WT_IN : (st == 7) ? WT_UP : (st == 5) ? WT_OUT : WT_DN;
            const bool rs_ = !pj;
            const int ksl = (st == 5) ? KS_OUT : KS_DN;
            pg8::Gemm g{A, Bt, rs_ ? MP : M, N, K}; pg8::StaticOrder S; S.init(rs_ ? MP : M, N, F.G, (int)blockIdx.x, K, rs_ ? (MS / 256) * (D / 256) * ksl : 0, rs_ ? ksl : 1);
            pg8::EpiDual E{pj, (bf16*)(F.ws + WS_PROJ), again ? (float*)(F.ws + WS_R1 + 32 * MiB) : F.out, N, (st == 1 && kind == 2) ? INP(23) : nullptr, (float*)(F.ws + WS_R1), MP, K / ksl, st == 7,
                pg8::EpiConvAct{(bf16*)(F.ws + WS_ACT), (bf16*)(F.ws + WS_U), INP(27) + (size_t)layer * 3 * DFF, INP(28) + (size_t)layer * DFF, (PG8_LAS float*)(F.lds + XCH_OFF), MP / 256}};
            pg8::gemm_phase<pg8::EpiDual, pg8::StaticOrder, true, true>(F.lds, g, S, E);
            { const int nun = (rs_ ? MP / 256 : M / 256) * (N / 256), ex0 = nun % F.G, exu = (F.G - ex0 >= 64) ? ex0 : 0;
                if (st == 1) { __syncthreads(); prep_two(F, INP(26) + (size_t)layer * D * 2 * DFF, 2 * DFF, D, 2 * DFF, WT_UP, 0, 0, 1.0f, INP(29) + (size_t)layer * DFF * D, D, DFF, D, WT_DN, true, exu); }
                if (st == 7 && layer + 1 < DEPTH) { const int k2 = (layer + 1) % 3, j2 = (layer + 1) / 3;
                    const float* win2 = (k2 == 0) ? INP(12) + (size_t)j2 * D * A_IN : (k2 == 1) ? INP(17) : INP(22);
                    const float* wout2 = (k2 == 0) ? INP(16) + (size_t)j2 * D * D : (k2 == 1) ? INP(21) : INP(25);
                    const int ldw2 = (k2 == 2) ? C_IN : A_IN, nin2 = (k2 == 2) ? C_IN : NPROJ;
                    const int sb2 = (k2 == 0) ? 512 : 0, se2 = (k2 == 0) ? 1024 : (k2 == 1) ? 512 : 0; const float sv2 = (k2 == 0) ? 0.125f : 0.08838834764831845f;
                    __syncthreads(); prep_two(F, win2, ldw2, D, nin2, WT_IN, sb2, se2, sv2, wout2, D, D, D, WT_OUT, false, exu); } }
            if (st == 1 && kind < 2) { const int ex = ((M / 256) * (NPROJ / 256)) % F.G; gates_small(F, XN, (const bf16*)(F.ws + WS_GATES + 3 * MiB / 2), GATES, (ex < F.G / 2) ? ex : 0, kind == 0, INP(13) + j * HA, INP(14) + j * HA); }
        } else if (st == 2) {
            if (kind == 0) { if (EN(20)) mlstm_A(F); TS_MARK(F, 25); if (EN(21)) mlstm_S(F, j, INP(15), INP(2), INP(3), INP(4)); TS_MARK(F, 1); }
            else if (kind == 1) { TS_MARK(F, 26); if (EN(22)) gla_A(F, INP(18), INP(19)); TS_MARK(F, 27); if (EN(23)) gla_S(F, INP(18), INP(19), INP(20), INP(5)); TS_MARK(F, 1); }
            else { TS_MARK(F, 28); if (EN(24)) swa_prompt(F, INP(24)); TS_MARK(F, 29); if (EN(25)) swa_sample(F, INP(24), INP(6), INP(7)); TS_MARK(F, 1); }
        } else if (st == 3) {
            if (kind == 0) { TS_MARK(F, 48); if (EN(30)) mlstm_B(F, j); TS_MARK(F, 1); } else { TS_MARK(F, 49); if (EN(31)) gla_B(F); TS_MARK(F, 1); }
        } else if (st == 4) {
            if (kind == 0) { TS_MARK(F, 47); if (EN(40)) mlstm_C(F, j, INP(15)); TS_MARK(F, 1); } else { TS_MARK(F, 46); if (EN(41)) gla_C(F, INP(18), INP(19), INP(20)); TS_MARK(F, 1); }
        } else if (st == 6 && EN(6)) {
            norm_rows<false>(F, F.out, F.out + (size_t)MP * D, nullptr, INP(10) + (size_t)layer * D, XN, nullptr, nullptr, (const float*)(F.ws + WS_R1), KS_OUT);
        }
        else if (st == 8 && EN(8)) {
            convfix_phase(F, layer, INP(8), INP(27), INP(28));
        }
        if (((MK_REP >> st) & 1) && !again) { again = true; --ph; __syncthreads(); continue; }
        again = false;
#if MK_TMASK && defined(MK_TBARONLY)
        if (tmr_) t0p_ = __builtin_amdgcn_s_memrealtime();
#endif
        if (ph + 1 < hi) { xcd_barrier(bar);
#if defined(MK_BAR2)
            xcd_barrier(bar);
#endif
        }
#if MK_TMASK
        if (tmr_ && ((MK_TMASK >> st) & 1)) tsum_ += __builtin_amdgcn_s_memrealtime() - t0p_;
#endif
    }
#if MK_TSEG
    if (blockIdx.x == 0 && threadIdx.x == 0) { const unsigned long long ts_ = ((volatile LAS unsigned long long*)(F.MISC + 16))[1]; const unsigned long long tw_ = __builtin_amdgcn_s_memrealtime(); while (__builtin_amdgcn_s_memrealtime() - tw_ < ts_ * 4ull) __builtin_amdgcn_s_sleep(8); }
#endif
#if MK_TMASK
    if (tmr_) { const unsigned long long tw_ = __builtin_amdgcn_s_memrealtime(); while (__builtin_amdgcn_s_memrealtime() - tw_ < tsum_ * 4ull) __builtin_amdgcn_s_sleep(8); }
#endif
}

extern "C" void kernel_launch(void* const* d_in, const int* in_sizes, int n_in, void* d_out, int out_size, void* d_ws, size_t ws_size, hipStream_t stream) {
    static int grid = 0;
    if (grid == 0) {
        if (n_in != 30 || (size_t)out_size != O_END || ws_size < WS_END) { fprintf(stderr, "kernel_launch: built for 30 inputs, %zu outputs, >= %zu bytes of workspace; got n_in %d, out %d, ws %zu; nothing launched\n", (size_t)O_END, (size_t)WS_END, n_in, out_size, ws_size); grid = -1; return; }
        int dev = 0, cus = 0, per_cu = 0;
        if (hipGetDevice(&dev) != hipSuccess || hipDeviceGetAttribute(&cus, hipDeviceAttributeMultiprocessorCount, dev) != hipSuccess) { fprintf(stderr, "kernel_launch: device query failed\n"); grid = -1; return; }
        if (hipFuncSetAttribute((const void*)trunk_fwd, hipFuncAttributeMaxDynamicSharedMemorySize, LDS_BYTES) != hipSuccess) { fprintf(stderr, "kernel_launch: hipFuncSetAttribute failed\n"); grid = -1; return; }
        if (hipOccupancyMaxActiveBlocksPerMultiprocessor(&per_cu, (const void*)trunk_fwd, NTHR, LDS_BYTES) != hipSuccess || per_cu < 1) { fprintf(stderr, "kernel_launch: occupancy query says %d workgroups per CU\n", per_cu); }
        (void)hipGetLastError();
        grid = cus;
    }
    if (grid < 0) return;
    if (hipMemsetAsync((char*)d_ws + WS_CTL, 0, CTL_ZERO_BYTES, stream) != hipSuccess) { fprintf(stderr, "kernel_launch: hipMemsetAsync failed\n"); return; }
    Args a{};
    for (int i = 0; i < 30; ++i) a.in[i] = (const float*)d_in[i];
    a.out = (float*)d_out; a.ws = (unsigned char*)d_ws;
#if MK_MULTI
    for (int ph = 0; ph < N_PHASES; ++ph) { if (phase_empty(ph)) continue; a.ph_lo = ph; a.ph_hi = ph + 1;
        hipLaunchKernelGGL(trunk_fwd, dim3(grid), dim3(NTHR), LDS_BYTES, stream, a); }
#else
    a.ph_lo = 0; a.ph_hi = N_PHASES;
    hipLaunchKernelGGL(trunk_fwd, dim3(grid), dim3(NTHR), LDS_BYTES, stream, a);
#endif
    const hipError_t le = hipPeekAtLastError();
    if (le != hipSuccess) fprintf(stderr, "kernel_launch: launch failed: %s\n", hipGetErrorName(le));
}
```

```cpp
#include <hip/hip_runtime.h>
#include <cstdio>
#include <cstdint>
#define MK_MULTI 0
#define MK_REP 0
namespace pg8 {
#define PG8_LAS __attribute__((address_space(3)))
typedef unsigned short bf16_t;
typedef short bf16x8 __attribute__((ext_vector_type(8)));
typedef float f32x4 __attribute__((ext_vector_type(4)));
typedef unsigned u32x4 __attribute__((ext_vector_type(4)));
typedef unsigned u32x2 __attribute__((ext_vector_type(2)));
constexpr int BM = 256, BK = 64, HALF = 128, HTB = HALF * BK * 2  , STAGE_BYTES = 8 * HTB, NXCD = 8, WGM = 8;

__host__ __device__ __forceinline__ int lds_byte(int r, int c) { const int st = (r >> 4) * 2 + (c >> 5), rr = r & 15, cc = c & 31, ob = rr * 64 + cc * 2; return st * 1024 + (ob ^ (((ob >> 9) & 1) << 5)); }
__host__ __device__ __forceinline__ void stage_rc(int b, int& R, int& C) { const int st = b / 1024, sb = b % 1024, swz = sb ^ (((sb >> 9) & 1) << 5); R = (st >> 1) * 16 + swz / 64; C = (st & 1) * 32 + (swz % 64) / 2; }
__host__ __device__ __forceinline__ int perm32(int rho) { const int n = rho >> 4, i = rho & 15; return 8 * (i >> 2) + 4 * n + (i & 3); }

struct Unit { int pm, pn, k0, nt, mode; };
struct Gemm { const bf16_t* A; const bf16_t* Bt; int M, N, K; };

struct StaticOrder {
    int nM, nN, nwg, G, c, ntk, nsub, ks, kl;
    __host__ __device__ __forceinline__ void init(int M, int N, int G_, int c_, int K_, int nsub_ = 0, int ks_ = 1) { nM = M / BM; nN = N / BM; nwg = nM * nN; G = G_; c = c_; ntk = K_ / BK; nsub = nsub_; ks = ks_; kl = K_ / ks_; }
    __host__ __device__ __forceinline__ bool next(int i, Unit& u) const {
        const long L = (long)i * G + c; if (L >= nwg + nsub) return false;
        int pm, pn, k0, nt_, mode;
        if (L >= nwg) { const int e = (int)L - nwg, sl = e % ks, u8 = e / ks; pm = nM + u8 / nN; pn = u8 % nN; k0 = sl * kl; nt_ = kl / BK; mode = 1; }
        else {
            int wgid = (int)L; { const int q = nwg / NXCD, r = nwg % NXCD, xcd = wgid % NXCD, off = wgid / NXCD; wgid = (xcd < r ? xcd * (q + 1) : r * (q + 1) + (xcd - r) * q) + off; }
            const int nig = WGM * nN, gid = wgid / nig, fm = gid * WGM, gsz = (nM - fm) < WGM ? (nM - fm) : WGM;
            pm = fm + ((wgid % nig) % gsz); pn = (wgid % nig) / gsz; k0 = 0; nt_ = ntk; mode = 0; }
        u.pm = pm; u.pn = pn; u.k0 = k0; u.nt = nt_; u.mode = mode; return true;
    }
    __device__ __forceinline__ void a_ready(const Unit&) const {}
    __device__ __forceinline__ void done(const Unit&) const {}
};

__device__ __forceinline__ unsigned cvt_pk_bf16(float lo, float hi) { unsigned r; asm volatile("v_cvt_pk_bf16_f32 %0, %1, %2" : "=v"(r) : "v"(lo), "v"(hi)); return r; }
typedef float f32x2 __attribute__((ext_vector_type(2)));
struct EpiBf16 {
    static constexpr bool PERM = true, AFTER_DRAIN = false;
    bf16_t* O; int ldc; const float* bias;
    __device__ __forceinline__ void operator()(const f32x4 (&acc)[2][2][4][2], const Unit& u, int wr, int wc, int fr, int fq) const {
        const int row0 = u.pm * BM + wr * 64 + fr; const int col0 = u.pn * BM + wc * 32 + 8 * fq;
        f32x4 bv[2][2];
#pragma unroll
        for (int bj = 0; bj < 2; ++bj)
#pragma unroll
            for (int n = 0; n < 2; ++n) bv[bj][n] = bias ? *(const f32x4*)(bias + col0 + bj * HALF + 4 * n) : (f32x4){0.f, 0.f, 0.f, 0.f};
#pragma unroll
        for (int ai = 0; ai < 2; ++ai)
#pragma unroll
            for (int m = 0; m < 4; ++m) { bf16_t* rowp = O + (size_t)(row0 + ai * HALF + m * 16) * ldc + col0;
#pragma unroll
                for (int bj = 0; bj < 2; ++bj) { const f32x4 v0 = acc[ai][bj][m][0] + bv[bj][0], v1 = acc[ai][bj][m][1] + bv[bj][1];
                    u32x4 w; w.x = cvt_pk_bf16(v0[0], v0[1]); w.y = cvt_pk_bf16(v0[2], v0[3]); w.z = cvt_pk_bf16(v1[0], v1[1]); w.w = cvt_pk_bf16(v1[2], v1[3]);
                    *(u32x4*)(rowp + bj * HALF) = w; } }
    }
};
struct EpiRes {
    static constexpr bool PERM = false, AFTER_DRAIN = false;
    float* X; int ldc;
    __device__ __forceinline__ void operator()(const f32x4 (&acc)[2][2][4][2], const Unit& u, int wr, int wc, int fr, int fq) const {
        const int row0 = u.pm * BM + wr * 64 + fr, col0 = u.pn * BM + wc * 32 + 4 * fq;
#pragma unroll
        for (int ai = 0; ai < 2; ++ai)
#pragma unroll
            for (int m = 0; m < 4; ++m) { float* rowp = X + (size_t)(row0 + ai * HALF + m * 16) * ldc + col0;
#pragma unroll
                for (int bj = 0; bj < 2; ++bj)
#pragma unroll
                    for (int n = 0; n < 2; ++n) *(f32x4*)(rowp + bj * HALF + n * 16) = acc[ai][bj][m][n]; }
    }
};
struct EpiConvAct {
    bf16_t* ACT; bf16_t* U; const float* cw; const float* cb; PG8_LAS float* xch; int first_raw_tile;
    __device__ __forceinline__ void operator()(const f32x4 (&acc)[2][2][4][2], const Unit& u, int wr, int wc, int fr, int fq) const {
        constexpr int FF = 2816;
        asm volatile("" : "+v"(fr), "+v"(fq), "+s"(wr), "+s"(wc));
        const int lane = fq * 16 + fr, fb_t = wc * 32 + 8 * fq, fb = u.pn * 128 + fb_t;
        const bool rawtile = u.pm >= first_raw_tile;
        if (fr >= 14) {
#pragma unroll
            for (int ai = 0; ai < 2; ++ai) { PG8_LAS float* xp = xch + ((ai * 2 + wr) * 2 + (fr - 14)) * 128 + fb_t;
#pragma unroll
                for (int n = 0; n < 2; ++n) *(PG8_LAS f32x4*)(xp + 4 * n) = acc[ai][0][3][n]; }
        }
        float w0[8], w1[8], w2[8], bb[8];
#pragma unroll
        for (int n = 0; n < 2; ++n) { const f32x4 a = *(const f32x4*)(cw + fb + 4 * n), b = *(const f32x4*)(cw + FF + fb + 4 * n), c = *(const f32x4*)(cw + 2 * FF + fb + 4 * n), d = *(const f32x4*)(cb + fb + 4 * n);
#pragma unroll
            for (int e = 0; e < 4; ++e) { w0[4 * n + e] = a[e]; w1[4 * n + e] = b[e]; w2[4 * n + e] = c[e]; bb[4 * n + e] = d[e]; } }
        asm volatile("s_waitcnt lgkmcnt(0)" ::: "memory"); __builtin_amdgcn_s_barrier(); asm volatile("" ::: "memory");
#pragma unroll
        for (int ai = 0; ai < 2; ++ai) {
            float p1[8], p2[8];
            const int pb = ai * 2 + wr - 1;
#pragma unroll
            for (int i = 0; i < 8; ++i) { p1[i] = 0.f; p2[i] = 0.f; }
            if (pb >= 0 && fr < 2) { const PG8_LAS float* x63 = xch + (pb * 2 + 1) * 128 + fb_t; const PG8_LAS float* x62 = xch + (pb * 2 + 0) * 128 + fb_t;
#pragma unroll
                for (int i = 0; i < 8; ++i) { const float a63 = x63[i], a62 = x62[i]; p1[i] = a63; p2[i] = (fr == 0) ? a62 : a63; } }
#pragma unroll
            for (int m = 0; m < 4; ++m) {
                const size_t row = (size_t)u.pm * BM + ai * HALF + wr * 64 + m * 16 + fr;
                float o[8];
#pragma unroll
                for (int n = 0; n < 2; ++n)
#pragma unroll
                    for (int e = 0; e < 4; ++e) { const int i = 4 * n + e; const float g0 = acc[ai][0][m][n][e];
                        const float r1 = __builtin_bit_cast(float, __builtin_amdgcn_update_dpp(0, __builtin_bit_cast(int, g0), 0x121, 0xf, 0xf, false));
                        const float r2 = __builtin_bit_cast(float, __builtin_amdgcn_update_dpp(0, __builtin_bit_cast(int, g0), 0x122, 0xf, 0xf, false));
                        const float g1 = (fr >= 1) ? r1 : p1[i], g2 = (fr >= 2) ? r2 : p2[i];
                        p1[i] = r1; p2[i] = r2;
                        const float cv = bb[i] + w0[i] * g2 + w1[i] * g1 + w2[i] * g0;
                        o[i] = cv / (1.0f + __expf(-cv)) * acc[ai][1][m][n][e]; }
                if (!rawtile) { u32x4 w; w.x = cvt_pk_bf16(o[0], o[1]); w.y = cvt_pk_bf16(o[2], o[3]); w.z = cvt_pk_bf16(o[4], o[5]); w.w = cvt_pk_bf16(o[6], o[7]); *(u32x4*)(ACT + row * FF + fb) = w; }
                const bool rawrow = rawtile || (ai == 0 && wr == 0 && m == 0 && fr < 2) || (ai == 1 && wr == 1 && m == 3 && fr >= 14);
                if (rawrow) { const f32x4 a0 = acc[ai][0][m][0], a1 = acc[ai][0][m][1], b0 = acc[ai][1][m][0], b1 = acc[ai][1][m][1];
                    u32x4 w; w.x = cvt_pk_bf16(a0[0], a0[1]); w.y = cvt_pk_bf16(a0[2], a0[3]); w.z = cvt_pk_bf16(a1[0], a1[1]); w.w = cvt_pk_bf16(a1[2], a1[3]); *(u32x4*)(U + row * (2 * FF) + fb) = w;
                    w.x = cvt_pk_bf16(b0[0], b0[1]); w.y = cvt_pk_bf16(b0[2], b0[3]); w.z = cvt_pk_bf16(b1[0], b1[1]); w.w = cvt_pk_bf16(b1[2], b1[3]); *(u32x4*)(U + row * (2 * FF) + FF + fb) = w; }
                __builtin_amdgcn_sched_barrier(0);
            }
        }
    }
};
struct EpiDual {
    static constexpr bool AFTER_DRAIN = false;
    bool PERM; bf16_t* O; float* X; int ldc; const float* bias; float* slab; int row_base, kl; bool conv; EpiConvAct ca;
    __device__ __forceinline__ void init(f32x4 (&acc)[2][2][4][2], const Unit& u, int wr, int wc, int fr, int fq) const {
        if (!PERM && u.mode == 0) { const int row0 = u.pm * BM + wr * 64 + fr, col0 = u.pn * BM + wc * 32 + 4 * fq;
#pragma unroll
            for (int ai = 0; ai < 2; ++ai)
#pragma unroll
                for (int m = 0; m < 4; ++m) { const float* rowp = X + (size_t)(row0 + ai * HALF + m * 16) * ldc + col0;
#pragma unroll
                    for (int bj = 0; bj < 2; ++bj)
#pragma unroll
                        for (int n = 0; n < 2; ++n) acc[ai][bj][m][n] = *(const f32x4*)(rowp + bj * HALF + n * 16); }
        } else {
#pragma unroll
            for (int a = 0; a < 2; ++a)
#pragma unroll
                for (int b = 0; b < 2; ++b)
#pragma unroll
                    for (int m = 0; m < 4; ++m)
#pragma unroll
                        for (int n = 0; n < 2; ++n) acc[a][b][m][n] = (f32x4){0.f, 0.f, 0.f, 0.f}; }
    }
    __device__ __forceinline__ void operator()(const f32x4 (&acc)[2][2][4][2], const Unit& u, int wr, int wc, int fr, int fq) const {
        asm volatile("" : "+v"(fr), "+v"(fq), "+s"(wr), "+s"(wc));
        if (u.mode == 1) {
            float* sb = slab + (size_t)(u.k0 / kl) * 512 * ldc; const int row0 = u.pm * BM - row_base + wr * 64 + fr, col0 = u.pn * BM + wc * 32 + 4 * fq;
#pragma unroll
            for (int ai = 0; ai < 2; ++ai)
#pragma unroll
                for (int m = 0; m < 4; ++m) { float* rowp = sb + (size_t)(row0 + ai * HALF + m * 16) * ldc + col0;
#pragma unroll
                    for (int bj = 0; bj < 2; ++bj)
#pragma unroll
                        for (int n = 0; n < 2; ++n) *(f32x4*)(rowp + bj * HALF + n * 16) = acc[ai][bj][m][n]; }
        } else if (conv) { ca(acc, u, wr, wc, fr, fq);
        } else if (PERM) { EpiBf16 e{O, ldc, bias}; e(acc, u, wr, wc, fr, fq); } else { EpiRes e{X, ldc}; e(acc, u, wr, wc, fr, fq); }
    }
};
#ifndef MK_TSEG_ST
#define MK_TSEG_ST -1
#endif
#if defined(MK_TSEG) && MK_TSEG
#define PG8_TS(id) do { if (blockIdx.x == 0 && threadIdx.x == 0) { volatile PG8_LAS unsigned* M__ = (volatile PG8_LAS unsigned*)(lds + 131072 + 320); if (MK_TSEG_ST < 0 || M__[23] != 0u) { const unsigned long long t__ = __builtin_amdgcn_s_memrealtime(); \
    volatile PG8_LAS unsigned long long* T__ = (volatile PG8_LAS unsigned long long*)(M__ + 16); if (M__[22] == (unsigned)MK_TSEG) T__[1] += t__ - T__[0]; T__[0] = t__; M__[22] = (unsigned)(id); } } } while (0)
#else
#define PG8_TS(id) do { } while (0)
#endif
template <class Epi, class Sched, bool ALIGN_EPI = false, bool SP2 = false>
__device__ __forceinline__ void gemm_phase(PG8_LAS unsigned char* lds, const Gemm g, const Sched& S, const Epi& E) {
    int tid_ = threadIdx.x; asm volatile("" : "+v"(tid_));
    const int tid = tid_, wid = __builtin_amdgcn_readfirstlane(tid >> 6), lane = tid & 63, wr = wid >> 2, wc = wid & 3, fr = lane & 15, fq = lane >> 4;
    const int K = g.K;
    unsigned voffA[2], voffB[2];
#pragma unroll
    for (int i = 0; i < 2; ++i) { int R, C; stage_rc(tid * 16 + i * 8192, R, C); const int Rb = E.PERM ? ((R & ~31) + perm32(R & 31)) : R;
        voffA[i] = (unsigned)(R * K + C) * 2u; voffB[i] = (unsigned)(Rb * K + C) * 2u; }
    const size_t kstep = (size_t)(BK * 2);
    const size_t hstep = (size_t)HALF * K * 2;
    const size_t tstep = 2 * hstep;
    const unsigned ldsw = (unsigned)wid * 1024u;
    const int aoff = lds_byte(wr * 64 + fr, fq * 8), boff = lds_byte(wc * 32 + fr, fq * 8);
#define PG8_SA(b, h) (((b) * 2 + (h)) * HTB)
#define PG8_SB(b, h) ((4 + (b) * 2 + (h)) * HTB)
#define PG8_STAGE(bufoff, gbase, voff) do { _Pragma("unroll") for (int _i = 0; _i < 2; ++_i) \
        __builtin_amdgcn_global_load_lds((const unsigned*)((const char*)(gbase) + (voff)[_i]), (PG8_LAS unsigned*)(lds + (bufoff) + ldsw + _i * 8192), 16, 0, 0); } while (0)
#define PG8_LDA(dst, b, h) do { _Pragma("unroll") for (int m = 0; m < 4; ++m) _Pragma("unroll") for (int k = 0; k < 2; ++k) dst[m][k] = *(const PG8_LAS bf16x8*)(lds + PG8_SA(b, h) + aoff + m * 2048 + k * 1024); } while (0)
#define PG8_LDB(dst, b, h) do { _Pragma("unroll") for (int n = 0; n < 2; ++n) _Pragma("unroll") for (int k = 0; k < 2; ++k) dst[n][k] = *(const PG8_LAS bf16x8*)(lds + PG8_SB(b, h) + boff + n * 2048 + k * 1024); } while (0)
#define PG8_MMA(ai, bj, At, Bt) do { __builtin_amdgcn_s_setprio(1); _Pragma("unroll") for (int m = 0; m < 4; ++m) _Pragma("unroll") for (int n = 0; n < 2; ++n) _Pragma("unroll") for (int k = 0; k < 2; ++k) \
        acc[ai][bj][m][n] = __builtin_amdgcn_mfma_f32_16x16x32_bf16(Bt[n][k], At[m][k], acc[ai][bj][m][n], 0, 0, 0); __builtin_amdgcn_s_setprio(0); } while (0)
#define PG8_WAIT_V(n) asm volatile("s_waitcnt vmcnt(" #n ")" ::: "memory")
#define PG8_WAIT_L(n) asm volatile("s_waitcnt lgkmcnt(" #n ")" ::: "memory")
#define PG8_BAR __builtin_amdgcn_s_barrier()
#define PG8_SCHED __builtin_amdgcn_sched_barrier(0)
    PG8_TS(71);
    Unit cur, nxt; int ui = 0;
    if (!S.next(0, cur)) return;
    f32x4 acc[2][2][4][2];
    E.init(acc, cur, wr, wc, fr, fq);
    bf16x8 At[4][2], B0[2][2], B1[2][2];
    const char* cA = (const char*)g.A + (size_t)cur.pm * tstep + (size_t)cur.k0 * 2; const char* cB = (const char*)g.Bt + (size_t)cur.pn * tstep + (size_t)cur.k0 * 2;
    S.a_ready(cur);
    if constexpr (SP2) {
        PG8_STAGE(PG8_SB(0, 0), cB, voffB); PG8_STAGE(PG8_SB(0, 1), cB + hstep, voffB); PG8_STAGE(PG8_SA(0, 0), cA, voffA); PG8_STAGE(PG8_SA(0, 1), cA + hstep, voffA);
        if (wr == 1) PG8_BAR;
        PG8_WAIT_V(2); PG8_BAR;
        PG8_STAGE(PG8_SB(1, 0), cB + kstep, voffB); PG8_STAGE(PG8_SA(1, 0), cA + kstep, voffA); PG8_STAGE(PG8_SB(1, 1), cB + hstep + kstep, voffB);
        PG8_WAIT_V(6); PG8_BAR;
    } else {
        PG8_STAGE(PG8_SB(0, 0), cB, voffB); PG8_STAGE(PG8_SA(0, 0), cA, voffA); PG8_STAGE(PG8_SB(0, 1), cB + hstep, voffB); PG8_STAGE(PG8_SA(0, 1), cA + hstep, voffA);
        if (wr == 1) PG8_BAR;
        PG8_WAIT_V(4); PG8_BAR;
        PG8_STAGE(PG8_SB(1, 0), cB + kstep, voffB); PG8_STAGE(PG8_SA(1, 0), cA + kstep, voffA); PG8_STAGE(PG8_SB(1, 1), cB + hstep + kstep, voffB);
        PG8_WAIT_V(6); PG8_BAR;
    }
    for (;;) {
        PG8_TS(72);
        const bool has_next = S.next(ui + 1, nxt);
        const char* nA = has_next ? (const char*)g.A + (size_t)nxt.pm * tstep + (size_t)nxt.k0 * 2 : cA; const char* nB = has_next ? (const char*)g.Bt + (size_t)nxt.pn * tstep + (size_t)nxt.k0 * 2 : cB;
        const int nt = cur.nt;
        for (int t = 0; t < nt; t += 2) {
            const bool last = (t == nt - 2);
            const char* a1 = cA + (size_t)(t + 1) * kstep;
            const char* a2 = last ? nA : cA + (size_t)(t + 2) * kstep; const char* b2 = last ? nB : cB + (size_t)(t + 2) * kstep;
            const char* a3 = a2 + kstep; const char* b3 = b2 + kstep;
            if (last && has_next) S.a_ready(nxt);
            if constexpr (SP2) {
            PG8_LDB(B0, 0, 0); PG8_LDB(B1, 0, 1); PG8_SCHED; PG8_LDA(At, 0, 0); PG8_STAGE(PG8_SA(1, 1), a1 + hstep, voffA);
            PG8_WAIT_V(8); PG8_WAIT_L(0); PG8_BAR; PG8_MMA(0, 0, At, B0); PG8_MMA(0, 1, At, B1); PG8_BAR; PG8_SCHED;
            PG8_LDA(At, 0, 1); PG8_STAGE(PG8_SB(0, 0), b2, voffB); PG8_STAGE(PG8_SB(0, 1), b2 + hstep, voffB); PG8_STAGE(PG8_SA(0, 0), a2, voffA);
            PG8_WAIT_V(8); PG8_WAIT_L(0); PG8_BAR; PG8_MMA(1, 0, At, B0); PG8_MMA(1, 1, At, B1); PG8_BAR; PG8_SCHED;
            PG8_LDB(B0, 1, 0); PG8_LDB(B1, 1, 1); PG8_SCHED; PG8_LDA(At, 1, 0); PG8_STAGE(PG8_SA(0, 1), a2 + hstep, voffA);
            PG8_WAIT_V(8); PG8_WAIT_L(0); PG8_BAR; PG8_MMA(0, 0, At, B0); PG8_MMA(0, 1, At, B1); PG8_BAR; PG8_SCHED;
            PG8_LDA(At, 1, 1); PG8_STAGE(PG8_SB(1, 0), b3, voffB); PG8_STAGE(PG8_SB(1, 1), b3 + hstep, voffB); PG8_STAGE(PG8_SA(1, 0), a3, voffA);
            PG8_WAIT_V(8); PG8_WAIT_L(0); PG8_BAR; PG8_MMA(1, 0, At, B0); PG8_MMA(1, 1, At, B1); PG8_BAR; PG8_SCHED;
            } else {
            PG8_LDB(B0, 0, 0); PG8_SCHED; PG8_LDA(At, 0, 0); PG8_STAGE(PG8_SA(1, 1), a1 + hstep, voffA);
            PG8_WAIT_L(8); PG8_BAR; PG8_WAIT_L(0); PG8_MMA(0, 0, At, B0); PG8_BAR; PG8_SCHED;
            PG8_LDB(B1, 0, 1); PG8_STAGE(PG8_SB(0, 0), b2, voffB);
            PG8_BAR; PG8_WAIT_L(0); PG8_MMA(0, 1, At, B1); PG8_BAR;
            PG8_LDA(At, 0, 1); PG8_STAGE(PG8_SA(0, 0), a2, voffA);
            PG8_BAR; PG8_WAIT_L(0); PG8_MMA(1, 0, At, B0); PG8_BAR; PG8_SCHED;
            PG8_STAGE(PG8_SB(0, 1), b2 + hstep, voffB);
            PG8_WAIT_V(6); PG8_BAR; PG8_MMA(1, 1, At, B1); PG8_BAR;
            PG8_LDB(B0, 1, 0); PG8_SCHED; PG8_LDA(At, 1, 0); PG8_STAGE(PG8_SA(0, 1), a2 + hstep, voffA);
            PG8_WAIT_L(8); PG8_BAR; PG8_WAIT_L(0); PG8_MMA(0, 0, At, B0); PG8_BAR; PG8_SCHED;
            PG8_LDB(B1, 1, 1); PG8_STAGE(PG8_SB(1, 0), b3, voffB);
            PG8_BAR; PG8_WAIT_L(0); PG8_MMA(0, 1, At, B1); PG8_BAR;
            PG8_LDA(At, 1, 1); PG8_STAGE(PG8_SA(1, 0), a3, voffA);
            PG8_BAR; PG8_WAIT_L(0); PG8_MMA(1, 0, At, B0); PG8_BAR; PG8_SCHED;
            PG8_STAGE(PG8_SB(1, 1), b3 + hstep, voffB);
            PG8_WAIT_V(6); PG8_BAR; PG8_MMA(1, 1, At, B1); PG8_BAR;
            }
        }
        PG8_TS(73);
        if constexpr (ALIGN_EPI) { if (wr == 0) PG8_BAR; }
        if constexpr (!Epi::AFTER_DRAIN) { E(acc, cur, wr, wc, fr, fq); S.done(cur); }
        PG8_TS(74);
        if (!has_next) break;
        E.init(acc, nxt, wr, wc, fr, fq);
        cur = nxt; cA = nA; cB = nB; ++ui;
        if constexpr (ALIGN_EPI) { if (wr == 1) PG8_BAR; }
    }
    PG8_TS(75);
    PG8_WAIT_V(0);
    if constexpr (!ALIGN_EPI) { if (wr == 0) PG8_BAR; }
    PG8_BAR;
    if constexpr (Epi::AFTER_DRAIN) { E.fused(acc, cur, wr, wc, fr, fq, lds, wid, lane); S.done(cur); }
#undef PG8_SA
#undef PG8_SB
#undef PG8_STAGE
#undef PG8_LDA
#undef PG8_LDB
#undef PG8_MMA
#undef PG8_WAIT_V
#undef PG8_WAIT_L
#undef PG8_BAR
#undef PG8_SCHED
}
}
constexpr int NWAVES = 8, NTHR = 512;
constexpr int D = 1024, BP = 4, TP = 4096, MP = BP * TP, BS = 128, TS = 4, MS = BS * TS, M = MP + MS;
constexpr int DEPTH = 4;
constexpr int HA = 8, DKA = 64, DVA = 128;
constexpr int HB = 4, DKB = 128, DVB = 256, RANK = 16;
constexpr int HC = 16, HKV = 4, HDC = 64, GROUP = 4, WIN = 128;
constexpr int DFF = 2816, A_IN = 3088, B_IN = 3088, C_IN = 1536, NPROJ = 3072;
constexpr int NCH = 64, LCH = 64;
constexpr float EPS = 1e-6f, SOFTCAP = 15.0f;

constexpr size_t O_YP = 0, O_YS = O_YP + (size_t)MP * D, O_PAC = O_YS + (size_t)MS * D, O_PAN = O_PAC + 2ull * BP * HA * DKA * DVA, O_PAM = O_PAN + 2ull * BP * HA * DKA,
    O_PG = O_PAM + 2ull * BP * HA, O_PSK = O_PG + (size_t)BP * HB * DKB * DVB, O_PSV = O_PSK + (size_t)BP * WIN * HKV * HDC, O_PF = O_PSV + (size_t)BP * WIN * HKV * HDC,
    O_SAC = O_PF + 4ull * BP * 2 * DFF, O_SAN = O_SAC + 2ull * BS * HA * DKA * DVA, O_SAM = O_SAN + 2ull * BS * HA * DKA, O_SG = O_SAM + 2ull * BS * HA,
    O_SSK = O_SG + (size_t)BS * HB * DKB * DVB, O_SSV = O_SSK + (size_t)BS * WIN * HKV * HDC, O_SF = O_SSV + (size_t)BS * WIN * HKV * HDC, O_END = O_SF + 4ull * BS * 2 * DFF;
static_assert(O_END == 63666240ull, "output size");

constexpr size_t MiB = 1u << 20;
constexpr size_t WS_CTL = 0, CTL_ZERO_BYTES = 1 * MiB;
constexpr size_t WS_WIN = 1 * MiB, WS_WOUT = 7 * MiB, WS_WUP = 9 * MiB, WS_WDN = 20 * MiB;
constexpr size_t WS_GATES = 26 * MiB;
constexpr size_t WS_XN = 28 * MiB;
constexpr size_t WS_H = 61 * MiB;
constexpr size_t WS_R1 = 94 * MiB;
constexpr size_t WS_PROJ = WS_R1;
constexpr size_t WS_SCR = WS_R1 + 99 * MiB;
constexpr size_t SC_LOC = WS_SCR;
constexpr size_t SC_ST = WS_SCR + 128 * MiB;
constexpr size_t SC_AUX = WS_SCR + 192 * MiB;
constexpr size_t WS_U = WS_R1;
constexpr size_t WS_ACT = WS_R1 + 182 * MiB;
constexpr size_t WS_END = WS_R1 + 293 * MiB;
static_assert(WS_WIN + (size_t)NPROJ * D * 2 <= WS_WOUT && WS_WOUT + (size_t)D * D * 2 <= WS_WUP && WS_WUP + 2ull * DFF * D * 2 <= WS_WDN && WS_WDN + (size_t)D * DFF * 2 <= WS_GATES, "ws map: weights");
static_assert(WS_GATES + (size_t)M * 16 * 4 <= WS_XN && WS_XN + (size_t)M * D * 2 <= WS_H && WS_H + (size_t)M * D * 2 <= WS_R1 && WS_PROJ + (size_t)M * NPROJ * 2 <= WS_SCR, "ws map: activations");
static_assert(WS_U + (size_t)M * 2 * DFF * 2 <= WS_ACT && WS_ACT + (size_t)M * DFF * 2 <= WS_END && SC_AUX + 2 * MiB <= WS_END, "ws map: ffn");
constexpr int AX_CHK = 0;
constexpr int AX_MST = 8192;
constexpr int AX_NLOC = 16384;
constexpr int AX_NST = 16384 + 131072;
constexpr int AX_BL = 0;
static_assert((AX_NST + 131072) * 4 <= (int)(2 * MiB), "aux");

constexpr int CW_BAR = 4096;

constexpr int RING_BYTES = 131072;
constexpr int LDSCTL_OFF = RING_BYTES, MISC_OFF = LDSCTL_OFF + 320;
constexpr int XCH_OFF = 132096;
constexpr int LDS_BYTES = 147456;

#define GAS __attribute__((address_space(1)))
#define LAS __attribute__((address_space(3)))
typedef unsigned short bf16;
typedef unsigned v4u __attribute__((ext_vector_type(4)));
typedef unsigned v2u __attribute__((ext_vector_type(2)));
typedef float f32x4 __attribute__((ext_vector_type(4)));
typedef float f32x2 __attribute__((ext_vector_type(2)));
typedef short bf16x8 __attribute__((ext_vector_type(8)));
#define LDS_WAIT() asm volatile("s_waitcnt lgkmcnt(0)" ::: "memory")
#define VM_WAIT() asm volatile("s_waitcnt vmcnt(0)" ::: "memory")
__device__ __forceinline__ unsigned f2bf(float f) { unsigned u = __builtin_bit_cast(unsigned, f); return (u + 0x7fffu + ((u >> 16) & 1u)) >> 16; }
__device__ __forceinline__ unsigned pk2(float lo, float hi) { return f2bf(lo) | (f2bf(hi) << 16); }
__device__ __forceinline__ float bf2f(unsigned h) { return __builtin_bit_cast(float, (h & 0xffffu) << 16); }
__device__ __forceinline__ float bflo(unsigned w) { return __builtin_bit_cast(float, w << 16); }
__device__ __forceinline__ float bfhi(unsigned w) { return __builtin_bit_cast(float, w & 0xffff0000u); }
__device__ __forceinline__ float wave_sum(float v) {
#pragma unroll
    for (int o = 1; o < 64; o <<= 1) v += __shfl_xor(v, o);
    return v;
}
__device__ __forceinline__ float wave_max(float v) {
#pragma unroll
    for (int o = 1; o < 64; o <<= 1) v = fmaxf(v, __shfl_xor(v, o));
    return v;
}
__device__ __forceinline__ float wave_scan_sum(float v, int lane) {
#pragma unroll
    for (int o = 1; o < 64; o <<= 1) { const float y = __shfl_up(v, o); if (lane >= o) v += y; }
    return v;
}
__device__ __forceinline__ float wave_scan_max(float v, int lane) {
#pragma unroll
    for (int o = 1; o < 64; o <<= 1) { const float y = __shfl_up(v, o); if (lane >= o) v = fmaxf(v, y); }
    return v;
}
__device__ __forceinline__ float logsigmoidf(float x) { return fminf(x, 0.f) - __logf(1.0f + __expf(-fabsf(x))); }
__device__ __forceinline__ float softcapf(float z) { const float e = __expf(z * (2.0f / SOFTCAP)); return SOFTCAP * (1.0f - 2.0f / (e + 1.0f)); }
__device__ __forceinline__ float sigmoidf_(float x) { return 1.0f / (1.0f + __expf(-x)); }

template <int KS> __device__ __forceinline__ f32x4 mma_ll(const LAS bf16* X, int ldx, const LAS bf16* Y, int ldy, f32x4 acc, int lane) {
    const int r16 = lane & 15, q = lane >> 4;
#pragma unroll
    for (int ks = 0; ks < KS; ++ks) {
        const bf16x8 a = *(const LAS bf16x8*)(X + r16 * ldx + ks * 32 + q * 8);
        const bf16x8 b = *(const LAS bf16x8*)(Y + r16 * ldy + ks * 32 + q * 8);
        acc = __builtin_amdgcn_mfma_f32_16x16x32_bf16(a, b, acc, 0, 0, 0);
    }
    return acc;
}
template <int KS> __device__ __forceinline__ f32x4 mma_gl(const bf16* X, int ldx, const LAS bf16* Y, int ldy, f32x4 acc, int lane) {
    const int r16 = lane & 15, q = lane >> 4;
    bf16x8 a[KS];
#pragma unroll
    for (int ks = 0; ks < KS; ++ks) a[ks] = *(const bf16x8*)(X + (size_t)r16 * ldx + ks * 32 + q * 8);
#pragma unroll
    for (int ks = 0; ks < KS; ++ks) {
        const bf16x8 b = *(const LAS bf16x8*)(Y + r16 * ldy + ks * 32 + q * 8);
        acc = __builtin_amdgcn_mfma_f32_16x16x32_bf16(a[ks], b, acc, 0, 0, 0);
    }
    return acc;
}
template <int R, int C> __device__ __forceinline__ void stage_nat(LAS bf16* dst, int lld, const bf16* src, size_t gld, int tid) {
    constexpr int CP = C / 8;
    for (int p = tid; p < R * CP; p += NTHR) { const int r = p / CP, c8 = p % CP; *(LAS v4u*)(dst + r * lld + c8 * 8) = *(const v4u*)(src + (size_t)r * gld + c8 * 8); }
}
template <int R, int C> __device__ __forceinline__ void stage_tr(LAS bf16* dst, int lld, const bf16* src, size_t gld, int tid) {
    constexpr int CP = C / 8;
    for (int p = tid; p < R * CP; p += NTHR) { const int r = p % R, c8 = p / R; const v4u v = *(const v4u*)(src + (size_t)r * gld + c8 * 8);
        LAS bf16* d = dst + (c8 * 8) * lld + r;
        d[0 * lld] = (bf16)(v.x & 0xffffu); d[1 * lld] = (bf16)(v.x >> 16); d[2 * lld] = (bf16)(v.y & 0xffffu); d[3 * lld] = (bf16)(v.y >> 16);
        d[4 * lld] = (bf16)(v.z & 0xffffu); d[5 * lld] = (bf16)(v.z >> 16); d[6 * lld] = (bf16)(v.w & 0xffffu); d[7 * lld] = (bf16)(v.w >> 16); }
}
#define XB_TMO      128
#define XB_XCNT(j)  (256  + 64 * (j))
#define XB_XSUB(j)  (1280 + 64 * (j))
#define XB_XGEN(j)  (2304 + 64 * (j))
#define XB_TOP      3328
#define XB_TOPGEN   3392
#define XCD_BAR_WORDS 3456
#define XB_SPIN_CAP (1u << 18)

__device__ __forceinline__ unsigned xb_ld(unsigned* p)              { return __hip_atomic_load(p, __ATOMIC_RELAXED, __HIP_MEMORY_SCOPE_AGENT); }
__device__ __forceinline__ unsigned xb_add(unsigned* p, unsigned v) { return __hip_atomic_fetch_add(p, v, __ATOMIC_RELAXED, __HIP_MEMORY_SCOPE_AGENT); }
__device__ __forceinline__ unsigned xb_xcc_id() { return (unsigned)__builtin_amdgcn_s_getreg((3 << 11) | 20) & 0xFu; }
#define XB_SPIN(cond, bar) do { unsigned _sp = 0; while (cond) { __builtin_amdgcn_s_sleep(1); \
    if ((++_sp & 255u) == 0u) { if (xb_ld(&(bar)[XB_TMO])) break; if (_sp > XB_SPIN_CAP) { atomicAdd(&(bar)[XB_TMO], 1u); break; } } } } while (0)

struct XcdBarrier {
    unsigned* bar; unsigned x;
    volatile LAS unsigned* st;
};

__device__ __forceinline__ XcdBarrier xcd_barrier_post(unsigned* bar, volatile LAS unsigned* st) {
    XcdBarrier b; b.bar = bar; b.x = xb_xcc_id(); b.st = st;
    if (threadIdx.x == 0) (void)xb_add(&bar[XB_XCNT(b.x)], 1u);
    return b;
}
__device__ __forceinline__ void xcd_barrier_complete(unsigned* bar, unsigned x, unsigned& nloc, unsigned& nx) {
    const unsigned G = gridDim.x * gridDim.y * gridDim.z;
    unsigned sum, cnt, mine, sp = 0u;
    for (;;) {
        sum = 0u; cnt = 0u; mine = 0u;
#pragma unroll
        for (unsigned j = 0; j < 16; ++j) { const unsigned c = xb_ld(&bar[XB_XCNT(j)]); sum += c; cnt += (c > 0u) ? 1u : 0u; mine = (j == x) ? c : mine; }
        if (sum == G) break;
        __builtin_amdgcn_s_sleep(1);
        if ((++sp & 255u) == 0u) { if (xb_ld(&bar[XB_TMO])) break; if (sp > XB_SPIN_CAP) { atomicAdd(&bar[XB_TMO], 1u); break; } }
    }
    nloc = mine > 0u ? mine : 1u; nx = cnt > 0u ? cnt : 1u;
}

__device__ __forceinline__ void xcd_barrier(const XcdBarrier& b) {
    asm volatile("s_waitcnt vmcnt(0)" ::: "memory");
    __syncthreads();
    if (threadIdx.x == 0) {
        unsigned* bar = b.bar;
        __builtin_amdgcn_s_waitcnt(0);
        unsigned nloc = b.st[0], nx = b.st[1];
        if (nloc == 0u) { xcd_barrier_complete(bar, b.x, nloc, nx); b.st[0] = nloc; b.st[1] = nx; }
        const unsigned old = xb_add(&bar[XB_XSUB(b.x)], 1u);
        const unsigned gen = old / nloc;
        if (old + 1u == (gen + 1u) * nloc) {
            __builtin_amdgcn_fence(__ATOMIC_RELEASE, "agent");
            asm volatile("s_waitcnt vmcnt(0)" ::: "memory");
            const unsigned og = xb_add(&bar[XB_TOP], 1u);
            const unsigned tg = og / nx;
            if (og + 1u == (tg + 1u) * nx) xb_add(&bar[XB_TOPGEN], 1u);
            else XB_SPIN(xb_ld(&bar[XB_TOPGEN]) == tg, bar);
            __builtin_amdgcn_fence(__ATOMIC_ACQUIRE, "agent");
            xb_add(&bar[XB_XGEN(b.x)], 1u);
            asm volatile("s_waitcnt vmcnt(0)" ::: "memory");
        } else {
            XB_SPIN(xb_ld(&bar[XB_XGEN(b.x)]) == gen, bar);
            __builtin_amdgcn_fence(__ATOMIC_ACQUIRE, "agent");
            asm volatile("s_waitcnt vmcnt(0)" ::: "memory");
        }
    }
    __syncthreads();
}
struct Frame {
    LAS unsigned char* lds;
    volatile LAS unsigned* MISC;
    unsigned* ctl;
    int tid, lane, wave;
    int vcu, G;
    float* out; unsigned char* ws;
};
#define GW_ID(F) ((F).vcu * NWAVES + (F).wave)
#define GW_N(F) ((F).G * NWAVES)
#ifndef MK_TSEG
#define MK_TSEG 0
#endif
#if MK_TSEG
#ifndef MK_TSEG_ST
#define MK_TSEG_ST -1
#endif
#define TS_MARK(F, id) do { if (blockIdx.x == 0 && (F).tid == 0 && (MK_TSEG_ST < 0 || (F).MISC[23] != 0u)) { const unsigned long long t__ = __builtin_amdgcn_s_memrealtime(); volatile LAS unsigned long long* T__ = (volatile LAS unsigned long long*)((F).MISC + 16); \
    if ((F).MISC[22] == (unsigned)MK_TSEG) T__[1] += t__ - T__[0]; T__[0] = t__; (F).MISC[22] = (unsigned)(id); } } while (0)
#else
#define TS_MARK(F, id) do { } while (0)
#endif

__device__ __forceinline__ void transpose_item(const float* __restrict__ W, int ldw, int K, bf16* __restrict__ WT, LAS float* scr, int kb, int nb, int sb, int se, float sv, int lane, bool upmap = false) {
    const int k0 = 64 * kb, n0 = 32 * nb;
    const int d0 = !upmap ? n0 : (n0 < DFF ? (n0 >> 7) * 256 + (n0 & 127) : ((n0 - DFF) >> 7) * 256 + 128 + ((n0 - DFF) & 127));
    f32x4 v[8];
#pragma unroll
    for (int i = 0; i < 8; ++i) v[i] = *(const f32x4*)(W + (size_t)(k0 + i * 8 + (lane >> 3)) * ldw + n0 + (lane & 7) * 4);
#pragma unroll
    for (int i = 0; i < 8; ++i) { LAS float* d = scr + (i * 8 + (lane >> 3)) * 33 + (lane & 7) * 4; d[0] = v[i].x; d[1] = v[i].y; d[2] = v[i].z; d[3] = v[i].w; }
    LDS_WAIT(); asm volatile("" ::: "memory");
    const int c = lane & 7;
    const float sc = (n0 >= sb && n0 < se) ? sv : 1.0f;
#pragma unroll
    for (int j = 0; j < 4; ++j) { const int n = (lane >> 3) + 8 * j; const LAS float* s = scr + (8 * c) * 33 + n;
        v4u o; o.x = pk2(s[0 * 33] * sc, s[1 * 33] * sc); o.y = pk2(s[2 * 33] * sc, s[3 * 33] * sc); o.z = pk2(s[4 * 33] * sc, s[5 * 33] * sc); o.w = pk2(s[6 * 33] * sc, s[7 * 33] * sc);
        *(v4u*)(WT + (size_t)(d0 + n) * K + k0 + 8 * c) = o; }
    LDS_WAIT(); asm volatile("" ::: "memory");
}
__device__ __forceinline__ void prep_two(Frame& F, const float* W0, int ldw0, int K0, int N0, bf16* T0, int sb, int se, float sv, const float* W1, int ldw1, int K1, int N1, bf16* T1, bool upmap0 = false, int cu_lo = 0) {
    if ((int)blockIdx.x < cu_lo) return;
    LAS float* scr = (LAS float*)(F.lds + F.wave * 16384);
    const int nb0 = N0 / 32, I0 = (K0 / 64) * nb0, nb1 = N1 / 32, I1 = (K1 / 64) * nb1;
    for (int it = ((int)blockIdx.x - cu_lo) * NWAVES + F.wave; it < I0 + I1; it += (F.G - cu_lo) * NWAVES) {
        if (it < I0) transpose_item(W0, ldw0, K0, T0, scr, it / nb0, it % nb0, sb, se, sv, F.lane, upmap0);
        else { const int r = it - I0; transpose_item(W1, ldw1, K1, T1, scr, r / nb1, r % nb1, 0, 0, 1.0f, F.lane); }
    }
}

template <bool GATES> __device__ __forceinline__ void norm_rows(Frame& F, const float* xp, const float* xs, float* Xdst, const float* g, bf16* XN, float* gates, const LAS float* WgT, const float* slab, int nslab) {
    f32x4 gv[4];
#pragma unroll
    for (int j = 0; j < 4; ++j) gv[j] = ((const f32x4*)g)[F.lane + 64 * j];
    f32x4 nx[4];
    { const int m0 = GW_ID(F); if (m0 < M) { const float* xr = (m0 < MP) ? xp + (size_t)m0 * D : xs + (size_t)(m0 - MP) * D;
#pragma unroll
        for (int j = 0; j < 4; ++j) nx[j] = ((const f32x4*)xr)[F.lane + 64 * j]; } }
    for (int m = GW_ID(F); m < M; m += GW_N(F)) {
        f32x4 v[4]; float ss = 0.f;
#pragma unroll
        for (int j = 0; j < 4; ++j) v[j] = nx[j];
        { const int mn = m + GW_N(F); if (mn < M) { const float* xr = (mn < MP) ? xp + (size_t)mn * D : xs + (size_t)(mn - MP) * D;
#pragma unroll
            for (int j = 0; j < 4; ++j) nx[j] = ((const f32x4*)xr)[F.lane + 64 * j]; } }
        if (nslab > 0 && m >= MP) {
            for (int sl = 0; sl < nslab; ++sl) { const f32x4* sp = (const f32x4*)(slab + ((size_t)sl * MS + (m - MP)) * D);
#pragma unroll
                for (int j = 0; j < 4; ++j) v[j] = v[j] + sp[F.lane + 64 * j]; }
#pragma unroll
            for (int j = 0; j < 4; ++j) ((f32x4*)(F.out + (size_t)m * D))[F.lane + 64 * j] = v[j];
        }
#pragma unroll
        for (int j = 0; j < 4; ++j) ss += (v[j].x * v[j].x + v[j].y * v[j].y) + (v[j].z * v[j].z + v[j].w * v[j].w);
        if (Xdst) {
#pragma unroll
            for (int j = 0; j < 4; ++j) ((f32x4*)(Xdst + (size_t)m * D))[F.lane + 64 * j] = v[j];
        }
        const float rs = 1.0f / sqrtf(wave_sum(ss) * (1.0f / D) + EPS);
        v2u* o8 = (v2u*)(XN + (size_t)m * D);
#pragma unroll
        for (int j = 0; j < 4; ++j) { v[j] = v[j] * rs * gv[j]; v2u w; w.x = pk2(v[j].x, v[j].y); w.y = pk2(v[j].z, v[j].w); o8[F.lane + 64 * j] = w; }
        if (GATES) {
            float s[16];
#pragma unroll
            for (int c = 0; c < 16; ++c) { float a = 0.f;
#pragma unroll
                for (int j = 0; j < 4; ++j) { const f32x4 w = ((const LAS f32x4*)(WgT + c * 1024))[F.lane + 64 * j]; a += (v[j].x * w.x + v[j].y * w.y) + (v[j].z * w.z + v[j].w * w.w); }
                s[c] = a; if ((c & 3) == 3) asm volatile("" ::: "memory"); }
            const bool b5 = (F.lane & 32) != 0, b4 = (F.lane & 16) != 0, b3 = (F.lane & 8) != 0, b2 = (F.lane & 4) != 0;
#pragma unroll
            for (int i = 0; i < 8; ++i) { const float send = b5 ? s[i] : s[i + 8], keep = b5 ? s[i + 8] : s[i]; s[i] = keep + __shfl_xor(send, 32); }
#pragma unroll
            for (int i = 0; i < 4; ++i) { const float send = b4 ? s[i] : s[i + 4], keep = b4 ? s[i + 4] : s[i]; s[i] = keep + __shfl_xor(send, 16); }
#pragma unroll
            for (int i = 0; i < 2; ++i) { const float send = b3 ? s[i] : s[i + 2], keep = b3 ? s[i + 2] : s[i]; s[i] = keep + __shfl_xor(send, 8); }
            { const float send = b2 ? s[0] : s[1], keep = b2 ? s[1] : s[0]; s[0] = keep + __shfl_xor(send, 4); }
            s[0] += __shfl_xor(s[0], 2); s[0] += __shfl_xor(s[0], 1);
            if ((F.lane & 3) == 0) gates[(size_t)m * 16 + (F.lane >> 2)] = s[0];
        }
    }
}
#define NR_LOAD(buf, mm) do { if ((mm) < M) { const float* xr_ = ((mm) < MP) ? xp + (size_t)(mm) * D : xs + (size_t)((mm) - MP) * D; \
    _Pragma("unroll") for (int j_ = 0; j_ < 4; ++j_) buf[j_] = ((const f32x4*)xr_)[F.lane + 64 * j_]; } } while (0)
#define NR_PROC(buf, mm) do { if ((mm) < M) { f32x4 v_[4]; float ss_ = 0.f; \
    _Pragma("unroll") for (int j_ = 0; j_ < 4; ++j_) v_[j_] = buf[j_]; \
    NR_LOAD(buf, (mm) + 3 * GW_N(F)); \
    if (nslab > 0 && (mm) >= MP) { for (int sl_ = 0; sl_ < nslab; ++sl_) { const f32x4* sp_ = (const f32x4*)(slab + ((size_t)sl_ * MS + ((mm) - MP)) * D); \
            _Pragma("unroll") for (int j_ = 0; j_ < 4; ++j_) v_[j_] = v_[j_] + sp_[F.lane + 64 * j_]; } \
        _Pragma("unroll") for (int j_ = 0; j_ < 4; ++j_) ((f32x4*)(F.out + (size_t)(mm) * D))[F.lane + 64 * j_] = v_[j_]; } \
    _Pragma("unroll") for (int j_ = 0; j_ < 4; ++j_) ss_ += (v_[j_].x * v_[j_].x + v_[j_].y * v_[j_].y) + (v_[j_].z * v_[j_].z + v_[j_].w * v_[j_].w); \
    if (Xdst) { _Pragma("unroll") for (int j_ = 0; j_ < 4; ++j_) ((f32x4*)(Xdst + (size_t)(mm) * D))[F.lane + 64 * j_] = v_[j_]; } \
    const float rs_ = 1.0f / sqrtf(wave_sum(ss_) * (1.0f / D) + EPS); v2u* o8_ = (v2u*)(XN + (size_t)(mm) * D); \
    _Pragma("unroll") for (int j_ = 0; j_ < 4; ++j_) { const f32x4 y_ = v_[j_] * rs_ * gv[j_]; v2u w_; w_.x = pk2(y_.x, y_.y); w_.y = pk2(y_.z, y_.w); o8_[F.lane + 64 * j_] = w_; } } } while (0)
__device__ __forceinline__ void norm_rows3(Frame& F, const float* xp, const float* xs, float* Xdst, const float* g, bf16* XN, const float* slab, int nslab) {
    f32x4 gv[4];
#pragma unroll
    for (int j = 0; j < 4; ++j) gv[j] = ((const f32x4*)g)[F.lane + 64 * j];
    f32x4 ba[4], bb[4], bc[4]; const int S = GW_N(F), m0 = GW_ID(F);
    NR_LOAD(ba, m0); NR_LOAD(bb, m0 + S); NR_LOAD(bc, m0 + 2 * S);
    for (int m = m0; m < M; m += 3 * S) { NR_PROC(ba, m); NR_PROC(bb, m + S); NR_PROC(bc, m + 2 * S); }
}
__device__ __forceinline__ void stage_wgT(Frame& F, const float* W, int ldw, int c0, LAS float* WgT) {
    for (int e = F.tid; e < 16 * 1024; e += NTHR) { const int k = e >> 4, c = e & 15; WgT[c * 1024 + k] = W[(size_t)k * ldw + c0 + c]; }
}

__device__ __forceinline__ void unpack8(const v4u v, float (&f)[8]) { f[0] = bflo(v.x); f[1] = bfhi(v.x); f[2] = bflo(v.y); f[3] = bfhi(v.y); f[4] = bflo(v.z); f[5] = bfhi(v.z); f[6] = bflo(v.w); f[7] = bfhi(v.w); }
__device__ __forceinline__ void convfix_unit(Frame& F, int layer, int pm, int pn, int k0, int kw, const float* __restrict__ conv_state, const float* __restrict__ cw, const float* __restrict__ cb) {
    const bf16* __restrict__ U = (const bf16*)(F.ws + WS_U); bf16* ACT = (bf16*)(F.ws + WS_ACT);
    const float* cwl = cw + (size_t)layer * 3 * DFF; const float* cbl = cb + (size_t)layer * DFF;
    if (pm < MP / 256) {
        const int row0 = pm * 256;
        for (int fc = F.tid; fc < DFF / 8; fc += NTHR) { const int f0 = fc * 8;
            if ((pm & 15) == 15 && pn == 0) { float a[8], b[8]; unpack8(*(const v4u*)(U + (size_t)(row0 + 254) * (2 * DFF) + f0), a); unpack8(*(const v4u*)(U + (size_t)(row0 + 255) * (2 * DFF) + f0), b);
                float* o = F.out + O_PF + ((size_t)(layer * BP + (pm >> 4)) * 2) * DFF + f0;
#pragma unroll
                for (int i = 0; i < 8; ++i) { o[i] = a[i]; o[DFF + i] = b[i]; } }
            if ((pm & 15) != 0) {
                const v4u ug2 = *(const v4u*)(U + (size_t)(row0 - 2) * (2 * DFF) + f0), ug1 = *(const v4u*)(U + (size_t)(row0 - 1) * (2 * DFF) + f0);
                const v4u ua0 = *(const v4u*)(U + (size_t)row0 * (2 * DFF) + f0), ua1 = *(const v4u*)(U + (size_t)(row0 + 1) * (2 * DFF) + f0);
                const v4u uu0 = *(const v4u*)(U + (size_t)row0 * (2 * DFF) + DFF + f0), uu1 = *(const v4u*)(U + (size_t)(row0 + 1) * (2 * DFF) + DFF + f0);
                float g2[8], g1[8], ga[8], gb[8], u0[8], u1[8]; unpack8(ug2, g2); unpack8(ug1, g1); unpack8(ua0, ga); unpack8(ua1, gb); unpack8(uu0, u0); unpack8(uu1, u1);
                float oa[8], ob[8];
#pragma unroll
                for (int i = 0; i < 8; ++i) { const float w0 = cwl[f0 + i], w1 = cwl[DFF + f0 + i], w2 = cwl[2 * DFF + f0 + i], bb = cbl[f0 + i];
                    const float c0 = bb + w0 * g2[i] + w1 * g1[i] + w2 * ga[i], c1 = bb + w0 * g1[i] + w1 * ga[i] + w2 * gb[i];
                    oa[i] = c0 * sigmoidf_(c0) * u0[i]; ob[i] = c1 * sigmoidf_(c1) * u1[i]; }
                v4u w; w.x = pk2(oa[0], oa[1]); w.y = pk2(oa[2], oa[3]); w.z = pk2(oa[4], oa[5]); w.w = pk2(oa[6], oa[7]); *(v4u*)(ACT + (size_t)row0 * DFF + f0) = w;
                w.x = pk2(ob[0], ob[1]); w.y = pk2(ob[2], ob[3]); w.z = pk2(ob[4], ob[5]); w.w = pk2(ob[6], ob[7]); *(v4u*)(ACT + (size_t)(row0 + 1) * DFF + f0) = w; }
        }
    } else {
        const int nch = kw >> 3, b0 = (pm - MP / 256) * 64;
        for (int it = F.tid; it < 64 * nch; it += NTHR) { const int fc = it % nch, bi = it / nch, b = b0 + bi, f0 = k0 + fc * 8, row0 = MP + b * TS;
            const float* cs = conv_state + ((size_t)(layer * BS + b) * 2) * DFF + f0;
            float g2[8], g1[8];
            { const f32x4 a0 = *(const f32x4*)cs, a1 = *(const f32x4*)(cs + 4), b0v = *(const f32x4*)(cs + DFF), b1v = *(const f32x4*)(cs + DFF + 4);
#pragma unroll
                for (int i = 0; i < 4; ++i) { g2[i] = a0[i]; g2[4 + i] = a1[i]; g1[i] = b0v[i]; g1[4 + i] = b1v[i]; } }
            v4u ug[4], uu[4];
#pragma unroll
            for (int r = 0; r < 4; ++r) { ug[r] = *(const v4u*)(U + (size_t)(row0 + r) * (2 * DFF) + f0); uu[r] = *(const v4u*)(U + (size_t)(row0 + r) * (2 * DFF) + DFF + f0); }
            float w0[8], w1[8], w2[8], bb[8];
#pragma unroll
            for (int i = 0; i < 8; ++i) { w0[i] = cwl[f0 + i]; w1[i] = cwl[DFF + f0 + i]; w2[i] = cwl[2 * DFF + f0 + i]; bb[i] = cbl[f0 + i]; }
#pragma unroll
            for (int r = 0; r < 4; ++r) { float g0[8], up[8]; unpack8(ug[r], g0); unpack8(uu[r], up); float o[8];
#pragma unroll
                for (int i = 0; i < 8; ++i) { const float cv = bb[i] + w0[i] * g2[i] + w1[i] * g1[i] + w2[i] * g0[i]; o[i] = cv * sigmoidf_(cv) * up[i]; g2[i] = g1[i]; g1[i] = g0[i]; }
                v4u w; w.x = pk2(o[0], o[1]); w.y = pk2(o[2], o[3]); w.z = pk2(o[4], o[5]); w.w = pk2(o[6], o[7]); *(v4u*)(ACT + (size_t)(row0 + r) * DFF + f0) = w; }
            if (pn == 0) { float* o = F.out + O_SF + ((size_t)(layer * BS + b) * 2) * DFF + f0;
#pragma unroll
                for (int i = 0; i < 8; ++i) { o[i] = g2[i]; o[DFF + i] = g1[i]; } }
        }
    }
}

__device__ __forceinline__ void convfix_phase(Frame& F, int layer, const float* conv_state, const float* cw, const float* cb) {
    const bf16* U = (const bf16*)(F.ws + WS_U); bf16* ACT = (bf16*)(F.ws + WS_ACT);
    constexpr int FC = DFF / 8, NPT = MP / 256;
    const int gt = F.vcu * NTHR + F.tid, GT = F.G * NTHR;
    const float* cwl = cw + (size_t)layer * 3 * DFF; const float* cbl = cb + (size_t)layer * DFF;
    for (int it = gt; it < (NPT + BS) * FC; it += GT) {
        const bool samp = it >= NPT * FC; const int r2 = samp ? it - NPT * FC : it;
        const int fc = r2 % FC, rb = r2 / FC, f0 = fc * 8;
        float g2[8], g1[8]; int row0, nrows;
        if (!samp) { row0 = rb * 256; nrows = 2;
            if ((rb & 15) == 15) { float a[8], b[8]; unpack8(*(const v4u*)(U + (size_t)(row0 + 254) * (2 * DFF) + f0), a); unpack8(*(const v4u*)(U + (size_t)(row0 + 255) * (2 * DFF) + f0), b);
                float* o = F.out + O_PF + ((size_t)(layer * BP + (rb >> 4)) * 2) * DFF + f0;
#pragma unroll
                for (int i = 0; i < 8; ++i) { o[i] = a[i]; o[DFF + i] = b[i]; } }
            if ((rb & 15) == 0) continue;
            unpack8(*(const v4u*)(U + (size_t)(row0 - 2) * (2 * DFF) + f0), g2); unpack8(*(const v4u*)(U + (size_t)(row0 - 1) * (2 * DFF) + f0), g1);
        } else { row0 = MP + rb * TS; nrows = TS; const float* cs = conv_state + ((size_t)(layer * BS + rb) * 2) * DFF + f0;
#pragma unroll
            for (int i = 0; i < 8; ++i) { g2[i] = cs[i]; g1[i] = cs[DFF + i]; }
        }
        float w0[8], w1[8], w2[8], bb[8];
#pragma unroll
        for (int i = 0; i < 8; ++i) { w0[i] = cwl[f0 + i]; w1[i] = cwl[DFF + f0 + i]; w2[i] = cwl[2 * DFF + f0 + i]; bb[i] = cbl[f0 + i]; }
        for (int r = 0; r < nrows; ++r) {
            const size_t row = (size_t)(row0 + r);
            float g0[8], up[8]; unpack8(*(const v4u*)(U + row * (2 * DFF) + f0), g0); unpack8(*(const v4u*)(U + row * (2 * DFF) + DFF + f0), up);
            float o[8];
#pragma unroll
            for (int i = 0; i < 8; ++i) { const float cv = bb[i] + w0[i] * g2[i] + w1[i] * g1[i] + w2[i] * g0[i]; o[i] = cv * sigmoidf_(cv) * up[i]; g2[i] = g1[i]; g1[i] = g0[i]; }
            v4u w; w.x = pk2(o[0], o[1]); w.y = pk2(o[2], o[3]); w.z = pk2(o[4], o[5]); w.w = pk2(o[6], o[7]);
            *(v4u*)(ACT + row * DFF + f0) = w;
        }
        if (samp) { float* o = F.out + O_SF + ((size_t)(layer * BS + rb) * 2) * DFF + f0;
#pragma unroll
            for (int i = 0; i < 8; ++i) { o[i] = g2[i]; o[DFF + i] = g1[i]; } }
    }
}

constexpr int MLC = 128, MNCH = TP / MLC, MITEMS = BP * HA * MNCH;
constexpr int ST_ROWS = 144;
__device__ __forceinline__ void ml_gates(const float* GT, int row0, int h, int lane, float& a0, float& a1, float& fc0, float& fc1) {
    const float ig0 = GT[(size_t)(row0 + lane) * 16 + h], lf0 = GT[(size_t)(row0 + lane) * 16 + 8 + h];
    const float ig1 = GT[(size_t)(row0 + 64 + lane) * 16 + h], lf1 = GT[(size_t)(row0 + 64 + lane) * 16 + 8 + h];
    fc0 = wave_scan_sum(lf0, lane); const float tot0 = __shfl(fc0, 63); fc1 = tot0 + wave_scan_sum(lf1, lane);
    a0 = ig0 - fc0; a1 = ig1 - fc1;
}
__device__ __forceinline__ void mlstm_A(Frame& F) {
    LAS bf16* Kt = (LAS bf16*)F.lds; LAS bf16* Vt = Kt + 64 * 136; LAS float* wv = (LAS float*)(Vt + 128 * 136);
    const bf16* PROJ = (const bf16*)(F.ws + WS_PROJ); const float* GT = (const float*)(F.ws + WS_GATES);
    float* CLOC = (float*)(F.ws + SC_LOC); float* AUX = (float*)(F.ws + SC_AUX);
    for (int item = F.vcu; item < MITEMS; item += F.G) {
        const int bh = item >> 5, c = item & 31, b = bh >> 3, h = bh & 7, row0 = b * TP + c * MLC;
        TS_MARK(F, 21);
        v4u vv[4];
#pragma unroll
        for (int u = 0; u < 4; ++u) { const int p = F.tid + u * NTHR, r = p & 127, c8 = p >> 7; vv[u] = *(const v4u*)(PROJ + (size_t)(row0 + r) * NPROJ + 1024 + h * 128 + c8 * 8); }
        v4u kv[2];
#pragma unroll
        for (int u = 0; u < 2; ++u) { const int p = F.tid + u * NTHR, r = p & 127, c8 = p >> 7; kv[u] = *(const v4u*)(PROJ + (size_t)(row0 + r) * NPROJ + 512 + h * 64 + c8 * 8); }
        if (F.wave == 0) { float a0, a1, f0, f1; ml_gates(GT, row0, h, F.lane, a0, a1, f0, f1); const float amax = wave_max(fmaxf(a0, a1)), fl = __shfl(f1, 63);
            wv[F.lane] = __expf(a0 - amax); wv[64 + F.lane] = __expf(a1 - amax); if (F.lane == 0) { AUX[AX_CHK + 2 * item] = amax; AUX[AX_CHK + 2 * item + 1] = fl; } }
#pragma unroll
        for (int u = 0; u < 4; ++u) { const int p = F.tid + u * NTHR, r = p & 127, c8 = p >> 7; const v4u v = vv[u]; LAS bf16* d = Vt + (c8 * 8) * 136 + r;
            d[0 * 136] = (bf16)(v.x & 0xffffu); d[1 * 136] = (bf16)(v.x >> 16); d[2 * 136] = (bf16)(v.y & 0xffffu); d[3 * 136] = (bf16)(v.y >> 16);
            d[4 * 136] = (bf16)(v.z & 0xffffu); d[5 * 136] = (bf16)(v.z >> 16); d[6 * 136] = (bf16)(v.w & 0xffffu); d[7 * 136] = (bf16)(v.w >> 16); }
        __syncthreads();
        TS_MARK(F, 22);
#pragma unroll
        for (int u = 0; u < 2; ++u) { const int p = F.tid + u * NTHR, r = p & 127, c8 = p >> 7; float e[8]; unpack8(kv[u], e); const float w = wv[r]; LAS bf16* d = Kt + (c8 * 8) * 136 + r;
#pragma unroll
            for (int i = 0; i < 8; ++i) d[i * 136] = (bf16)f2bf(e[i] * w); }
        __syncthreads();
        TS_MARK(F, 23);
#pragma unroll
        for (int jj = 0; jj < 4; ++jj) { const int tile = F.wave * 4 + jj, dkt = tile & 3, dvt = tile >> 2;
            const f32x4 acc = mma_ll<4>(Kt + dkt * 16 * 136, 136, Vt + dvt * 16 * 136, 136, (f32x4){0.f, 0.f, 0.f, 0.f}, F.lane);
            *(f32x4*)(CLOC + ((size_t)item * 128 + dvt * 16 + (F.lane & 15)) * 64 + dkt * 16 + 4 * (F.lane >> 4)) = acc; }
        if (F.tid < 64) { float sm = 0.f; for (int ss = 0; ss < MLC; ss += 8) { float e[8]; unpack8(*(const LAS v4u*)(Kt + F.tid * 136 + ss), e);
#pragma unroll
                for (int i = 0; i < 8; ++i) sm += e[i]; }
            AUX[AX_NLOC + item * 64 + F.tid] = sm; }
        __syncthreads();
        TS_MARK(F, 24);
    }
}
__device__ __forceinline__ void mlstm_B(Frame& F, int j) {
    const float* __restrict__ CLOC = (const float*)(F.ws + SC_LOC); bf16* __restrict__ ST = (bf16*)(F.ws + SC_ST); float* AUX = (float*)(F.ws + SC_AUX);
    for (int slot = F.vcu * NTHR + F.tid; slot < BP * HA * 4096; slot += F.G * NTHR) {
        const int bh = slot >> 12, e = slot & 4095, dv = e >> 5, dk = (e & 31) * 2;
        float m = 0.f, c0 = 0.f, c1 = 0.f, nacc = 0.f;
        for (int cb = 0; cb < MNCH; cb += 8) {
            f32x2 cl[8]; float nl[8], am[8], fl[8];
#pragma unroll
            for (int u = 0; u < 8; ++u) { const int item = bh * MNCH + cb + u; cl[u] = *(const f32x2*)(CLOC + ((size_t)item * 128 + dv) * 64 + dk); am[u] = AUX[AX_CHK + 2 * item]; fl[u] = AUX[AX_CHK + 2 * item + 1];
                nl[u] = (e < 64) ? AUX[AX_NLOC + item * 64 + e] : 0.f; }
#pragma unroll
            for (int u = 0; u < 8; ++u) { const int item = bh * MNCH + cb + u;
                const float Mn = fmaxf(m, am[u]), g = __expf(m - Mn), ee = __expf(am[u] - Mn);
                bf16* sti = ST + (size_t)item * ST_ROWS * 64;
                *(unsigned*)(sti + dv * 64 + dk) = pk2(c0, c1);
                if (e < 64) sti[128 * 64 + e] = (bf16)f2bf(nacc);
                else if (e < 64 + 15 * 32) { const int z = e - 64; *(unsigned*)(sti + (129 + (z >> 5)) * 64 + (z & 31) * 2) = 0u; }
                if (e == 0) AUX[AX_MST + item] = m;
                c0 = g * c0 + ee * cl[u].x; c1 = g * c1 + ee * cl[u].y; nacc = g * nacc + ee * nl[u];
                m = fl[u] + Mn; } }
        const int b = bh >> 3, h = bh & 7;
        float* oc = F.out + O_PAC + (((size_t)(j * BP + b) * HA + h) * DKA) * DVA;
        oc[(size_t)dk * DVA + dv] = c0; oc[(size_t)(dk + 1) * DVA + dv] = c1;
        if (e < 64) F.out[O_PAN + ((size_t)(j * BP + b) * HA + h) * DKA + e] = nacc;
        if (e == 0) F.out[O_PAM + (size_t)(j * BP + b) * HA + h] = m;
    }
}
__device__ __forceinline__ void mlstm_C(Frame& F, int j, const float* anorm) {
    LAS bf16* Qs = (LAS bf16*)F.lds; LAS bf16* Ks = Qs + 128 * 72; LAS bf16* Vt = Ks + 128 * 72; LAS bf16* Ws = Vt + ST_ROWS * 136;
    LAS float* fa = (LAS float*)(Ws + 128 * 136); LAS float* fM = fa + 128; LAS float* fg = fM + 128; LAS float* fe = fg + 128;
    const bf16* PROJ = (const bf16*)(F.ws + WS_PROJ); const float* GT = (const float*)(F.ws + WS_GATES);
    const bf16* ST = (const bf16*)(F.ws + SC_ST); const float* AUX = (const float*)(F.ws + SC_AUX); bf16* H = (bf16*)(F.ws + WS_H);
    const int r16 = F.lane & 15, q = F.lane >> 4;
    for (int p = F.tid; p < 16 * 136; p += NTHR) Vt[128 * 136 + p] = (bf16)((p < 128) ? 0x3f80u : 0u);
    for (int item = F.vcu; item < MITEMS; item += F.G) {
        const int bh = item >> 5, c = item & 31, b = bh >> 3, h = bh & 7, row0 = b * TP + c * MLC;
        TS_MARK(F, 41);
        v4u vv[4], qv[2], kv[2];
#pragma unroll
        for (int u = 0; u < 4; ++u) { const int p = F.tid + u * NTHR, r = p & 127, c8 = p >> 7; vv[u] = *(const v4u*)(PROJ + (size_t)(row0 + r) * NPROJ + 1024 + h * 128 + c8 * 8); }
#pragma unroll
        for (int u = 0; u < 2; ++u) { const int p = F.tid + u * NTHR, r = p >> 3, c8 = p & 7; qv[u] = *(const v4u*)(PROJ + (size_t)(row0 + r) * NPROJ + h * 64 + c8 * 8); kv[u] = *(const v4u*)(PROJ + (size_t)(row0 + r) * NPROJ + 512 + h * 64 + c8 * 8); }
        if (F.wave == 0) { float a0, a1, f0, f1; ml_gates(GT, row0, h, F.lane, a0, a1, f0, f1); const float mc = AUX[AX_MST + item];
            const float cm0 = wave_scan_max(a0, F.lane), cm1 = fmaxf(__shfl(cm0, 63), wave_scan_max(a1, F.lane)); const float M0 = fmaxf(mc, cm0), M1 = fmaxf(mc, cm1);
            fa[F.lane] = a0; fa[64 + F.lane] = a1; fM[F.lane] = M0; fM[64 + F.lane] = M1; fg[F.lane] = __expf(mc - M0); fg[64 + F.lane] = __expf(mc - M1);
            fe[F.lane] = __expf(-(f0 + M0)); fe[64 + F.lane] = __expf(-(f1 + M1)); }
#pragma unroll
        for (int u = 0; u < 2; ++u) { const int p = F.tid + u * NTHR, r = p >> 3, c8 = p & 7; *(LAS v4u*)(Qs + r * 72 + c8 * 8) = qv[u]; *(LAS v4u*)(Ks + r * 72 + c8 * 8) = kv[u]; }
#pragma unroll
        for (int u = 0; u < 4; ++u) { const int p = F.tid + u * NTHR, r = p & 127, c8 = p >> 7; const v4u v = vv[u]; LAS bf16* d = Vt + (c8 * 8) * 136 + r;
            d[0 * 136] = (bf16)(v.x & 0xffffu); d[1 * 136] = (bf16)(v.x >> 16); d[2 * 136] = (bf16)(v.y & 0xffffu); d[3 * 136] = (bf16)(v.y >> 16);
            d[4 * 136] = (bf16)(v.z & 0xffffu); d[5 * 136] = (bf16)(v.z >> 16); d[6 * 136] = (bf16)(v.w & 0xffffu); d[7 * 136] = (bf16)(v.w >> 16); }
        __syncthreads();
        TS_MARK(F, 42);
#pragma unroll
        for (int tt = 0; tt < 8; ++tt) { const int st = (F.wave - tt) & 7; f32x4 acc = (f32x4){0.f, 0.f, 0.f, 0.f};
            if (st <= tt) acc = mma_ll<2>(Qs + tt * 16 * 72, 72, Ks + st * 16 * 72, 72, acc, F.lane);
            const int sx = st * 16 + r16; const float as = fa[sx];
#pragma unroll
            for (int r = 0; r < 4; ++r) { const int t = tt * 16 + 4 * q + r; const float w = (sx <= t) ? acc[r] * __expf(as - fM[t]) : 0.f; Ws[t * 136 + sx] = (bf16)f2bf(w); } }
        __syncthreads();
        TS_MARK(F, 43);
        const int tt = F.wave, t = tt * 16 + r16, nks = (tt + 2) >> 1;
        f32x4 ngv[8]; v2u ovv[8];
#pragma unroll
        for (int dvt = 0; dvt < 8; ++dvt) { const int col = h * 128 + dvt * 16 + 4 * q; ngv[dvt] = *(const f32x4*)(anorm + j * 1024 + col); ovv[dvt] = *(const v2u*)(PROJ + (size_t)(row0 + t) * NPROJ + 2048 + col); }
        f32x4 a1[9], a2[9];
#pragma unroll
        for (int dvt = 0; dvt < 9; ++dvt) {
            a2[dvt] = mma_gl<2>(ST + ((size_t)item * ST_ROWS + dvt * 16) * 64, 64, Qs + tt * 16 * 72, 72, (f32x4){0.f, 0.f, 0.f, 0.f}, F.lane);
            f32x4 acc = (f32x4){0.f, 0.f, 0.f, 0.f};
            for (int ks = 0; ks < nks; ++ks) { const bf16x8 av = *(const LAS bf16x8*)(Vt + (dvt * 16 + r16) * 136 + ks * 32 + q * 8); const bf16x8 bw = *(const LAS bf16x8*)(Ws + (tt * 16 + r16) * 136 + ks * 32 + q * 8);
                acc = __builtin_amdgcn_mfma_f32_16x16x32_bf16(av, bw, acc, 0, 0, 0); }
            a1[dvt] = acc; }
        TS_MARK(F, 44);
        const float gt = fg[t]; const float den = __shfl(a1[8][0], r16) + gt * __shfl(a2[8][0], r16); const float rd = 1.0f / fmaxf(fabsf(den), fe[t]);
        float sq = 0.f;
#pragma unroll
        for (int dvt = 0; dvt < 8; ++dvt)
#pragma unroll
            for (int r = 0; r < 4; ++r) { const float hv = (a1[dvt][r] + gt * a2[dvt][r]) * rd; a1[dvt][r] = hv; sq += hv * hv; }
        sq += __shfl_xor(sq, 16); sq += __shfl_xor(sq, 32);
        const float rs = 1.0f / sqrtf(sq * (1.0f / DVA) + EPS);
#pragma unroll
        for (int dvt = 0; dvt < 8; ++dvt) { const int col = h * 128 + dvt * 16 + 4 * q;
            const f32x4 ng = ngv[dvt]; const v2u ov = ovv[dvt];
            const float o0 = a1[dvt][0] * rs * ng.x * sigmoidf_(bflo(ov.x)), o1 = a1[dvt][1] * rs * ng.y * sigmoidf_(bfhi(ov.x)), o2 = a1[dvt][2] * rs * ng.z * sigmoidf_(bflo(ov.y)), o3 = a1[dvt][3] * rs * ng.w * sigmoidf_(bfhi(ov.y));
            v2u w; w.x = pk2(o0, o1); w.y = pk2(o2, o3); *(v2u*)(H + (size_t)(row0 + t) * D + col) = w; }
        __syncthreads();
        TS_MARK(F, 45);
    }
}
struct MlsPre { float m0, gi[4], gf[4], qk, v, cvv[16], o, an, n0v; };
#define MLS_LOAD(P, it_) do { const int b_ = (it_) >> 3, h_ = (it_) & 7, row_ = MP + b_ * TS; \
    (P).m0 = st_m[(size_t)(j * BS + b_) * HA + h_]; \
    _Pragma("unroll") for (int t_ = 0; t_ < 4; ++t_) { (P).gi[t_] = GT[(size_t)(row_ + t_) * 16 + h_]; (P).gf[t_] = GT[(size_t)(row_ + t_) * 16 + 8 + h_]; } \
    { const int t_ = (F.tid >> 6) & 3, d_ = F.tid & 63; (P).qk = bf2f(PROJ[(size_t)(row_ + t_) * NPROJ + ((F.tid < 256) ? 0 : 512) + h_ * 64 + d_]); } \
    { const int t2_ = F.tid >> 7, dv_ = F.tid & 127; (P).v = bf2f(PROJ[(size_t)(row_ + t2_) * NPROJ + 1024 + h_ * 128 + dv_]); (P).o = bf2f(PROJ[(size_t)(row_ + t2_) * NPROJ + 2048 + h_ * 128 + dv_]); (P).an = anorm[j * 1024 + h_ * 128 + dv_]; \
      const float* c0p_ = st_c + (((size_t)(j * BS + b_) * HA + h_) * DKA) * DVA; \
      _Pragma("unroll") for (int i_ = 0; i_ < 16; ++i_) (P).cvv[i_] = c0p_[(size_t)(t2_ * 16 + i_) * DVA + dv_]; } \
    (P).n0v = st_n[((size_t)(j * BS + b_) * HA + h_) * DKA + (F.tid & 63)]; } while (0)
__device__ __forceinline__ void mlstm_S(Frame& F, int j, const float* __restrict__ anorm, const float* __restrict__ st_c, const float* __restrict__ st_n, const float* __restrict__ st_m) {
    LAS float* qs = (LAS float*)F.lds; LAS float* ks = qs + 256; LAS float* vs = ks + 256; LAS float* qkw = vs + 512; LAS float* qn = qkw + 16; LAS float* part = qn + 16; LAS float* red = part + 2048; LAS float* ns = red + 16;
    const bf16* __restrict__ PROJ = (const bf16*)(F.ws + WS_PROJ); const float* __restrict__ GT = (const float*)(F.ws + WS_GATES); bf16* H = (bf16*)(F.ws + WS_H);
    MlsPre nx;
    if (F.vcu < BS * HA) MLS_LOAD(nx, F.vcu);
    for (int item = F.vcu; item < BS * HA; item += F.G) {
        const int b = item >> 3, h = item & 7, row0 = MP + b * TS;
        TS_MARK(F, 51);
        const MlsPre P = nx;
        if (item + F.G < BS * HA) MLS_LOAD(nx, item + F.G);
        float a[4], fc[4], Ml[4], g[4], mt[4]; const float m0 = P.m0;
        { float run = 0.f, cm = -3.0e38f;
#pragma unroll
            for (int t = 0; t < 4; ++t) { run += P.gf[t]; fc[t] = run; a[t] = P.gi[t] - run; cm = fmaxf(cm, a[t]); Ml[t] = fmaxf(m0, cm); g[t] = __expf(m0 - Ml[t]); mt[t] = run + Ml[t]; } }
        { const int t = (F.tid >> 6) & 3, d = F.tid & 63; if (F.tid < 256) qs[t * 64 + d] = P.qk; else ks[t * 64 + d] = P.qk;
            vs[F.tid] = P.v; if (F.tid < 64) ns[F.tid] = P.n0v; }
        __syncthreads();
        TS_MARK(F, 52);
        if (F.tid < 512) { const int pr = F.tid >> 4, l16 = F.tid & 15;
            const int t = (pr < 16) ? (pr >> 2) : (pr & 3), s = pr & 3; float dt = 0.f;
            if (pr < 20) { const LAS float* y = (pr < 16) ? ks + s * 64 : ns;
#pragma unroll
                for (int i = 0; i < 4; ++i) dt += qs[t * 64 + l16 * 4 + i] * y[l16 * 4 + i]; }
            dt += __shfl_xor(dt, 8); dt += __shfl_xor(dt, 4); dt += __shfl_xor(dt, 2); dt += __shfl_xor(dt, 1);
            if (l16 == 0 && pr < 16) { float as = a[0], Mt = Ml[0];
                as = (s == 1) ? a[1] : as; as = (s == 2) ? a[2] : as; as = (s == 3) ? a[3] : as; Mt = (t == 1) ? Ml[1] : Mt; Mt = (t == 2) ? Ml[2] : Mt; Mt = (t == 3) ? Ml[3] : Mt;
                qkw[pr] = (s <= t) ? dt * __expf(as - Mt) : 0.f; }
            else if (l16 == 0 && pr < 20) qn[pr - 16] = dt; }
        { const int dv = F.tid & 127, dkq = F.tid >> 7; float* cout = F.out + O_SAC + (((size_t)(j * BS + b) * HA + h) * DKA) * DVA;
            float p0 = 0.f, p1 = 0.f, p2 = 0.f, p3 = 0.f; const float gl = g[3];
            float wl[4];
#pragma unroll
            for (int s = 0; s < 4; ++s) wl[s] = __expf(a[s] - Ml[3]) * vs[s * 128 + dv];
#pragma unroll
            for (int i4 = 0; i4 < 4; ++i4) { const int dk0 = dkq * 16 + i4 * 4;
                const f32x4 q0 = *(const LAS f32x4*)(qs + dk0), q1 = *(const LAS f32x4*)(qs + 64 + dk0), q2 = *(const LAS f32x4*)(qs + 128 + dk0), q3 = *(const LAS f32x4*)(qs + 192 + dk0);
                const f32x4 k0 = *(const LAS f32x4*)(ks + dk0), k1 = *(const LAS f32x4*)(ks + 64 + dk0), k2 = *(const LAS f32x4*)(ks + 128 + dk0), k3 = *(const LAS f32x4*)(ks + 192 + dk0);
#pragma unroll
                for (int e = 0; e < 4; ++e) { const float cv = P.cvv[i4 * 4 + e];
                    p0 += q0[e] * cv; p1 += q1[e] * cv; p2 += q2[e] * cv; p3 += q3[e] * cv;
                    cout[(size_t)(dk0 + e) * DVA + dv] = gl * cv + (wl[0] * k0[e] + wl[1] * k1[e]) + (wl[2] * k2[e] + wl[3] * k3[e]); } }
            part[(dkq * 4 + 0) * 128 + dv] = p0; part[(dkq * 4 + 1) * 128 + dv] = p1; part[(dkq * 4 + 2) * 128 + dv] = p2; part[(dkq * 4 + 3) * 128 + dv] = p3; }
        __syncthreads();
        TS_MARK(F, 53);
        float hv;
        { const int t = F.tid >> 7, dv = F.tid & 127; float gt = g[0], emt = mt[0];
            gt = (t == 1) ? g[1] : gt; gt = (t == 2) ? g[2] : gt; gt = (t == 3) ? g[3] : gt; emt = (t == 1) ? mt[1] : emt; emt = (t == 2) ? mt[2] : emt; emt = (t == 3) ? mt[3] : emt;
            float num = 0.f, den = 0.f;
#pragma unroll
            for (int s = 0; s < 4; ++s) { const float w = qkw[t * 4 + s]; num += w * vs[s * 128 + dv]; den += w; }
            num += gt * ((part[(0 * 4 + t) * 128 + dv] + part[(1 * 4 + t) * 128 + dv]) + (part[(2 * 4 + t) * 128 + dv] + part[(3 * 4 + t) * 128 + dv]));
            den += gt * qn[t];
            hv = num / fmaxf(fabsf(den), __expf(-emt));
            const float sq = wave_sum(hv * hv); if (F.lane == 0) red[F.wave] = sq; }
        __syncthreads();
        TS_MARK(F, 54);
        { const int t = F.tid >> 7, dv = F.tid & 127, col = h * 128 + dv; const float rs = 1.0f / sqrtf((red[2 * t] + red[2 * t + 1]) * (1.0f / DVA) + EPS);
            H[(size_t)(row0 + t) * D + col] = (bf16)f2bf(hv * rs * P.an * sigmoidf_(P.o)); }
        if (F.tid < 64) { const int d = F.tid; float nn = g[3] * ns[d];
#pragma unroll
            for (int s = 0; s < 4; ++s) nn += __expf(a[s] - Ml[3]) * ks[s * 64 + d];
            F.out[O_SAN + ((size_t)(j * BS + b) * HA + h) * DKA + d] = nn; }
        if (F.tid == 0) F.out[O_SAM + (size_t)(j * BS + b) * HA + h] = mt[3];
        __syncthreads();
        TS_MARK(F, 55);
    }
}
__device__ __forceinline__ void gla_bc(Frame& F, const f32x4 zv, const float (&wg)[16], float bgv, LAS float* zs, LAS float* gsum, LAS float* bc) {
    if (F.tid < 256) ((LAS f32x4*)zs)[F.tid] = zv;
    const int d = F.tid & 127, tq = F.tid >> 7;
    __syncthreads();
    float pr[16]; float run = 0.f;
#pragma unroll
    for (int i = 0; i < 16; ++i) { const LAS float* z = zs + (tq * 16 + i) * 16; float x = bgv;
#pragma unroll
        for (int r = 0; r < 16; ++r) x += z[r] * wg[r];
        run += logsigmoidf(x) * (1.0f / 16.0f); pr[i] = run; }
    gsum[tq * 128 + d] = run;
    __syncthreads();
    float off = 0.f;
    if (tq > 0) off += gsum[d];
    if (tq > 1) off += gsum[128 + d];
    if (tq > 2) off += gsum[256 + d];
#pragma unroll
    for (int i = 0; i < 16; ++i) bc[(tq * 16 + i) * 128 + d] = pr[i] + off;
    __syncthreads();
}
#define GLA_WG(h_) do { if ((h_) != hcur) { hcur = (h_); const int col_ = (h_) * 128 + (F.tid & 127); _Pragma("unroll") for (int r_ = 0; r_ < 16; ++r_) wg[r_] = WG[r_ * 512 + col_]; bgv = BG[col_]; } } while (0)
__device__ __forceinline__ void gla_A(Frame& F, const float* __restrict__ WG, const float* __restrict__ BG) {
    LAS float* zs = (LAS float*)F.lds; LAS float* gsum = zs + 1024; LAS float* bc = gsum + 512; LAS bf16* Kt = (LAS bf16*)(bc + 8192); LAS bf16* Vt = Kt + 128 * 72;
    const bf16* __restrict__ PROJ = (const bf16*)(F.ws + WS_PROJ); const float* __restrict__ GT = (const float*)(F.ws + WS_GATES); float* SLOC = (float*)(F.ws + SC_LOC); float* AUX = (float*)(F.ws + SC_AUX);
    float wg[16], bgv = 0.f; int hcur = -1;
    for (int item = F.vcu; item < BP * HB * NCH; item += F.G) {
        const int bh = item >> 6, c = item & 63, b = bh >> 2, h = bh & 3, row0 = b * TP + c * LCH;
        f32x4 zv = (f32x4){0.f, 0.f, 0.f, 0.f}; if (F.tid < 256) zv = ((const f32x4*)(GT + (size_t)row0 * 16))[F.tid];
        v4u kv[2], vv[4];
#pragma unroll
        for (int u = 0; u < 2; ++u) { const int p = F.tid + u * NTHR, r = p & 63, c8 = p >> 6; kv[u] = *(const v4u*)(PROJ + (size_t)(row0 + r) * NPROJ + 512 + h * 128 + c8 * 8); }
#pragma unroll
        for (int u = 0; u < 4; ++u) { const int p = F.tid + u * NTHR, r = p & 63, c8 = p >> 6; vv[u] = *(const v4u*)(PROJ + (size_t)(row0 + r) * NPROJ + 1024 + h * 256 + c8 * 8); }
        GLA_WG(h);
        gla_bc(F, zv, wg, bgv, zs, gsum, bc);
        if (F.tid < 128) AUX[AX_BL + item * 128 + F.tid] = bc[63 * 128 + F.tid];
#pragma unroll
        for (int u = 0; u < 2; ++u) { const int p = F.tid + u * NTHR, r = p & 63, c8 = p >> 6; float e[8]; unpack8(kv[u], e);
            LAS bf16* dd = Kt + (c8 * 8) * 72 + r;
#pragma unroll
            for (int i = 0; i < 8; ++i) { const int dk = c8 * 8 + i; dd[i * 72] = (bf16)f2bf(e[i] * __expf(bc[63 * 128 + dk] - bc[r * 128 + dk])); } }
#pragma unroll
        for (int u = 0; u < 4; ++u) { const int p = F.tid + u * NTHR, r = p & 63, c8 = p >> 6; const v4u v = vv[u]; LAS bf16* d = Vt + (c8 * 8) * 72 + r;
            d[0 * 72] = (bf16)(v.x & 0xffffu); d[1 * 72] = (bf16)(v.x >> 16); d[2 * 72] = (bf16)(v.y & 0xffffu); d[3 * 72] = (bf16)(v.y >> 16);
            d[4 * 72] = (bf16)(v.z & 0xffffu); d[5 * 72] = (bf16)(v.z >> 16); d[6 * 72] = (bf16)(v.w & 0xffffu); d[7 * 72] = (bf16)(v.w >> 16); }
        __syncthreads();
        for (int jj = 0; jj < 16; ++jj) { const int tile = F.wave * 16 + jj, dkt = tile & 7, dvt = tile >> 3;
            const f32x4 acc = mma_ll<2>(Kt + dkt * 16 * 72, 72, Vt + dvt * 16 * 72, 72, (f32x4){0.f, 0.f, 0.f, 0.f}, F.lane);
            *(f32x4*)(SLOC + ((size_t)item * 256 + dvt * 16 + (F.lane & 15)) * 128 + dkt * 16 + 4 * (F.lane >> 4)) = acc; }
        __syncthreads();
    }
}
__device__ __forceinline__ void gla_B(Frame& F) {
    const float* __restrict__ SLOC = (const float*)(F.ws + SC_LOC); bf16* __restrict__ ST = (bf16*)(F.ws + SC_ST); const float* __restrict__ AUX = (const float*)(F.ws + SC_AUX);
    for (int slot = F.vcu * NTHR + F.tid; slot < BP * HB * 8192; slot += F.G * NTHR) {
        const int bh = slot >> 13, e = slot & 8191, dv = e >> 5, dk0 = (e & 31) * 4;
        f32x4 S = (f32x4){0.f, 0.f, 0.f, 0.f};
        for (int cb = 0; cb < NCH; cb += 8) {
            f32x4 bl[8], sl[8];
#pragma unroll
            for (int u = 0; u < 8; ++u) { const int item = bh * 64 + cb + u; bl[u] = *(const f32x4*)(AUX + AX_BL + item * 128 + dk0); sl[u] = *(const f32x4*)(SLOC + ((size_t)item * 256 + dv) * 128 + dk0); }
#pragma unroll
            for (int u = 0; u < 8; ++u) { const int item = bh * 64 + cb + u;
                v2u w; w.x = pk2(S.x, S.y); w.y = pk2(S.z, S.w); *(v2u*)(ST + ((size_t)item * 256 + dv) * 128 + dk0) = w;
                S.x = __expf(bl[u].x) * S.x + sl[u].x; S.y = __expf(bl[u].y) * S.y + sl[u].y; S.z = __expf(bl[u].z) * S.z + sl[u].z; S.w = __expf(bl[u].w) * S.w + sl[u].w; } }
        float* o = F.out + O_PG + ((size_t)bh * DKB + dk0) * DVB + dv;
        o[0] = S.x; o[DVB] = S.y; o[2 * DVB] = S.z; o[3 * DVB] = S.w;
    }
}
__device__ __forceinline__ void gla_C(Frame& F, const float* __restrict__ WG, const float* __restrict__ BG, const float* __restrict__ bnorm) {
    LAS float* zs = (LAS float*)F.lds; LAS float* gsum = zs + 1024; LAS float* bc = gsum + 512; LAS bf16* Qs = (LAS bf16*)(bc + 8192); LAS bf16* Ks = Qs + 64 * 136; LAS bf16* Vt = Ks + 64 * 136;
    LAS bf16* At = Vt + 256 * 72; LAS float* ssq = (LAS float*)(At + 64 * 72);
    const bf16* __restrict__ PROJ = (const bf16*)(F.ws + WS_PROJ); const float* __restrict__ GT = (const float*)(F.ws + WS_GATES); const bf16* __restrict__ ST = (const bf16*)(F.ws + SC_ST); bf16* H = (bf16*)(F.ws + WS_H);
    const int r16 = F.lane & 15, q = F.lane >> 4;
    for (int item = F.vcu; item < BP * HB * NCH; item += F.G) {
        const int bh = item >> 6, c = item & 63, b = bh >> 2, h = bh & 3, row0 = b * TP + c * LCH;
        TS_MARK(F, 61);
        float wg[16], bgv = 0.f; int hcur = -1;
        f32x4 zv = (f32x4){0.f, 0.f, 0.f, 0.f}; if (F.tid < 256) zv = ((const f32x4*)(GT + (size_t)row0 * 16))[F.tid];
        v4u qv[2], kv[2], vv[4];
#pragma unroll
        for (int u = 0; u < 2; ++u) { const int p = F.tid + u * NTHR, r = p >> 4, c8 = p & 15; qv[u] = *(const v4u*)(PROJ + (size_t)(row0 + r) * NPROJ + h * 128 + c8 * 8); kv[u] = *(const v4u*)(PROJ + (size_t)(row0 + r) * NPROJ + 512 + h * 128 + c8 * 8); }
        GLA_WG(h);
        gla_bc(F, zv, wg, bgv, zs, gsum, bc);
        TS_MARK(F, 62);
#pragma unroll
        for (int u = 0; u < 4; ++u) { const int p = F.tid + u * NTHR, r = p & 63, c8 = p >> 6; vv[u] = *(const v4u*)(PROJ + (size_t)(row0 + r) * NPROJ + 1024 + h * 256 + c8 * 8); }
#pragma unroll
        for (int u = 0; u < 2; ++u) { const int p = F.tid + u * NTHR, r = p >> 4, c8 = p & 15; float e[8], f[8]; unpack8(qv[u], e); unpack8(kv[u], f);
#pragma unroll
            for (int i = 0; i < 8; ++i) { const float bb = bc[r * 128 + c8 * 8 + i]; e[i] *= __expf(bb); f[i] *= __expf(-bb); }
            v4u w; w.x = pk2(e[0], e[1]); w.y = pk2(e[2], e[3]); w.z = pk2(e[4], e[5]); w.w = pk2(e[6], e[7]); *(LAS v4u*)(Qs + r * 136 + c8 * 8) = w;
            w.x = pk2(f[0], f[1]); w.y = pk2(f[2], f[3]); w.z = pk2(f[4], f[5]); w.w = pk2(f[6], f[7]); *(LAS v4u*)(Ks + r * 136 + c8 * 8) = w; }
#pragma unroll
        for (int u = 0; u < 4; ++u) { const int p = F.tid + u * NTHR, r = p & 63, c8 = p >> 6; const v4u v = vv[u]; LAS bf16* d = Vt + (c8 * 8) * 72 + r;
            d[0 * 72] = (bf16)(v.x & 0xffffu); d[1 * 72] = (bf16)(v.x >> 16); d[2 * 72] = (bf16)(v.y & 0xffffu); d[3 * 72] = (bf16)(v.y >> 16);
            d[4 * 72] = (bf16)(v.z & 0xffffu); d[5 * 72] = (bf16)(v.z >> 16); d[6 * 72] = (bf16)(v.w & 0xffffu); d[7 * 72] = (bf16)(v.w >> 16); }
        f32x4 ngv[2]; v2u rvv[2][4];
#pragma unroll
        for (int dl = 0; dl < 2; ++dl) { const int dvt = F.wave * 2 + dl, col = h * 256 + dvt * 16 + 4 * q; ngv[dl] = *(const f32x4*)(bnorm + col);
#pragma unroll
            for (int tt = 0; tt < 4; ++tt) rvv[dl][tt] = *(const v2u*)(PROJ + (size_t)(row0 + tt * 16 + r16) * NPROJ + 2048 + col); }
        __syncthreads();
        TS_MARK(F, 63);
        bf16x8 sa[2][4];
#pragma unroll
        for (int dl = 0; dl < 2; ++dl)
#pragma unroll
            for (int ks = 0; ks < 4; ++ks) sa[dl][ks] = *(const bf16x8*)(ST + ((size_t)item * 256 + (F.wave * 2 + dl) * 16 + r16) * 128 + ks * 32 + q * 8);
#pragma unroll
        for (int jj = 0; jj < 2; ++jj) { const int tile = F.wave * 2 + jj, tt = tile >> 2, st = tile & 3; f32x4 acc = (f32x4){0.f, 0.f, 0.f, 0.f};
            if (st <= tt) acc = mma_ll<4>(Qs + tt * 16 * 136, 136, Ks + st * 16 * 136, 136, acc, F.lane);
            const int sx = st * 16 + r16;
#pragma unroll
            for (int r = 0; r < 4; ++r) { const int t = tt * 16 + 4 * q + r; At[t * 72 + sx] = (bf16)f2bf((sx <= t) ? acc[r] : 0.f); } }
        __syncthreads();
        TS_MARK(F, 64);
        f32x4 o[2][4];
#pragma unroll
        for (int dl = 0; dl < 2; ++dl) { const int dvt = F.wave * 2 + dl;
#pragma unroll
            for (int tt = 0; tt < 4; ++tt) { f32x4 acc = mma_ll<2>(Vt + dvt * 16 * 72, 72, At + tt * 16 * 72, 72, (f32x4){0.f, 0.f, 0.f, 0.f}, F.lane);
#pragma unroll
                for (int ks = 0; ks < 4; ++ks) { const bf16x8 bq = *(const LAS bf16x8*)(Qs + (tt * 16 + r16) * 136 + ks * 32 + q * 8); acc = __builtin_amdgcn_mfma_f32_16x16x32_bf16(sa[dl][ks], bq, acc, 0, 0, 0); }
                o[dl][tt] = acc; } }
#pragma unroll
        for (int tt = 0; tt < 4; ++tt) { float sq = 0.f;
#pragma unroll
            for (int dl = 0; dl < 2; ++dl)
#pragma unroll
                for (int r = 0; r < 4; ++r) sq += o[dl][tt][r] * o[dl][tt][r];
            sq += __shfl_xor(sq, 16); sq += __shfl_xor(sq, 32);
            if (F.lane < 16) ssq[F.wave * 64 + tt * 16 + r16] = sq; }
        TS_MARK(F, 65);
        __syncthreads();
        TS_MARK(F, 66);
#pragma unroll
        for (int tt = 0; tt < 4; ++tt) { const int t = tt * 16 + r16; float tot = 0.f;
#pragma unroll
            for (int w = 0; w < 8; ++w) tot += ssq[w * 64 + t];
            const float rs = 1.0f / sqrtf(tot * (1.0f / DVB) + EPS);
#pragma unroll
            for (int dl = 0; dl < 2; ++dl) { const int col = h * 256 + (F.wave * 2 + dl) * 16 + 4 * q;
                const f32x4 ng = ngv[dl]; const v2u rv = rvv[dl][tt];
                const float r0 = bflo(rv.x), r1 = bfhi(rv.x), r2 = bflo(rv.y), r3 = bfhi(rv.y);
                const float o0 = o[dl][tt][0] * rs * ng.x * r0 * sigmoidf_(r0), o1 = o[dl][tt][1] * rs * ng.y * r1 * sigmoidf_(r1), o2 = o[dl][tt][2] * rs * ng.z * r2 * sigmoidf_(r2), o3 = o[dl][tt][3] * rs * ng.w * r3 * sigmoidf_(r3);
                v2u w; w.x = pk2(o0, o1); w.y = pk2(o2, o3); *(v2u*)(H + (size_t)(row0 + t) * D + col) = w; } }
        __syncthreads();
    }
}
__device__ __forceinline__ void gla_S(Frame& F, const float* WG, const float* BG, const float* bnorm, const float* st_s) {
    LAS float* bcs = (LAS float*)F.lds;
    LAS float* qs = bcs + 512;
    LAS float* kr = qs + 512;
    LAS float* kh = kr + 512;
    LAS float* vs = kh + 512;
    LAS float* att = vs + 1024;
    LAS float* part = att + 16;
    LAS float* red = part + 2048;
    const bf16* PROJ = (const bf16*)(F.ws + WS_PROJ); const float* GT = (const float*)(F.ws + WS_GATES); bf16* H = (bf16*)(F.ws + WS_H);
    for (int item = F.vcu; item < BS * HB; item += F.G) {
        const int b = item >> 2, h = item & 3, row0 = MP + b * TS;
        { const int t = F.tid >> 7, d = F.tid & 127, col = h * 128 + d; float x = BG[col];
#pragma unroll
            for (int r = 0; r < 16; ++r) x += GT[(size_t)(row0 + t) * 16 + r] * WG[r * 512 + col];
            bcs[t * 128 + d] = logsigmoidf(x) * (1.0f / 16.0f);
            kr[t * 128 + d] = bf2f(PROJ[(size_t)(row0 + t) * NPROJ + 512 + col]);
            vs[t * 256 + d] = bf2f(PROJ[(size_t)(row0 + t) * NPROJ + 1024 + h * 256 + d]); vs[t * 256 + 128 + d] = bf2f(PROJ[(size_t)(row0 + t) * NPROJ + 1024 + h * 256 + 128 + d]); }
        __syncthreads();
        if (F.tid < 128) { const int d = F.tid; float run = 0.f;
#pragma unroll
            for (int t = 0; t < 4; ++t) { run += bcs[t * 128 + d]; bcs[t * 128 + d] = run; } }
        __syncthreads();
        { const int t = F.tid >> 7, d = F.tid & 127, col = h * 128 + d; const float bb = bcs[t * 128 + d], bl = bcs[3 * 128 + d];
            qs[t * 128 + d] = bf2f(PROJ[(size_t)(row0 + t) * NPROJ + col]) * __expf(bb); kh[t * 128 + d] = kr[t * 128 + d] * __expf(bl - bb); }
        __syncthreads();
        { const int pr = F.tid >> 5, l32 = F.tid & 31, t = pr >> 2, s = pr & 3; float dt = 0.f;
            if (s <= t) {
#pragma unroll
                for (int i = 0; i < 4; ++i) { const int d = l32 * 4 + i; dt += qs[t * 128 + d] * kr[s * 128 + d] * __expf(-bcs[s * 128 + d]); } }
            dt += __shfl_xor(dt, 16); dt += __shfl_xor(dt, 8); dt += __shfl_xor(dt, 4); dt += __shfl_xor(dt, 2); dt += __shfl_xor(dt, 1);
            if (l32 == 0) att[pr] = dt; }
        { const int dv = F.tid & 255, dkh = F.tid >> 8; const float* s0 = st_s + (((size_t)b * HB + h) * DKB) * DVB; float* so = F.out + O_SG + (((size_t)b * HB + h) * DKB) * DVB;
            float p0 = 0.f, p1 = 0.f, p2 = 0.f, p3 = 0.f; const float v0 = vs[dv], v1 = vs[256 + dv], v2 = vs[512 + dv], v3 = vs[768 + dv];
            for (int d0 = dkh * 64; d0 < dkh * 64 + 64; d0 += 16) {
                float svv[16];
#pragma unroll
                for (int i = 0; i < 16; ++i) svv[i] = s0[(size_t)(d0 + i) * DVB + dv];
#pragma unroll
                for (int i4 = 0; i4 < 4; ++i4) { const int dk0 = d0 + i4 * 4;
                    const f32x4 q0 = *(const LAS f32x4*)(qs + dk0), q1 = *(const LAS f32x4*)(qs + 128 + dk0), q2 = *(const LAS f32x4*)(qs + 256 + dk0), q3 = *(const LAS f32x4*)(qs + 384 + dk0);
                    const f32x4 k0 = *(const LAS f32x4*)(kh + dk0), k1 = *(const LAS f32x4*)(kh + 128 + dk0), k2 = *(const LAS f32x4*)(kh + 256 + dk0), k3 = *(const LAS f32x4*)(kh + 384 + dk0);
                    const f32x4 bl = *(const LAS f32x4*)(bcs + 3 * 128 + dk0);
#pragma unroll
                    for (int e = 0; e < 4; ++e) { const float sv = svv[i4 * 4 + e];
                        p0 += q0[e] * sv; p1 += q1[e] * sv; p2 += q2[e] * sv; p3 += q3[e] * sv;
                        so[(size_t)(dk0 + e) * DVB + dv] = __expf(bl[e]) * sv + (k0[e] * v0 + k1[e] * v1) + (k2[e] * v2 + k3[e] * v3); } } }
            part[(dkh * 4 + 0) * 256 + dv] = p0; part[(dkh * 4 + 1) * 256 + dv] = p1; part[(dkh * 4 + 2) * 256 + dv] = p2; part[(dkh * 4 + 3) * 256 + dv] = p3; }
        __syncthreads();
        float ov[2];
        { const int dv = F.tid & 255, th = F.tid >> 8;
#pragma unroll
            for (int u = 0; u < 2; ++u) { const int t = th + 2 * u; float o = part[t * 256 + dv] + part[(4 + t) * 256 + dv];
#pragma unroll
                for (int s = 0; s < 4; ++s) o += att[t * 4 + s] * vs[s * 256 + dv];
                ov[u] = o; const float sq = wave_sum(o * o); if (F.lane == 0) red[F.wave * 2 + u] = sq; } }
        __syncthreads();
        { const int dv = F.tid & 255, th = F.tid >> 8, col = h * 256 + dv;
#pragma unroll
            for (int u = 0; u < 2; ++u) { const int t = th + 2 * u; const int w0 = th * 4; const float tot = (red[(w0 + 0) * 2 + u] + red[(w0 + 1) * 2 + u]) + (red[(w0 + 2) * 2 + u] + red[(w0 + 3) * 2 + u]);
                const float rs = 1.0f / sqrtf(tot * (1.0f / DVB) + EPS); const float r = bf2f(PROJ[(size_t)(row0 + t) * NPROJ + 2048 + col]);
                H[(size_t)(row0 + t) * D + col] = (bf16)f2bf(ov[u] * rs * bnorm[col] * r * sigmoidf_(r)); } }
        __syncthreads();
    }
}

__device__ __forceinline__ void swa_tile(const LAS bf16* Kw, const LAS bf16* Vt, int ldv, LAS bf16* Pw, int kt0, int jmin, const bf16* qp_r16, bf16* op_r16, const int (&relb)[4], const float (&snk)[4], int lane) {
    const int r16 = lane & 15, q = lane >> 4;
    const bf16x8 qa0 = *(const bf16x8*)(qp_r16 + q * 8), qa1 = *(const bf16x8*)(qp_r16 + 32 + q * 8);
    f32x4 s[9];
#pragma unroll
    for (int kt = 0; kt < 9; ++kt) { const LAS bf16* kp = Kw + ((kt0 + kt) * 16 + r16) * 72 + q * 8;
        f32x4 acc = __builtin_amdgcn_mfma_f32_16x16x32_bf16(qa0, *(const LAS bf16x8*)kp, (f32x4){0.f, 0.f, 0.f, 0.f}, 0, 0, 0);
        s[kt] = __builtin_amdgcn_mfma_f32_16x16x32_bf16(qa1, *(const LAS bf16x8*)(kp + 32), acc, 0, 0, 0); }
    float mx[4] = {-3.0e38f, -3.0e38f, -3.0e38f, -3.0e38f};
#pragma unroll
    for (int kt = 0; kt < 9; ++kt) { const int j = (kt0 + kt) * 16 + r16;
#pragma unroll
        for (int r = 0; r < 4; ++r) { const int rel = relb[r] - j; const bool ok = (rel >= 0) && (rel <= WIN) && (j >= jmin); const float v = ok ? s[kt][r] * 0.125f : -3.0e38f; s[kt][r] = v; mx[r] = fmaxf(mx[r], v); } }
    float sm[4];
#pragma unroll
    for (int r = 0; r < 4; ++r) { float m = mx[r]; m = fmaxf(m, __shfl_xor(m, 1)); m = fmaxf(m, __shfl_xor(m, 2)); m = fmaxf(m, __shfl_xor(m, 4)); m = fmaxf(m, __shfl_xor(m, 8)); mx[r] = fmaxf(m, snk[r]); sm[r] = 0.f; }
#pragma unroll
    for (int kt = 0; kt < 9; ++kt)
#pragma unroll
        for (int r = 0; r < 4; ++r) { const float p = (s[kt][r] > -1.0e38f) ? __expf(s[kt][r] - mx[r]) : 0.f; s[kt][r] = p; sm[r] += p; }
#pragma unroll
    for (int r = 0; r < 4; ++r) { float t = sm[r]; t += __shfl_xor(t, 1); t += __shfl_xor(t, 2); t += __shfl_xor(t, 4); t += __shfl_xor(t, 8); sm[r] = 1.0f / (t + __expf(snk[r] - mx[r])); }
#pragma unroll
    for (int kt = 0; kt < 9; ++kt)
#pragma unroll
        for (int r = 0; r < 4; ++r) Pw[(4 * q + r) * 168 + kt * 16 + r16] = (bf16)f2bf(s[kt][r] * sm[r]);
#pragma unroll
    for (int r = 0; r < 4; ++r) Pw[(4 * q + r) * 168 + 144 + r16] = (bf16)0;
    LDS_WAIT();
#pragma unroll
    for (int dt = 0; dt < 4; ++dt) { f32x4 acc = (f32x4){0.f, 0.f, 0.f, 0.f};
#pragma unroll
        for (int ks = 0; ks < 5; ++ks) { const bf16x8 va = *(const LAS bf16x8*)(Vt + (dt * 16 + r16) * ldv + kt0 * 16 + ks * 32 + q * 8); const bf16x8 pb = *(const LAS bf16x8*)(Pw + r16 * 168 + ks * 32 + q * 8);
            acc = __builtin_amdgcn_mfma_f32_16x16x32_bf16(va, pb, acc, 0, 0, 0); }
        v2u w; w.x = pk2(acc[0], acc[1]); w.y = pk2(acc[2], acc[3]); *(v2u*)(op_r16 + dt * 16 + 4 * q) = w; }
    LDS_WAIT();
}
__device__ __forceinline__ void swa_prompt(Frame& F, const float* sinks) {
    LAS bf16* Kw = (LAS bf16*)F.lds; LAS bf16* Vt = Kw + 256 * 72; LAS bf16* Pw = Vt + 64 * 280 + F.wave * (16 * 168);
    const bf16* PROJ = (const bf16*)(F.ws + WS_PROJ); bf16* H = (bf16*)(F.ws + WS_H);
    const int r16 = F.lane & 15, q = F.lane >> 4;
    for (int item = F.vcu; item < BP * HKV * (TP / WIN); item += F.G) {
        const int qb = item & 31, hkv = (item >> 5) & 3, b = item >> 7;
        const int krow0 = b * TP + (qb - 1) * WIN;
        for (int p = F.tid; p < 256 * 8; p += NTHR) { const int r = p >> 3, c8 = p & 7; v4u v = (v4u){0u, 0u, 0u, 0u};
            if (qb > 0 || r >= WIN) v = *(const v4u*)(PROJ + (size_t)(krow0 + r) * C_IN + 1024 + hkv * 64 + c8 * 8);
            *(LAS v4u*)(Kw + r * 72 + c8 * 8) = v; }
        for (int p = F.tid; p < 256 * 8; p += NTHR) { const int r = p & 255, c8 = p >> 8; v4u v = (v4u){0u, 0u, 0u, 0u};
            if (qb > 0 || r >= WIN) v = *(const v4u*)(PROJ + (size_t)(krow0 + r) * C_IN + 1280 + hkv * 64 + c8 * 8);
            LAS bf16* d = Vt + (c8 * 8) * 280 + r;
            d[0 * 280] = (bf16)(v.x & 0xffffu); d[1 * 280] = (bf16)(v.x >> 16); d[2 * 280] = (bf16)(v.y & 0xffffu); d[3 * 280] = (bf16)(v.y >> 16);
            d[4 * 280] = (bf16)(v.z & 0xffffu); d[5 * 280] = (bf16)(v.z >> 16); d[6 * 280] = (bf16)(v.w & 0xffffu); d[7 * 280] = (bf16)(v.w >> 16); }
        for (int p = F.tid; p < 64 * 24; p += NTHR) { const int r = p / 24, cc = p % 24; Vt[r * 280 + 256 + cc] = (bf16)0; }
        __syncthreads();
        const int g = F.wave >> 1, hq = hkv * 4 + g;
        const float sk = sinks[hq]; const float snk[4] = {sk, sk, sk, sk};
        for (int mt = 0; mt < 4; ++mt) { const int tq0 = (F.wave & 1) * 64 + mt * 16; const int relb[4] = {WIN + tq0 + 4 * q, WIN + tq0 + 4 * q + 1, WIN + tq0 + 4 * q + 2, WIN + tq0 + 4 * q + 3};
            const size_t row = (size_t)b * TP + qb * WIN + tq0 + r16;
            swa_tile(Kw, Vt, 280, Pw, tq0 >> 4, (qb == 0) ? WIN : 0, PROJ + row * C_IN + hq * 64, H + row * D + hq * 64, relb, snk, F.lane); }
        __syncthreads();
    }
    for (int e = F.vcu * NTHR + F.tid; e < BP * WIN * 256; e += F.G * NTHR) { const int d = e & 255, jrow = (e >> 8) & 127, b = e >> 15; const size_t row = (size_t)b * TP + TP - WIN + jrow;
        F.out[O_PSK + ((size_t)b * WIN + jrow) * 256 + d] = bf2f(PROJ[row * C_IN + 1024 + d]); F.out[O_PSV + ((size_t)b * WIN + jrow) * 256 + d] = bf2f(PROJ[row * C_IN + 1280 + d]); }
}
__device__ __forceinline__ void swa_sample(Frame& F, const float* sinks, const float* ck, const float* cv) {
    LAS bf16* Kw = (LAS bf16*)F.lds; LAS bf16* Vt = Kw + 144 * 72; LAS bf16* Pw = Vt + 64 * 168;
    const bf16* PROJ = (const bf16*)(F.ws + WS_PROJ); bf16* H = (bf16*)(F.ws + WS_H);
    const int r16 = F.lane & 15, q = F.lane >> 4;
    for (int item = F.vcu; item < BS * HKV; item += F.G) {
        const int b = item >> 2, hkv = item & 3;
        { float kxs[18], vxs[18];
#pragma unroll
            for (int u = 0; u < 18; ++u) { const int e = F.tid + u * NTHR, r = e >> 6, d = e & 63; float kx = 0.f, vx = 0.f;
                if (r < WIN) { const size_t ci = (((size_t)b * WIN + r) * HKV + hkv) * HDC + d; kx = ck[ci]; vx = cv[ci]; }
                else if (r < WIN + TS) { const size_t row = (size_t)MP + b * TS + (r - WIN); kx = bf2f(PROJ[row * C_IN + 1024 + hkv * 64 + d]); vx = bf2f(PROJ[row * C_IN + 1280 + hkv * 64 + d]); }
                kxs[u] = kx; vxs[u] = vx; }
#pragma unroll
            for (int u = 0; u < 18; ++u) { const int e = F.tid + u * NTHR, r = e >> 6, d = e & 63; const float kx = kxs[u], vx = vxs[u];
                Kw[r * 72 + d] = (bf16)f2bf(kx); Vt[d * 168 + r] = (bf16)f2bf(vx);
                if (r >= TS && r < WIN + TS) { const size_t oi = (((size_t)b * WIN + (r - TS)) * HKV + hkv) * HDC + d; F.out[O_SSK + oi] = kx; F.out[O_SSV + oi] = vx; } } }
        for (int e = F.tid; e < 64 * 16; e += NTHR) { const int d = e >> 4, cc = e & 15; Vt[d * 168 + 144 + cc] = (bf16)0; }
        __syncthreads();
        if (F.wave == 0) { const int gq = r16 >> 2, tq = r16 & 3; const size_t row = (size_t)MP + b * TS + tq; const int hq = hkv * 4 + gq;
            const int relb[4] = {WIN + 0, WIN + 1, WIN + 2, WIN + 3};
            const float sk = sinks[hkv * 4 + q]; const float snk[4] = {sk, sk, sk, sk};
            swa_tile(Kw, Vt, 168, Pw, 0, 0, PROJ + row * C_IN + hq * 64, H + row * D + hq * 64, relb, snk, F.lane); }
        __syncthreads();
    }
}

__device__ __forceinline__ void gemm_small(Frame& F, const bf16* A, const bf16* Bt, int K, int N, bool pj, bf16* O, float* X, const float* bias) {
    const int r16 = F.lane & 15, q = F.lane >> 4, nct = N >> 4, ntile = (MS / 16) * nct;
    for (int id = GW_ID(F); id < ntile; id += GW_N(F)) {
        const int ct = id % nct, rt = id / nct;
        const bf16* ap = A + (size_t)(MP + rt * 16 + r16) * K + q * 8; const bf16* bp = Bt + (size_t)(ct * 16 + r16) * K + q * 8;
        f32x4 acc0 = (f32x4){0.f, 0.f, 0.f, 0.f}, acc1 = acc0;
#pragma unroll 2
        for (int k0 = 0; k0 < K; k0 += 256) {
            bf16x8 a[8], b[8];
#pragma unroll
            for (int i = 0; i < 8; ++i) { a[i] = *(const bf16x8*)(ap + k0 + i * 32); b[i] = *(const bf16x8*)(bp + k0 + i * 32); }
#pragma unroll
            for (int i = 0; i < 8; i += 2) { acc0 = __builtin_amdgcn_mfma_f32_16x16x32_bf16(b[i], a[i], acc0, 0, 0, 0); acc1 = __builtin_amdgcn_mfma_f32_16x16x32_bf16(b[i + 1], a[i + 1], acc1, 0, 0, 0); }
        }
        const f32x4 acc = acc0 + acc1; const size_t row = (size_t)(MP + rt * 16 + r16); const int col = ct * 16 + 4 * q;
        if (pj) { f32x4 v = acc; if (bias) v = v + *(const f32x4*)(bias + col); v2u w; w.x = pk2(v.x, v.y); w.y = pk2(v.z, v.w); *(v2u*)(O + row * N + col) = w; }
        else { f32x4* xp = (f32x4*)(X + row * N + col); *xp = *xp + acc; }
    }
}

__device__ __forceinline__ void gates_small(Frame& F, const bf16* XN, const bf16* WgT, float* GT, int cu_lo, bool act, const float* bi, const float* bf_) {
    const int r16 = F.lane & 15, q = F.lane >> 4, bx = (int)blockIdx.x;
    if (bx < cu_lo) return;
    for (int id = (bx - cu_lo) * NWAVES + F.wave; id < M / 16; id += (F.G - cu_lo) * NWAVES) {
        const bf16* ap = WgT + (size_t)r16 * D + q * 8; const bf16* bp = XN + (size_t)(id * 16 + r16) * D + q * 8;
        f32x4 acc0 = (f32x4){0.f, 0.f, 0.f, 0.f}, acc1 = acc0;
#pragma unroll
        for (int k0 = 0; k0 < D; k0 += 256) {
            bf16x8 a[8], b[8];
#pragma unroll
            for (int i = 0; i < 8; ++i) { a[i] = *(const bf16x8*)(ap + k0 + i * 32); b[i] = *(const bf16x8*)(bp + k0 + i * 32); }
#pragma unroll
            for (int i = 0; i < 8; i += 2) { acc0 = __builtin_amdgcn_mfma_f32_16x16x32_bf16(a[i], b[i], acc0, 0, 0, 0); acc1 = __builtin_amdgcn_mfma_f32_16x16x32_bf16(a[i + 1], b[i + 1], acc1, 0, 0, 0); }
        }
        f32x4 v = acc0 + acc1;
        if (act) { const f32x4 bb = (q < 2) ? *(const f32x4*)(bi + 4 * q) : *(const f32x4*)(bf_ + 4 * (q - 2));
#pragma unroll
            for (int r = 0; r < 4; ++r) { const float z = softcapf(v[r] + bb[r]); v[r] = (q < 2) ? z : logsigmoidf(z); } }
        *(f32x4*)(GT + (size_t)(id * 16 + r16) * 16 + 4 * q) = v;
    }
}
__device__ __forceinline__ void final_norm(Frame& F, const float* g, const float* slab, int nslab) {
    f32x4 gv[4];
#pragma unroll
    for (int j = 0; j < 4; ++j) gv[j] = ((const f32x4*)g)[F.lane + 64 * j];
    f32x4 nx[4];
    { const int m0 = GW_ID(F); if (m0 < M) {
#pragma unroll
        for (int j = 0; j < 4; ++j) nx[j] = ((const f32x4*)(F.out + (size_t)m0 * D))[F.lane + 64 * j]; } }
    for (int m = GW_ID(F); m < M; m += GW_N(F)) {
        f32x4* xr = (f32x4*)(F.out + (size_t)m * D); f32x4 v[4]; float ss = 0.f;
#pragma unroll
        for (int j = 0; j < 4; ++j) v[j] = nx[j];
        { const int mn = m + GW_N(F); if (mn < M) {
#pragma unroll
            for (int j = 0; j < 4; ++j) nx[j] = ((const f32x4*)(F.out + (size_t)mn * D))[F.lane + 64 * j]; } }
        if (m >= MP) for (int sl = 0; sl < nslab; ++sl) { const f32x4* sp = (const f32x4*)(slab + ((size_t)sl * MS + (m - MP)) * D);
#pragma unroll
            for (int j = 0; j < 4; ++j) v[j] = v[j] + sp[F.lane + 64 * j]; }
#pragma unroll
        for (int j = 0; j < 4; ++j) ss += (v[j].x * v[j].x + v[j].y * v[j].y) + (v[j].z * v[j].z + v[j].w * v[j].w);
        const float rs = 1.0f / sqrtf(wave_sum(ss) * (1.0f / D) + EPS);
#pragma unroll
        for (int j = 0; j < 4; ++j) xr[F.lane + 64 * j] = v[j] * rs * gv[j];
    }
}

#ifndef MK_ONLY
#define MK_ONLY -1
#endif
#ifndef MK_OFF
#define MK_OFF -2
#endif
#define EN(x) ((MK_ONLY < 0 || MK_ONLY == (x)) && MK_OFF != (x))
#ifndef MK_REP
#define MK_REP 0
#endif
#ifndef MK_TMASK
#define MK_TMASK 0
#endif
#ifndef MK_MULTI
#define MK_MULTI 0
#endif
constexpr int N_PHASES = DEPTH * 10 + 1;
constexpr int KS_OUT = 4, KS_DN = 11;
struct Args { const float* in[30]; float* out; unsigned char* ws; int ph_lo, ph_hi; };
__host__ __device__ __forceinline__ bool phase_empty(int ph) { if (ph >= DEPTH * 10) return false; const int layer = ph / 10, st = ph % 10; return (layer % 3 == 2) && (st == 3 || st == 4); }

#define INP(k) ({ int k_ = (k); asm volatile("" : "+s"(k_)); ((const float* const*)__builtin_amdgcn_kernarg_segment_ptr())[k_]; })
__global__ void __launch_bounds__(NTHR, 2) trunk_fwd(Args args) {
    extern __shared__ __attribute__((aligned(16))) unsigned char lds[];
    Frame F;
    F.lds = (LAS unsigned char*)lds;
    F.MISC = (volatile LAS unsigned*)(F.lds + MISC_OFF);
    F.tid = threadIdx.x; F.lane = F.tid & 63; F.wave = __builtin_amdgcn_readfirstlane(F.tid >> 6);
    F.G = gridDim.x; { const int bx = blockIdx.x; F.vcu = (F.G % 8 == 0) ? (bx % 8) * (F.G / 8) + bx / 8 : bx; }
    const int vcu0 = F.vcu;
    F.out = args.out; F.ws = args.ws; F.ctl = (unsigned*)(args.ws + WS_CTL);
    for (int u = F.tid; u < (LDS_BYTES - LDSCTL_OFF) / 4; u += NTHR) ((LAS unsigned*)(F.lds + LDSCTL_OFF))[u] = 0u;
    __syncthreads();
    const int lo = args.ph_lo, hi = args.ph_hi;
    XcdBarrier bar; bar.bar = F.ctl + CW_BAR; bar.x = 0; bar.st = nullptr;
    if (hi - lo > 1) bar = xcd_barrier_post(F.ctl + CW_BAR, F.MISC + 8);

    bool again = false;
#if MK_TMASK
    unsigned long long tsum_ = 0, t0p_ = 0; const bool tmr_ = (blockIdx.x == 0);
#endif
    for (int ph = lo; ph < hi; ++ph) {
        if (phase_empty(ph)) continue;
#if MK_TMASK
        if (tmr_ && !again) t0p_ = __builtin_amdgcn_s_memrealtime();
#endif
        if (ph == DEPTH * 10) { if (EN(10)) final_norm(F, INP(11), (const float*)(F.ws + WS_R1), KS_DN);
#if MK_TMASK
            if (tmr_ && ((MK_TMASK >> 10) & 1)) tsum_ += __builtin_amdgcn_s_memrealtime() - t0p_;
#endif
            continue; }
        const int layer = ph / 10, st = ph % 10, kind = layer % 3, j = layer / 3;
        { int t_ = threadIdx.x; asm volatile("" : "+v"(t_)); F.tid = t_; F.lane = t_ & 63; F.wave = __builtin_amdgcn_readfirstlane(t_ >> 6);
          int g_ = gridDim.x, v_ = vcu0; asm volatile("" : "+s"(g_), "+s"(v_)); F.G = g_; F.vcu = v_;
          unsigned char* w_ = args.ws; float* o_ = args.out; asm volatile("" : "+s"(w_), "+s"(o_)); F.ws = w_; F.out = o_; }
#if MK_TSEG
        if (MK_TSEG_ST >= 0 && blockIdx.x == 0 && threadIdx.x == 0) F.MISC[23] = (st == MK_TSEG_ST) ? 1u : 0u;
#endif
        bf16* WT_IN = (bf16*)(F.ws + WS_WIN); bf16* WT_OUT = (bf16*)(F.ws + WS_WOUT); bf16* WT_UP = (bf16*)(F.ws + WS_WUP); bf16* WT_DN = (bf16*)(F.ws + WS_WDN);
        bf16* XN = (bf16*)(F.ws + WS_XN); bf16* HB_ = (bf16*)(F.ws + WS_H); float* GATES = (float*)(F.ws + WS_GATES);


        if (st == 0 && EN(0)) {
            const float* win = (kind == 0) ? INP(12) + (size_t)j * D * A_IN : (kind == 1) ? INP(17) : INP(22);
            const float* wout = (kind == 0) ? INP(16) + (size_t)j * D * D : (kind == 1) ? INP(21) : INP(25);
            const int ldw = (kind == 2) ? C_IN : A_IN, nin = (kind == 2) ? C_IN : NPROJ;
            const int sb = (kind == 0) ? 512 : 0, se = (kind == 0) ? 1024 : (kind == 1) ? 512 : 0; const float sv = (kind == 0) ? 0.125f : 0.08838834764831845f;
            if (layer == 0) prep_two(F, win, ldw, D, nin, WT_IN, sb, se, sv, wout, D, D, D, WT_OUT);
            const float* xp = (layer == 0) ? INP(0) : F.out; const float* xs = (layer == 0) ? INP(1) : F.out + (size_t)MP * D; float* xd = (layer == 0) ? F.out : nullptr;
            const float* g = INP(9) + (size_t)layer * D;
            if (kind < 2) {
                bf16* WgT = (bf16*)(F.ws + WS_GATES + 3 * MiB / 2);
                for (int e = F.vcu * NTHR + F.tid; e < 16 * D; e += F.G * NTHR) { const int k = e >> 4, c = e & 15; WgT[c * D + k] = (bf16)f2bf(win[(size_t)k * A_IN + NPROJ + c]); } }
            norm_rows<false>(F, xp, xs, xd, g, XN, nullptr, nullptr, (const float*)(F.ws + WS_R1), (layer == 0) ? 0 : KS_DN);
        } else if ((st == 1 || st == 7 || st == 5 || st == 9) && EN(1)) {
            const bool pj = (st == 1 || st == 7);
            const int N = (st == 7) ? 2 * DFF : (st == 1) ? ((kind == 2) ? C_IN : NPROJ) : D, K = (st == 9) ? DFF : D;
            const bf16* A = pj ? XN : (st == 5) ? HB_ : (const bf16*)(F.ws + WS_ACT);
            const bf16* Bt = (st == 1) ? WT_IN : (st == 7) ? WT_UP : (st == 5) ? WT_OUT : WT_DN;
            const bool rs_ = !pj;
            const int ksl = (st == 5) ? KS_OUT : KS_DN;
            pg8::Gemm g{A, Bt, rs_ ? MP : M, N, K}; pg8::StaticOrder S; S.init(rs_ ? MP : M, N, F.G, (int)blockIdx.x, K, rs_ ? (MS / 256) * (D / 256) * ksl : 0, rs_ ? ksl : 1);
            pg8::EpiDual E{pj, (bf16*)(F.ws + WS_PROJ), again ? (float*)(F.ws + WS_R1 + 32 * MiB) : F.out, N, (st == 1 && kind == 2) ? INP(23) : nullptr, (float*)(F.ws + WS_R1), MP, K / ksl, st == 7,
                pg8::EpiConvAct{(bf16*)(F.ws + WS_ACT), (bf16*)(F.ws + WS_U), INP(27) + (size_t)layer * 3 * DFF, INP(28) + (size_t)layer * DFF, (PG8_LAS float*)(F.lds + XCH_OFF), MP / 256}};
            pg8::gemm_phase<pg8::EpiDual, pg8::StaticOrder, true, true>(F.lds, g, S, E);
            { const int nun = (rs_ ? MP / 256 : M / 256) * (N / 256), ex0 = nun % F.G, exu = (F.G - ex0 >= 64) ? ex0 : 0;
                if (st == 1) { __syncthreads(); prep_two(F, INP(26) + (size_t)layer * D * 2 * DFF, 2 * DFF, D, 2 * DFF, WT_UP, 0, 0, 1.0f, INP(29) + (size_t)layer * DFF * D, D, DFF, D, WT_DN, true, exu); }
                if (st == 7 && layer + 1 < DEPTH) { const int k2 = (layer + 1) % 3, j2 = (layer + 1) / 3;
                    const float* win2 = (k2 == 0) ? INP(12) + (size_t)j2 * D * A_IN : (k2 == 1) ? INP(17) : INP(22);
                    const float* wout2 = (k2 == 0) ? INP(16) + (size_t)j2 * D * D : (k2 == 1) ? INP(21) : INP(25);
                    const int ldw2 = (k2 == 2) ? C_IN : A_IN, nin2 = (k2 == 2) ? C_IN : NPROJ;
                    const int sb2 = (k2 == 0) ? 512 : 0, se2 = (k2 == 0) ? 1024 : (k2 == 1) ? 512 : 0; const float sv2 = (k2 == 0) ? 0.125f : 0.08838834764831845f;
                    __syncthreads(); prep_two(F, win2, ldw2, D, nin2, WT_IN, sb2, se2, sv2, wout2, D, D, D, WT_OUT, false, exu); } }
            if (st == 1 && kind < 2) { const int ex = ((M / 256) * (NPROJ / 256)) % F.G; gates_small(F, XN, (const bf16*)(F.ws + WS_GATES + 3 * MiB / 2), GATES, (ex < F.G / 2) ? ex : 0, kind == 0, INP(13) + j * HA, INP(14) + j * HA); }
        } else if (st == 2) {
            if (kind == 0) { if (EN(20)) mlstm_A(F); TS_MARK(F, 25); if (EN(21)) mlstm_S(F, j, INP(15), INP(2), INP(3), INP(4)); TS_MARK(F, 1); }
            else if (kind == 1) { TS_MARK(F, 26); if (EN(22)) gla_A(F, INP(18), INP(19)); TS_MARK(F, 27); if (EN(23)) gla_S(F, INP(18), INP(19), INP(20), INP(5)); TS_MARK(F, 1); }
            else { TS_MARK(F, 28); if (EN(24)) swa_prompt(F, INP(24)); TS_MARK(F, 29); if (EN(25)) swa_sample(F, INP(24), INP(6), INP(7)); TS_MARK(F, 1); }
        } else if (st == 3) {
            if (kind == 0) { TS_MARK(F, 48); if (EN(30)) mlstm_B(F, j); TS_MARK(F, 1); } else { TS_MARK(F, 49); if (EN(31)) gla_B(F); TS_MARK(F, 1); }
        } else if (st == 4) {
            if (kind == 0) { TS_MARK(F, 47); if (EN(40)) mlstm_C(F, j, INP(15)); TS_MARK(F, 1); } else { TS_MARK(F, 46); if (EN(41)) gla_C(F, INP(18), INP(19), INP(20)); TS_MARK(F, 1); }
        } else if (st == 6 && EN(6)) {
            norm_rows<false>(F, F.out, F.out + (size_t)MP * D, nullptr, INP(10) + (size_t)layer * D, XN, nullptr, nullptr, (const float*)(F.ws + WS_R1), KS_OUT);
        }
        else if (st == 8 && EN(8)) {
            convfix_phase(F, layer, INP(8), INP(27), INP(28));
        }
        if (((MK_REP >> st) & 1) && !again) { again = true; --ph; __syncthreads(); continue; }
        again = false;
#if MK_TMASK && defined(MK_TBARONLY)
        if (tmr_) t0p_ = __builtin_amdgcn_s_memrealtime();
#endif
        if (ph + 1 < hi) { xcd_barrier(bar);
#if defined(MK_BAR2)
            xcd_barrier(bar);
#endif
        }
#if MK_TMASK
        if (tmr_ && ((MK_TMASK >> st) & 1)) tsum_ += __builtin_amdgcn_s_memrealtime() - t0p_;
#endif
    }
#if MK_TSEG
    if (blockIdx.x == 0 && threadIdx.x == 0) { const unsigned long long ts_ = ((volatile LAS unsigned long long*)(F.MISC + 16))[1]; const unsigned long long tw_ = __builtin_amdgcn_s_memrealtime(); while (__builtin_amdgcn_s_memrealtime() - tw_ < ts_ * 4ull) __builtin_amdgcn_s_sleep(8); }
#endif
#if MK_TMASK
    if (tmr_) { const unsigned long long tw_ = __builtin_amdgcn_s_memrealtime(); while (__builtin_amdgcn_s_memrealtime() - tw_ < tsum_ * 4ull) __builtin_amdgcn_s_sleep(8); }
#endif
}

extern "C" void kernel_launch(void* const* d_in, const int* in_sizes, int n_in, void* d_out, int out_size, void* d_ws, size_t ws_size, hipStream_t stream) {
    static int grid = 0;
    if (grid == 0) {
        if (n_in != 30 || (size_t)out_size != O_END || ws_size < WS_END) { fprintf(stderr, "kernel_launch: built for 30 inputs, %zu outputs, >= %zu bytes of workspace; got n_in %d, out %d, ws %zu; nothing launched\n", (size_t)O_END, (size_t)WS_END, n_in, out_size, ws_size); grid = -1; return; }
        int dev = 0, cus = 0, per_cu = 0;
        if (hipGetDevice(&dev) != hipSuccess || hipDeviceGetAttribute(&cus, hipDeviceAttributeMultiprocessorCount, dev) != hipSuccess) { fprintf(stderr, "kernel_launch: device query failed\n"); grid = -1; return; }
        if (hipFuncSetAttribute((const void*)trunk_fwd, hipFuncAttributeMaxDynamicSharedMemorySize, LDS_BYTES) != hipSuccess) { fprintf(stderr, "kernel_launch: hipFuncSetAttribute failed\n"); grid = -1; return; }
        if (hipOccupancyMaxActiveBlocksPerMultiprocessor(&per_cu, (const void*)trunk_fwd, NTHR, LDS_BYTES) != hipSuccess || per_cu < 1) { fprintf(stderr, "kernel_launch: occupancy query says %d workgroups per CU\n", per_cu); }
        (void)hipGetLastError();
        grid = cus;
    }
    if (grid < 0) return;
    if (hipMemsetAsync((char*)d_ws + WS_CTL, 0, CTL_ZERO_BYTES, stream) != hipSuccess) { fprintf(stderr, "kernel_launch: hipMemsetAsync failed\n"); return; }
    Args a{};
    for (int i = 0; i < 30; ++i) a.in[i] = (const float*)d_in[i];
    a.out = (float*)d_out; a.ws = (unsigned char*)d_ws;
#if MK_MULTI
    for (int ph = 0; ph < N_PHASES; ++ph) { if (phase_empty(ph)) continue; a.ph_lo = ph; a.ph_hi = ph + 1;
        hipLaunchKernelGGL(trunk_fwd, dim3(grid), dim3(NTHR), LDS_BYTES, stream, a); }
#else
    a.ph_lo = 0; a.ph_hi = N_PHASES;
    hipLaunchKernelGGL(trunk_fwd, dim3(grid), dim3(NTHR), LDS_BYTES, stream, a);
#endif
    const hipError_t le = hipPeekAtLastError();
    if (le != hipSuccess) fprintf(stderr, "kernel_launch: launch failed: %s\n", hipGetErrorName(le));
}
```

```cpp
#include <hip/hip_runtime.h>
#include <cstdio>
#include <cstdint>
#define MK_MULTI 0
#define MK_REP 0
namespace pg8 {
#define PG8_LAS __attribute__((address_space(3)))
typedef unsigned short bf16_t;
typedef short bf16x8 __attribute__((ext_vector_type(8)));
typedef float f32x4 __attribute__((ext_vector_type(4)));
typedef unsigned u32x4 __attribute__((ext_vector_type(4)));
typedef unsigned u32x2 __attribute__((ext_vector_type(2)));
constexpr int BM = 256, BK = 64, HALF = 128, HTB = HALF * BK * 2  , STAGE_BYTES = 8 * HTB, NXCD = 8, WGM = 8;

__host__ __device__ __forceinline__ int lds_byte(int r, int c) { const int st = (r >> 4) * 2 + (c >> 5), rr = r & 15, cc = c & 31, ob = rr * 64 + cc * 2; return st * 1024 + (ob ^ (((ob >> 9) & 1) << 5)); }
__host__ __device__ __forceinline__ void stage_rc(int b, int& R, int& C) { const int st = b / 1024, sb = b % 1024, swz = sb ^ (((sb >> 9) & 1) << 5); R = (st >> 1) * 16 + swz / 64; C = (st & 1) * 32 + (swz % 64) / 2; }
__host__ __device__ __forceinline__ int perm32(int rho) { const int n = rho >> 4, i = rho & 15; return 8 * (i >> 2) + 4 * n + (i & 3); }

struct Unit { int pm, pn, k0, nt, mode; };
struct Gemm { const bf16_t* A; const bf16_t* Bt; int M, N, K; };

struct StaticOrder {
    int nM, nN, nwg, G, c, ntk, nsub, ks, kl;
    __host__ __device__ __forceinline__ void init(int M, int N, int G_, int c_, int K_, int nsub_ = 0, int ks_ = 1) { nM = M / BM; nN = N / BM; nwg = nM * nN; G = G_; c = c_; ntk = K_ / BK; nsub = nsub_; ks = ks_; kl = K_ / ks_; }
    __host__ __device__ __forceinline__ bool next(int i, Unit& u) const {
        const long L = (long)i * G + c; if (L >= nwg + nsub) return false;
        int pm, pn, k0, nt_, mode;
        if (L >= nwg) { const int e = (int)L - nwg, sl = e % ks, u8 = e / ks; pm = nM + u8 / nN; pn = u8 % nN; k0 = sl * kl; nt_ = kl / BK; mode = 1; }
        else {
            int wgid = (int)L; { const int q = nwg / NXCD, r = nwg % NXCD, xcd = wgid % NXCD, off = wgid / NXCD; wgid = (xcd < r ? xcd * (q + 1) : r * (q + 1) + (xcd - r) * q) + off; }
            const int nig = WGM * nN, gid = wgid / nig, fm = gid * WGM, gsz = (nM - fm) < WGM ? (nM - fm) : WGM;
            pm = fm + ((wgid % nig) % gsz); pn = (wgid % nig) / gsz; k0 = 0; nt_ = ntk; mode = 0; }
        u.pm = pm; u.pn = pn; u.k0 = k0; u.nt = nt_; u.mode = mode; return true;
    }
    __device__ __forceinline__ void a_ready(const Unit&) const {}
    __device__ __forceinline__ void done(const Unit&) const {}
};

__device__ __forceinline__ unsigned cvt_pk_bf16(float lo, float hi) { unsigned r; asm volatile("v_cvt_pk_bf16_f32 %0, %1, %2" : "=v"(r) : "v"(lo), "v"(hi)); return r; }
typedef float f32x2 __attribute__((ext_vector_type(2)));
struct EpiBf16 {
    static constexpr bool PERM = true, AFTER_DRAIN = false;
    bf16_t* O; int ldc; const float* bias;
    __device__ __forceinline__ void operator()(const f32x4 (&acc)[2][2][4][2], const Unit& u, int wr, int wc, int fr, int fq) const {
        const int row0 = u.pm * BM + wr * 64 + fr; const int col0 = u.pn * BM + wc * 32 + 8 * fq;
        f32x4 bv[2][2];
#pragma unroll
        for (int bj = 0; bj < 2; ++bj)
#pragma unroll
            for (int n = 0; n < 2; ++n) bv[bj][n] = bias ? *(const f32x4*)(bias + col0 + bj * HALF + 4 * n) : (f32x4){0.f, 0.f, 0.f, 0.f};
#pragma unroll
        for (int ai = 0; ai < 2; ++ai)
#pragma unroll
            for (int m = 0; m < 4; ++m) { bf16_t* rowp = O + (size_t)(row0 + ai * HALF + m * 16) * ldc + col0;
#pragma unroll
                for (int bj = 0; bj < 2; ++bj) { const f32x4 v0 = acc[ai][bj][m][0] + bv[bj][0], v1 = acc[ai][bj][m][1] + bv[bj][1];
                    u32x4 w; w.x = cvt_pk_bf16(v0[0], v0[1]); w.y = cvt_pk_bf16(v0[2], v0[3]); w.z = cvt_pk_bf16(v1[0], v1[1]); w.w = cvt_pk_bf16(v1[2], v1[3]);
                    *(u32x4*)(rowp + bj * HALF) = w; } }
    }
};
struct EpiRes {
    static constexpr bool PERM = false, AFTER_DRAIN = false;
    float* X; int ldc;
    __device__ __forceinline__ void operator()(const f32x4 (&acc)[2][2][4][2], const Unit& u, int wr, int wc, int fr, int fq) const {
        const int row0 = u.pm * BM + wr * 64 + fr, col0 = u.pn * BM + wc * 32 + 4 * fq;
#pragma unroll
        for (int ai = 0; ai < 2; ++ai)
#pragma unroll
            for (int m = 0; m < 4; ++m) { float* rowp = X + (size_t)(row0 + ai * HALF + m * 16) * ldc + col0;
#pragma unroll
                for (int bj = 0; bj < 2; ++bj)
#pragma unroll
                    for (int n = 0; n < 2; ++n) *(f32x4*)(rowp + bj * HALF + n * 16) = acc[ai][bj][m][n]; }
    }
};
struct EpiConvAct {
    bf16_t* ACT; bf16_t* U; const float* cw; const float* cb; PG8_LAS float* xch; int first_raw_tile;
    __device__ __forceinline__ void operator()(const f32x4 (&acc)[2][2][4][2], const Unit& u, int wr, int wc, int fr, int fq) const {
        constexpr int FF = 2816;
        asm volatile("" : "+v"(fr), "+v"(fq), "+s"(wr), "+s"(wc));
        const int lane = fq * 16 + fr, fb_t = wc * 32 + 8 * fq, fb = u.pn * 128 + fb_t;
        const bool rawtile = u.pm >= first_raw_tile;
        if (fr >= 14) {
#pragma unroll
            for (int ai = 0; ai < 2; ++ai) { PG8_LAS float* xp = xch + ((ai * 2 + wr) * 2 + (fr - 14)) * 128 + fb_t;
#pragma unroll
                for (int n = 0; n < 2; ++n) *(PG8_LAS f32x4*)(xp + 4 * n) = acc[ai][0][3][n]; }
        }
        float w0[8], w1[8], w2[8], bb[8];
#pragma unroll
        for (int n = 0; n < 2; ++n) { const f32x4 a = *(const f32x4*)(cw + fb + 4 * n), b = *(const f32x4*)(cw + FF + fb + 4 * n), c = *(const f32x4*)(cw + 2 * FF + fb + 4 * n), d = *(const f32x4*)(cb + fb + 4 * n);
#pragma unroll
            for (int e = 0; e < 4; ++e) { w0[4 * n + e] = a[e]; w1[4 * n + e] = b[e]; w2[4 * n + e] = c[e]; bb[4 * n + e] = d[e]; } }
        asm volatile("s_waitcnt lgkmcnt(0)" ::: "memory"); __builtin_amdgcn_s_barrier(); asm volatile("" ::: "memory");
#pragma unroll
        for (int ai = 0; ai < 2; ++ai) {
            float p1[8], p2[8];
            const int pb = ai * 2 + wr - 1;
#pragma unroll
            for (int i = 0; i < 8; ++i) { p1[i] = 0.f; p2[i] = 0.f; }
            if (pb >= 0 && fr < 2) { const PG8_LAS float* x63 = xch + (pb * 2 + 1) * 128 + fb_t; const PG8_LAS float* x62 = xch + (pb * 2 + 0) * 128 + fb_t;
#pragma unroll
                for (int i = 0; i < 8; ++i) { const float a63 = x63[i], a62 = x62[i]; p1[i] = a63; p2[i] = (fr == 0) ? a62 : a63; } }
#pragma unroll
            for (int m = 0; m < 4; ++m) {
                const size_t row = (size_t)u.pm * BM + ai * HALF + wr * 64 + m * 16 + fr;
                float o[8];
#pragma unroll
                for (int n = 0; n < 2; ++n)
#pragma unroll
                    for (int e = 0; e < 4; ++e) { const int i = 4 * n + e; const float g0 = acc[ai][0][m][n][e];
                        const float r1 = __builtin_bit_cast(float, __builtin_amdgcn_update_dpp(0, __builtin_bit_cast(int, g0), 0x121, 0xf, 0xf, false));
                        const float r2 = __builtin_bit_cast(float, __builtin_amdgcn_update_dpp(0, __builtin_bit_cast(int, g0), 0x122, 0xf, 0xf, false));
                        const float g1 = (fr >= 1) ? r1 : p1[i], g2 = (fr >= 2) ? r2 : p2[i];
                        p1[i] = r1; p2[i] = r2;
                        const float cv = bb[i] + w0[i] * g2 + w1[i] * g1 + w2[i] * g0;
                        o[i] = cv * __builtin_amdgcn_rcpf(1.0f + __expf(-cv)) * acc[ai][1][m][n][e]; }
                if (!rawtile) { u32x4 w; w.x = cvt_pk_bf16(o[0], o[1]); w.y = cvt_pk_bf16(o[2], o[3]); w.z = cvt_pk_bf16(o[4], o[5]); w.w = cvt_pk_bf16(o[6], o[7]); *(u32x4*)(ACT + row * FF + fb) = w; }
                const bool rawrow = rawtile || (ai == 0 && wr == 0 && m == 0 && fr < 2) || (ai == 1 && wr == 1 && m == 3 && fr >= 14);
                if (rawrow) { const f32x4 a0 = acc[ai][0][m][0], a1 = acc[ai][0][m][1], b0 = acc[ai][1][m][0], b1 = acc[ai][1][m][1];
                    u32x4 w; w.x = cvt_pk_bf16(a0[0], a0[1]); w.y = cvt_pk_bf16(a0[2], a0[3]); w.z = cvt_pk_bf16(a1[0], a1[1]); w.w = cvt_pk_bf16(a1[2], a1[3]); *(u32x4*)(U + row * (2 * FF) + fb) = w;
                    w.x = cvt_pk_bf16(b0[0], b0[1]); w.y = cvt_pk_bf16(b0[2], b0[3]); w.z = cvt_pk_bf16(b1[0], b1[1]); w.w = cvt_pk_bf16(b1[2], b1[3]); *(u32x4*)(U + row * (2 * FF) + FF + fb) = w; }
                __builtin_amdgcn_sched_barrier(0);
            }
        }
    }
};
struct EpiDual {
    static constexpr bool AFTER_DRAIN = false;
    bool PERM; bf16_t* O; float* X; int ldc; const float* bias; float* slab; int row_base, kl; bool conv; EpiConvAct ca;
    __device__ __forceinline__ void init(f32x4 (&acc)[2][2][4][2], const Unit& u, int wr, int wc, int fr, int fq) const {
        if (!PERM && u.mode == 0) { const int row0 = u.pm * BM + wr * 64 + fr, col0 = u.pn * BM + wc * 32 + 4 * fq;
#pragma unroll
            for (int ai = 0; ai < 2; ++ai)
#pragma unroll
                for (int m = 0; m < 4; ++m) { const float* rowp = X + (size_t)(row0 + ai * HALF + m * 16) * ldc + col0;
#pragma unroll
                    for (int bj = 0; bj < 2; ++bj)
#pragma unroll
                        for (int n = 0; n < 2; ++n) acc[ai][bj][m][n] = *(const f32x4*)(rowp + bj * HALF + n * 16); }
        } else {
#pragma unroll
            for (int a = 0; a < 2; ++a)
#pragma unroll
                for (int b = 0; b < 2; ++b)
#pragma unroll
                    for (int m = 0; m < 4; ++m)
#pragma unroll
                        for (int n = 0; n < 2; ++n) acc[a][b][m][n] = (f32x4){0.f, 0.f, 0.f, 0.f}; }
    }
    __device__ __forceinline__ void operator()(const f32x4 (&acc)[2][2][4][2], const Unit& u, int wr, int wc, int fr, int fq) const {
        asm volatile("" : "+v"(fr), "+v"(fq), "+s"(wr), "+s"(wc));
        if (u.mode == 1) {
            float* sb = slab + (size_t)(u.k0 / kl) * 512 * ldc; const int row0 = u.pm * BM - row_base + wr * 64 + fr, col0 = u.pn * BM + wc * 32 + 4 * fq;
#pragma unroll
            for (int ai = 0; ai < 2; ++ai)
#pragma unroll
                for (int m = 0; m < 4; ++m) { float* rowp = sb + (size_t)(row0 + ai * HALF + m * 16) * ldc + col0;
#pragma unroll
                    for (int bj = 0; bj < 2; ++bj)
#pragma unroll
                        for (int n = 0; n < 2; ++n) *(f32x4*)(rowp + bj * HALF + n * 16) = acc[ai][bj][m][n]; }
        } else if (conv) { ca(acc, u, wr, wc, fr, fq);
        } else if (PERM) { EpiBf16 e{O, ldc, bias}; e(acc, u, wr, wc, fr, fq); } else { EpiRes e{X, ldc}; e(acc, u, wr, wc, fr, fq); }
    }
};
#ifndef MK_TSEG_ST
#define MK_TSEG_ST -1
#endif
#if defined(MK_TSEG) && MK_TSEG
#define PG8_TS(id) do { if (blockIdx.x == 0 && threadIdx.x == 0) { volatile PG8_LAS unsigned* M__ = (volatile PG8_LAS unsigned*)(lds + 131072 + 320); if (MK_TSEG_ST < 0 || M__[23] != 0u) { const unsigned long long t__ = __builtin_amdgcn_s_memrealtime(); \
    volatile PG8_LAS unsigned long long* T__ = (volatile PG8_LAS unsigned long long*)(M__ + 16); if (M__[22] == (unsigned)MK_TSEG) T__[1] += t__ - T__[0]; T__[0] = t__; M__[22] = (unsigned)(id); } } } while (0)
#else
#define PG8_TS(id) do { } while (0)
#endif
template <class Epi, class Sched, bool ALIGN_EPI = false, bool SP2 = false>
__device__ __forceinline__ void gemm_phase(PG8_LAS unsigned char* lds, const Gemm g, const Sched& S, const Epi& E) {
    int tid_ = threadIdx.x; asm volatile("" : "+v"(tid_));
    const int tid = tid_, wid = __builtin_amdgcn_readfirstlane(tid >> 6), lane = tid & 63, wr = wid >> 2, wc = wid & 3, fr = lane & 15, fq = lane >> 4;
    const int K = g.K;
    unsigned voffA[2], voffB[2];
#pragma unroll
    for (int i = 0; i < 2; ++i) { int R, C; stage_rc(tid * 16 + i * 8192, R, C); const int Rb = E.PERM ? ((R & ~31) + perm32(R & 31)) : R;
        voffA[i] = (unsigned)(R * K + C) * 2u; voffB[i] = (unsigned)(Rb * K + C) * 2u; }
    const size_t kstep = (size_t)(BK * 2);
    const size_t hstep = (size_t)HALF * K * 2;
    const size_t tstep = 2 * hstep;
    const unsigned ldsw = (unsigned)wid * 1024u;
    const int aoff = lds_byte(wr * 64 + fr, fq * 8), boff = lds_byte(wc * 32 + fr, fq * 8);
#define PG8_SA(b, h) (((b) * 2 + (h)) * HTB)
#define PG8_SB(b, h) ((4 + (b) * 2 + (h)) * HTB)
#define PG8_STAGE(bufoff, gbase, voff) do { _Pragma("unroll") for (int _i = 0; _i < 2; ++_i) \
        __builtin_amdgcn_global_load_lds((const unsigned*)((const char*)(gbase) + (voff)[_i]), (PG8_LAS unsigned*)(lds + (bufoff) + ldsw + _i * 8192), 16, 0, 0); } while (0)
#define PG8_LDA(dst, b, h) do { _Pragma("unroll") for (int m = 0; m < 4; ++m) _Pragma("unroll") for (int k = 0; k < 2; ++k) dst[m][k] = *(const PG8_LAS bf16x8*)(lds + PG8_SA(b, h) + aoff + m * 2048 + k * 1024); } while (0)
#define PG8_LDB(dst, b, h) do { _Pragma("unroll") for (int n = 0; n < 2; ++n) _Pragma("unroll") for (int k = 0; k < 2; ++k) dst[n][k] = *(const PG8_LAS bf16x8*)(lds + PG8_SB(b, h) + boff + n * 2048 + k * 1024); } while (0)
#define PG8_MMA(ai, bj, At, Bt) do { __builtin_amdgcn_s_setprio(1); _Pragma("unroll") for (int m = 0; m < 4; ++m) _Pragma("unroll") for (int n = 0; n < 2; ++n) _Pragma("unroll") for (int k = 0; k < 2; ++k) \
        acc[ai][bj][m][n] = __builtin_amdgcn_mfma_f32_16x16x32_bf16(Bt[n][k], At[m][k], acc[ai][bj][m][n], 0, 0, 0); __builtin_amdgcn_s_setprio(0); } while (0)
#define PG8_WAIT_V(n) asm volatile("s_waitcnt vmcnt(" #n ")" ::: "memory")
#define PG8_WAIT_L(n) asm volatile("s_waitcnt lgkmcnt(" #n ")" ::: "memory")
#define PG8_BAR __builtin_amdgcn_s_barrier()
#define PG8_SCHED __builtin_amdgcn_sched_barrier(0)
    PG8_TS(71);
    Unit cur, nxt; int ui = 0;
    if (!S.next(0, cur)) return;
    f32x4 acc[2][2][4][2];
    E.init(acc, cur, wr, wc, fr, fq);
    bf16x8 At[4][2], B0[2][2], B1[2][2];
    const char* cA = (const char*)g.A + (size_t)cur.pm * tstep + (size_t)cur.k0 * 2; const char* cB = (const char*)g.Bt + (size_t)cur.pn * tstep + (size_t)cur.k0 * 2;
    S.a_ready(cur);
    if constexpr (SP2) {
        PG8_STAGE(PG8_SB(0, 0), cB, voffB); PG8_STAGE(PG8_SB(0, 1), cB + hstep, voffB); PG8_STAGE(PG8_SA(0, 0), cA, voffA); PG8_STAGE(PG8_SA(0, 1), cA + hstep, voffA);
        if (wr == 1) PG8_BAR;
        PG8_WAIT_V(2); PG8_BAR;
        PG8_STAGE(PG8_SB(1, 0), cB + kstep, voffB); PG8_STAGE(PG8_SA(1, 0), cA + kstep, voffA); PG8_STAGE(PG8_SB(1, 1), cB + hstep + kstep, voffB);
        PG8_WAIT_V(6); PG8_BAR;
    } else {
        PG8_STAGE(PG8_SB(0, 0), cB, voffB); PG8_STAGE(PG8_SA(0, 0), cA, voffA); PG8_STAGE(PG8_SB(0, 1), cB + hstep, voffB); PG8_STAGE(PG8_SA(0, 1), cA + hstep, voffA);
        if (wr == 1) PG8_BAR;
        PG8_WAIT_V(4); PG8_BAR;
        PG8_STAGE(PG8_SB(1, 0), cB + kstep, voffB); PG8_STAGE(PG8_SA(1, 0), cA + kstep, voffA); PG8_STAGE(PG8_SB(1, 1), cB + hstep + kstep, voffB);
        PG8_WAIT_V(6); PG8_BAR;
    }
    for (;;) {
        PG8_TS(72);
        const bool has_next = S.next(ui + 1, nxt);
        const char* nA = has_next ? (const char*)g.A + (size_t)nxt.pm * tstep + (size_t)nxt.k0 * 2 : cA; const char* nB = has_next ? (const char*)g.Bt + (size_t)nxt.pn * tstep + (size_t)nxt.k0 * 2 : cB;
        const int nt = cur.nt;
        for (int t = 0; t < nt; t += 2) {
            const bool last = (t == nt - 2);
            const char* a1 = cA + (size_t)(t + 1) * kstep;
            const char* a2 = last ? nA : cA + (size_t)(t + 2) * kstep; const char* b2 = last ? nB : cB + (size_t)(t + 2) * kstep;
            const char* a3 = a2 + kstep; const char* b3 = b2 + kstep;
            if (last && has_next) S.a_ready(nxt);
            if constexpr (SP2) {
            PG8_LDB(B0, 0, 0); PG8_LDB(B1, 0, 1); PG8_SCHED; PG8_LDA(At, 0, 0); PG8_STAGE(PG8_SA(1, 1), a1 + hstep, voffA);
            PG8_WAIT_V(8); PG8_WAIT_L(0); PG8_BAR; PG8_MMA(0, 0, At, B0); PG8_MMA(0, 1, At, B1); PG8_BAR; PG8_SCHED;
            PG8_LDA(At, 0, 1); PG8_STAGE(PG8_SB(0, 0), b2, voffB); PG8_STAGE(PG8_SB(0, 1), b2 + hstep, voffB); PG8_STAGE(PG8_SA(0, 0), a2, voffA);
            PG8_WAIT_V(8); PG8_WAIT_L(0); PG8_BAR; PG8_MMA(1, 0, At, B0); PG8_MMA(1, 1, At, B1); PG8_BAR; PG8_SCHED;
            PG8_LDB(B0, 1, 0); PG8_LDB(B1, 1, 1); PG8_SCHED; PG8_LDA(At, 1, 0); PG8_STAGE(PG8_SA(0, 1), a2 + hstep, voffA);
            PG8_WAIT_V(8); PG8_WAIT_L(0); PG8_BAR; PG8_MMA(0, 0, At, B0); PG8_MMA(0, 1, At, B1); PG8_BAR; PG8_SCHED;
            PG8_LDA(At, 1, 1); PG8_STAGE(PG8_SB(1, 0), b3, voffB); PG8_STAGE(PG8_SB(1, 1), b3 + hstep, voffB); PG8_STAGE(PG8_SA(1, 0), a3, voffA);
            PG8_WAIT_V(8); PG8_WAIT_L(0); PG8_BAR; PG8_MMA(1, 0, At, B0); PG8_MMA(1, 1, At, B1); PG8_BAR; PG8_SCHED;
            } else {
            PG8_LDB(B0, 0, 0); PG8_SCHED; PG8_LDA(At, 0, 0); PG8_STAGE(PG8_SA(1, 1), a1 + hstep, voffA);
            PG8_WAIT_L(8); PG8_BAR; PG8_WAIT_L(0); PG8_MMA(0, 0, At, B0); PG8_BAR; PG8_SCHED;
            PG8_LDB(B1, 0, 1); PG8_STAGE(PG8_SB(0, 0), b2, voffB);
            PG8_BAR; PG8_WAIT_L(0); PG8_MMA(0, 1, At, B1); PG8_BAR;
            PG8_LDA(At, 0, 1); PG8_STAGE(PG8_SA(0, 0), a2, voffA);
            PG8_BAR; PG8_WAIT_L(0); PG8_MMA(1, 0, At, B0); PG8_BAR; PG8_SCHED;
            PG8_STAGE(PG8_SB(0, 1), b2 + hstep, voffB);
            PG8_WAIT_V(6); PG8_BAR; PG8_MMA(1, 1, At, B1); PG8_BAR;
            PG8_LDB(B0, 1, 0); PG8_SCHED; PG8_LDA(At, 1, 0); PG8_STAGE(PG8_SA(0, 1), a2 + hstep, voffA);
            PG8_WAIT_L(8); PG8_BAR; PG8_WAIT_L(0); PG8_MMA(0, 0, At, B0); PG8_BAR; PG8_SCHED;
            PG8_LDB(B1, 1, 1); PG8_STAGE(PG8_SB(1, 0), b3, voffB);
            PG8_BAR; PG8_WAIT_L(0); PG8_MMA(0, 1, At, B1); PG8_BAR;
            PG8_LDA(At, 1, 1); PG8_STAGE(PG8_SA(1, 0), a3, voffA);
            PG8_BAR; PG8_WAIT_L(0); PG8_MMA(1, 0, At, B0); PG8_BAR; PG8_SCHED;
            PG8_STAGE(PG8_SB(1, 1), b3 + hstep, voffB);
            PG8_WAIT_V(6); PG8_BAR; PG8_MMA(1, 1, At, B1); PG8_BAR;
            }
        }
        PG8_TS(73);
        if constexpr (ALIGN_EPI) { if (wr == 0) PG8_BAR; }
        if constexpr (!Epi::AFTER_DRAIN) { E(acc, cur, wr, wc, fr, fq); S.done(cur); }
        PG8_TS(74);
        if (!has_next) break;
        E.init(acc, nxt, wr, wc, fr, fq);
        cur = nxt; cA = nA; cB = nB; ++ui;
        if constexpr (ALIGN_EPI) { if (wr == 1) PG8_BAR; }
    }
    PG8_TS(75);
    PG8_WAIT_V(0);
    if constexpr (!ALIGN_EPI) { if (wr == 0) PG8_BAR; }
    PG8_BAR;
    if constexpr (Epi::AFTER_DRAIN) { E.fused(acc, cur, wr, wc, fr, fq, lds, wid, lane); S.done(cur); }
#undef PG8_SA
#undef PG8_SB
#undef PG8_STAGE
#undef PG8_LDA
#undef PG8_LDB
#undef PG8_MMA
#undef PG8_WAIT_V
#undef PG8_WAIT_L
#undef PG8_BAR
#undef PG8_SCHED
}
}
constexpr int NWAVES = 8, NTHR = 512;
constexpr int D = 1024, BP = 4, TP = 4096, MP = BP * TP, BS = 128, TS = 4, MS = BS * TS, M = MP + MS;
constexpr int DEPTH = 4;
constexpr int HA = 8, DKA = 64, DVA = 128;
constexpr int HB = 4, DKB = 128, DVB = 256, RANK = 16;
constexpr int HC = 16, HKV = 4, HDC = 64, GROUP = 4, WIN = 128;
constexpr int DFF = 2816, A_IN = 3088, B_IN = 3088, C_IN = 1536, NPROJ = 3072;
constexpr int NCH = 64, LCH = 64;
constexpr float EPS = 1e-6f, SOFTCAP = 15.0f;

constexpr size_t O_YP = 0, O_YS = O_YP + (size_t)MP * D, O_PAC = O_YS + (size_t)MS * D, O_PAN = O_PAC + 2ull * BP * HA * DKA * DVA, O_PAM = O_PAN + 2ull * BP * HA * DKA,
    O_PG = O_PAM + 2ull * BP * HA, O_PSK = O_PG + (size_t)BP * HB * DKB * DVB, O_PSV = O_PSK + (size_t)BP * WIN * HKV * HDC, O_PF = O_PSV + (size_t)BP * WIN * HKV * HDC,
    O_SAC = O_PF + 4ull * BP * 2 * DFF, O_SAN = O_SAC + 2ull * BS * HA * DKA * DVA, O_SAM = O_SAN + 2ull * BS * HA * DKA, O_SG = O_SAM + 2ull * BS * HA,
    O_SSK = O_SG + (size_t)BS * HB * DKB * DVB, O_SSV = O_SSK + (size_t)BS * WIN * HKV * HDC, O_SF = O_SSV + (size_t)BS * WIN * HKV * HDC, O_END = O_SF + 4ull * BS * 2 * DFF;
static_assert(O_END == 63666240ull, "output size");

constexpr size_t MiB = 1u << 20;
constexpr size_t WS_CTL = 0, CTL_ZERO_BYTES = 1 * MiB;
constexpr size_t WS_WIN = 1 * MiB, WS_WOUT = 7 * MiB, WS_WUP = 9 * MiB, WS_WDN = 20 * MiB;
constexpr size_t WS_GATES = 26 * MiB;
constexpr size_t WS_XN = 28 * MiB;
constexpr size_t WS_H = 61 * MiB;
constexpr size_t WS_R1 = 94 * MiB;
constexpr size_t WS_PROJ = WS_R1;
constexpr size_t WS_SCR = WS_R1 + 99 * MiB;
constexpr size_t SC_LOC = WS_SCR;
constexpr size_t SC_ST = WS_SCR + 128 * MiB;
constexpr size_t SC_AUX = WS_SCR + 192 * MiB;
constexpr size_t WS_U = WS_R1;
constexpr size_t WS_ACT = WS_R1 + 182 * MiB;
constexpr size_t WS_END = WS_R1 + 293 * MiB;
static_assert(WS_WIN + (size_t)NPROJ * D * 2 <= WS_WOUT && WS_WOUT + (size_t)D * D * 2 <= WS_WUP && WS_WUP + 2ull * DFF * D * 2 <= WS_WDN && WS_WDN + (size_t)D * DFF * 2 <= WS_GATES, "ws map: weights");
static_assert(WS_GATES + (size_t)M * 16 * 4 <= WS_XN && WS_XN + (size_t)M * D * 2 <= WS_H && WS_H + (size_t)M * D * 2 <= WS_R1 && WS_PROJ + (size_t)M * NPROJ * 2 <= WS_SCR, "ws map: activations");
static_assert(WS_U + (size_t)M * 2 * DFF * 2 <= WS_ACT && WS_ACT + (size_t)M * DFF * 2 <= WS_END && SC_AUX + 2 * MiB <= WS_END, "ws map: ffn");
constexpr int AX_CHK = 0;
constexpr int AX_MST = 8192;
constexpr int AX_NLOC = 16384;
constexpr int AX_NST = 16384 + 131072;
constexpr int AX_BL = 0;
static_assert((AX_NST + 131072) * 4 <= (int)(2 * MiB), "aux");

constexpr int CW_BAR = 4096;

constexpr int RING_BYTES = 131072;
constexpr int LDSCTL_OFF = RING_BYTES, MISC_OFF = LDSCTL_OFF + 320;
constexpr int XCH_OFF = 132096;
constexpr int LDS_BYTES = 147456;

#define GAS __attribute__((address_space(1)))
#define LAS __attribute__((address_space(3)))
typedef unsigned short bf16;
typedef unsigned v4u __attribute__((ext_vector_type(4)));
typedef unsigned v2u __attribute__((ext_vector_type(2)));
typedef float f32x4 __attribute__((ext_vector_type(4)));
typedef float f32x2 __attribute__((ext_vector_type(2)));
typedef short bf16x8 __attribute__((ext_vector_type(8)));
#define LDS_WAIT() asm volatile("s_waitcnt lgkmcnt(0)" ::: "memory")
#define VM_WAIT() asm volatile("s_waitcnt vmcnt(0)" ::: "memory")
__device__ __forceinline__ unsigned pk2h(float lo, float hi) { unsigned r; asm volatile("v_cvt_pk_bf16_f32 %0, %1, %2" : "=v"(r) : "v"(lo), "v"(hi)); return r; }
__device__ __forceinline__ unsigned f2bf(float f) { return pk2h(f, 0.0f) & 0xffffu; }
__device__ __forceinline__ unsigned f2bf_sw(float f) { unsigned u = __builtin_bit_cast(unsigned, f); return (u + 0x7fffu + ((u >> 16) & 1u)) >> 16; }
__device__ __forceinline__ unsigned pk2(float lo, float hi) { return f2bf_sw(lo) | (f2bf_sw(hi) << 16); }
__device__ __forceinline__ float bf2f(unsigned h) { return __builtin_bit_cast(float, (h & 0xffffu) << 16); }
__device__ __forceinline__ float bflo(unsigned w) { return __builtin_bit_cast(float, w << 16); }
__device__ __forceinline__ float bfhi(unsigned w) { return __builtin_bit_cast(float, w & 0xffff0000u); }
__device__ __forceinline__ float wave_sum(float v) {
#pragma unroll
    for (int o = 1; o < 64; o <<= 1) v += __shfl_xor(v, o);
    return v;
}
__device__ __forceinline__ float wave_max(float v) {
#pragma unroll
    for (int o = 1; o < 64; o <<= 1) v = fmaxf(v, __shfl_xor(v, o));
    return v;
}
__device__ __forceinline__ float wave_scan_sum(float v, int lane) {
#pragma unroll
    for (int o = 1; o < 64; o <<= 1) { const float y = __shfl_up(v, o); if (lane >= o) v += y; }
    return v;
}
__device__ __forceinline__ float wave_scan_max(float v, int lane) {
#pragma unroll
    for (int o = 1; o < 64; o <<= 1) { const float y = __shfl_up(v, o); if (lane >= o) v = fmaxf(v, y); }
    return v;
}
__device__ __forceinline__ float logsigmoidf(float x) { return fminf(x, 0.f) - __logf(1.0f + __expf(-fabsf(x))); }
__device__ __forceinline__ float softcapf(float z) { const float e = __expf(z * (2.0f / SOFTCAP)); return SOFTCAP * (1.0f - 2.0f * __builtin_amdgcn_rcpf(e + 1.0f)); }
__device__ __forceinline__ float frcp(float x) { return __builtin_amdgcn_rcpf(x); }
__device__ __forceinline__ float frsq(float x) { return __builtin_amdgcn_rsqf(x); }
__device__ __forceinline__ float sigmoidf_(float x) { return frcp(1.0f + __expf(-x)); }

template <int KS> __device__ __forceinline__ f32x4 mma_ll(const LAS bf16* X, int ldx, const LAS bf16* Y, int ldy, f32x4 acc, int lane) {
    const int r16 = lane & 15, q = lane >> 4;
#pragma unroll
    for (int ks = 0; ks < KS; ++ks) {
        const bf16x8 a = *(const LAS bf16x8*)(X + r16 * ldx + ks * 32 + q * 8);
        const bf16x8 b = *(const LAS bf16x8*)(Y + r16 * ldy + ks * 32 + q * 8);
        acc = __builtin_amdgcn_mfma_f32_16x16x32_bf16(a, b, acc, 0, 0, 0);
    }
    return acc;
}
template <int KS> __device__ __forceinline__ f32x4 mma_gl(const bf16* X, int ldx, const LAS bf16* Y, int ldy, f32x4 acc, int lane) {
    const int r16 = lane & 15, q = lane >> 4;
    bf16x8 a[KS];
#pragma unroll
    for (int ks = 0; ks < KS; ++ks) a[ks] = *(const bf16x8*)(X + (size_t)r16 * ldx + ks * 32 + q * 8);
#pragma unroll
    for (int ks = 0; ks < KS; ++ks) {
        const bf16x8 b = *(const LAS bf16x8*)(Y + r16 * ldy + ks * 32 + q * 8);
        acc = __builtin_amdgcn_mfma_f32_16x16x32_bf16(a[ks], b, acc, 0, 0, 0);
    }
    return acc;
}
template <int R, int C> __device__ __forceinline__ void stage_nat(LAS bf16* dst, int lld, const bf16* src, size_t gld, int tid) {
    constexpr int CP = C / 8;
    for (int p = tid; p < R * CP; p += NTHR) { const int r = p / CP, c8 = p % CP; *(LAS v4u*)(dst + r * lld + c8 * 8) = *(const v4u*)(src + (size_t)r * gld + c8 * 8); }
}
template <int R, int C> __device__ __forceinline__ void stage_tr(LAS bf16* dst, int lld, const bf16* src, size_t gld, int tid) {
    constexpr int CP = C / 8;
    for (int p = tid; p < R * CP; p += NTHR) { const int r = p % R, c8 = p / R; const v4u v = *(const v4u*)(src + (size_t)r * gld + c8 * 8);
        LAS bf16* d = dst + (c8 * 8) * lld + r;
        d[0 * lld] = (bf16)(v.x & 0xffffu); d[1 * lld] = (bf16)(v.x >> 16); d[2 * lld] = (bf16)(v.y & 0xffffu); d[3 * lld] = (bf16)(v.y >> 16);
        d[4 * lld] = (bf16)(v.z & 0xffffu); d[5 * lld] = (bf16)(v.z >> 16); d[6 * lld] = (bf16)(v.w & 0xffffu); d[7 * lld] = (bf16)(v.w >> 16); }
}
#define XB_TMO      128
#define XB_XCNT(j)  (256  + 64 * (j))
#define XB_XSUB(j)  (1280 + 64 * (j))
#define XB_XGEN(j)  (2304 + 64 * (j))
#define XB_TOP      3328
#define XB_TOPGEN   3392
#define XCD_BAR_WORDS 3456
#define XB_SPIN_CAP (1u << 18)

__device__ __forceinline__ unsigned xb_ld(unsigned* p)              { return __hip_atomic_load(p, __ATOMIC_RELAXED, __HIP_MEMORY_SCOPE_AGENT); }
__device__ __forceinline__ unsigned xb_add(unsigned* p, unsigned v) { return __hip_atomic_fetch_add(p, v, __ATOMIC_RELAXED, __HIP_MEMORY_SCOPE_AGENT); }
__device__ __forceinline__ unsigned xb_xcc_id() { return (unsigned)__builtin_amdgcn_s_getreg((3 << 11) | 20) & 0xFu; }
#define XB_SPIN(cond, bar) do { unsigned _sp = 0; while (cond) { __builtin_amdgcn_s_sleep(1); \
    if ((++_sp & 255u) == 0u) { if (xb_ld(&(bar)[XB_TMO])) break; if (_sp > XB_SPIN_CAP) { atomicAdd(&(bar)[XB_TMO], 1u); break; } } } } while (0)

struct XcdBarrier {
    unsigned* bar; unsigned x;
    volatile LAS unsigned* st;
};

__device__ __forceinline__ XcdBarrier xcd_barrier_post(unsigned* bar, volatile LAS unsigned* st) {
    XcdBarrier b; b.bar = bar; b.x = xb_xcc_id(); b.st = st;
    if (threadIdx.x == 0) (void)xb_add(&bar[XB_XCNT(b.x)], 1u);
    return b;
}
__device__ __forceinline__ void xcd_barrier_complete(unsigned* bar, unsigned x, unsigned& nloc, unsigned& nx) {
    const unsigned G = gridDim.x * gridDim.y * gridDim.z;
    unsigned sum, cnt, mine, sp = 0u;
    for (;;) {
        sum = 0u; cnt = 0u; mine = 0u;
#pragma unroll
        for (unsigned j = 0; j < 16; ++j) { const unsigned c = xb_ld(&bar[XB_XCNT(j)]); sum += c; cnt += (c > 0u) ? 1u : 0u; mine = (j == x) ? c : mine; }
        if (sum == G) break;
        __builtin_amdgcn_s_sleep(1);
        if ((++sp & 255u) == 0u) { if (xb_ld(&bar[XB_TMO])) break; if (sp > XB_SPIN_CAP) { atomicAdd(&bar[XB_TMO], 1u); break; } }
    }
    nloc = mine > 0u ? mine : 1u; nx = cnt > 0u ? cnt : 1u;
}

__device__ __forceinline__ void xcd_barrier(const XcdBarrier& b) {
    asm volatile("s_waitcnt vmcnt(0)" ::: "memory");
    __syncthreads();
    if (threadIdx.x == 0) {
        unsigned* bar = b.bar;
        __builtin_amdgcn_s_waitcnt(0);
        unsigned nloc = b.st[0], nx = b.st[1];
        if (nloc == 0u) { xcd_barrier_complete(bar, b.x, nloc, nx); b.st[0] = nloc; b.st[1] = nx; }
        const unsigned old = xb_add(&bar[XB_XSUB(b.x)], 1u);
        const unsigned gen = old / nloc;
        if (old + 1u == (gen + 1u) * nloc) {
            __builtin_amdgcn_fence(__ATOMIC_RELEASE, "agent");
            asm volatile("s_waitcnt vmcnt(0)" ::: "memory");
            const unsigned og = xb_add(&bar[XB_TOP], 1u);
            const unsigned tg = og / nx;
            if (og + 1u == (tg + 1u) * nx) xb_add(&bar[XB_TOPGEN], 1u);
            else XB_SPIN(xb_ld(&bar[XB_TOPGEN]) == tg, bar);
            __builtin_amdgcn_fence(__ATOMIC_ACQUIRE, "agent");
            xb_add(&bar[XB_XGEN(b.x)], 1u);
            asm volatile("s_waitcnt vmcnt(0)" ::: "memory");
        } else {
            XB_SPIN(xb_ld(&bar[XB_XGEN(b.x)]) == gen, bar);
            __builtin_amdgcn_fence(__ATOMIC_ACQUIRE, "agent");
            asm volatile("s_waitcnt vmcnt(0)" ::: "memory");
        }
    }
    __syncthreads();
}
struct Frame {
    LAS unsigned char* lds;
    volatile LAS unsigned* MISC;
    unsigned* ctl;
    int tid, lane, wave;
    int vcu, G;
    float* out; unsigned char* ws;
};
#define GW_ID(F) ((F).vcu * NWAVES + (F).wave)
#define GW_N(F) ((F).G * NWAVES)
#ifndef MK_TSEG
#define MK_TSEG 0
#endif
#if MK_TSEG
#ifndef MK_TSEG_ST
#define MK_TSEG_ST -1
#endif
#define TS_MARK(F, id) do { if (blockIdx.x == 0 && (F).tid == 0 && (MK_TSEG_ST < 0 || (F).MISC[23] != 0u)) { const unsigned long long t__ = __builtin_amdgcn_s_memrealtime(); volatile LAS unsigned long long* T__ = (volatile LAS unsigned long long*)((F).MISC + 16); \
    if ((F).MISC[22] == (unsigned)MK_TSEG) T__[1] += t__ - T__[0]; T__[0] = t__; (F).MISC[22] = (unsigned)(id); } } while (0)
#else
#define TS_MARK(F, id) do { } while (0)
#endif

__device__ __forceinline__ void transpose_item(const float* __restrict__ W, int ldw, int K, bf16* __restrict__ WT, LAS float* scr, int kb, int nb, int sb, int se, float sv, int lane, bool upmap = false) {
    const int k0 = 64 * kb, n0 = 32 * nb;
    const int d0 = !upmap ? n0 : (n0 < DFF ? (n0 >> 7) * 256 + (n0 & 127) : ((n0 - DFF) >> 7) * 256 + 128 + ((n0 - DFF) & 127));
    f32x4 v[8];
#pragma unroll
    for (int i = 0; i < 8; ++i) v[i] = *(const f32x4*)(W + (size_t)(k0 + i * 8 + (lane >> 3)) * ldw + n0 + (lane & 7) * 4);
#pragma unroll
    for (int i = 0; i < 8; ++i) { LAS float* d = scr + (i * 8 + (lane >> 3)) * 33 + (lane & 7) * 4; d[0] = v[i].x; d[1] = v[i].y; d[2] = v[i].z; d[3] = v[i].w; }
    LDS_WAIT(); asm volatile("" ::: "memory");
    const int c = lane & 7;
    const float sc = (n0 >= sb && n0 < se) ? sv : 1.0f;
#pragma unroll
    for (int j = 0; j < 4; ++j) { const int n = (lane >> 3) + 8 * j; const LAS float* s = scr + (8 * c) * 33 + n;
        v4u o; o.x = pk2h(s[0 * 33] * sc, s[1 * 33] * sc); o.y = pk2h(s[2 * 33] * sc, s[3 * 33] * sc); o.z = pk2h(s[4 * 33] * sc, s[5 * 33] * sc); o.w = pk2h(s[6 * 33] * sc, s[7 * 33] * sc);
        *(v4u*)(WT + (size_t)(d0 + n) * K + k0 + 8 * c) = o; }
    LDS_WAIT(); asm volatile("" ::: "memory");
}
__device__ __forceinline__ void prep_two(Frame& F, const float* W0, int ldw0, int K0, int N0, bf16* T0, int sb, int se, float sv, const float* W1, int ldw1, int K1, int N1, bf16* T1, bool upmap0 = false, int cu_lo = 0) {
    if ((int)blockIdx.x < cu_lo) return;
    LAS float* scr = (LAS float*)(F.lds + F.wave * 16384);
    const int nb0 = N0 / 32, I0 = (K0 / 64) * nb0, nb1 = N1 / 32, I1 = (K1 / 64) * nb1;
    for (int it = ((int)blockIdx.x - cu_lo) * NWAVES + F.wave; it < I0 + I1; it += (F.G - cu_lo) * NWAVES) {
        if (it < I0) transpose_item(W0, ldw0, K0, T0, scr, it / nb0, it % nb0, sb, se, sv, F.lane, upmap0);
        else { const int r = it - I0; transpose_item(W1, ldw1, K1, T1, scr, r / nb1, r % nb1, 0, 0, 1.0f, F.lane); }
    }
}

template <bool GATES> __device__ __forceinline__ void norm_rows(Frame& F, const float* xp, const float* xs, float* Xdst, const float* g, bf16* XN, float* gates, const LAS float* WgT, const float* slab, int nslab) {
    f32x4 gv[4];
#pragma unroll
    for (int j = 0; j < 4; ++j) gv[j] = ((const f32x4*)g)[F.lane + 64 * j];
    f32x4 nx[4];
    { const int m0 = GW_ID(F); if (m0 < M) { const float* xr = (m0 < MP) ? xp + (size_t)m0 * D : xs + (size_t)(m0 - MP) * D;
#pragma unroll
        for (int j = 0; j < 4; ++j) nx[j] = ((const f32x4*)xr)[F.lane + 64 * j]; } }
    for (int m = GW_ID(F); m < M; m += GW_N(F)) {
        f32x4 v[4]; float ss = 0.f;
#pragma unroll
        for (int j = 0; j < 4; ++j) v[j] = nx[j];
        { const int mn = m + GW_N(F); if (mn < M) { const float* xr = (mn < MP) ? xp + (size_t)mn * D : xs + (size_t)(mn - MP) * D;
#pragma unroll
            for (int j = 0; j < 4; ++j) nx[j] = ((const f32x4*)xr)[F.lane + 64 * j]; } }
        if (nslab > 0 && m >= MP) {
            for (int sl = 0; sl < nslab; ++sl) { const f32x4* sp = (const f32x4*)(slab + ((size_t)sl * MS + (m - MP)) * D);
#pragma unroll
                for (int j = 0; j < 4; ++j) v[j] = v[j] + sp[F.lane + 64 * j]; }
#pragma unroll
            for (int j = 0; j < 4; ++j) ((f32x4*)(F.out + (size_t)m * D))[F.lane + 64 * j] = v[j];
        }
#pragma unroll
        for (int j = 0; j < 4; ++j) ss += (v[j].x * v[j].x + v[j].y * v[j].y) + (v[j].z * v[j].z + v[j].w * v[j].w);
        if (Xdst) {
#pragma unroll
            for (int j = 0; j < 4; ++j) ((f32x4*)(Xdst + (size_t)m * D))[F.lane + 64 * j] = v[j];
        }
        const float rs = frsq(wave_sum(ss) * (1.0f / D) + EPS);
        v2u* o8 = (v2u*)(XN + (size_t)m * D);
#pragma unroll
        for (int j = 0; j < 4; ++j) { v[j] = v[j] * rs * gv[j]; v2u w; w.x = pk2h(v[j].x, v[j].y); w.y = pk2h(v[j].z, v[j].w); o8[F.lane + 64 * j] = w; }
        if (GATES) {
            float s[16];
#pragma unroll
            for (int c = 0; c < 16; ++c) { float a = 0.f;
#pragma unroll
                for (int j = 0; j < 4; ++j) { const f32x4 w = ((const LAS f32x4*)(WgT + c * 1024))[F.lane + 64 * j]; a += (v[j].x * w.x + v[j].y * w.y) + (v[j].z * w.z + v[j].w * w.w); }
                s[c] = a; if ((c & 3) == 3) asm volatile("" ::: "memory"); }
            const bool b5 = (F.lane & 32) != 0, b4 = (F.lane & 16) != 0, b3 = (F.lane & 8) != 0, b2 = (F.lane & 4) != 0;
#pragma unroll
            for (int i = 0; i < 8; ++i) { const float send = b5 ? s[i] : s[i + 8], keep = b5 ? s[i + 8] : s[i]; s[i] = keep + __shfl_xor(send, 32); }
#pragma unroll
            for (int i = 0; i < 4; ++i) { const float send = b4 ? s[i] : s[i + 4], keep = b4 ? s[i + 4] : s[i]; s[i] = keep + __shfl_xor(send, 16); }
#pragma unroll
            for (int i = 0; i < 2; ++i) { const float send = b3 ? s[i] : s[i + 2], keep = b3 ? s[i + 2] : s[i]; s[i] = keep + __shfl_xor(send, 8); }
            { const float send = b2 ? s[0] : s[1], keep = b2 ? s[1] : s[0]; s[0] = keep + __shfl_xor(send, 4); }
            s[0] += __shfl_xor(s[0], 2); s[0] += __shfl_xor(s[0], 1);
            if ((F.lane & 3) == 0) gates[(size_t)m * 16 + (F.lane >> 2)] = s[0];
        }
    }
}
#define NR_LOAD(buf, mm) do { if ((mm) < M) { const float* xr_ = ((mm) < MP) ? xp + (size_t)(mm) * D : xs + (size_t)((mm) - MP) * D; \
    _Pragma("unroll") for (int j_ = 0; j_ < 4; ++j_) buf[j_] = ((const f32x4*)xr_)[F.lane + 64 * j_]; } } while (0)
#define NR_PROC(buf, mm) do { if ((mm) < M) { f32x4 v_[4]; float ss_ = 0.f; \
    _Pragma("unroll") for (int j_ = 0; j_ < 4; ++j_) v_[j_] = buf[j_]; \
    NR_LOAD(buf, (mm) + 3 * GW_N(F)); \
    if (nslab > 0 && (mm) >= MP) { for (int sl_ = 0; sl_ < nslab; ++sl_) { const f32x4* sp_ = (const f32x4*)(slab + ((size_t)sl_ * MS + ((mm) - MP)) * D); \
            _Pragma("unroll") for (int j_ = 0; j_ < 4; ++j_) v_[j_] = v_[j_] + sp_[F.lane + 64 * j_]; } \
        _Pragma("unroll") for (int j_ = 0; j_ < 4; ++j_) ((f32x4*)(F.out + (size_t)(mm) * D))[F.lane + 64 * j_] = v_[j_]; } \
    _Pragma("unroll") for (int j_ = 0; j_ < 4; ++j_) ss_ += (v_[j_].x * v_[j_].x + v_[j_].y * v_[j_].y) + (v_[j_].z * v_[j_].z + v_[j_].w * v_[j_].w); \
    if (Xdst) { _Pragma("unroll") for (int j_ = 0; j_ < 4; ++j_) ((f32x4*)(Xdst + (size_t)(mm) * D))[F.lane + 64 * j_] = v_[j_]; } \
    const float rs_ = frsq(wave_sum(ss_) * (1.0f / D) + EPS); v2u* o8_ = (v2u*)(XN + (size_t)(mm) * D); \
    _Pragma("unroll") for (int j_ = 0; j_ < 4; ++j_) { const f32x4 y_ = v_[j_] * rs_ * gv[j_]; v2u w_; w_.x = pk2(y_.x, y_.y); w_.y = pk2(y_.z, y_.w); o8_[F.lane + 64 * j_] = w_; } } } while (0)
__device__ __forceinline__ void norm_rows3(Frame& F, const float* xp, const float* xs, float* Xdst, const float* g, bf16* XN, const float* slab, int nslab) {
    f32x4 gv[4];
#pragma unroll
    for (int j = 0; j < 4; ++j) gv[j] = ((const f32x4*)g)[F.lane + 64 * j];
    f32x4 ba[4], bb[4], bc[4]; const int S = GW_N(F), m0 = GW_ID(F);
    NR_LOAD(ba, m0); NR_LOAD(bb, m0 + S); NR_LOAD(bc, m0 + 2 * S);
    for (int m = m0; m < M; m += 3 * S) { NR_PROC(ba, m); NR_PROC(bb, m + S); NR_PROC(bc, m + 2 * S); }
}
__device__ __forceinline__ void stage_wgT(Frame& F, const float* W, int ldw, int c0, LAS float* WgT) {
    for (int e = F.tid; e < 16 * 1024; e += NTHR) { const int k = e >> 4, c = e & 15; WgT[c * 1024 + k] = W[(size_t)k * ldw + c0 + c]; }
}

__device__ __forceinline__ void unpack8(const v4u v, float (&f)[8]) { f[0] = bflo(v.x); f[1] = bfhi(v.x); f[2] = bflo(v.y); f[3] = bfhi(v.y); f[4] = bflo(v.z); f[5] = bfhi(v.z); f[6] = bflo(v.w); f[7] = bfhi(v.w); }
__device__ __forceinline__ void convfix_unit(Frame& F, int layer, int pm, int pn, int k0, int kw, const float* __restrict__ conv_state, const float* __restrict__ cw, const float* __restrict__ cb) {
    const bf16* __restrict__ U = (const bf16*)(F.ws + WS_U); bf16* ACT = (bf16*)(F.ws + WS_ACT);
    const float* cwl = cw + (size_t)layer * 3 * DFF; const float* cbl = cb + (size_t)layer * DFF;
    if (pm < MP / 256) {
        const int row0 = pm * 256;
        for (int fc = F.tid; fc < DFF / 8; fc += NTHR) { const int f0 = fc * 8;
            if ((pm & 15) == 15 && pn == 0) { float a[8], b[8]; unpack8(*(const v4u*)(U + (size_t)(row0 + 254) * (2 * DFF) + f0), a); unpack8(*(const v4u*)(U + (size_t)(row0 + 255) * (2 * DFF) + f0), b);
                float* o = F.out + O_PF + ((size_t)(layer * BP + (pm >> 4)) * 2) * DFF + f0;
#pragma unroll
                for (int i = 0; i < 8; ++i) { o[i] = a[i]; o[DFF + i] = b[i]; } }
            if ((pm & 15) != 0) {
                const v4u ug2 = *(const v4u*)(U + (size_t)(row0 - 2) * (2 * DFF) + f0), ug1 = *(const v4u*)(U + (size_t)(row0 - 1) * (2 * DFF) + f0);
                const v4u ua0 = *(const v4u*)(U + (size_t)row0 * (2 * DFF) + f0), ua1 = *(const v4u*)(U + (size_t)(row0 + 1) * (2 * DFF) + f0);
                const v4u uu0 = *(const v4u*)(U + (size_t)row0 * (2 * DFF) + DFF + f0), uu1 = *(const v4u*)(U + (size_t)(row0 + 1) * (2 * DFF) + DFF + f0);
                float g2[8], g1[8], ga[8], gb[8], u0[8], u1[8]; unpack8(ug2, g2); unpack8(ug1, g1); unpack8(ua0, ga); unpack8(ua1, gb); unpack8(uu0, u0); unpack8(uu1, u1);
                float oa[8], ob[8];
#pragma unroll
                for (int i = 0; i < 8; ++i) { const float w0 = cwl[f0 + i], w1 = cwl[DFF + f0 + i], w2 = cwl[2 * DFF + f0 + i], bb = cbl[f0 + i];
                    const float c0 = bb + w0 * g2[i] + w1 * g1[i] + w2 * ga[i], c1 = bb + w0 * g1[i] + w1 * ga[i] + w2 * gb[i];
                    oa[i] = c0 * sigmoidf_(c0) * u0[i]; ob[i] = c1 * sigmoidf_(c1) * u1[i]; }
                v4u w; w.x = pk2(oa[0], oa[1]); w.y = pk2(oa[2], oa[3]); w.z = pk2(oa[4], oa[5]); w.w = pk2(oa[6], oa[7]); *(v4u*)(ACT + (size_t)row0 * DFF + f0) = w;
                w.x = pk2(ob[0], ob[1]); w.y = pk2(ob[2], ob[3]); w.z = pk2(ob[4], ob[5]); w.w = pk2(ob[6], ob[7]); *(v4u*)(ACT + (size_t)(row0 + 1) * DFF + f0) = w; }
        }
    } else {
        const int nch = kw >> 3, b0 = (pm - MP / 256) * 64;
        for (int it = F.tid; it < 64 * nch; it += NTHR) { const int fc = it % nch, bi = it / nch, b = b0 + bi, f0 = k0 + fc * 8, row0 = MP + b * TS;
            const float* cs = conv_state + ((size_t)(layer * BS + b) * 2) * DFF + f0;
            float g2[8], g1[8];
            { const f32x4 a0 = *(const f32x4*)cs, a1 = *(const f32x4*)(cs + 4), b0v = *(const f32x4*)(cs + DFF), b1v = *(const f32x4*)(cs + DFF + 4);
#pragma unroll
                for (int i = 0; i < 4; ++i) { g2[i] = a0[i]; g2[4 + i] = a1[i]; g1[i] = b0v[i]; g1[4 + i] = b1v[i]; } }
            v4u ug[4], uu[4];
#pragma unroll
            for (int r = 0; r < 4; ++r) { ug[r] = *(const v4u*)(U + (size_t)(row0 + r) * (2 * DFF) + f0); uu[r] = *(const v4u*)(U + (size_t)(row0 + r) * (2 * DFF) + DFF + f0); }
            float w0[8], w1[8], w2[8], bb[8];
#pragma unroll
            for (int i = 0; i < 8; ++i) { w0[i] = cwl[f0 + i]; w1[i] = cwl[DFF + f0 + i]; w2[i] = cwl[2 * DFF + f0 + i]; bb[i] = cbl[f0 + i]; }
#pragma unroll
            for (int r = 0; r < 4; ++r) { float g0[8], up[8]; unpack8(ug[r], g0); unpack8(uu[r], up); float o[8];
#pragma unroll
                for (int i = 0; i < 8; ++i) { const float cv = bb[i] + w0[i] * g2[i] + w1[i] * g1[i] + w2[i] * g0[i]; o[i] = cv * sigmoidf_(cv) * up[i]; g2[i] = g1[i]; g1[i] = g0[i]; }
                v4u w; w.x = pk2(o[0], o[1]); w.y = pk2(o[2], o[3]); w.z = pk2(o[4], o[5]); w.w = pk2(o[6], o[7]); *(v4u*)(ACT + (size_t)(row0 + r) * DFF + f0) = w; }
            if (pn == 0) { float* o = F.out + O_SF + ((size_t)(layer * BS + b) * 2) * DFF + f0;
#pragma unroll
                for (int i = 0; i < 8; ++i) { o[i] = g2[i]; o[DFF + i] = g1[i]; } }
        }
    }
}

__device__ __forceinline__ void convfix_phase(Frame& F, int layer, const float* conv_state, const float* cw, const float* cb) {
    const bf16* U = (const bf16*)(F.ws + WS_U); bf16* ACT = (bf16*)(F.ws + WS_ACT);
    constexpr int FC = DFF / 8, NPT = MP / 256;
    const int gt = F.vcu * NTHR + F.tid, GT = F.G * NTHR;
    const float* cwl = cw + (size_t)layer * 3 * DFF; const float* cbl = cb + (size_t)layer * DFF;
    for (int it = gt; it < (NPT + BS) * FC; it += GT) {
        const bool samp = it >= NPT * FC; const int r2 = samp ? it - NPT * FC : it;
        const int fc = r2 % FC, rb = r2 / FC, f0 = fc * 8;
        float g2[8], g1[8]; int row0, nrows;
        if (!samp) { row0 = rb * 256; nrows = 2;
            if ((rb & 15) == 15) { float a[8], b[8]; unpack8(*(const v4u*)(U + (size_t)(row0 + 254) * (2 * DFF) + f0), a); unpack8(*(const v4u*)(U + (size_t)(row0 + 255) * (2 * DFF) + f0), b);
                float* o = F.out + O_PF + ((size_t)(layer * BP + (rb >> 4)) * 2) * DFF + f0;
#pragma unroll
                for (int i = 0; i < 8; ++i) { o[i] = a[i]; o[DFF + i] = b[i]; } }
            if ((rb & 15) == 0) continue;
            unpack8(*(const v4u*)(U + (size_t)(row0 - 2) * (2 * DFF) + f0), g2); unpack8(*(const v4u*)(U + (size_t)(row0 - 1) * (2 * DFF) + f0), g1);
        } else { row0 = MP + rb * TS; nrows = TS; const float* cs = conv_state + ((size_t)(layer * BS + rb) * 2) * DFF + f0;
#pragma unroll
            for (int i = 0; i < 8; ++i) { g2[i] = cs[i]; g1[i] = cs[DFF + i]; }
        }
        float w0[8], w1[8], w2[8], bb[8];
#pragma unroll
        for (int i = 0; i < 8; ++i) { w0[i] = cwl[f0 + i]; w1[i] = cwl[DFF + f0 + i]; w2[i] = cwl[2 * DFF + f0 + i]; bb[i] = cbl[f0 + i]; }
        for (int r = 0; r < nrows; ++r) {
            const size_t row = (size_t)(row0 + r);
            float g0[8], up[8]; unpack8(*(const v4u*)(U + row * (2 * DFF) + f0), g0); unpack8(*(const v4u*)(U + row * (2 * DFF) + DFF + f0), up);
            float o[8];
#pragma unroll
            for (int i = 0; i < 8; ++i) { const float cv = bb[i] + w0[i] * g2[i] + w1[i] * g1[i] + w2[i] * g0[i]; o[i] = cv * sigmoidf_(cv) * up[i]; g2[i] = g1[i]; g1[i] = g0[i]; }
            v4u w; w.x = pk2h(o[0], o[1]); w.y = pk2h(o[2], o[3]); w.z = pk2h(o[4], o[5]); w.w = pk2h(o[6], o[7]);
            *(v4u*)(ACT + row * DFF + f0) = w;
        }
        if (samp) { float* o = F.out + O_SF + ((size_t)(layer * BS + rb) * 2) * DFF + f0;
#pragma unroll
            for (int i = 0; i < 8; ++i) { o[i] = g2[i]; o[DFF + i] = g1[i]; } }
    }
}

constexpr int MLC = 128, MNCH = TP / MLC, MITEMS = BP * HA * MNCH;
constexpr int ST_ROWS = 144;
__device__ __forceinline__ void ml_gates(const float* GT, int row0, int h, int lane, float& a0, float& a1, float& fc0, float& fc1) {
    const float ig0 = GT[(size_t)(row0 + lane) * 16 + h], lf0 = GT[(size_t)(row0 + lane) * 16 + 8 + h];
    const float ig1 = GT[(size_t)(row0 + 64 + lane) * 16 + h], lf1 = GT[(size_t)(row0 + 64 + lane) * 16 + 8 + h];
    fc0 = wave_scan_sum(lf0, lane); const float tot0 = __shfl(fc0, 63); fc1 = tot0 + wave_scan_sum(lf1, lane);
    a0 = ig0 - fc0; a1 = ig1 - fc1;
}
__device__ __forceinline__ void mlstm_A(Frame& F) {
    LAS bf16* Kt = (LAS bf16*)F.lds; LAS bf16* Vt = Kt + 64 * 136; LAS float* wv = (LAS float*)(Vt + 128 * 136);
    const bf16* PROJ = (const bf16*)(F.ws + WS_PROJ); const float* GT = (const float*)(F.ws + WS_GATES);
    float* CLOC = (float*)(F.ws + SC_LOC); float* AUX = (float*)(F.ws + SC_AUX);
    for (int item = F.vcu; item < MITEMS; item += F.G) {
        const int bh = item >> 5, c = item & 31, b = bh >> 3, h = bh & 7, row0 = b * TP + c * MLC;
        TS_MARK(F, 21);
        v4u vv[4];
#pragma unroll
        for (int u = 0; u < 4; ++u) { const int p = F.tid + u * NTHR, r = p & 127, c8 = p >> 7; vv[u] = *(const v4u*)(PROJ + (size_t)(row0 + r) * NPROJ + 1024 + h * 128 + c8 * 8); }
        v4u kv[2];
#pragma unroll
        for (int u = 0; u < 2; ++u) { const int p = F.tid + u * NTHR, r = p & 127, c8 = p >> 7; kv[u] = *(const v4u*)(PROJ + (size_t)(row0 + r) * NPROJ + 512 + h * 64 + c8 * 8); }
        if (F.wave == 0) { float a0, a1, f0, f1; ml_gates(GT, row0, h, F.lane, a0, a1, f0, f1); const float amax = wave_max(fmaxf(a0, a1)), fl = __shfl(f1, 63);
            wv[F.lane] = __expf(a0 - amax); wv[64 + F.lane] = __expf(a1 - amax); if (F.lane == 0) { AUX[AX_CHK + 2 * item] = amax; AUX[AX_CHK + 2 * item + 1] = fl; } }
#pragma unroll
        for (int u = 0; u < 4; ++u) { const int p = F.tid + u * NTHR, r = p & 127, c8 = p >> 7; const v4u v = vv[u]; LAS bf16* d = Vt + (c8 * 8) * 136 + r;
            d[0 * 136] = (bf16)(v.x & 0xffffu); d[1 * 136] = (bf16)(v.x >> 16); d[2 * 136] = (bf16)(v.y & 0xffffu); d[3 * 136] = (bf16)(v.y >> 16);
            d[4 * 136] = (bf16)(v.z & 0xffffu); d[5 * 136] = (bf16)(v.z >> 16); d[6 * 136] = (bf16)(v.w & 0xffffu); d[7 * 136] = (bf16)(v.w >> 16); }
        __syncthreads();
        TS_MARK(F, 22);
#pragma unroll
        for (int u = 0; u < 2; ++u) { const int p = F.tid + u * NTHR, r = p & 127, c8 = p >> 7; float e[8]; unpack8(kv[u], e); const float w = wv[r]; LAS bf16* d = Kt + (c8 * 8) * 136 + r;
#pragma unroll
            for (int i = 0; i < 8; ++i) d[i * 136] = (bf16)f2bf(e[i] * w); }
        __syncthreads();
        TS_MARK(F, 23);
#pragma unroll
        for (int jj = 0; jj < 4; ++jj) { const int tile = F.wave * 4 + jj, dkt = tile & 3, dvt = tile >> 2;
            const f32x4 acc = mma_ll<4>(Kt + dkt * 16 * 136, 136, Vt + dvt * 16 * 136, 136, (f32x4){0.f, 0.f, 0.f, 0.f}, F.lane);
            *(f32x4*)(CLOC + ((size_t)item * 128 + dvt * 16 + (F.lane & 15)) * 64 + dkt * 16 + 4 * (F.lane >> 4)) = acc; }
        if (F.tid < 64) { float sm = 0.f; for (int ss = 0; ss < MLC; ss += 8) { float e[8]; unpack8(*(const LAS v4u*)(Kt + F.tid * 136 + ss), e);
#pragma unroll
                for (int i = 0; i < 8; ++i) sm += e[i]; }
            AUX[AX_NLOC + item * 64 + F.tid] = sm; }
        __syncthreads();
        TS_MARK(F, 24);
    }
}
__device__ __forceinline__ void mlstm_B(Frame& F, int j) {
    const float* __restrict__ CLOC = (const float*)(F.ws + SC_LOC); bf16* __restrict__ ST = (bf16*)(F.ws + SC_ST); float* AUX = (float*)(F.ws + SC_AUX);
    for (int slot = F.vcu * NTHR + F.tid; slot < BP * HA * 4096; slot += F.G * NTHR) {
        const int bh = slot >> 12, e = slot & 4095, dv = e >> 5, dk = (e & 31) * 2;
        float m = 0.f, c0 = 0.f, c1 = 0.f, nacc = 0.f;
        for (int cb = 0; cb < MNCH; cb += 8) {
            f32x2 cl[8]; float nl[8], am[8], fl[8];
#pragma unroll
            for (int u = 0; u < 8; ++u) { const int item = bh * MNCH + cb + u; cl[u] = *(const f32x2*)(CLOC + ((size_t)item * 128 + dv) * 64 + dk); am[u] = AUX[AX_CHK + 2 * item]; fl[u] = AUX[AX_CHK + 2 * item + 1];
                nl[u] = (e < 64) ? AUX[AX_NLOC + item * 64 + e] : 0.f; }
#pragma unroll
            for (int u = 0; u < 8; ++u) { const int item = bh * MNCH + cb + u;
                const float Mn = fmaxf(m, am[u]), g = __expf(m - Mn), ee = __expf(am[u] - Mn);
                bf16* sti = ST + (size_t)item * ST_ROWS * 64;
                *(unsigned*)(sti + dv * 64 + dk) = pk2h(c0, c1);
                if (e < 64) sti[128 * 64 + e] = (bf16)f2bf(nacc);
                else if (e < 64 + 15 * 32) { const int z = e - 64; *(unsigned*)(sti + (129 + (z >> 5)) * 64 + (z & 31) * 2) = 0u; }
                if (e == 0) AUX[AX_MST + item] = m;
                c0 = g * c0 + ee * cl[u].x; c1 = g * c1 + ee * cl[u].y; nacc = g * nacc + ee * nl[u];
                m = fl[u] + Mn; } }
        const int b = bh >> 3, h = bh & 7;
        float* oc = F.out + O_PAC + (((size_t)(j * BP + b) * HA + h) * DKA) * DVA;
        oc[(size_t)dk * DVA + dv] = c0; oc[(size_t)(dk + 1) * DVA + dv] = c1;
        if (e < 64) F.out[O_PAN + ((size_t)(j * BP + b) * HA + h) * DKA + e] = nacc;
        if (e == 0) F.out[O_PAM + (size_t)(j * BP + b) * HA + h] = m;
    }
}
__device__ __forceinline__ void mlstm_C(Frame& F, int j, const float* anorm) {
    LAS bf16* Qs = (LAS bf16*)F.lds; LAS bf16* Ks = Qs + 128 * 72; LAS bf16* Vt = Ks + 128 * 72; LAS bf16* Ws = Vt + ST_ROWS * 136;
    LAS float* fa = (LAS float*)(Ws + 128 * 136); LAS float* fM = fa + 128; LAS float* fg = fM + 128; LAS float* fe = fg + 128;
    const bf16* PROJ = (const bf16*)(F.ws + WS_PROJ); const float* GT = (const float*)(F.ws + WS_GATES);
    const bf16* ST = (const bf16*)(F.ws + SC_ST); const float* AUX = (const float*)(F.ws + SC_AUX); bf16* H = (bf16*)(F.ws + WS_H);
    const int r16 = F.lane & 15, q = F.lane >> 4;
    for (int p = F.tid; p < 16 * 136; p += NTHR) Vt[128 * 136 + p] = (bf16)((p < 128) ? 0x3f80u : 0u);
    for (int item = F.vcu; item < MITEMS; item += F.G) {
        const int bh = item >> 5, c = item & 31, b = bh >> 3, h = bh & 7, row0 = b * TP + c * MLC;
        TS_MARK(F, 41);
        v4u vv[4], qv[2], kv[2];
#pragma unroll
        for (int u = 0; u < 4; ++u) { const int p = F.tid + u * NTHR, r = p & 127, c8 = p >> 7; vv[u] = *(const v4u*)(PROJ + (size_t)(row0 + r) * NPROJ + 1024 + h * 128 + c8 * 8); }
#pragma unroll
        for (int u = 0; u < 2; ++u) { const int p = F.tid + u * NTHR, r = p >> 3, c8 = p & 7; qv[u] = *(const v4u*)(PROJ + (size_t)(row0 + r) * NPROJ + h * 64 + c8 * 8); kv[u] = *(const v4u*)(PROJ + (size_t)(row0 + r) * NPROJ + 512 + h * 64 + c8 * 8); }
        if (F.wave == 0) { float a0, a1, f0, f1; ml_gates(GT, row0, h, F.lane, a0, a1, f0, f1); const float mc = AUX[AX_MST + item];
            const float cm0 = wave_scan_max(a0, F.lane), cm1 = fmaxf(__shfl(cm0, 63), wave_scan_max(a1, F.lane)); const float M0 = fmaxf(mc, cm0), M1 = fmaxf(mc, cm1);
            fa[F.lane] = a0; fa[64 + F.lane] = a1; fM[F.lane] = M0; fM[64 + F.lane] = M1; fg[F.lane] = __expf(mc - M0); fg[64 + F.lane] = __expf(mc - M1);
            fe[F.lane] = __expf(-(f0 + M0)); fe[64 + F.lane] = __expf(-(f1 + M1)); }
#pragma unroll
        for (int u = 0; u < 2; ++u) { const int p = F.tid + u * NTHR, r = p >> 3, c8 = p & 7; *(LAS v4u*)(Qs + r * 72 + c8 * 8) = qv[u]; *(LAS v4u*)(Ks + r * 72 + c8 * 8) = kv[u]; }
#pragma unroll
        for (int u = 0; u < 4; ++u) { const int p = F.tid + u * NTHR, r = p & 127, c8 = p >> 7; const v4u v = vv[u]; LAS bf16* d = Vt + (c8 * 8) * 136 + r;
            d[0 * 136] = (bf16)(v.x & 0xffffu); d[1 * 136] = (bf16)(v.x >> 16); d[2 * 136] = (bf16)(v.y & 0xffffu); d[3 * 136] = (bf16)(v.y >> 16);
            d[4 * 136] = (bf16)(v.z & 0xffffu); d[5 * 136] = (bf16)(v.z >> 16); d[6 * 136] = (bf16)(v.w & 0xffffu); d[7 * 136] = (bf16)(v.w >> 16); }
        __syncthreads();
        TS_MARK(F, 42);
#pragma unroll
        for (int tt = 0; tt < 8; ++tt) { const int st = (F.wave - tt) & 7; f32x4 acc = (f32x4){0.f, 0.f, 0.f, 0.f};
            if (st <= tt) acc = mma_ll<2>(Qs + tt * 16 * 72, 72, Ks + st * 16 * 72, 72, acc, F.lane);
            const int sx = st * 16 + r16; const float as = fa[sx];
#pragma unroll
            for (int r = 0; r < 4; ++r) { const int t = tt * 16 + 4 * q + r; const float w = (sx <= t) ? acc[r] * __expf(as - fM[t]) : 0.f; Ws[t * 136 + sx] = (bf16)f2bf(w); } }
        __syncthreads();
        TS_MARK(F, 43);
        const int tt = F.wave, t = tt * 16 + r16, nks = (tt + 2) >> 1;
        f32x4 ngv[8]; v2u ovv[8];
#pragma unroll
        for (int dvt = 0; dvt < 8; ++dvt) { const int col = h * 128 + dvt * 16 + 4 * q; ngv[dvt] = *(const f32x4*)(anorm + j * 1024 + col); ovv[dvt] = *(const v2u*)(PROJ + (size_t)(row0 + t) * NPROJ + 2048 + col); }
        f32x4 a1[9], a2[9];
#pragma unroll
        for (int dvt = 0; dvt < 9; ++dvt) {
            a2[dvt] = mma_gl<2>(ST + ((size_t)item * ST_ROWS + dvt * 16) * 64, 64, Qs + tt * 16 * 72, 72, (f32x4){0.f, 0.f, 0.f, 0.f}, F.lane);
            f32x4 acc = (f32x4){0.f, 0.f, 0.f, 0.f};
            for (int ks = 0; ks < nks; ++ks) { const bf16x8 av = *(const LAS bf16x8*)(Vt + (dvt * 16 + r16) * 136 + ks * 32 + q * 8); const bf16x8 bw = *(const LAS bf16x8*)(Ws + (tt * 16 + r16) * 136 + ks * 32 + q * 8);
                acc = __builtin_amdgcn_mfma_f32_16x16x32_bf16(av, bw, acc, 0, 0, 0); }
            a1[dvt] = acc; }
        TS_MARK(F, 44);
        const float gt = fg[t]; const float den = __shfl(a1[8][0], r16) + gt * __shfl(a2[8][0], r16); const float rd = frcp(fmaxf(fabsf(den), fe[t]));
        float sq = 0.f;
#pragma unroll
        for (int dvt = 0; dvt < 8; ++dvt)
#pragma unroll
            for (int r = 0; r < 4; ++r) { const float hv = (a1[dvt][r] + gt * a2[dvt][r]) * rd; a1[dvt][r] = hv; sq += hv * hv; }
        sq += __shfl_xor(sq, 16); sq += __shfl_xor(sq, 32);
        const float rs = frsq(sq * (1.0f / DVA) + EPS);
#pragma unroll
        for (int dvt = 0; dvt < 8; ++dvt) { const int col = h * 128 + dvt * 16 + 4 * q;
            const f32x4 ng = ngv[dvt]; const v2u ov = ovv[dvt];
            const float o0 = a1[dvt][0] * rs * ng.x * sigmoidf_(bflo(ov.x)), o1 = a1[dvt][1] * rs * ng.y * sigmoidf_(bfhi(ov.x)), o2 = a1[dvt][2] * rs * ng.z * sigmoidf_(bflo(ov.y)), o3 = a1[dvt][3] * rs * ng.w * sigmoidf_(bfhi(ov.y));
            v2u w; w.x = pk2h(o0, o1); w.y = pk2h(o2, o3); *(v2u*)(H + (size_t)(row0 + t) * D + col) = w; }
        __syncthreads();
        TS_MARK(F, 45);
    }
}
struct MlsPre { float m0, gi[4], gf[4], qk, v, cvv[16], o, an, n0v; };
#define MLS_LOAD(P, it_) do { const int b_ = (it_) >> 3, h_ = (it_) & 7, row_ = MP + b_ * TS; \
    (P).m0 = st_m[(size_t)(j * BS + b_) * HA + h_]; \
    _Pragma("unroll") for (int t_ = 0; t_ < 4; ++t_) { (P).gi[t_] = GT[(size_t)(row_ + t_) * 16 + h_]; (P).gf[t_] = GT[(size_t)(row_ + t_) * 16 + 8 + h_]; } \
    { const int t_ = (F.tid >> 6) & 3, d_ = F.tid & 63; (P).qk = bf2f(PROJ[(size_t)(row_ + t_) * NPROJ + ((F.tid < 256) ? 0 : 512) + h_ * 64 + d_]); } \
    { const int t2_ = F.tid >> 7, dv_ = F.tid & 127; (P).v = bf2f(PROJ[(size_t)(row_ + t2_) * NPROJ + 1024 + h_ * 128 + dv_]); (P).o = bf2f(PROJ[(size_t)(row_ + t2_) * NPROJ + 2048 + h_ * 128 + dv_]); (P).an = anorm[j * 1024 + h_ * 128 + dv_]; \
      const float* c0p_ = st_c + (((size_t)(j * BS + b_) * HA + h_) * DKA) * DVA; \
      _Pragma("unroll") for (int i_ = 0; i_ < 16; ++i_) (P).cvv[i_] = c0p_[(size_t)(t2_ * 16 + i_) * DVA + dv_]; } \
    (P).n0v = st_n[((size_t)(j * BS + b_) * HA + h_) * DKA + (F.tid & 63)]; } while (0)
__device__ __forceinline__ void mlstm_S(Frame& F, int j, const float* __restrict__ anorm, const float* __restrict__ st_c, const float* __restrict__ st_n, const float* __restrict__ st_m) {
    LAS float* qs = (LAS float*)F.lds; LAS float* ks = qs + 256; LAS float* vs = ks + 256; LAS float* qkw = vs + 512; LAS float* qn = qkw + 16; LAS float* part = qn + 16; LAS float* red = part + 2048; LAS float* ns = red + 16;
    const bf16* __restrict__ PROJ = (const bf16*)(F.ws + WS_PROJ); const float* __restrict__ GT = (const float*)(F.ws + WS_GATES); bf16* H = (bf16*)(F.ws + WS_H);
    MlsPre nx;
    if (F.vcu < BS * HA) MLS_LOAD(nx, F.vcu);
    for (int item = F.vcu; item < BS * HA; item += F.G) {
        const int b = item >> 3, h = item & 7, row0 = MP + b * TS;
        TS_MARK(F, 51);
        const MlsPre P = nx;
        if (item + F.G < BS * HA) MLS_LOAD(nx, item + F.G);
        float a[4], fc[4], Ml[4], g[4], mt[4]; const float m0 = P.m0;
        { float run = 0.f, cm = -3.0e38f;
#pragma unroll
            for (int t = 0; t < 4; ++t) { run += P.gf[t]; fc[t] = run; a[t] = P.gi[t] - run; cm = fmaxf(cm, a[t]); Ml[t] = fmaxf(m0, cm); g[t] = __expf(m0 - Ml[t]); mt[t] = run + Ml[t]; } }
        { const int t = (F.tid >> 6) & 3, d = F.tid & 63; if (F.tid < 256) qs[t * 64 + d] = P.qk; else ks[t * 64 + d] = P.qk;
            vs[F.tid] = P.v; if (F.tid < 64) ns[F.tid] = P.n0v; }
        __syncthreads();
        TS_MARK(F, 52);
        if (F.tid < 512) { const int pr = F.tid >> 4, l16 = F.tid & 15;
            const int t = (pr < 16) ? (pr >> 2) : (pr & 3), s = pr & 3; float dt = 0.f;
            if (pr < 20) { const LAS float* y = (pr < 16) ? ks + s * 64 : ns;
#pragma unroll
                for (int i = 0; i < 4; ++i) dt += qs[t * 64 + l16 * 4 + i] * y[l16 * 4 + i]; }
            dt += __shfl_xor(dt, 8); dt += __shfl_xor(dt, 4); dt += __shfl_xor(dt, 2); dt += __shfl_xor(dt, 1);
            if (l16 == 0 && pr < 16) { float as = a[0], Mt = Ml[0];
                as = (s == 1) ? a[1] : as; as = (s == 2) ? a[2] : as; as = (s == 3) ? a[3] : as; Mt = (t == 1) ? Ml[1] : Mt; Mt = (t == 2) ? Ml[2] : Mt; Mt = (t == 3) ? Ml[3] : Mt;
                qkw[pr] = (s <= t) ? dt * __expf(as - Mt) : 0.f; }
            else if (l16 == 0 && pr < 20) qn[pr - 16] = dt; }
        { const int dv = F.tid & 127, dkq = F.tid >> 7; float* cout = F.out + O_SAC + (((size_t)(j * BS + b) * HA + h) * DKA) * DVA;
            float p0 = 0.f, p1 = 0.f, p2 = 0.f, p3 = 0.f; const float gl = g[3];
            float wl[4];
#pragma unroll
            for (int s = 0; s < 4; ++s) wl[s] = __expf(a[s] - Ml[3]) * vs[s * 128 + dv];
#pragma unroll
            for (int i4 = 0; i4 < 4; ++i4) { const int dk0 = dkq * 16 + i4 * 4;
                const f32x4 q0 = *(const LAS f32x4*)(qs + dk0), q1 = *(const LAS f32x4*)(qs + 64 + dk0), q2 = *(const LAS f32x4*)(qs + 128 + dk0), q3 = *(const LAS f32x4*)(qs + 192 + dk0);
                const f32x4 k0 = *(const LAS f32x4*)(ks + dk0), k1 = *(const LAS f32x4*)(ks + 64 + dk0), k2 = *(const LAS f32x4*)(ks + 128 + dk0), k3 = *(const LAS f32x4*)(ks + 192 + dk0);
#pragma unroll
                for (int e = 0; e < 4; ++e) { const float cv = P.cvv[i4 * 4 + e];
                    p0 += q0[e] * cv; p1 += q1[e] * cv; p2 += q2[e] * cv; p3 += q3[e] * cv;
                    cout[(size_t)(dk0 + e) * DVA + dv] = gl * cv + (wl[0] * k0[e] + wl[1] * k1[e]) + (wl[2] * k2[e] + wl[3] * k3[e]); } }
            part[(dkq * 4 + 0) * 128 + dv] = p0; part[(dkq * 4 + 1) * 128 + dv] = p1; part[(dkq * 4 + 2) * 128 + dv] = p2; part[(dkq * 4 + 3) * 128 + dv] = p3; }
        __syncthreads();
        TS_MARK(F, 53);
        float hv;
        { const int t = F.tid >> 7, dv = F.tid & 127; float gt = g[0], emt = mt[0];
            gt = (t == 1) ? g[1] : gt; gt = (t == 2) ? g[2] : gt; gt = (t == 3) ? g[3] : gt; emt = (t == 1) ? mt[1] : emt; emt = (t == 2) ? mt[2] : emt; emt = (t == 3) ? mt[3] : emt;
            float num = 0.f, den = 0.f;
#pragma unroll
            for (int s = 0; s < 4; ++s) { const float w = qkw[t * 4 + s]; num += w * vs[s * 128 + dv]; den += w; }
            num += gt * ((part[(0 * 4 + t) * 128 + dv] + part[(1 * 4 + t) * 128 + dv]) + (part[(2 * 4 + t) * 128 + dv] + part[(3 * 4 + t) * 128 + dv]));
            den += gt * qn[t];
            hv = num * frcp(fmaxf(fabsf(den), __expf(-emt)));
            const float sq = wave_sum(hv * hv); if (F.lane == 0) red[F.wave] = sq; }
        __syncthreads();
        TS_MARK(F, 54);
        { const int t = F.tid >> 7, dv = F.tid & 127, col = h * 128 + dv; const float rs = frsq((red[2 * t] + red[2 * t + 1]) * (1.0f / DVA) + EPS);
            H[(size_t)(row0 + t) * D + col] = (bf16)f2bf(hv * rs * P.an * sigmoidf_(P.o)); }
        if (F.tid < 64) { const int d = F.tid; float nn = g[3] * ns[d];
#pragma unroll
            for (int s = 0; s < 4; ++s) nn += __expf(a[s] - Ml[3]) * ks[s * 64 + d];
            F.out[O_SAN + ((size_t)(j * BS + b) * HA + h) * DKA + d] = nn; }
        if (F.tid == 0) F.out[O_SAM + (size_t)(j * BS + b) * HA + h] = mt[3];
        __syncthreads();
        TS_MARK(F, 55);
    }
}
__device__ __forceinline__ void gla_bc(Frame& F, const f32x4 zv, const float (&wg)[16], float bgv, LAS float* zs, LAS float* gsum, LAS float* bc) {
    if (F.tid < 256) ((LAS f32x4*)zs)[F.tid] = zv;
    const int d = F.tid & 127, tq = F.tid >> 7;
    __syncthreads();
    float pr[16]; float run = 0.f;
#pragma unroll
    for (int i = 0; i < 16; ++i) { const LAS float* z = zs + (tq * 16 + i) * 16; float x = bgv;
#pragma unroll
        for (int r = 0; r < 16; ++r) x += z[r] * wg[r];
        run += logsigmoidf(x) * (1.0f / 16.0f); pr[i] = run; }
    gsum[tq * 128 + d] = run;
    __syncthreads();
    float off = 0.f;
    if (tq > 0) off += gsum[d];
    if (tq > 1) off += gsum[128 + d];
    if (tq > 2) off += gsum[256 + d];
#pragma unroll
    for (int i = 0; i < 16; ++i) bc[(tq * 16 + i) * 128 + d] = pr[i] + off;
    __syncthreads();
}
#define GLA_WG(h_) do { if ((h_) != hcur) { hcur = (h_); const int col_ = (h_) * 128 + (F.tid & 127); _Pragma("unroll") for (int r_ = 0; r_ < 16; ++r_) wg[r_] = WG[r_ * 512 + col_]; bgv = BG[col_]; } } while (0)
__device__ __forceinline__ void gla_A(Frame& F, const float* __restrict__ WG, const float* __restrict__ BG) {
    LAS float* zs = (LAS float*)F.lds; LAS float* gsum = zs + 1024; LAS float* bc = gsum + 512; LAS bf16* Kt = (LAS bf16*)(bc + 8192); LAS bf16* Vt = Kt + 128 * 72;
    const bf16* __restrict__ PROJ = (const bf16*)(F.ws + WS_PROJ); const float* __restrict__ GT = (const float*)(F.ws + WS_GATES); float* SLOC = (float*)(F.ws + SC_LOC); float* AUX = (float*)(F.ws + SC_AUX);
    float wg[16], bgv = 0.f; int hcur = -1;
    for (int item = F.vcu; item < BP * HB * NCH; item += F.G) {
        const int bh = item >> 6, c = item & 63, b = bh >> 2, h = bh & 3, row0 = b * TP + c * LCH;
        f32x4 zv = (f32x4){0.f, 0.f, 0.f, 0.f}; if (F.tid < 256) zv = ((const f32x4*)(GT + (size_t)row0 * 16))[F.tid];
        v4u kv[2], vv[4];
#pragma unroll
        for (int u = 0; u < 2; ++u) { const int p = F.tid + u * NTHR, r = p & 63, c8 = p >> 6; kv[u] = *(const v4u*)(PROJ + (size_t)(row0 + r) * NPROJ + 512 + h * 128 + c8 * 8); }
#pragma unroll
        for (int u = 0; u < 4; ++u) { const int p = F.tid + u * NTHR, r = p & 63, c8 = p >> 6; vv[u] = *(const v4u*)(PROJ + (size_t)(row0 + r) * NPROJ + 1024 + h * 256 + c8 * 8); }
        GLA_WG(h);
        gla_bc(F, zv, wg, bgv, zs, gsum, bc);
        if (F.tid < 128) AUX[AX_BL + item * 128 + F.tid] = bc[63 * 128 + F.tid];
#pragma unroll
        for (int u = 0; u < 2; ++u) { const int p = F.tid + u * NTHR, r = p & 63, c8 = p >> 6; float e[8]; unpack8(kv[u], e);
            LAS bf16* dd = Kt + (c8 * 8) * 72 + r;
#pragma unroll
            for (int i = 0; i < 8; ++i) { const int dk = c8 * 8 + i; dd[i * 72] = (bf16)f2bf(e[i] * __expf(bc[63 * 128 + dk] - bc[r * 128 + dk])); } }
#pragma unroll
        for (int u = 0; u < 4; ++u) { const int p = F.tid + u * NTHR, r = p & 63, c8 = p >> 6; const v4u v = vv[u]; LAS bf16* d = Vt + (c8 * 8) * 72 + r;
            d[0 * 72] = (bf16)(v.x & 0xffffu); d[1 * 72] = (bf16)(v.x >> 16); d[2 * 72] = (bf16)(v.y & 0xffffu); d[3 * 72] = (bf16)(v.y >> 16);
            d[4 * 72] = (bf16)(v.z & 0xffffu); d[5 * 72] = (bf16)(v.z >> 16); d[6 * 72] = (bf16)(v.w & 0xffffu); d[7 * 72] = (bf16)(v.w >> 16); }
        __syncthreads();
        for (int jj = 0; jj < 16; ++jj) { const int tile = F.wave * 16 + jj, dkt = tile & 7, dvt = tile >> 3;
            const f32x4 acc = mma_ll<2>(Kt + dkt * 16 * 72, 72, Vt + dvt * 16 * 72, 72, (f32x4){0.f, 0.f, 0.f, 0.f}, F.lane);
            *(f32x4*)(SLOC + ((size_t)item * 256 + dvt * 16 + (F.lane & 15)) * 128 + dkt * 16 + 4 * (F.lane >> 4)) = acc; }
        __syncthreads();
    }
}
__device__ __forceinline__ void gla_B(Frame& F) {
    const float* __restrict__ SLOC = (const float*)(F.ws + SC_LOC); bf16* __restrict__ ST = (bf16*)(F.ws + SC_ST); const float* __restrict__ AUX = (const float*)(F.ws + SC_AUX);
    for (int slot = F.vcu * NTHR + F.tid; slot < BP * HB * 8192; slot += F.G * NTHR) {
        const int bh = slot >> 13, e = slot & 8191, dv = e >> 5, dk0 = (e & 31) * 4;
        f32x4 S = (f32x4){0.f, 0.f, 0.f, 0.f};
        for (int cb = 0; cb < NCH; cb += 8) {
            f32x4 bl[8], sl[8];
#pragma unroll
            for (int u = 0; u < 8; ++u) { const int item = bh * 64 + cb + u; bl[u] = *(const f32x4*)(AUX + AX_BL + item * 128 + dk0); sl[u] = *(const f32x4*)(SLOC + ((size_t)item * 256 + dv) * 128 + dk0); }
#pragma unroll
            for (int u = 0; u < 8; ++u) { const int item = bh * 64 + cb + u;
                v2u w; w.x = pk2h(S.x, S.y); w.y = pk2h(S.z, S.w); *(v2u*)(ST + ((size_t)item * 256 + dv) * 128 + dk0) = w;
                S.x = __expf(bl[u].x) * S.x + sl[u].x; S.y = __expf(bl[u].y) * S.y + sl[u].y; S.z = __expf(bl[u].z) * S.z + sl[u].z; S.w = __expf(bl[u].w) * S.w + sl[u].w; } }
        float* o = F.out + O_PG + ((size_t)bh * DKB + dk0) * DVB + dv;
        o[0] = S.x; o[DVB] = S.y; o[2 * DVB] = S.z; o[3 * DVB] = S.w;
    }
}
__device__ __forceinline__ void gla_C(Frame& F, const float* __restrict__ WG, const float* __restrict__ BG, const float* __restrict__ bnorm) {
    LAS float* zs = (LAS float*)F.lds; LAS float* gsum = zs + 1024; LAS float* bc = gsum + 512; LAS bf16* Qs = (LAS bf16*)(bc + 8192); LAS bf16* Ks = Qs + 64 * 136; LAS bf16* Vt = Ks + 64 * 136;
    LAS bf16* At = Vt + 256 * 72; LAS float* ssq = (LAS float*)(At + 64 * 72);
    const bf16* __restrict__ PROJ = (const bf16*)(F.ws + WS_PROJ); const float* __restrict__ GT = (const float*)(F.ws + WS_GATES); const bf16* __restrict__ ST = (const bf16*)(F.ws + SC_ST); bf16* H = (bf16*)(F.ws + WS_H);
    const int r16 = F.lane & 15, q = F.lane >> 4;
    for (int item = F.vcu; item < BP * HB * NCH; item += F.G) {
        const int bh = item >> 6, c = item & 63, b = bh >> 2, h = bh & 3, row0 = b * TP + c * LCH;
        TS_MARK(F, 61);
        float wg[16], bgv = 0.f; int hcur = -1;
        f32x4 zv = (f32x4){0.f, 0.f, 0.f, 0.f}; if (F.tid < 256) zv = ((const f32x4*)(GT + (size_t)row0 * 16))[F.tid];
        v4u qv[2], kv[2], vv[4];
#pragma unroll
        for (int u = 0; u < 2; ++u) { const int p = F.tid + u * NTHR, r = p >> 4, c8 = p & 15; qv[u] = *(const v4u*)(PROJ + (size_t)(row0 + r) * NPROJ + h * 128 + c8 * 8); kv[u] = *(const v4u*)(PROJ + (size_t)(row0 + r) * NPROJ + 512 + h * 128 + c8 * 8); }
        GLA_WG(h);
        gla_bc(F, zv, wg, bgv, zs, gsum, bc);
        TS_MARK(F, 62);
#pragma unroll
        for (int u = 0; u < 4; ++u) { const int p = F.tid + u * NTHR, r = p & 63, c8 = p >> 6; vv[u] = *(const v4u*)(PROJ + (size_t)(row0 + r) * NPROJ + 1024 + h * 256 + c8 * 8); }
#pragma unroll
        for (int u = 0; u < 2; ++u) { const int p = F.tid + u * NTHR, r = p >> 4, c8 = p & 15; float e[8], f[8]; unpack8(qv[u], e); unpack8(kv[u], f);
#pragma unroll
            for (int i = 0; i < 8; ++i) { const float bb = bc[r * 128 + c8 * 8 + i]; e[i] *= __expf(bb); f[i] *= __expf(-bb); }
            v4u w; w.x = pk2h(e[0], e[1]); w.y = pk2h(e[2], e[3]); w.z = pk2h(e[4], e[5]); w.w = pk2h(e[6], e[7]); *(LAS v4u*)(Qs + r * 136 + c8 * 8) = w;
            w.x = pk2h(f[0], f[1]); w.y = pk2h(f[2], f[3]); w.z = pk2h(f[4], f[5]); w.w = pk2h(f[6], f[7]); *(LAS v4u*)(Ks + r * 136 + c8 * 8) = w; }
#pragma unroll
        for (int u = 0; u < 4; ++u) { const int p = F.tid + u * NTHR, r = p & 63, c8 = p >> 6; const v4u v = vv[u]; LAS bf16* d = Vt + (c8 * 8) * 72 + r;
            d[0 * 72] = (bf16)(v.x & 0xffffu); d[1 * 72] = (bf16)(v.x >> 16); d[2 * 72] = (bf16)(v.y & 0xffffu); d[3 * 72] = (bf16)(v.y >> 16);
            d[4 * 72] = (bf16)(v.z & 0xffffu); d[5 * 72] = (bf16)(v.z >> 16); d[6 * 72] = (bf16)(v.w & 0xffffu); d[7 * 72] = (bf16)(v.w >> 16); }
        f32x4 ngv[2]; v2u rvv[2][4];
#pragma unroll
        for (int dl = 0; dl < 2; ++dl) { const int dvt = F.wave * 2 + dl, col = h * 256 + dvt * 16 + 4 * q; ngv[dl] = *(const f32x4*)(bnorm + col);
#pragma unroll
            for (int tt = 0; tt < 4; ++tt) rvv[dl][tt] = *(const v2u*)(PROJ + (size_t)(row0 + tt * 16 + r16) * NPROJ + 2048 + col); }
        __syncthreads();
        TS_MARK(F, 63);
        bf16x8 sa[2][4];
#pragma unroll
        for (int dl = 0; dl < 2; ++dl)
#pragma unroll
            for (int ks = 0; ks < 4; ++ks) sa[dl][ks] = *(const bf16x8*)(ST + ((size_t)item * 256 + (F.wave * 2 + dl) * 16 + r16) * 128 + ks * 32 + q * 8);
#pragma unroll
        for (int jj = 0; jj < 2; ++jj) { const int tile = F.wave * 2 + jj, tt = tile >> 2, st = tile & 3; f32x4 acc = (f32x4){0.f, 0.f, 0.f, 0.f};
            if (st <= tt) acc = mma_ll<4>(Qs + tt * 16 * 136, 136, Ks + st * 16 * 136, 136, acc, F.lane);
            const int sx = st * 16 + r16;
#pragma unroll
            for (int r = 0; r < 4; ++r) { const int t = tt * 16 + 4 * q + r; At[t * 72 + sx] = (bf16)f2bf((sx <= t) ? acc[r] : 0.f); } }
        __syncthreads();
        TS_MARK(F, 64);
        f32x4 o[2][4];
#pragma unroll
        for (int dl = 0; dl < 2; ++dl) { const int dvt = F.wave * 2 + dl;
#pragma unroll
            for (int tt = 0; tt < 4; ++tt) { f32x4 acc = mma_ll<2>(Vt + dvt * 16 * 72, 72, At + tt * 16 * 72, 72, (f32x4){0.f, 0.f, 0.f, 0.f}, F.lane);
#pragma unroll
                for (int ks = 0; ks < 4; ++ks) { const bf16x8 bq = *(const LAS bf16x8*)(Qs + (tt * 16 + r16) * 136 + ks * 32 + q * 8); acc = __builtin_amdgcn_mfma_f32_16x16x32_bf16(sa[dl][ks], bq, acc, 0, 0, 0); }
                o[dl][tt] = acc; } }
#pragma unroll
        for (int tt = 0; tt < 4; ++tt) { float sq = 0.f;
#pragma unroll
            for (int dl = 0; dl < 2; ++dl)
#pragma unroll
                for (int r = 0; r < 4; ++r) sq += o[dl][tt][r] * o[dl][tt][r];
            sq += __shfl_xor(sq, 16); sq += __shfl_xor(sq, 32);
            if (F.lane < 16) ssq[F.wave * 64 + tt * 16 + r16] = sq; }
        TS_MARK(F, 65);
        __syncthreads();
        TS_MARK(F, 66);
#pragma unroll
        for (int tt = 0; tt < 4; ++tt) { const int t = tt * 16 + r16; float tot = 0.f;
#pragma unroll
            for (int w = 0; w < 8; ++w) tot += ssq[w * 64 + t];
            const float rs = frsq(tot * (1.0f / DVB) + EPS);
#pragma unroll
            for (int dl = 0; dl < 2; ++dl) { const int col = h * 256 + (F.wave * 2 + dl) * 16 + 4 * q;
                const f32x4 ng = ngv[dl]; const v2u rv = rvv[dl][tt];
                const float r0 = bflo(rv.x), r1 = bfhi(rv.x), r2 = bflo(rv.y), r3 = bfhi(rv.y);
                const float o0 = o[dl][tt][0] * rs * ng.x * r0 * sigmoidf_(r0), o1 = o[dl][tt][1] * rs * ng.y * r1 * sigmoidf_(r1), o2 = o[dl][tt][2] * rs * ng.z * r2 * sigmoidf_(r2), o3 = o[dl][tt][3] * rs * ng.w * r3 * sigmoidf_(r3);
                v2u w; w.x = pk2h(o0, o1); w.y = pk2h(o2, o3); *(v2u*)(H + (size_t)(row0 + t) * D + col) = w; } }
        __syncthreads();
    }
}
__device__ __forceinline__ void gla_S(Frame& F, const float* WG, const float* BG, const float* bnorm, const float* st_s) {
    LAS float* bcs = (LAS float*)F.lds;
    LAS float* qs = bcs + 512;
    LAS float* kr = qs + 512;
    LAS float* kh = kr + 512;
    LAS float* vs = kh + 512;
    LAS float* att = vs + 1024;
    LAS float* part = att + 16;
    LAS float* red = part + 2048;
    const bf16* PROJ = (const bf16*)(F.ws + WS_PROJ); const float* GT = (const float*)(F.ws + WS_GATES); bf16* H = (bf16*)(F.ws + WS_H);
    for (int item = F.vcu; item < BS * HB; item += F.G) {
        const int b = item >> 2, h = item & 3, row0 = MP + b * TS;
        { const int t = F.tid >> 7, d = F.tid & 127, col = h * 128 + d; float x = BG[col];
#pragma unroll
            for (int r = 0; r < 16; ++r) x += GT[(size_t)(row0 + t) * 16 + r] * WG[r * 512 + col];
            bcs[t * 128 + d] = logsigmoidf(x) * (1.0f / 16.0f);
            kr[t * 128 + d] = bf2f(PROJ[(size_t)(row0 + t) * NPROJ + 512 + col]);
            vs[t * 256 + d] = bf2f(PROJ[(size_t)(row0 + t) * NPROJ + 1024 + h * 256 + d]); vs[t * 256 + 128 + d] = bf2f(PROJ[(size_t)(row0 + t) * NPROJ + 1024 + h * 256 + 128 + d]); }
        __syncthreads();
        if (F.tid < 128) { const int d = F.tid; float run = 0.f;
#pragma unroll
            for (int t = 0; t < 4; ++t) { run += bcs[t * 128 + d]; bcs[t * 128 + d] = run; } }
        __syncthreads();
        { const int t = F.tid >> 7, d = F.tid & 127, col = h * 128 + d; const float bb = bcs[t * 128 + d], bl = bcs[3 * 128 + d];
            qs[t * 128 + d] = bf2f(PROJ[(size_t)(row0 + t) * NPROJ + col]) * __expf(bb); kh[t * 128 + d] = kr[t * 128 + d] * __expf(bl - bb); }
        __syncthreads();
        { const int pr = F.tid >> 5, l32 = F.tid & 31, t = pr >> 2, s = pr & 3; float dt = 0.f;
            if (s <= t) {
#pragma unroll
                for (int i = 0; i < 4; ++i) { const int d = l32 * 4 + i; dt += qs[t * 128 + d] * kr[s * 128 + d] * __expf(-bcs[s * 128 + d]); } }
            dt += __shfl_xor(dt, 16); dt += __shfl_xor(dt, 8); dt += __shfl_xor(dt, 4); dt += __shfl_xor(dt, 2); dt += __shfl_xor(dt, 1);
            if (l32 == 0) att[pr] = dt; }
        { const int dv = F.tid & 255, dkh = F.tid >> 8; const float* s0 = st_s + (((size_t)b * HB + h) * DKB) * DVB; float* so = F.out + O_SG + (((size_t)b * HB + h) * DKB) * DVB;
            float p0 = 0.f, p1 = 0.f, p2 = 0.f, p3 = 0.f; const float v0 = vs[dv], v1 = vs[256 + dv], v2 = vs[512 + dv], v3 = vs[768 + dv];
            for (int d0 = dkh * 64; d0 < dkh * 64 + 64; d0 += 16) {
                float svv[16];
#pragma unroll
                for (int i = 0; i < 16; ++i) svv[i] = s0[(size_t)(d0 + i) * DVB + dv];
#pragma unroll
                for (int i4 = 0; i4 < 4; ++i4) { const int dk0 = d0 + i4 * 4;
                    const f32x4 q0 = *(const LAS f32x4*)(qs + dk0), q1 = *(const LAS f32x4*)(qs + 128 + dk0), q2 = *(const LAS f32x4*)(qs + 256 + dk0), q3 = *(const LAS f32x4*)(qs + 384 + dk0);
                    const f32x4 k0 = *(const LAS f32x4*)(kh + dk0), k1 = *(const LAS f32x4*)(kh + 128 + dk0), k2 = *(const LAS f32x4*)(kh + 256 + dk0), k3 = *(const LAS f32x4*)(kh + 384 + dk0);
                    const f32x4 bl = *(const LAS f32x4*)(bcs + 3 * 128 + dk0);
#pragma unroll
                    for (int e = 0; e < 4; ++e) { const float sv = svv[i4 * 4 + e];
                        p0 += q0[e] * sv; p1 += q1[e] * sv; p2 += q2[e] * sv; p3 += q3[e] * sv;
                        so[(size_t)(dk0 + e) * DVB + dv] = __expf(bl[e]) * sv + (k0[e] * v0 + k1[e] * v1) + (k2[e] * v2 + k3[e] * v3); } } }
            part[(dkh * 4 + 0) * 256 + dv] = p0; part[(dkh * 4 + 1) * 256 + dv] = p1; part[(dkh * 4 + 2) * 256 + dv] = p2; part[(dkh * 4 + 3) * 256 + dv] = p3; }
        __syncthreads();
        float ov[2];
        { const int dv = F.tid & 255, th = F.tid >> 8;
#pragma unroll
            for (int u = 0; u < 2; ++u) { const int t = th + 2 * u; float o = part[t * 256 + dv] + part[(4 + t) * 256 + dv];
#pragma unroll
                for (int s = 0; s < 4; ++s) o += att[t * 4 + s] * vs[s * 256 + dv];
                ov[u] = o; const float sq = wave_sum(o * o); if (F.lane == 0) red[F.wave * 2 + u] = sq; } }
        __syncthreads();
        { const int dv = F.tid & 255, th = F.tid >> 8, col = h * 256 + dv;
#pragma unroll
            for (int u = 0; u < 2; ++u) { const int t = th + 2 * u; const int w0 = th * 4; const float tot = (red[(w0 + 0) * 2 + u] + red[(w0 + 1) * 2 + u]) + (red[(w0 + 2) * 2 + u] + red[(w0 + 3) * 2 + u]);
                const float rs = frsq(tot * (1.0f / DVB) + EPS); const float r = bf2f(PROJ[(size_t)(row0 + t) * NPROJ + 2048 + col]);
                H[(size_t)(row0 + t) * D + col] = (bf16)f2bf(ov[u] * rs * bnorm[col] * r * sigmoidf_(r)); } }
        __syncthreads();
    }
}

__device__ __forceinline__ void swa_tile(const LAS bf16* Kw, const LAS bf16* Vt, int ldv, LAS bf16* Pw, int kt0, int jmin, const bf16* qp_r16, bf16* op_r16, const int (&relb)[4], const float (&snk)[4], int lane) {
    const int r16 = lane & 15, q = lane >> 4;
    const bf16x8 qa0 = *(const bf16x8*)(qp_r16 + q * 8), qa1 = *(const bf16x8*)(qp_r16 + 32 + q * 8);
    f32x4 s[9];
#pragma unroll
    for (int kt = 0; kt < 9; ++kt) { const LAS bf16* kp = Kw + ((kt0 + kt) * 16 + r16) * 72 + q * 8;
        f32x4 acc = __builtin_amdgcn_mfma_f32_16x16x32_bf16(qa0, *(const LAS bf16x8*)kp, (f32x4){0.f, 0.f, 0.f, 0.f}, 0, 0, 0);
        s[kt] = __builtin_amdgcn_mfma_f32_16x16x32_bf16(qa1, *(const LAS bf16x8*)(kp + 32), acc, 0, 0, 0); }
    float mx[4] = {-3.0e38f, -3.0e38f, -3.0e38f, -3.0e38f};
#pragma unroll
    for (int kt = 0; kt < 9; ++kt) { const int j = (kt0 + kt) * 16 + r16;
#pragma unroll
        for (int r = 0; r < 4; ++r) { const int rel = relb[r] - j; const bool ok = (rel >= 0) && (rel <= WIN) && (j >= jmin); const float v = ok ? s[kt][r] * 0.125f : -3.0e38f; s[kt][r] = v; mx[r] = fmaxf(mx[r], v); } }
    float sm[4];
#pragma unroll
    for (int r = 0; r < 4; ++r) { float m = mx[r]; m = fmaxf(m, __shfl_xor(m, 1)); m = fmaxf(m, __shfl_xor(m, 2)); m = fmaxf(m, __shfl_xor(m, 4)); m = fmaxf(m, __shfl_xor(m, 8)); mx[r] = fmaxf(m, snk[r]); sm[r] = 0.f; }
#pragma unroll
    for (int kt = 0; kt < 9; ++kt)
#pragma unroll
        for (int r = 0; r < 4; ++r) { const float p = (s[kt][r] > -1.0e38f) ? __expf(s[kt][r] - mx[r]) : 0.f; s[kt][r] = p; sm[r] += p; }
#pragma unroll
    for (int r = 0; r < 4; ++r) { float t = sm[r]; t += __shfl_xor(t, 1); t += __shfl_xor(t, 2); t += __shfl_xor(t, 4); t += __shfl_xor(t, 8); sm[r] = frcp(t + __expf(snk[r] - mx[r])); }
#pragma unroll
    for (int kt = 0; kt < 9; ++kt)
#pragma unroll
        for (int r = 0; r < 4; ++r) Pw[(4 * q + r) * 168 + kt * 16 + r16] = (bf16)f2bf(s[kt][r] * sm[r]);
#pragma unroll
    for (int r = 0; r < 4; ++r) Pw[(4 * q + r) * 168 + 144 + r16] = (bf16)0;
    LDS_WAIT();
#pragma unroll
    for (int dt = 0; dt < 4; ++dt) { f32x4 acc = (f32x4){0.f, 0.f, 0.f, 0.f};
#pragma unroll
        for (int ks = 0; ks < 5; ++ks) { const bf16x8 va = *(const LAS bf16x8*)(Vt + (dt * 16 + r16) * ldv + kt0 * 16 + ks * 32 + q * 8); const bf16x8 pb = *(const LAS bf16x8*)(Pw + r16 * 168 + ks * 32 + q * 8);
            acc = __builtin_amdgcn_mfma_f32_16x16x32_bf16(va, pb, acc, 0, 0, 0); }
        v2u w; w.x = pk2(acc[0], acc[1]); w.y = pk2(acc[2], acc[3]); *(v2u*)(op_r16 + dt * 16 + 4 * q) = w; }
    LDS_WAIT();
}
__device__ __forceinline__ void swa_prompt(Frame& F, const float* sinks) {
    LAS bf16* Kw = (LAS bf16*)F.lds; LAS bf16* Vt = Kw + 256 * 72; LAS bf16* Pw = Vt + 64 * 280 + F.wave * (16 * 168);
    const bf16* PROJ = (const bf16*)(F.ws + WS_PROJ); bf16* H = (bf16*)(F.ws + WS_H);
    const int r16 = F.lane & 15, q = F.lane >> 4;
    for (int item = F.vcu; item < BP * HKV * (TP / WIN); item += F.G) {
        const int qb = item & 31, hkv = (item >> 5) & 3, b = item >> 7;
        const int krow0 = b * TP + (qb - 1) * WIN;
        for (int p = F.tid; p < 256 * 8; p += NTHR) { const int r = p >> 3, c8 = p & 7; v4u v = (v4u){0u, 0u, 0u, 0u};
            if (qb > 0 || r >= WIN) v = *(const v4u*)(PROJ + (size_t)(krow0 + r) * C_IN + 1024 + hkv * 64 + c8 * 8);
            *(LAS v4u*)(Kw + r * 72 + c8 * 8) = v; }
        for (int p = F.tid; p < 256 * 8; p += NTHR) { const int r = p & 255, c8 = p >> 8; v4u v = (v4u){0u, 0u, 0u, 0u};
            if (qb > 0 || r >= WIN) v = *(const v4u*)(PROJ + (size_t)(krow0 + r) * C_IN + 1280 + hkv * 64 + c8 * 8);
            LAS bf16* d = Vt + (c8 * 8) * 280 + r;
            d[0 * 280] = (bf16)(v.x & 0xffffu); d[1 * 280] = (bf16)(v.x >> 16); d[2 * 280] = (bf16)(v.y & 0xffffu); d[3 * 280] = (bf16)(v.y >> 16);
            d[4 * 280] = (bf16)(v.z & 0xffffu); d[5 * 280] = (bf16)(v.z >> 16); d[6 * 280] = (bf16)(v.w & 0xffffu); d[7 * 280] = (bf16)(v.w >> 16); }
        for (int p = F.tid; p < 64 * 24; p += NTHR) { const int r = p / 24, cc = p % 24; Vt[r * 280 + 256 + cc] = (bf16)0; }
        __syncthreads();
        const int g = F.wave >> 1, hq = hkv * 4 + g;
        const float sk = sinks[hq]; const float snk[4] = {sk, sk, sk, sk};
        for (int mt = 0; mt < 4; ++mt) { const int tq0 = (F.wave & 1) * 64 + mt * 16; const int relb[4] = {WIN + tq0 + 4 * q, WIN + tq0 + 4 * q + 1, WIN + tq0 + 4 * q + 2, WIN + tq0 + 4 * q + 3};
            const size_t row = (size_t)b * TP + qb * WIN + tq0 + r16;
            swa_tile(Kw, Vt, 280, Pw, tq0 >> 4, (qb == 0) ? WIN : 0, PROJ + row * C_IN + hq * 64, H + row * D + hq * 64, relb, snk, F.lane); }
        __syncthreads();
    }
    for (int e = F.vcu * NTHR + F.tid; e < BP * WIN * 256; e += F.G * NTHR) { const int d = e & 255, jrow = (e >> 8) & 127, b = e >> 15; const size_t row = (size_t)b * TP + TP - WIN + jrow;
        F.out[O_PSK + ((size_t)b * WIN + jrow) * 256 + d] = bf2f(PROJ[row * C_IN + 1024 + d]); F.out[O_PSV + ((size_t)b * WIN + jrow) * 256 + d] = bf2f(PROJ[row * C_IN + 1280 + d]); }
}
__device__ __forceinline__ void swa_sample(Frame& F, const float* sinks, const float* ck, const float* cv) {
    LAS bf16* Kw = (LAS bf16*)F.lds; LAS bf16* Vt = Kw + 144 * 72; LAS bf16* Pw = Vt + 64 * 168;
    const bf16* PROJ = (const bf16*)(F.ws + WS_PROJ); bf16* H = (bf16*)(F.ws + WS_H);
    const int r16 = F.lane & 15, q = F.lane >> 4;
    for (int item = F.vcu; item < BS * HKV; item += F.G) {
        const int b = item >> 2, hkv = item & 3;
        { float kxs[18], vxs[18];
#pragma unroll
            for (int u = 0; u < 18; ++u) { const int e = F.tid + u * NTHR, r = e >> 6, d = e & 63; float kx = 0.f, vx = 0.f;
                if (r < WIN) { const size_t ci = (((size_t)b * WIN + r) * HKV + hkv) * HDC + d; kx = ck[ci]; vx = cv[ci]; }
                else if (r < WIN + TS) { const size_t row = (size_t)MP + b * TS + (r - WIN); kx = bf2f(PROJ[row * C_IN + 1024 + hkv * 64 + d]); vx = bf2f(PROJ[row * C_IN + 1280 + hkv * 64 + d]); }
                kxs[u] = kx; vxs[u] = vx; }
#pragma unroll
            for (int u = 0; u < 18; ++u) { const int e = F.tid + u * NTHR, r = e >> 6, d = e & 63; const float kx = kxs[u], vx = vxs[u];
                Kw[r * 72 + d] = (bf16)f2bf(kx); Vt[d * 168 + r] = (bf16)f2bf(vx);
                if (r >= TS && r < WIN + TS) { const size_t oi = (((size_t)b * WIN + (r - TS)) * HKV + hkv) * HDC + d; F.out[O_SSK + oi] = kx; F.out[O_SSV + oi] = vx; } } }
        for (int e = F.tid; e < 64 * 16; e += NTHR) { const int d = e >> 4, cc = e & 15; Vt[d * 168 + 144 + cc] = (bf16)0; }
        __syncthreads();
        if (F.wave == 0) { const int gq = r16 >> 2, tq = r16 & 3; const size_t row = (size_t)MP + b * TS + tq; const int hq = hkv * 4 + gq;
            const int relb[4] = {WIN + 0, WIN + 1, WIN + 2, WIN + 3};
            const float sk = sinks[hkv * 4 + q]; const float snk[4] = {sk, sk, sk, sk};
            swa_tile(Kw, Vt, 168, Pw, 0, 0, PROJ + row * C_IN + hq * 64, H + row * D + hq * 64, relb, snk, F.lane); }
        __syncthreads();
    }
}

__device__ __forceinline__ void gemm_small(Frame& F, const bf16* A, const bf16* Bt, int K, int N, bool pj, bf16* O, float* X, const float* bias) {
    const int r16 = F.lane & 15, q = F.lane >> 4, nct = N >> 4, ntile = (MS / 16) * nct;
    for (int id = GW_ID(F); id < ntile; id += GW_N(F)) {
        const int ct = id % nct, rt = id / nct;
        const bf16* ap = A + (size_t)(MP + rt * 16 + r16) * K + q * 8; const bf16* bp = Bt + (size_t)(ct * 16 + r16) * K + q * 8;
        f32x4 acc0 = (f32x4){0.f, 0.f, 0.f, 0.f}, acc1 = acc0;
#pragma unroll 2
        for (int k0 = 0; k0 < K; k0 += 256) {
            bf16x8 a[8], b[8];
#pragma unroll
            for (int i = 0; i < 8; ++i) { a[i] = *(const bf16x8*)(ap + k0 + i * 32); b[i] = *(const bf16x8*)(bp + k0 + i * 32); }
#pragma unroll
            for (int i = 0; i < 8; i += 2) { acc0 = __builtin_amdgcn_mfma_f32_16x16x32_bf16(b[i], a[i], acc0, 0, 0, 0); acc1 = __builtin_amdgcn_mfma_f32_16x16x32_bf16(b[i + 1], a[i + 1], acc1, 0, 0, 0); }
        }
        const f32x4 acc = acc0 + acc1; const size_t row = (size_t)(MP + rt * 16 + r16); const int col = ct * 16 + 4 * q;
        if (pj) { f32x4 v = acc; if (bias) v = v + *(const f32x4*)(bias + col); v2u w; w.x = pk2(v.x, v.y); w.y = pk2(v.z, v.w); *(v2u*)(O + row * N + col) = w; }
        else { f32x4* xp = (f32x4*)(X + row * N + col); *xp = *xp + acc; }
    }
}

__device__ __forceinline__ void gates_small(Frame& F, const bf16* XN, const bf16* WgT, float* GT, int cu_lo, bool act, const float* bi, const float* bf_) {
    const int r16 = F.lane & 15, q = F.lane >> 4, bx = (int)blockIdx.x;
    if (bx < cu_lo) return;
    for (int id = (bx - cu_lo) * NWAVES + F.wave; id < M / 16; id += (F.G - cu_lo) * NWAVES) {
        const bf16* ap = WgT + (size_t)r16 * D + q * 8; const bf16* bp = XN + (size_t)(id * 16 + r16) * D + q * 8;
        f32x4 acc0 = (f32x4){0.f, 0.f, 0.f, 0.f}, acc1 = acc0;
#pragma unroll
        for (int k0 = 0; k0 < D; k0 += 256) {
            bf16x8 a[8], b[8];
#pragma unroll
            for (int i = 0; i < 8; ++i) { a[i] = *(const bf16x8*)(ap + k0 + i * 32); b[i] = *(const bf16x8*)(bp + k0 + i * 32); }
#pragma unroll
            for (int i = 0; i < 8; i += 2) { acc0 = __builtin_amdgcn_mfma_f32_16x16x32_bf16(a[i], b[i], acc0, 0, 0, 0); acc1 = __builtin_amdgcn_mfma_f32_16x16x32_bf16(a[i + 1], b[i + 1], acc1, 0, 0, 0); }
        }
        f32x4 v = acc0 + acc1;
        if (act) { const f32x4 bb = (q < 2) ? *(const f32x4*)(bi + 4 * q) : *(const f32x4*)(bf_ + 4 * (q - 2));
#pragma unroll
            for (int r = 0; r < 4; ++r) { const float z = softcapf(v[r] + bb[r]); v[r] = (q < 2) ? z : logsigmoidf(z); } }
        *(f32x4*)(GT + (size_t)(id * 16 + r16) * 16 + 4 * q) = v;
    }
}
__device__ __forceinline__ void final_norm(Frame& F, const float* g, const float* slab, int nslab) {
    f32x4 gv[4];
#pragma unroll
    for (int j = 0; j < 4; ++j) gv[j] = ((const f32x4*)g)[F.lane + 64 * j];
    f32x4 nx[4];
    { const int m0 = GW_ID(F); if (m0 < M) {
#pragma unroll
        for (int j = 0; j < 4; ++j) nx[j] = ((const f32x4*)(F.out + (size_t)m0 * D))[F.lane + 64 * j]; } }
    for (int m = GW_ID(F); m < M; m += GW_N(F)) {
        f32x4* xr = (f32x4*)(F.out + (size_t)m * D); f32x4 v[4]; float ss = 0.f;
#pragma unroll
        for (int j = 0; j < 4; ++j) v[j] = nx[j];
        { const int mn = m + GW_N(F); if (mn < M) {
#pragma unroll
            for (int j = 0; j < 4; ++j) nx[j] = ((const f32x4*)(F.out + (size_t)mn * D))[F.lane + 64 * j]; } }
        if (m >= MP) for (int sl = 0; sl < nslab; ++sl) { const f32x4* sp = (const f32x4*)(slab + ((size_t)sl * MS + (m - MP)) * D);
#pragma unroll
            for (int j = 0; j < 4; ++j) v[j] = v[j] + sp[F.lane + 64 * j]; }
#pragma unroll
        for (int j = 0; j < 4; ++j) ss += (v[j].x * v[j].x + v[j].y * v[j].y) + (v[j].z * v[j].z + v[j].w * v[j].w);
        const float rs = frsq(wave_sum(ss) * (1.0f / D) + EPS);
#pragma unroll
        for (int j = 0; j < 4; ++j) xr[F.lane + 64 * j] = v[j] * rs * gv[j];
    }
}

#ifndef MK_ONLY
#define MK_ONLY -1
#endif
#ifndef MK_OFF
#define MK_OFF -2
#endif
#define EN(x) ((MK_ONLY < 0 || MK_ONLY == (x)) && MK_OFF != (x))
#ifndef MK_REP
#define MK_REP 0
#endif
#ifndef MK_TMASK
#define MK_TMASK 0
#endif
#ifndef MK_MULTI
#define MK_MULTI 0
#endif
constexpr int N_PHASES = DEPTH * 10 + 1;
constexpr int KS_OUT = 4, KS_DN = 11;
struct Args { const float* in[30]; float* out; unsigned char* ws; int ph_lo, ph_hi; };
__host__ __device__ __forceinline__ bool phase_empty(int ph) { if (ph >= DEPTH * 10) return false; const int layer = ph / 10, st = ph % 10; return (layer % 3 == 2) && (st == 3 || st == 4); }

#define INP(k) ({ int k_ = (k); asm volatile("" : "+s"(k_)); ((const float* const*)__builtin_amdgcn_kernarg_segment_ptr())[k_]; })
__global__ void __launch_bounds__(NTHR, 2) trunk_fwd(Args args) {
    extern __shared__ __attribute__((aligned(16))) unsigned char lds[];
    Frame F;
    F.lds = (LAS unsigned char*)lds;
    F.MISC = (volatile LAS unsigned*)(F.lds + MISC_OFF);
    F.tid = threadIdx.x; F.lane = F.tid & 63; F.wave = __builtin_amdgcn_readfirstlane(F.tid >> 6);
    F.G = gridDim.x; { const int bx = blockIdx.x; F.vcu = (F.G % 8 == 0) ? (bx % 8) * (F.G / 8) + bx / 8 : bx; }
    const int vcu0 = F.vcu;
    F.out = args.out; F.ws = args.ws; F.ctl = (unsigned*)(args.ws + WS_CTL);
    for (int u = F.tid; u < (LDS_BYTES - LDSCTL_OFF) / 4; u += NTHR) ((LAS unsigned*)(F.lds + LDSCTL_OFF))[u] = 0u;
    __syncthreads();
    const int lo = args.ph_lo, hi = args.ph_hi;
    XcdBarrier bar; bar.bar = F.ctl + CW_BAR; bar.x = 0; bar.st = nullptr;
    if (hi - lo > 1) bar = xcd_barrier_post(F.ctl + CW_BAR, F.MISC + 8);

    bool again = false;
#if MK_TMASK
    unsigned long long tsum_ = 0, t0p_ = 0; const bool tmr_ = (blockIdx.x == 0);
#endif
    for (int ph = lo; ph < hi; ++ph) {
        if (phase_empty(ph)) continue;
#if MK_TMASK
        if (tmr_ && !again) t0p_ = __builtin_amdgcn_s_memrealtime();
#endif
        if (ph == DEPTH * 10) { if (EN(10)) final_norm(F, INP(11), (const float*)(F.ws + WS_R1), KS_DN);
#if MK_TMASK
            if (tmr_ && ((MK_TMASK >> 10) & 1)) tsum_ += __builtin_amdgcn_s_memrealtime() - t0p_;
#endif
            continue; }
        const int layer = ph / 10, st = ph % 10, kind = layer % 3, j = layer / 3;
        { int t_ = threadIdx.x; asm volatile("" : "+v"(t_)); F.tid = t_; F.lane = t_ & 63; F.wave = __builtin_amdgcn_readfirstlane(t_ >> 6);
          int g_ = gridDim.x, v_ = vcu0; asm volatile("" : "+s"(g_), "+s"(v_)); F.G = g_; F.vcu = v_;
          unsigned char* w_ = args.ws; float* o_ = args.out; asm volatile("" : "+s"(w_), "+s"(o_)); F.ws = w_; F.out = o_; }
#if MK_TSEG
        if (MK_TSEG_ST >= 0 && blockIdx.x == 0 && threadIdx.x == 0) F.MISC[23] = (st == MK_TSEG_ST) ? 1u : 0u;
#endif
        bf16* WT_IN = (bf16*)(F.ws + WS_WIN); bf16* WT_OUT = (bf16*)(F.ws + WS_WOUT); bf16* WT_UP = (bf16*)(F.ws + WS_WUP); bf16* WT_DN = (bf16*)(F.ws + WS_WDN);
        bf16* XN = (bf16*)(F.ws + WS_XN); bf16* HB_ = (bf16*)(F.ws + WS_H); float* GATES = (float*)(F.ws + WS_GATES);


        if (st == 0 && EN(0)) {
            const float* win = (kind == 0) ? INP(12) + (size_t)j * D * A_IN : (kind == 1) ? INP(17) : INP(22);
            const float* wout = (kind == 0) ? INP(16) + (size_t)j * D * D : (kind == 1) ? INP(21) : INP(25);
            const int ldw = (kind == 2) ? C_IN : A_IN, nin = (kind == 2) ? C_IN : NPROJ;
            const int sb = (kind == 0) ? 512 : 0, se = (kind == 0) ? 1024 : (kind == 1) ? 512 : 0; const float sv = (kind == 0) ? 0.125f : 0.08838834764831845f;
            if (layer == 0) prep_two(F, win, ldw, D, nin, WT_IN, sb, se, sv, wout, D, D, D, WT_OUT);
            const float* xp = (layer == 0) ? INP(0) : F.out; const float* xs = (layer == 0) ? INP(1) : F.out + (size_t)MP * D; float* xd = (layer == 0) ? F.out : nullptr;
            const float* g = INP(9) + (size_t)layer * D;
            if (kind < 2) {
                bf16* WgT = (bf16*)(F.ws + WS_GATES + 3 * MiB / 2);
                for (int e = F.vcu * NTHR + F.tid; e < 16 * D; e += F.G * NTHR) { const int k = e >> 4, c = e & 15; WgT[c * D + k] = (bf16)f2bf(win[(size_t)k * A_IN + NPROJ + c]); } }
            norm_rows<false>(F, xp, xs, xd, g, XN, nullptr, nullptr, (const float*)(F.ws + WS_R1), (layer == 0) ? 0 : KS_DN);
        } else if ((st == 1 || st == 7 || st == 5 || st == 9) && EN(1)) {
            const bool pj = (st == 1 || st == 7);
            const int N = (st == 7) ? 2 * DFF : (st == 1) ? ((kind == 2) ? C_IN : NPROJ) : D, K = (st == 9) ? DFF : D;
            const bf16* A = pj ? XN : (st == 5) ? HB_ : (const bf16*)(F.ws + WS_ACT);
            const bf16* Bt = (st == 1) ? WT_IN : (st == 7) ? WT_UP : (st == 5) ? WT_OUT : WT_DN;
            const bool rs_ = !pj;
            const int ksl = (st == 5) ? KS_OUT : KS_DN;
            pg8::Gemm g{A, Bt, rs_ ? MP : M, N, K}; pg8::StaticOrder S; S.init(rs_ ? MP : M, N, F.G, (int)blockIdx.x, K, rs_ ? (MS / 256) * (D / 256) * ksl : 0, rs_ ? ksl : 1);
            pg8::EpiDual E{pj, (bf16*)(F.ws + WS_PROJ), again ? (float*)(F.ws + WS_R1 + 32 * MiB) : F.out, N, (st == 1 && kind == 2) ? INP(23) : nullptr, (float*)(F.ws + WS_R1), MP, K / ksl, st == 7,
                pg8::EpiConvAct{(bf16*)(F.ws + WS_ACT), (bf16*)(F.ws + WS_U), INP(27) + (size_t)layer * 3 * DFF, INP(28) + (size_t)layer * DFF, (PG8_LAS float*)(F.lds + XCH_OFF), MP / 256}};
            pg8::gemm_phase<pg8::EpiDual, pg8::StaticOrder, true, true>(F.lds, g, S, E);
            { const int nun = (rs_ ? MP / 256 : M / 256) * (N / 256), ex0 = nun % F.G, exu = (F.G - ex0 >= 64) ? ex0 : 0;
                if (st == 1) { __syncthreads(); prep_two(F, INP(26) + (size_t)layer * D * 2 * DFF, 2 * DFF, D, 2 * DFF, WT_UP, 0, 0, 1.0f, INP(29) + (size_t)layer * DFF * D, D, DFF, D, WT_DN, true, exu); }
                if (st == 7 && layer + 1 < DEPTH) { const int k2 = (layer + 1) % 3, j2 = (layer + 1) / 3;
                    const float* win2 = (k2 == 0) ? INP(12) + (size_t)j2 * D * A_IN : (k2 == 1) ? INP(17) : INP(22);
                    const float* wout2 = (k2 == 0) ? INP(16) + (size_t)j2 * D * D : (k2 == 1) ? INP(21) : INP(25);
                    const int ldw2 = (k2 == 2) ? C_IN : A_IN, nin2 = (k2 == 2) ? C_IN : NPROJ;
                    const int sb2 = (k2 == 0) ? 512 : 0, se2 = (k2 == 0) ? 1024 : (k2 == 1) ? 512 : 0; const float sv2 = (k2 == 0) ? 0.125f : 0.08838834764831845f;
                    __syncthreads(); prep_two(F, win2, ldw2, D, nin2, WT_IN, sb2, se2, sv2, wout2, D, D, D, WT_OUT, false, exu); } }
            if (st == 1 && kind < 2) { const int ex = ((M / 256) * (NPROJ / 256)) % F.G; gates_small(F, XN, (const bf16*)(F.ws + WS_GATES + 3 * MiB / 2), GATES, (ex < F.G / 2) ? ex : 0, kind == 0, INP(13) + j * HA, INP(14) + j * HA); }
        } else if (st == 2) {
            if (kind == 0) { if (EN(20)) mlstm_A(F); TS_MARK(F, 25); if (EN(21)) mlstm_S(F, j, INP(15), INP(2), INP(3), INP(4)); TS_MARK(F, 1); }
            else if (kind == 1) { TS_MARK(F, 26); if (EN(22)) gla_A(F, INP(18), INP(19)); TS_MARK(F, 27); if (EN(23)) gla_S(F, INP(18), INP(19), INP(20), INP(5)); TS_MARK(F, 1); }
            else { TS_MARK(F, 28); if (EN(24)) swa_prompt(F, INP(24)); TS_MARK(F, 29); if (EN(25)) swa_sample(F, INP(24), INP(6), INP(7)); TS_MARK(F, 1); }
        } else if (st == 3) {
            if (kind == 0) { TS_MARK(F, 48); if (EN(30)) mlstm_B(F, j); TS_MARK(F, 1); } else { TS_MARK(F, 49); if (EN(31)) gla_B(F); TS_MARK(F, 1); }
        } else if (st == 4) {
            if (kind == 0) { TS_MARK(F, 47); if (EN(40)) mlstm_C(F, j, INP(15)); TS_MARK(F, 1); } else { TS_MARK(F, 46); if (EN(41)) gla_C(F, INP(18), INP(19), INP(20)); TS_MARK(F, 1); }
        } else if (st == 6 && EN(6)) {
            norm_rows<false>(F, F.out, F.out + (size_t)MP * D, nullptr, INP(10) + (size_t)layer * D, XN, nullptr, nullptr, (const float*)(F.ws + WS_R1), KS_OUT);
        }
        else if (st == 8 && EN(8)) {
            convfix_phase(F, layer, INP(8), INP(27), INP(28));
        }
        if (((MK_REP >> st) & 1) && !again) { again = true; --ph; __syncthreads(); continue; }
        again = false;
#if MK_TMASK && defined(MK_TBARONLY)
        if (tmr_) t0p_ = __builtin_amdgcn_s_memrealtime();
#endif
        if (ph + 1 < hi) { xcd_barrier(bar);
#if defined(MK_BAR2)
            xcd_barrier(bar);
#endif
        }
#if MK_TMASK
        if (tmr_ && ((MK_TMASK >> st) & 1)) tsum_ += __builtin_amdgcn_s_memrealtime() - t0p_;
#endif
    }
#if MK_TSEG
    if (blockIdx.x == 0 && threadIdx.x == 0) { const unsigned long long ts_ = ((volatile LAS unsigned long long*)(F.MISC + 16))[1]; const unsigned long long tw_ = __builtin_amdgcn_s_memrealtime(); while (__builtin_amdgcn_s_memrealtime() - tw_ < ts_ * 4ull) __builtin_amdgcn_s_sleep(8); }
#endif
#if MK_TMASK
    if (tmr_) { const unsigned long long tw_ = __builtin_amdgcn_s_memrealtime(); while (__builtin_amdgcn_s_memrealtime() - tw_ < tsum_ * 4ull) __builtin_amdgcn_s_sleep(8); }
#endif
}

extern "C" void kernel_launch(void* const* d_in, const int* in_sizes, int n_in, void* d_out, int out_size, void* d_ws, size_t ws_size, hipStream_t stream) {
    static int grid = 0;
    if (grid == 0) {
        if (n_in != 30 || (size_t)out_size != O_END || ws_size < WS_END) { fprintf(stderr, "kernel_launch: built for 30 inputs, %zu outputs, >= %zu bytes of workspace; got n_in %d, out %d, ws %zu; nothing launched\n", (size_t)O_END, (size_t)WS_END, n_in, out_size, ws_size); grid = -1; return; }
        int dev = 0, cus = 0, per_cu = 0;
        if (hipGetDevice(&dev) != hipSuccess || hipDeviceGetAttribute(&cus, hipDeviceAttributeMultiprocessorCount, dev) != hipSuccess) { fprintf(stderr, "kernel_launch: device query failed\n"); grid = -1; return; }
        if (hipFuncSetAttribute((const void*)trunk_fwd, hipFuncAttributeMaxDynamicSharedMemorySize, LDS_BYTES) != hipSuccess) { fprintf(stderr, "kernel_launch: hipFuncSetAttribute failed\n"); grid = -1; return; }
        if (hipOccupancyMaxActiveBlocksPerMultiprocessor(&per_cu, (const void*)trunk_fwd, NTHR, LDS_BYTES) != hipSuccess || per_cu < 1) { fprintf(stderr, "kernel_launch: occupancy query says %d workgroups per CU\n", per_cu); }
        (void)hipGetLastError();
        grid = cus;
    }
    if (grid < 0) return;
    if (hipMemsetAsync((char*)d_ws + WS_CTL, 0, CTL_ZERO_BYTES, stream) != hipSuccess) { fprintf(stderr, "kernel_launch: hipMemsetAsync failed\n"); return; }
    Args a{};
    for (int i = 0; i < 30; ++i) a.in[i] = (const float*)d_in[i];
    a.out = (float*)d_out; a.ws = (unsigned char*)d_ws;
#if MK_MULTI
    for (int ph = 0; ph < N_PHASES; ++ph) { if (phase_empty(ph)) continue; a.ph_lo = ph; a.ph_hi = ph + 1;
        hipLaunchKernelGGL(trunk_fwd, dim3(grid), dim3(NTHR), LDS_BYTES, stream, a); }
#else
    a.ph_lo = 0; a.ph_hi = N_PHASES;
    hipLaunchKernelGGL(trunk_fwd, dim3(grid), dim3(NTHR), LDS_BYTES, stream, a);
#endif
    const hipError_t le = hipPeekAtLastError();
    if (le != hipSuccess) fprintf(stderr, "kernel_launch: launch failed: %s\n", hipGetErrorName(le));
}
```
